# Optimizing an MI355X kernel written in HIP

```python
import math
import jax
import jax.numpy as jnp
from jax import lax
import numpy as np

D_MODEL = 2048
BATCH = 4
SEQ = 8192
DEPTH = 1

MIX_WIDTH = D_MODEL
ATTN_HEAD_DIM = 64
ATTN_WIDTH = MIX_WIDTH // 2
ATTN_Q_HEADS = ATTN_WIDTH // ATTN_HEAD_DIM
ATTN_KV_HEADS = ATTN_Q_HEADS // 8
WINDOW = 128
SSM_WIDTH = MIX_WIDTH - ATTN_WIDTH
SSM_HEAD_DIM = 64
SSM_HEADS = SSM_WIDTH // SSM_HEAD_DIM
SSM_GROUPS = 2
SSM_STATE = 128
SSM_CONV = 4
SSM_CHUNK = 128
N_EXPERTS = 32
TOP_K = 4
D_FF = D_MODEL
SWIGLU_LIMIT = 7.0
SWIGLU_ALPHA = 1.702
MOE_BLOCK = 512
EPS = 1e-6

KV_WIDTH = ATTN_KV_HEADS * ATTN_HEAD_DIM
BC_WIDTH = SSM_GROUPS * SSM_STATE
CONV_WIDTH = SSM_WIDTH + 2 * BC_WIDTH
IN_PROJ_DIM = ATTN_WIDTH + 2 * KV_WIDTH + SSM_WIDTH + CONV_WIDTH + SSM_HEADS
IN_SPLITS = [
    ATTN_WIDTH,
    ATTN_WIDTH + KV_WIDTH,
    ATTN_WIDTH + 2 * KV_WIDTH,
    ATTN_WIDTH + 2 * KV_WIDTH + SSM_WIDTH,
    ATTN_WIDTH + 2 * KV_WIDTH + SSM_WIDTH + CONV_WIDTH,
]

kernel_name = "hymba_swa_sink_ssd_moe_layer"


def rms_norm(x, g):
    xf = x.astype(jnp.float32)
    y = xf * lax.rsqrt(jnp.mean(xf * xf, axis=-1, keepdims=True) + EPS)
    return (y * g.astype(jnp.float32)).astype(x.dtype)


def sliding_window_sink_attention(q, k, v, sinks):
    b, s, hq, dh = q.shape
    hkv = k.shape[2]
    g = hq // hkv
    nb = s // WINDOW
    qb = q.reshape(b, nb, WINDOW, hkv, g, dh)

    def band(t):
        tp = jnp.pad(t, ((0, 0), (WINDOW, 0), (0, 0), (0, 0)))
        prev = tp[:, :s].reshape(b, nb, WINDOW, hkv, dh)
        cur = t.reshape(b, nb, WINDOW, hkv, dh)
        return jnp.concatenate([prev, cur], axis=2)

    kb, vb = band(k), band(v)
    scores = jnp.einsum('bnqhgd,bnkhd->bnhgqk', qb, kb).astype(jnp.float32) * (dh ** -0.5)
    qi = jnp.arange(WINDOW)[:, None]
    kj = jnp.arange(2 * WINDOW)[None, :]
    dist = qi + WINDOW - kj
    key_pos = jnp.arange(nb)[:, None, None] * WINDOW - WINDOW + kj[None]
    allowed = (dist >= 0) & (dist < WINDOW) & (key_pos >= 0)
    scores = jnp.where(allowed[None, :, None, None], scores, -jnp.inf)
    sink = sinks.astype(jnp.float32).reshape(1, 1, hkv, g, 1, 1)
    m = jnp.maximum(jnp.max(scores, axis=-1, keepdims=True), sink)
    p = jnp.exp(scores - m)
    probs = p / (jnp.sum(p, axis=-1, keepdims=True) + jnp.exp(sink - m))
    out = jnp.einsum('bnhgqk,bnkhd->bnqhgd', probs.astype(v.dtype), vb)
    return out.reshape(b, s, hq * dh)


def segsum(a):
    cs = jnp.cumsum(a, axis=-1)
    diff = cs[..., :, None] - cs[..., None, :]
    l = a.shape[-1]
    mask = jnp.tril(jnp.ones((l, l), dtype=bool))
    return jnp.where(mask, diff, -jnp.inf)


def ssd_chunked(xh, dt, a, bmat, cmat):
    b, s, h, p = xh.shape
    g, n = bmat.shape[2], bmat.shape[3]
    r = h // g
    l = SSM_CHUNK
    c = s // l
    f32 = jnp.float32
    X = (xh.astype(f32) * dt[..., None]).reshape(b, c, l, g, r, p)
    dA = jnp.moveaxis((dt * a).reshape(b, c, l, g, r), 2, -1)
    Bc = bmat.astype(f32).reshape(b, c, l, g, n)
    Cc = cmat.astype(f32).reshape(b, c, l, g, n)
    cs = jnp.cumsum(dA, axis=-1)
    L = jnp.exp(segsum(dA))
    CB = jnp.einsum('bclgn,bcsgn->bcgls', Cc, Bc)
    y_diag = jnp.einsum('bcgls,bcgrls,bcsgrp->bclgrp', CB, L, X)
    decay_to_end = jnp.exp(cs[..., -1:] - cs)
    chunk_states = jnp.einsum('bclgn,bcgrl,bclgrp->bcgrpn', Bc, decay_to_end, X)
    chunk_decay = jnp.exp(cs[..., -1])

    def step(state, inp):
        st, dec = inp
        return state * dec[..., None, None] + st, state

    init = jnp.zeros((b, g, r, p, n), f32)
    _, states_in = lax.scan(step, init, (jnp.moveaxis(chunk_states, 1, 0),
                                         jnp.moveaxis(chunk_decay, 1, 0)))
    states_in = jnp.moveaxis(states_in, 0, 1)
    y_off = jnp.einsum('bclgn,bcgrpn,bcgrl->bclgrp', Cc, states_in, jnp.exp(cs))
    return (y_diag + y_off).reshape(b, s, h, p).astype(xh.dtype)


def causal_depthwise_conv(x, w, bias):
    out = lax.conv_general_dilated(
        x, w[:, None, :], window_strides=(1,), padding=[(SSM_CONV - 1, 0)],
        dimension_numbers=('NWC', 'WIO', 'NWC'), feature_group_count=x.shape[-1])
    return out + bias


def ssd_mixer(z, xbc, dt_raw, conv_w, conv_b, dt_bias, a_log, d_skip, norm_w):
    b, s, _ = xbc.shape
    xbc = jax.nn.silu(causal_depthwise_conv(xbc, conv_w, conv_b))
    xs, bm, cm = jnp.split(xbc, [SSM_WIDTH, SSM_WIDTH + BC_WIDTH], axis=-1)
    xh = xs.reshape(b, s, SSM_HEADS, SSM_HEAD_DIM)
    bm = bm.reshape(b, s, SSM_GROUPS, SSM_STATE)
    cm = cm.reshape(b, s, SSM_GROUPS, SSM_STATE)
    dt = jax.nn.softplus(dt_raw.astype(jnp.float32) + dt_bias.astype(jnp.float32))
    a = -jnp.exp(a_log.astype(jnp.float32))
    y = ssd_chunked(xh, dt, a, bm, cm) + xh * d_skip[:, None]
    gated = (y.reshape(b, s, SSM_WIDTH) * jax.nn.silu(z)).reshape(b, s, SSM_GROUPS, SSM_WIDTH // SSM_GROUPS)
    return rms_norm(gated, norm_w.reshape(SSM_GROUPS, SSM_WIDTH // SSM_GROUPS)).reshape(b, s, SSM_WIDTH)


def moe_ffn(h, w_router, b_router, w_gate, b_gate, w_up, b_up, w_down, b_down):
    bsz, s, d = h.shape
    t = bsz * s
    tokens = h.reshape(t, d)
    logits = (tokens @ w_router + b_router).astype(jnp.float32)
    top_vals, top_idx = lax.top_k(logits, TOP_K)
    gates = jax.nn.softmax(top_vals, axis=-1)
    n_assign = t * TOP_K
    e_flat = top_idx.reshape(-1)
    tok_flat = jnp.arange(n_assign, dtype=jnp.int32) // TOP_K
    gate_flat = gates.reshape(-1)
    order = jnp.argsort(e_flat)
    se, stok, sg = e_flat[order], tok_flat[order], gate_flat[order]
    counts = jnp.bincount(e_flat, length=N_EXPERTS)
    padded = (counts + MOE_BLOCK - 1) // MOE_BLOCK * MOE_BLOCK
    starts = jnp.cumsum(counts) - counts
    pends = jnp.cumsum(padded)
    pstarts = pends - padded
    dest = pstarts[se] + jnp.arange(n_assign) - starts[se]
    n_blocks = -(-n_assign // MOE_BLOCK) + N_EXPERTS
    n_slots = n_blocks * MOE_BLOCK
    slot_tok = jnp.full((n_slots,), t, dtype=jnp.int32).at[dest].set(stok.astype(jnp.int32))
    slot_gate = jnp.zeros((n_slots,), jnp.float32).at[dest].set(sg)
    block_expert = jnp.minimum(
        jnp.searchsorted(pends, jnp.arange(n_blocks) * MOE_BLOCK, side='right'), N_EXPERTS - 1)
    tokens_pad = jnp.concatenate([tokens, jnp.zeros((1, d), tokens.dtype)], axis=0)

    def block_step(acc, inp):
        e, tok_ids, gw = inp
        xb = tokens_pad[tok_ids]
        gl = jnp.minimum(xb @ w_gate[e] + b_gate[e], SWIGLU_LIMIT)
        li = jnp.clip(xb @ w_up[e] + b_up[e], -SWIGLU_LIMIT, SWIGLU_LIMIT)
        hb = gl * jax.nn.sigmoid(SWIGLU_ALPHA * gl) * (li + 1.0)
        yb = hb @ w_down[e] + b_down[e]
        return acc.at[tok_ids].add(yb * gw[:, None].astype(yb.dtype)), None

    acc0 = jnp.zeros((t + 1, d), tokens.dtype)
    acc, _ = lax.scan(block_step, acc0, (block_expert,
                                         slot_tok.reshape(n_blocks, MOE_BLOCK),
                                         slot_gate.reshape(n_blocks, MOE_BLOCK)))
    return acc[:t].reshape(bsz, s, d)


def hybrid_layer(x, attn_norm_w, w_in, q_norm_w, k_norm_w, attn_sinks, conv_w, conv_b,
                 dt_bias, a_log, d_skip, ssm_norm_w, attn_out_norm_w, w_out, ffn_norm_w,
                 w_router, b_router, w_gate, b_gate, w_up, b_up, w_down, b_down):
    b, s, _ = x.shape
    hn = rms_norm(x, attn_norm_w)
    proj = hn @ w_in
    q, k, v, z, xbc, dt_raw = jnp.split(proj, IN_SPLITS, axis=-1)
    q = rms_norm(q.reshape(b, s, ATTN_Q_HEADS, ATTN_HEAD_DIM), q_norm_w)
    k = rms_norm(k.reshape(b, s, ATTN_KV_HEADS, ATTN_HEAD_DIM), k_norm_w)
    v = v.reshape(b, s, ATTN_KV_HEADS, ATTN_HEAD_DIM)
    attn = rms_norm(sliding_window_sink_attention(q, k, v, attn_sinks), attn_out_norm_w)
    ssm = ssd_mixer(z, xbc, dt_raw, conv_w, conv_b, dt_bias, a_log, d_skip, ssm_norm_w)
    x = x + jnp.concatenate([attn, ssm], axis=-1) @ w_out
    hf = rms_norm(x, ffn_norm_w)
    return x + moe_ffn(hf, w_router, b_router, w_gate, b_gate, w_up, b_up, w_down, b_down)


def setup_inputs(seed: int = 0) -> dict:
    key = jax.random.key(seed)
    ks = jax.random.split(key, 24)

    def nrm(k, shape, scale):
        return jax.random.normal(k, shape, jnp.float32) * scale

    def gain(k, shape):
        return 1.0 + nrm(k, shape, 0.05)

    dt0 = jnp.exp(jax.random.uniform(ks[8], (DEPTH, SSM_HEADS), jnp.float32,
                                     minval=math.log(1e-3), maxval=math.log(1e-1)))
    return {
        "x": nrm(ks[0], (BATCH, SEQ, D_MODEL), 1.0),
        "attn_norm_w": gain(ks[1], (DEPTH, D_MODEL)),
        "w_in": nrm(ks[2], (DEPTH, D_MODEL, IN_PROJ_DIM), D_MODEL ** -0.5),
        "q_norm_w": gain(ks[3], (DEPTH, ATTN_HEAD_DIM)),
        "k_norm_w": gain(ks[4], (DEPTH, ATTN_HEAD_DIM)),
        "attn_sinks": nrm(ks[5], (DEPTH, ATTN_Q_HEADS), 0.5),
        "conv_w": nrm(ks[6], (DEPTH, SSM_CONV, CONV_WIDTH), SSM_CONV ** -0.5),
        "conv_b": nrm(ks[7], (DEPTH, CONV_WIDTH), 0.02),
        "dt_bias": dt0 + jnp.log(-jnp.expm1(-dt0)),
        "a_log": jnp.log(jax.random.uniform(ks[9], (DEPTH, SSM_HEADS), jnp.float32, minval=1.0, maxval=16.0)),
        "d_skip": gain(ks[10], (DEPTH, SSM_HEADS)),
        "ssm_norm_w": gain(ks[11], (DEPTH, SSM_WIDTH)),
        "attn_out_norm_w": gain(ks[12], (DEPTH, ATTN_WIDTH)),
        "w_out": nrm(ks[13], (DEPTH, MIX_WIDTH, D_MODEL), MIX_WIDTH ** -0.5),
        "ffn_norm_w": gain(ks[14], (DEPTH, D_MODEL)),
        "w_router": nrm(ks[15], (DEPTH, D_MODEL, N_EXPERTS), D_MODEL ** -0.5),
        "b_router": nrm(ks[16], (DEPTH, N_EXPERTS), 0.01),
        "w_gate": nrm(ks[17], (DEPTH, N_EXPERTS, D_MODEL, D_FF), D_MODEL ** -0.5),
        "b_gate": nrm(ks[18], (DEPTH, N_EXPERTS, D_FF), 0.02),
        "w_up": nrm(ks[19], (DEPTH, N_EXPERTS, D_MODEL, D_FF), D_MODEL ** -0.5),
        "b_up": nrm(ks[20], (DEPTH, N_EXPERTS, D_FF), 0.02),
        "w_down": nrm(ks[21], (DEPTH, N_EXPERTS, D_FF, D_MODEL), D_FF ** -0.5),
        "b_down": nrm(ks[22], (DEPTH, N_EXPERTS, D_MODEL), 0.02),
    }


def reference(x, attn_norm_w, w_in, q_norm_w, k_norm_w, attn_sinks, conv_w, conv_b,
              dt_bias, a_log, d_skip, ssm_norm_w, attn_out_norm_w, w_out, ffn_norm_w,
              w_router, b_router, w_gate, b_gate, w_up, b_up, w_down, b_down):
    for i in range(DEPTH):
        x = hybrid_layer(x, attn_norm_w[i], w_in[i], q_norm_w[i], k_norm_w[i], attn_sinks[i],
                         conv_w[i], conv_b[i], dt_bias[i], a_log[i], d_skip[i], ssm_norm_w[i],
                         attn_out_norm_w[i], w_out[i], ffn_norm_w[i], w_router[i], b_router[i],
                         w_gate[i], b_gate[i], w_up[i], b_up[i], w_down[i], b_down[i])
    return x
```

```cpp
#include <hip/hip_runtime.h>
#include <cstdio>
#include <cstdint>

#ifndef MK_MULTI
#define MK_MULTI 0
#endif

#ifndef PROBE_CRIP
#define PROBE_CRIP 0
#endif
#ifndef PROBE_CRIP5
#define PROBE_CRIP5 0
#endif
#ifndef PROBE_CRIP7
#define PROBE_CRIP7 0
#endif
#ifndef PROBE_P6
#define PROBE_P6 0
#endif
#ifndef PROBE_P2
#define PROBE_P2 0
#endif
#ifndef PROBE_REPEAT
#define PROBE_REPEAT -1
#endif
#define GAS __attribute__((address_space(1)))
#define LAS __attribute__((address_space(3)))
typedef unsigned short bf16;
typedef unsigned v4u __attribute__((ext_vector_type(4)));
typedef unsigned v2u __attribute__((ext_vector_type(2)));
typedef float f32x4 __attribute__((ext_vector_type(4)));
typedef float f32x2 __attribute__((ext_vector_type(2)));
typedef short bf16x8 __attribute__((ext_vector_type(8)));
typedef int i32x4 __attribute__((ext_vector_type(4)));
typedef int i32x8 __attribute__((ext_vector_type(8)));

constexpr int NB = 4, SEQ = 8192, T = NB * SEQ, D = 2048;
constexpr int PROJ_LD = 3840;
constexpr int COL_Q = 0, COL_K = 1024, COL_V = 1152, COL_Z = 1280, COL_XBC = 2304;
constexpr int NIN = 3856, NIN_PAD = 4096;
constexpr int NXBC = 1536;
constexpr int NE = 32, FF = 2048, TOPK = 4;
constexpr int SLOT_ROWS = T * TOPK + NE * 256;
constexpr float EPS = 1e-6f;

constexpr size_t MiB = 1u << 20;
constexpr size_t WS_CTL = 0, CTL_BYTES = 1 * MiB;
constexpr size_t WS_WGU = 16 * MiB;
constexpr size_t WS_WIN = 528 * MiB;
constexpr size_t WS_WOUT = 544 * MiB;
constexpr size_t WS_HF = 552 * MiB;
constexpr size_t WS_Y2 = 16 * MiB;
constexpr size_t WS_WD = 680 * MiB;
constexpr size_t WS_HN = 936 * MiB;
constexpr size_t WS_MIX = WS_HN;
constexpr size_t WS_PROJ = 1064 * MiB;
constexpr size_t WS_XBC = 1304 * MiB;
constexpr size_t WS_ATT = 1496 * MiB;
constexpr size_t WS_X1 = WS_ATT;
constexpr size_t WS_YS = 1624 * MiB;
constexpr size_t WS_HB = 936 * MiB;
constexpr size_t WS_STATES = WS_XBC;
constexpr size_t WS_SIN = WS_YS;
constexpr size_t WS_CDEC = WS_YS + 64 * MiB;
constexpr size_t WS_DT = 1752 * MiB;
constexpr size_t WS_DTS = 1754 * MiB;
constexpr size_t WS_SSQ = 1756 * MiB;
constexpr size_t WS_STOK = 1760 * MiB;
constexpr size_t WS_SGATE = 1764 * MiB;
constexpr size_t WS_TOKE = 1768 * MiB;
constexpr size_t WS_TOKP = 1769 * MiB;
constexpr size_t WS_END = 1770 * MiB;
static_assert(WS_Y2 + (size_t)SLOT_ROWS * 2048 <= WS_WD, "y2 overlay");
static_assert(WS_HB + (size_t)SLOT_ROWS * 2048 * 2 <= WS_ATT, "hb overlay");
constexpr int CW_CNT = 1024;
constexpr int CW_BAR = 4096;
constexpr int CW_TICK = 2048 + 1024;
constexpr int NCV = 16;

constexpr int RING_BYTES = 131072;
constexpr int MISC_OFF = 162816;
constexpr int LDS_BYTES = 163840;
constexpr int NWAVES = 8, NTHREADS = 512;

typedef __bf16 hwbf16x2 __attribute__((ext_vector_type(2)));
__device__ __forceinline__ unsigned f2bf(float f) { return (unsigned)__builtin_bit_cast(unsigned short, (__bf16)f); }
__device__ __forceinline__ unsigned pk2(float lo, float hi) { const f32x2 v = {lo, hi}; return __builtin_bit_cast(unsigned, __builtin_convertvector(v, hwbf16x2)); }
__device__ __forceinline__ float bflo(unsigned w) { return __builtin_bit_cast(float, w << 16); }
__device__ __forceinline__ float bfhi(unsigned w) { return __builtin_bit_cast(float, w & 0xffff0000u); }
__device__ __forceinline__ float wave_sum(float v) {
#pragma unroll
    for (int o = 1; o < 64; o <<= 1) v += __shfl_xor(v, o);
    return v;
}
__device__ __forceinline__ float sat8(float x) { return __builtin_amdgcn_fmed3f(x, -448.0f, 448.0f); }
__device__ __forceinline__ unsigned pk4_fp8(float a, float b, float c, float d) { int v = 0; v = __builtin_amdgcn_cvt_pk_fp8_f32(a, b, v, false); v = __builtin_amdgcn_cvt_pk_fp8_f32(c, d, v, true); return (unsigned)v; }
constexpr float FP8_SW = 256.f;
constexpr float FP8_SA = 16.f;
constexpr float FP8_SH = 4.f;
constexpr float FP8_SY = 32.f;
__device__ __forceinline__ float fsigmoid(float x) { return __builtin_amdgcn_rcpf(1.0f + __expf(-x)); }
__device__ __forceinline__ void unpack8(const v4u q, float (&d)[8]) { d[0] = bflo(q.x); d[1] = bfhi(q.x); d[2] = bflo(q.y); d[3] = bfhi(q.y); d[4] = bflo(q.z); d[5] = bfhi(q.z); d[6] = bflo(q.w); d[7] = bfhi(q.w); }
#define LDS_WAIT() asm volatile("s_waitcnt lgkmcnt(0)" ::: "memory")

#define XB_TMO      128
#define XB_XCNT(j)  (256  + 64 * (j))
#define XB_XSUB(j)  (1280 + 64 * (j))
#define XB_XGEN(j)  (2304 + 64 * (j))
#define XB_TOP      3328
#define XB_TOPGEN   3392
#define XCD_BAR_WORDS 3456
#define XB_SPIN_CAP (1u << 18)
__device__ __forceinline__ unsigned xb_ld(unsigned* p)              { return __hip_atomic_load(p, __ATOMIC_RELAXED, __HIP_MEMORY_SCOPE_AGENT); }
__device__ __forceinline__ unsigned xb_add(unsigned* p, unsigned v) { return __hip_atomic_fetch_add(p, v, __ATOMIC_RELAXED, __HIP_MEMORY_SCOPE_AGENT); }
__device__ __forceinline__ unsigned xb_xcc_id() { return (unsigned)__builtin_amdgcn_s_getreg((3 << 11) | 20) & 0xFu; }
#define XB_SPIN(cond, bar) do { unsigned _sp = 0; while (cond) { __builtin_amdgcn_s_sleep(1); \
    if ((++_sp & 255u) == 0u) { if (xb_ld(&(bar)[XB_TMO])) break; if (_sp > XB_SPIN_CAP) { atomicAdd(&(bar)[XB_TMO], 1u); break; } } } } while (0)
struct XcdBarrier { unsigned* bar; unsigned x; volatile LAS unsigned* st; };
__device__ __forceinline__ XcdBarrier xcd_barrier_post(unsigned* bar, volatile LAS unsigned* st) {
    XcdBarrier b; b.bar = bar; b.x = xb_xcc_id(); b.st = st;
    if (threadIdx.x == 0) st[2] = xb_add(&bar[XB_XCNT(b.x)], 1u);
    return b;
}
__device__ __forceinline__ void xcd_barrier_complete(unsigned* bar, unsigned x, unsigned& nloc, unsigned& nx) {
    const unsigned G = gridDim.x * gridDim.y * gridDim.z;
    unsigned sum, cnt, mine, sp = 0u;
    for (;;) {
        sum = 0u; cnt = 0u; mine = 0u;
#pragma unroll
        for (unsigned j = 0; j < 16; ++j) { const unsigned c = xb_ld(&bar[XB_XCNT(j)]); sum += c; cnt += (c > 0u) ? 1u : 0u; mine = (j == x) ? c : mine; }
        if (sum == G) break;
        __builtin_amdgcn_s_sleep(1);
        if ((++sp & 255u) == 0u) { if (xb_ld(&bar[XB_TMO])) break; if (sp > XB_SPIN_CAP) { atomicAdd(&bar[XB_TMO], 1u); break; } }
    }
    nloc = mine > 0u ? mine : 1u; nx = cnt > 0u ? cnt : 1u;
}
__device__ __forceinline__ void xcd_barrier(const XcdBarrier& b) {
    asm volatile("s_waitcnt vmcnt(0)" ::: "memory");
    __syncthreads();
    if (threadIdx.x == 0) {
        unsigned* bar = b.bar;
        __builtin_amdgcn_s_waitcnt(0);
        unsigned nloc = b.st[0], nx = b.st[1];
        if (nloc == 0u) { xcd_barrier_complete(bar, b.x, nloc, nx); b.st[0] = nloc; b.st[1] = nx; }
        const unsigned old = xb_add(&bar[XB_XSUB(b.x)], 1u);
        const unsigned gen = old / nloc;
        if (old + 1u == (gen + 1u) * nloc) {
            __builtin_amdgcn_fence(__ATOMIC_RELEASE, "agent");
            asm volatile("s_waitcnt vmcnt(0)" ::: "memory");
            const unsigned og = xb_add(&bar[XB_TOP], 1u);
            const unsigned tg = og / nx;
            if (og + 1u == (tg + 1u) * nx) xb_add(&bar[XB_TOPGEN], 1u);
            else XB_SPIN(xb_ld(&bar[XB_TOPGEN]) == tg, bar);
            __builtin_amdgcn_fence(__ATOMIC_ACQUIRE, "agent");
            xb_add(&bar[XB_XGEN(b.x)], 1u);
            asm volatile("s_waitcnt vmcnt(0)" ::: "memory");
        } else {
            XB_SPIN(xb_ld(&bar[XB_XGEN(b.x)]) == gen, bar);
            __builtin_amdgcn_fence(__ATOMIC_ACQUIRE, "agent");
            asm volatile("s_waitcnt vmcnt(0)" ::: "memory");
        }
    }
    __syncthreads();
}

struct Params {
    const float* x; const float* attn_norm_w; const float* w_in; const float* q_norm_w; const float* k_norm_w; const float* sinks;
    const float* conv_w; const float* conv_b; const float* dt_bias; const float* a_log; const float* d_skip; const float* ssm_norm_w;
    const float* attn_out_norm_w; const float* w_out; const float* ffn_norm_w; const float* w_router; const float* b_router;
    const float* w_gate; const float* b_gate; const float* w_up; const float* b_up; const float* w_down; const float* b_down;
    float* out; unsigned char* ws; int ph_lo, ph_hi, variant, pad;
};

namespace pg8 {
constexpr int BM = 256, BK = 64, HALF = 128, HTB = HALF * BK * 2, GK = 2048;
__device__ __forceinline__ int lds_byte(int r, int c) { const int st = (r >> 4) * 2 + (c >> 5), rr = r & 15, cc = c & 31, ob = rr * 64 + cc * 2; return st * 1024 + (ob ^ (((ob >> 9) & 1) << 5)); }
__device__ __forceinline__ void stage_rc(int b, int& R, int& C) { const int st = b / 1024, sb = b % 1024, swz = sb ^ (((sb >> 9) & 1) << 5); R = (st >> 1) * 16 + swz / 64; C = (st & 1) * 32 + (swz % 64) / 2; }
__device__ __forceinline__ int perm32(int rho) { const int n = rho >> 4, i = rho & 15; return 8 * (i >> 2) + 4 * n + (i & 3); }

struct Unit { const char* aBase; const char* bBase; const int* aidx; int avalid; int pm, pn, e; };

template <class Epi, class Sched>
__device__ __forceinline__ void gemm_phase(LAS unsigned char* lds, const Sched& S, const Epi& E) {
    constexpr int RP = Sched::ROWB, nt = RP / 128;
    constexpr bool F8 = Sched::FP8;
    const int tid = threadIdx.x, wid = __builtin_amdgcn_readfirstlane(tid >> 6), lane = tid & 63, wr = wid >> 2, wc = wid & 3, fr = lane & 15, fq = lane >> 4;
    int sR[2], sC[2];
    unsigned voffB[2], vA[2][2];
#pragma unroll
    for (int i = 0; i < 2; ++i) { stage_rc(tid * 16 + i * 8192, sR[i], sC[i]); const int Rb = Epi::PERM ? ((sR[i] & ~31) + perm32(sR[i] & 31)) : sR[i];
        voffB[i] = (unsigned)(Rb * RP + sC[i] * 2); }
    const size_t kstep = (size_t)(BK * 2);
    const size_t hstep = (size_t)HALF * RP;
    const unsigned ldsw = (unsigned)wid * 1024u;
    const int aoff = lds_byte(wr * 64 + fr, fq * 8), boff = lds_byte(wc * 32 + fr, fq * 8);
#define PG8_SA(b, h) (((b) * 2 + (h)) * HTB)
#define PG8_SB(b, h) ((4 + (b) * 2 + (h)) * HTB)
#define PG8_STAGE(bufoff, gbase, voff) do { if constexpr (!(Sched::CRIP & 2)) _Pragma("unroll") for (int _i = 0; _i < 2; ++_i) { unsigned _o = (voff)[_i]; asm volatile("" : "+v"(_o)); \
        __builtin_amdgcn_global_load_lds((const unsigned*)((const char*)(gbase) + _o), (LAS unsigned*)(lds + (bufoff) + ldsw + _i * 8192), 16, 0, 0); } } while (0)
#define PG8_CAT(x, y) __builtin_shufflevector(x, y, 0, 1, 2, 3, 4, 5, 6, 7)
#define PG8_LO(v) __builtin_bit_cast(bf16x8, __builtin_shufflevector(v, v, 0, 1, 2, 3))
#define PG8_HI(v) __builtin_bit_cast(bf16x8, __builtin_shufflevector(v, v, 4, 5, 6, 7))
#define PG8_LDA(dst, b, h) do { if constexpr (!(Sched::CRIP & 4)) _Pragma("unroll") for (int m = 0; m < 4; ++m) dst[m] = PG8_CAT(*(const LAS i32x4*)(lds + PG8_SA(b, h) + aoff + m * 2048), *(const LAS i32x4*)(lds + PG8_SA(b, h) + aoff + m * 2048 + 1024)); } while (0)
#define PG8_LDB(dst, b, h) do { if constexpr (!(Sched::CRIP & 4)) _Pragma("unroll") for (int n = 0; n < 2; ++n) dst[n] = PG8_CAT(*(const LAS i32x4*)(lds + PG8_SB(b, h) + boff + n * 2048), *(const LAS i32x4*)(lds + PG8_SB(b, h) + boff + n * 2048 + 1024)); } while (0)
#define PG8_MMA(ai, bj, At, Bt) do { __builtin_amdgcn_s_setprio(1); \
        if constexpr (Sched::CRIP & 1) {} else if constexpr (F8) { asm volatile("s_nop 1\n\t" \
            "v_mfma_scale_f32_16x16x128_f8f6f4 %0, %8, %10, %0, %14, %14 op_sel_hi:[0,0,0]\n\t" "v_mfma_scale_f32_16x16x128_f8f6f4 %1, %9, %10, %1, %14, %14 op_sel_hi:[0,0,0]\n\t" \
            "v_mfma_scale_f32_16x16x128_f8f6f4 %2, %8, %11, %2, %14, %14 op_sel_hi:[0,0,0]\n\t" "v_mfma_scale_f32_16x16x128_f8f6f4 %3, %9, %11, %3, %14, %14 op_sel_hi:[0,0,0]\n\t" \
            "v_mfma_scale_f32_16x16x128_f8f6f4 %4, %8, %12, %4, %14, %14 op_sel_hi:[0,0,0]\n\t" "v_mfma_scale_f32_16x16x128_f8f6f4 %5, %9, %12, %5, %14, %14 op_sel_hi:[0,0,0]\n\t" \
            "v_mfma_scale_f32_16x16x128_f8f6f4 %6, %8, %13, %6, %14, %14 op_sel_hi:[0,0,0]\n\t" "v_mfma_scale_f32_16x16x128_f8f6f4 %7, %9, %13, %7, %14, %14 op_sel_hi:[0,0,0]" \
            : "+v"(acc[ai][bj][0][0]), "+v"(acc[ai][bj][0][1]), "+v"(acc[ai][bj][1][0]), "+v"(acc[ai][bj][1][1]), "+v"(acc[ai][bj][2][0]), "+v"(acc[ai][bj][2][1]), "+v"(acc[ai][bj][3][0]), "+v"(acc[ai][bj][3][1]) \
            : "v"(Bt[0]), "v"(Bt[1]), "v"(At[0]), "v"(At[1]), "v"(At[2]), "v"(At[3]), "v"(f8scale)); } \
        else { _Pragma("unroll") for (int m = 0; m < 4; ++m) _Pragma("unroll") for (int n = 0; n < 2; ++n) { \
               acc[ai][bj][m][n] = __builtin_amdgcn_mfma_f32_16x16x32_bf16(PG8_LO(Bt[n]), PG8_LO(At[m]), acc[ai][bj][m][n], 0, 0, 0); \
               acc[ai][bj][m][n] = __builtin_amdgcn_mfma_f32_16x16x32_bf16(PG8_HI(Bt[n]), PG8_HI(At[m]), acc[ai][bj][m][n], 0, 0, 0); } } \
        __builtin_amdgcn_s_setprio(0); } while (0)
#define PG8_WAIT_V(n) asm volatile("s_waitcnt vmcnt(" #n ")" ::: "memory")
#define PG8_WAIT_L(n) asm volatile("s_waitcnt lgkmcnt(" #n ")" ::: "memory")
#define PG8_BAR __builtin_amdgcn_s_barrier()
#define PG8_BAR2 do { if constexpr (!(Sched::CRIP & 16)) __builtin_amdgcn_s_barrier(); } while (0)
#define PG8_SCHED __builtin_amdgcn_sched_barrier(0)
    Unit cur, nxt; int ui = 0;
    if (!S.next(0, cur)) return;
    typename Epi::Pre epre;
    E.prefetch(cur, epre);
    LAS int* lidx = (LAS int*)(lds + 8 * HTB);
    if constexpr (Sched::GATHER) {
        if (tid < 256) { const int v = cur.aidx[tid]; lidx[tid] = (tid < cur.avalid) ? v : 0; }
        __syncthreads();
    }
#pragma unroll
    for (int h = 0; h < 2; ++h)
#pragma unroll
        for (int i = 0; i < 2; ++i) {
            const int r = h * HALF + sR[i];
            if constexpr (Sched::GATHER) vA[h][i] = (unsigned)(lidx[r] * RP + sC[i] * 2);
            else vA[h][i] = (unsigned)(r * RP + sC[i] * 2);
        }
    f32x4 acc[2][2][4][2];
#pragma unroll
    for (int a = 0; a < 2; ++a)
#pragma unroll
        for (int b = 0; b < 2; ++b)
#pragma unroll
            for (int m = 0; m < 4; ++m)
#pragma unroll
                for (int n = 0; n < 2; ++n) acc[a][b][m][n] = (f32x4){0.f, 0.f, 0.f, 0.f};
    i32x8 At[4], B0[2], B1[2];
    if constexpr (Sched::CRIP & 4) { _Pragma("unroll") for (int m = 0; m < 4; ++m) At[m] = (i32x8){0, 0, 0, 0, 0, 0, 0, 0}; _Pragma("unroll") for (int n = 0; n < 2; ++n) { B0[n] = At[0]; B1[n] = At[0]; } }
    int f8scale = 0x7f7f7f7f; asm volatile("" : "+v"(f8scale));
    const char* cA = cur.aBase; const char* cB = cur.bBase;
#ifndef KROT
#define KROT(pm, pn) (((pm) + (pn)) & (nt - 1))
#endif
#define PG8_KT(rot, tau) ((size_t)(((tau) + (rot)) & (nt - 1)) * kstep)
    int crot = KROT(cur.pm, cur.pn);
    PG8_STAGE(PG8_SB(0, 0), cB + PG8_KT(crot, 0), voffB); PG8_STAGE(PG8_SB(0, 1), cB + hstep + PG8_KT(crot, 0), voffB); PG8_STAGE(PG8_SA(0, 0), cA + PG8_KT(crot, 0), vA[0]); PG8_STAGE(PG8_SA(0, 1), cA + PG8_KT(crot, 0), vA[1]);
    if (wr == 1) PG8_BAR;
    PG8_WAIT_V(2); PG8_BAR;
    PG8_STAGE(PG8_SB(1, 0), cB + PG8_KT(crot, 1), voffB); PG8_STAGE(PG8_SA(1, 0), cA + PG8_KT(crot, 1), vA[0]); PG8_STAGE(PG8_SB(1, 1), cB + hstep + PG8_KT(crot, 1), voffB);
    PG8_WAIT_V(6); PG8_BAR;
    for (;;) {
        const bool has_next = S.next(ui + 1, nxt);
        const char* nA = has_next ? nxt.aBase : cA; const char* nB = has_next ? nxt.bBase : cB;
        const int nrot = has_next ? KROT(nxt.pm, nxt.pn) : crot;
        for (int t = 0; t < nt; t += 2) {
            const bool last = (t == nt - 2);
            const char* a1 = cA + PG8_KT(crot, t + 1);
            const char* a2 = last ? nA + PG8_KT(nrot, 0) : cA + PG8_KT(crot, t + 2); const char* b2 = last ? nB + PG8_KT(nrot, 0) : cB + PG8_KT(crot, t + 2);
            const char* a3 = last ? nA + PG8_KT(nrot, 1) : cA + PG8_KT(crot, t + 3); const char* b3 = last ? nB + PG8_KT(nrot, 1) : cB + PG8_KT(crot, t + 3);
            int gi = 0;
            if constexpr (Sched::GATHER) { if (t == 0 && has_next && tid < 256) gi = nxt.aidx[tid]; }
            PG8_LDB(B0, 0, 0); PG8_LDB(B1, 0, 1); PG8_SCHED; PG8_LDA(At, 0, 0); PG8_STAGE(PG8_SA(1, 1), a1, vA[1]);
            PG8_WAIT_V(8); PG8_WAIT_L(0); PG8_BAR; PG8_MMA(0, 0, At, B0); PG8_MMA(0, 1, At, B1); PG8_BAR2; PG8_SCHED;
            if constexpr (Sched::GATHER) { if (last && has_next) {
                int tz = threadIdx.x; asm volatile("" : "+v"(tz));
#pragma unroll
                for (int i = 0; i < 2; ++i) { int R, C; stage_rc(tz * 16 + i * 8192, R, C);
#pragma unroll
                    for (int h = 0; h < 2; ++h) vA[h][i] = (unsigned)(lidx[h * HALF + R] * RP + C * 2); } } }
            PG8_LDA(At, 0, 1); PG8_STAGE(PG8_SB(0, 0), b2, voffB); PG8_STAGE(PG8_SB(0, 1), b2 + hstep, voffB); PG8_STAGE(PG8_SA(0, 0), a2, vA[0]);
            PG8_WAIT_V(8); PG8_WAIT_L(0); PG8_BAR; PG8_MMA(1, 0, At, B0); PG8_MMA(1, 1, At, B1); PG8_BAR2; PG8_SCHED;
            PG8_LDB(B0, 1, 0); PG8_LDB(B1, 1, 1); PG8_SCHED; PG8_LDA(At, 1, 0); PG8_STAGE(PG8_SA(0, 1), a2, vA[1]);
            PG8_WAIT_V(8); PG8_WAIT_L(0); PG8_BAR; PG8_MMA(0, 0, At, B0); PG8_MMA(0, 1, At, B1); PG8_BAR2; PG8_SCHED;
            PG8_LDA(At, 1, 1); PG8_STAGE(PG8_SB(1, 0), b3, voffB); PG8_STAGE(PG8_SB(1, 1), b3 + hstep, voffB); PG8_STAGE(PG8_SA(1, 0), a3, vA[0]);
            PG8_WAIT_V(8); PG8_WAIT_L(0); PG8_BAR; PG8_MMA(1, 0, At, B0); PG8_MMA(1, 1, At, B1); PG8_BAR2; PG8_SCHED;
            if constexpr (Sched::GATHER) { if (t == 0 && has_next && tid < 256) lidx[tid] = (tid < nxt.avalid) ? gi : 0; }
        }
        if constexpr (F8) asm volatile("s_nop 15\n\ts_nop 15" ::: "memory");
        if (wr == 0) PG8_BAR;
        { int tz = threadIdx.x; asm volatile("" : "+v"(tz)); const int ewid = __builtin_amdgcn_readfirstlane(tz >> 6), el = tz & 63;
          E(acc, cur, epre, ewid >> 2, ewid & 3, el & 15, el >> 4); }
        if (!has_next) break;
#pragma unroll
        for (int a = 0; a < 2; ++a)
#pragma unroll
            for (int b = 0; b < 2; ++b)
#pragma unroll
                for (int m = 0; m < 4; ++m)
#pragma unroll
                    for (int n = 0; n < 2; ++n) acc[a][b][m][n] = (f32x4){0.f, 0.f, 0.f, 0.f};
        cur = nxt; cA = nA; cB = nB; crot = nrot; ++ui;
        E.prefetch(cur, epre);
        if (wr == 1) PG8_BAR;
    }
    PG8_WAIT_V(0);
    PG8_BAR;
#undef PG8_KT
#undef PG8_SA
#undef PG8_SB
#undef PG8_STAGE
#undef PG8_LDA
#undef PG8_LDB
#undef PG8_MMA
#undef PG8_CAT
#undef PG8_LO
#undef PG8_HI
#undef PG8_WAIT_V
#undef PG8_WAIT_L
#undef PG8_BAR
#undef PG8_BAR2
#undef PG8_SCHED
}

__device__ __forceinline__ bool tile_order(long L, int nM, int nN, int& pm, int& pn) {
    const int nwg = nM * nN; if (L >= nwg) return false;
    int wgid = (int)L; { const int q = nwg / 8, r = nwg % 8, xcd = wgid % 8, off = wgid / 8; wgid = (xcd < r ? xcd * (q + 1) : r * (q + 1) + (xcd - r) * q) + off; }
    const int nig = 8 * nN, gid = wgid / nig, fm = gid * 8, gsz = (nM - fm) < 8 ? (nM - fm) : 8;
    pm = fm + ((wgid % nig) % gsz); pn = (wgid % nig) / gsz; return true;
}
template <int CRIP_ = 0> struct SchedDenseT {
    static constexpr bool GATHER = false, FP8 = false; static constexpr int ROWB = 4096, CRIP = CRIP_;
    const char* A; const char* Bt; int nM, nN, G, c;
    __device__ __forceinline__ bool next(int i, Unit& u) const {
        int pm, pn; if (!tile_order((long)i * G + c, nM, nN, pm, pn)) return false;
        u.pm = pm; u.pn = pn; u.e = 0; u.aidx = nullptr; u.avalid = 256;
        u.aBase = A + (size_t)pm * 256 * GK * 2; u.bBase = Bt + (size_t)pn * 256 * GK * 2;
        if constexpr ((CRIP_ & 64) != 0) u.bBase = Bt;
        if constexpr ((CRIP_ & 128) != 0) u.aBase = A;
        return true;
    }
};
typedef SchedDenseT<0> SchedDense;
struct SchedQueue {
    static constexpr bool GATHER = false, FP8 = false; static constexpr int ROWB = 4096, CRIP = 0;
    const char* A; const char* Bt; int nM, nN, q, xcd; unsigned* tick; LAS int* tk;
    __device__ __forceinline__ bool next(int i, Unit& u) const {
        const int t = __builtin_amdgcn_readfirstlane(tk[i & 1]);
        if (i > 0 && threadIdx.x == 0) tk[(i + 1) & 1] = (int)__hip_atomic_fetch_add(tick, 1u, __ATOMIC_RELAXED, __HIP_MEMORY_SCOPE_AGENT);
        if (t >= q) return false;
        const int id = xcd * q + t, nig = 8 * nN, gid = id / nig, fm = gid * 8, gsz = (nM - fm) < 8 ? (nM - fm) : 8;
        const int pm = fm + ((id % nig) % gsz), pn = (id % nig) / gsz;
        u.pm = pm; u.pn = pn; u.e = 0; u.aidx = nullptr; u.avalid = 256;
        u.aBase = A + (size_t)pm * 256 * ROWB; u.bBase = Bt + (size_t)pn * 256 * ROWB; return true;
    }
};
template <bool GATHER_, int CRIP_ = 0> struct SchedMoE {
    static constexpr bool GATHER = GATHER_ && !(CRIP_ & 32), FP8 = true; static constexpr int ROWB = 2048, CRIP = CRIP_;
    const char* A; const char* Bt; const int* stok; const LAS int* tstart; const LAS int* cnt; int nN, nrowsB  , G, c;
    __device__ __forceinline__ bool next(int i, Unit& u) const {
        const int nM = __builtin_amdgcn_readfirstlane(tstart[NE]); int pm, pn; if (!tile_order((long)i * G + c, nM, nN, pm, pn)) return false;
        int e = 0;
        for (int j = 1; j < NE; ++j) e += (tstart[j] <= pm) ? 1 : 0;
        e = __builtin_amdgcn_readfirstlane(e);
        const int mt = __builtin_amdgcn_readfirstlane(pm - tstart[e]);
        u.pm = pm; u.pn = pn; u.e = e;
        u.avalid = __builtin_amdgcn_readfirstlane(cnt[e]) - mt * 256;
        u.aidx = stok + (size_t)e * T + mt * 256;
        u.aBase = GATHER ? A : A + (size_t)(GATHER_ ? (pm & 127) : pm) * 256 * ROWB;
        u.bBase = Bt + ((size_t)e * nrowsB + (size_t)pn * 256) * ROWB;
        if constexpr ((CRIP_ & 8) != 0) { u.aBase = A; u.bBase = Bt; }
        return true;
    }
};
}

struct EpiNoPre { };
struct EpiInProj {
    static constexpr bool PERM = true; typedef EpiNoPre Pre;
    bf16* proj; float* dtraw;
    __device__ __forceinline__ void prefetch(const pg8::Unit&, Pre&) const {}
    __device__ __forceinline__ void operator()(const f32x4 (&acc)[2][2][4][2], const pg8::Unit& u, const Pre&, int wr, int wc, int fr, int fq) const {
        const int row0 = u.pm * 256 + wr * 64 + fr;
        if (u.pn < 15) {
            const int col0 = u.pn * 256 + wc * 32 + 8 * fq;
#pragma unroll
            for (int ai = 0; ai < 2; ++ai)
#pragma unroll
                for (int m = 0; m < 4; ++m) { bf16* rowp = proj + (size_t)(row0 + ai * 128 + m * 16) * PROJ_LD + col0;
#pragma unroll
                    for (int bj = 0; bj < 2; ++bj) { const f32x4 v0 = acc[ai][bj][m][0], v1 = acc[ai][bj][m][1];
                        v4u w; w.x = pk2(v0[0], v0[1]); w.y = pk2(v0[2], v0[3]); w.z = pk2(v1[0], v1[1]); w.w = pk2(v1[2], v1[3]);
                        *(v4u*)(rowp + bj * 128) = w; } }
        } else if (wc == 0 && fq < 2) {
#pragma unroll
            for (int ai = 0; ai < 2; ++ai)
#pragma unroll
                for (int m = 0; m < 4; ++m) { float* rowp = dtraw + (size_t)(row0 + ai * 128 + m * 16) * 16 + 8 * fq;
                    *(f32x4*)(rowp) = acc[ai][0][m][0]; *(f32x4*)(rowp + 4) = acc[ai][0][m][1]; }
        }
    }
};
struct EpiOutProj {
    static constexpr bool PERM = true; typedef EpiNoPre Pre;
    const float* x; bf16* x1; float* ssq;
    __device__ __forceinline__ void prefetch(const pg8::Unit&, Pre&) const {}
    __device__ __forceinline__ void operator()(const f32x4 (&acc)[2][2][4][2], const pg8::Unit& u, const Pre&, int wr, int wc, int fr, int fq) const {
        const int row0 = u.pm * 256 + wr * 64 + fr, col0 = u.pn * 256 + wc * 32 + 8 * fq;
#pragma unroll
        for (int ai = 0; ai < 2; ++ai) {
            f32x4 xv[4][2][2];
#pragma unroll
            for (int m = 0; m < 4; ++m)
#pragma unroll
                for (int bj = 0; bj < 2; ++bj)
#pragma unroll
                    for (int n = 0; n < 2; ++n) xv[m][bj][n] = *(const f32x4*)(x + (size_t)(row0 + ai * 128 + m * 16) * D + col0 + bj * 128 + n * 4);
#pragma unroll
            for (int m = 0; m < 4; ++m) { asm volatile("" : "+v"(xv[m][0][0]), "+v"(xv[m][0][1]), "+v"(xv[m][1][0]), "+v"(xv[m][1][1])); }
#pragma unroll
            for (int m = 0; m < 4; ++m) { const int row = row0 + ai * 128 + m * 16; const size_t off = (size_t)row * D + col0; float s = 0.f;
#pragma unroll
                for (int bj = 0; bj < 2; ++bj) { const f32x4 o0 = xv[m][bj][0] + acc[ai][bj][m][0], o1 = xv[m][bj][1] + acc[ai][bj][m][1];
                    *(v4u*)(x1 + off + bj * 128) = (v4u){pk2(o0[0], o0[1]), pk2(o0[2], o0[3]), pk2(o1[0], o1[1]), pk2(o1[2], o1[3])};
                    s += ((o0[0] * o0[0] + o0[1] * o0[1]) + (o0[2] * o0[2] + o0[3] * o0[3])) + ((o1[0] * o1[0] + o1[1] * o1[1]) + (o1[2] * o1[2] + o1[3] * o1[3])); }
                s += __shfl_xor(s, 16); s += __shfl_xor(s, 32);
                if (fq == 0) ssq[(size_t)row * 32 + u.pn * 4 + wc] = s; }
        }
    }
};
struct EpiGateUp {
    static constexpr bool PERM = true;
    struct Pre { f32x4 bg[2], bu[2]; };
    unsigned char* hb; const float* b_gate; const float* b_up;
    __device__ __forceinline__ void prefetch(const pg8::Unit& u, Pre& q) const {
        int tz = threadIdx.x; asm volatile("" : "+v"(tz)); const int wc = (tz >> 6) & 3, fq = (tz >> 4) & 3;
        const int f0 = u.pn * 128 + wc * 32 + 8 * fq;
#pragma unroll
        for (int n = 0; n < 2; ++n) { q.bg[n] = *(const f32x4*)(b_gate + (size_t)u.e * FF + f0 + 4 * n); q.bu[n] = *(const f32x4*)(b_up + (size_t)u.e * FF + f0 + 4 * n); }
    }
    __device__ __forceinline__ void operator()(const f32x4 (&acc)[2][2][4][2], const pg8::Unit& u, const Pre& q, int wr, int wc, int fr, int fq) const {
        const int row0 = u.pm * 256 + wr * 64 + fr, f0 = u.pn * 128 + wc * 32 + 8 * fq;
        constexpr float DS = 1.0f / (FP8_SA * FP8_SW);
#pragma unroll
        for (int ai = 0; ai < 2; ++ai)
#pragma unroll
            for (int m = 0; m < 4; ++m) { unsigned char* rowp = hb + (size_t)(row0 + ai * 128 + m * 16) * FF + f0; float h[8];
#pragma unroll
                for (int n = 0; n < 2; ++n)
#pragma unroll
                    for (int j = 0; j < 4; ++j) { const float g = acc[ai][0][m][n][j] * DS + q.bg[n][j], up = acc[ai][1][m][n][j] * DS + q.bu[n][j];
                        const float gl = fminf(g, 7.0f), li = __builtin_amdgcn_fmed3f(up, -7.0f, 7.0f);
                        const float sg = __builtin_amdgcn_rcpf(1.0f + __builtin_amdgcn_exp2f(gl * (-1.702f * 1.44269504f)));
                        h[n * 4 + j] = (gl * sg) * (li * FP8_SH + FP8_SH); }
                *(v2u*)rowp = (v2u){pk4_fp8(h[0], h[1], h[2], h[3]), pk4_fp8(h[4], h[5], h[6], h[7])}; }
    }
};
struct EpiDown {
    static constexpr bool PERM = true;
    struct Pre { f32x4 bv[2][2]; float gt[2][4]; };
    unsigned char* y2; const float* b_down; const float* sgate; const LAS int* tstart;
    __device__ __forceinline__ void prefetch(const pg8::Unit& u, Pre& q) const {
        int tz = threadIdx.x; asm volatile("" : "+v"(tz)); const int wid = tz >> 6, wr = wid >> 2, wc = wid & 3, fr = tz & 15, fq = (tz >> 4) & 3;
        const int rl0 = wr * 64 + fr, col0 = u.pn * 256 + wc * 32 + 8 * fq;
        const int mt = __builtin_amdgcn_readfirstlane(u.pm - tstart[u.e]);
        const float* gp = sgate + (size_t)u.e * T + mt * 256;
#pragma unroll
        for (int bj = 0; bj < 2; ++bj)
#pragma unroll
            for (int n = 0; n < 2; ++n) q.bv[bj][n] = *(const f32x4*)(b_down + (size_t)u.e * D + col0 + bj * 128 + 4 * n);
#pragma unroll
        for (int ai = 0; ai < 2; ++ai)
#pragma unroll
            for (int m = 0; m < 4; ++m) q.gt[ai][m] = gp[rl0 + ai * 128 + m * 16];
    }
    __device__ __forceinline__ void operator()(const f32x4 (&acc)[2][2][4][2], const pg8::Unit& u, const Pre& q, int wr, int wc, int fr, int fq) const {
        const int rl0 = wr * 64 + fr, col0 = u.pn * 256 + wc * 32 + 8 * fq;
        constexpr float DS = 1.0f / (FP8_SH * FP8_SW);
#pragma unroll
        for (int ai = 0; ai < 2; ++ai)
#pragma unroll
            for (int m = 0; m < 4; ++m) { const int rl = rl0 + ai * 128 + m * 16; const float gt = q.gt[ai][m] * FP8_SY; unsigned char* rowp = y2 + (size_t)(u.pm * 256 + rl) * D + col0;
#pragma unroll
                for (int bj = 0; bj < 2; ++bj) { const f32x4 v0 = (acc[ai][bj][m][0] * DS + q.bv[bj][0]) * gt, v1 = (acc[ai][bj][m][1] * DS + q.bv[bj][1]) * gt;
                    *(v2u*)(rowp + bj * 128) = (v2u){pk4_fp8(sat8(v0[0]), sat8(v0[1]), sat8(v0[2]), sat8(v0[3])), pk4_fp8(sat8(v1[0]), sat8(v1[1]), sat8(v1[2]), sat8(v1[3]))}; } }
    }
};

__device__ __forceinline__ void p0_tr_item(const float* W, int ldw, int k0, int n0, int nvalid, bf16* WT, int dst_row0, LAS float* scr, int lane) {
    const int c4 = (lane & 15) * 4, kr = lane >> 4;
#pragma unroll 4
    for (int i = 0; i < 16; ++i) { const int kk = 4 * i + kr;
        f32x4 v = (f32x4){0.f, 0.f, 0.f, 0.f};
        if (c4 < nvalid) v = *(const f32x4*)(W + (size_t)(k0 + kk) * ldw + n0 + c4);
        LAS float* d = scr + kk * 65 + c4; d[0] = v[0]; d[1] = v[1]; d[2] = v[2]; d[3] = v[3]; }
    LDS_WAIT(); asm volatile("" ::: "memory");
    const int c = lane >> 3, np = lane & 7;
#pragma unroll
    for (int j = 0; j < 8; ++j) { const int n = 8 * j + np; const LAS float* s = scr + (8 * c) * 65 + n;
        v4u o; o.x = pk2(s[0 * 65], s[1 * 65]); o.y = pk2(s[2 * 65], s[3 * 65]); o.z = pk2(s[4 * 65], s[5 * 65]); o.w = pk2(s[6 * 65], s[7 * 65]);
        *(v4u*)(WT + (size_t)(dst_row0 + n) * 2048 + k0 + 8 * c) = o; }
    LDS_WAIT(); asm volatile("" ::: "memory");
}
__device__ __forceinline__ void f8_tile_load(const float* src, f32x4 (&v)[16], int lane) {
    const float* s0 = src + (size_t)(16 * (lane >> 3)) * 2048 + 4 * (lane & 7);
#pragma unroll
    for (int i = 0; i < 16; ++i) v[i] = __builtin_nontemporal_load((const f32x4*)(s0 + (size_t)i * 2048));
}
__device__ __forceinline__ void f8_tile_store(const f32x4 (&v)[16], unsigned char* dst, int lane) {
    unsigned d[16];
#pragma unroll
    for (int i = 0; i < 16; ++i) d[i] = pk4_fp8(sat8(v[i][0] * FP8_SW), sat8(v[i][1] * FP8_SW), sat8(v[i][2] * FP8_SW), sat8(v[i][3] * FP8_SW));
    unsigned o[4][4];
#pragma unroll
    for (int w = 0; w < 4; ++w) {
        const unsigned t0 = __builtin_amdgcn_perm(d[4 * w + 1], d[4 * w], 0x05010400u), t1 = __builtin_amdgcn_perm(d[4 * w + 1], d[4 * w], 0x07030602u);
        const unsigned t2 = __builtin_amdgcn_perm(d[4 * w + 3], d[4 * w + 2], 0x05010400u), t3 = __builtin_amdgcn_perm(d[4 * w + 3], d[4 * w + 2], 0x07030602u);
        o[0][w] = __builtin_amdgcn_perm(t2, t0, 0x05040100u); o[1][w] = __builtin_amdgcn_perm(t2, t0, 0x07060302u);
        o[2][w] = __builtin_amdgcn_perm(t3, t1, 0x05040100u); o[3][w] = __builtin_amdgcn_perm(t3, t1, 0x07060302u);
    }
    unsigned char* d0 = dst + (size_t)(4 * (lane & 7)) * 2048 + 16 * (lane >> 3);
#pragma unroll
    for (int b = 0; b < 4; ++b) __builtin_nontemporal_store((v4u){o[b][0], o[b][1], o[b][2], o[b][3]}, (v4u*)(d0 + (size_t)b * 2048));
}
__device__ __forceinline__ void f8_item(const Params& p, int it, const float*& src, unsigned char*& dst) {
    const int which = it >> 15, r = it & 32767, e = r >> 10, q = r & 1023, kb = q >> 6, nb = q & 63;
    if (which == 2) { src = p.w_down + (size_t)e * FF * D + (size_t)(kb * 128) * D + nb * 32; dst = p.ws + WS_WD + ((size_t)e * D + nb * 32) * 2048 + kb * 128; }
    else { const int f0 = nb * 32, drow = (f0 >> 7) * 256 + which * 128 + (f0 & 127);
        src = (which == 0 ? p.w_gate : p.w_up) + (size_t)e * D * FF + (size_t)(kb * 128) * FF + f0; dst = p.ws + WS_WGU + ((size_t)e * 4096 + drow) * 2048 + kb * 128; }
}
__device__ __forceinline__ void convert_experts(const Params& p, int first, int stride, int lane) {
    constexpr int NEXP = 3 * NE * 1024;
    f32x4 va[16], vb[16]; const float* sa; unsigned char* da; const float* sb; unsigned char* db;
    int ia = first, ib;
    if (ia < NEXP) { f8_item(p, ia, sa, da); f8_tile_load(sa, va, lane); }
    for (;;) {
        if (ia >= NEXP) break;
        ib = ia + stride; if (ib < NEXP) { f8_item(p, ib, sb, db); f8_tile_load(sb, vb, lane); }
        f8_tile_store(va, da, lane);
        if (ib >= NEXP) break;
        ia = ib + stride; if (ia < NEXP) { f8_item(p, ia, sa, da); f8_tile_load(sa, va, lane); }
        f8_tile_store(vb, db, lane);
    }
}
__device__ __forceinline__ void phase_prologue(const Params& p, LAS unsigned char* lds, int gw, int NGW, int wave, int lane) {
    LAS float* scr = (LAS float*)(lds + wave * 16896);
    bf16* WIN = (bf16*)(p.ws + WS_WIN); bf16* WOUT = (bf16*)(p.ws + WS_WOUT);
    constexpr int I_IN = 32 * 64, I_OUT = 32 * 32;
    for (int it = gw; it < I_IN + I_OUT; it += NGW) {
        int r = it;
        if (r < I_IN) { const int kb = r / 64, nb = r % 64; int nv = NIN - nb * 64; nv = nv < 0 ? 0 : (nv > 64 ? 64 : nv);
            p0_tr_item(p.w_in, NIN, kb * 64, nb * 64, nv, WIN, nb * 64, scr, lane); continue; }
        r -= I_IN;
        { const int kb = r / 32, nb = r % 32; p0_tr_item(p.w_out, D, kb * 64, nb * 64, 64, WOUT, nb * 64, scr, lane); }
    }
    bf16* HN = (bf16*)(p.ws + WS_HN);
    f32x4 gw4[8];
#pragma unroll
    for (int j = 0; j < 8; ++j) gw4[j] = *((const f32x4*)p.attn_norm_w + 64 * j + lane);
    f32x4 vn[8];
    if (gw < T) { const f32x4* xr = (const f32x4*)(p.x + (size_t)gw * D) + lane;
#pragma unroll
        for (int j = 0; j < 8; ++j) vn[j] = xr[64 * j]; }
    for (int m = gw; m < T; m += NGW) {
        f32x4 v[8]; float s = 0.f;
#pragma unroll
        for (int j = 0; j < 8; ++j) v[j] = vn[j];
        if (m + NGW < T) { const f32x4* xr = (const f32x4*)(p.x + (size_t)(m + NGW) * D) + lane;
#pragma unroll
            for (int j = 0; j < 8; ++j) vn[j] = xr[64 * j]; }
#pragma unroll
        for (int j = 0; j < 8; ++j) s += (v[j][0] * v[j][0] + v[j][1] * v[j][1]) + (v[j][2] * v[j][2] + v[j][3] * v[j][3]);
        const float rstd = rsqrtf(wave_sum(s) * (1.f / D) + EPS);
        v2u* o8 = (v2u*)(HN + (size_t)m * D) + lane;
#pragma unroll
        for (int j = 0; j < 8; ++j) { v2u w; w.x = pk2(v[j][0] * rstd * gw4[j][0], v[j][1] * rstd * gw4[j][1]); w.y = pk2(v[j][2] * rstd * gw4[j][2], v[j][3] * rstd * gw4[j][3]); o8[64 * j] = w; }
    }
}

__device__ __forceinline__ void phase_conv(const Params& p, int G) {
    const bf16* proj = (const bf16*)(p.ws + WS_PROJ); float* xbc = (float*)(p.ws + WS_XBC);
    const float* dtraw = (const float*)(p.ws + WS_DT); float* dts = (float*)(p.ws + WS_DTS);
    const int tid = threadIdx.x;
    for (int item = blockIdx.x; item < T / 64; item += G) {
        const int t0 = item * 64;
        if (tid < 384) {
            const int cg = tid % 192, half = tid / 192, c0 = cg * 8, ts = t0 + half * 32;
            float w[4][8], bb[8];
#pragma unroll
            for (int k = 0; k < 4; ++k)
#pragma unroll
                for (int j = 0; j < 8; ++j) w[k][j] = p.conv_w[k * NXBC + c0 + j];
#pragma unroll
            for (int j = 0; j < 8; ++j) bb[j] = p.conv_b[c0 + j];
            float r0[8], r1[8], r2[8];
            {
                const int tl = ts % SEQ;
                v4u q0 = (v4u){0u, 0u, 0u, 0u}, q1 = q0, q2 = q0;
                if (tl - 3 >= 0) q0 = *(const v4u*)(proj + (size_t)(ts - 3) * PROJ_LD + COL_XBC + c0);
                if (tl - 2 >= 0) q1 = *(const v4u*)(proj + (size_t)(ts - 2) * PROJ_LD + COL_XBC + c0);
                if (tl - 1 >= 0) q2 = *(const v4u*)(proj + (size_t)(ts - 1) * PROJ_LD + COL_XBC + c0);
                unpack8(q0, r0); unpack8(q1, r1); unpack8(q2, r2);
            }
            for (int i = 0; i < 32; ++i) {
                const int t = ts + i;
                const v4u q = *(const v4u*)(proj + (size_t)t * PROJ_LD + COL_XBC + c0);
                float r3[8]; unpack8(q, r3);
                float o[8];
#pragma unroll
                for (int j = 0; j < 8; ++j) { const float a = bb[j] + w[0][j] * r0[j] + w[1][j] * r1[j] + w[2][j] * r2[j] + w[3][j] * r3[j]; o[j] = a * fsigmoid(a); }
                float* dp = xbc + (size_t)t * NXBC + c0;
                *(f32x4*)dp = (f32x4){o[0], o[1], o[2], o[3]}; *(f32x4*)(dp + 4) = (f32x4){o[4], o[5], o[6], o[7]};
#pragma unroll
                for (int j = 0; j < 8; ++j) { r0[j] = r1[j]; r1[j] = r2[j]; r2[j] = r3[j]; }
            }
        } else {
            const int u = tid - 384;
#pragma unroll
            for (int i = 0; i < 8; ++i) { const int idx = u + 128 * i; const int t = t0 + (idx >> 4), h = idx & 15;
                const float v = dtraw[(size_t)t * 16 + h] + p.dt_bias[h];
                dts[(size_t)t * 16 + h] = fmaxf(v, 0.f) + log1pf(__expf(-fabsf(v))); }
        }
    }
}

__device__ __forceinline__ void phase_attn_simple(const Params& p, LAS unsigned char* lds, int G) {
    const bf16* proj = (const bf16*)(p.ws + WS_PROJ); float* att = (float*)(p.ws + WS_ATT);
    LAS float* Ks = (LAS float*)lds; LAS float* Vs = (LAS float*)(lds + 256 * 68 * 4);
    const int tid = threadIdx.x;
    for (int item = blockIdx.x; item < NB * 64 * 2; item += G) {
        const int b = item >> 7, n = (item >> 1) & 63, hk = item & 1;
        __syncthreads();
        {
            const int j = tid >> 1, hf = tid & 1, pos = n * 128 - 128 + j;
            float kv[32], vv[32];
            if (pos >= 0) {
                const bf16* kp = proj + (size_t)(b * SEQ + pos) * PROJ_LD + COL_K + hk * 64 + hf * 32;
                const bf16* vp = proj + (size_t)(b * SEQ + pos) * PROJ_LD + COL_V + hk * 64 + hf * 32;
#pragma unroll
                for (int c = 0; c < 4; ++c) { const v4u a = *(const v4u*)(kp + 8 * c), bq = *(const v4u*)(vp + 8 * c);
                    kv[8 * c + 0] = bflo(a.x); kv[8 * c + 1] = bfhi(a.x); kv[8 * c + 2] = bflo(a.y); kv[8 * c + 3] = bfhi(a.y); kv[8 * c + 4] = bflo(a.z); kv[8 * c + 5] = bfhi(a.z); kv[8 * c + 6] = bflo(a.w); kv[8 * c + 7] = bfhi(a.w);
                    vv[8 * c + 0] = bflo(bq.x); vv[8 * c + 1] = bfhi(bq.x); vv[8 * c + 2] = bflo(bq.y); vv[8 * c + 3] = bfhi(bq.y); vv[8 * c + 4] = bflo(bq.z); vv[8 * c + 5] = bfhi(bq.z); vv[8 * c + 6] = bflo(bq.w); vv[8 * c + 7] = bfhi(bq.w); }
            } else {
#pragma unroll
                for (int d = 0; d < 32; ++d) { kv[d] = 0.f; vv[d] = 0.f; }
            }
            float s = 0.f;
#pragma unroll
            for (int d = 0; d < 32; ++d) s += kv[d] * kv[d];
            s += __shfl_xor(s, 1);
            const float rstd = rsqrtf(s * (1.f / 64.f) + EPS);
#pragma unroll
            for (int d = 0; d < 32; ++d) { Ks[j * 68 + hf * 32 + d] = kv[d] * rstd * p.k_norm_w[hf * 32 + d]; Vs[j * 68 + hf * 32 + d] = vv[d]; }
        }
        __syncthreads();
        const int qi = tid & 127, grp = tid >> 7;
        const int tok = b * SEQ + n * 128 + qi;
        for (int hh = 0; hh < 2; ++hh) {
            const int hq = hk * 8 + grp * 2 + hh;
            float q[64];
            {
                const bf16* qp = proj + (size_t)tok * PROJ_LD + COL_Q + hq * 64;
                float s = 0.f;
#pragma unroll
                for (int c = 0; c < 8; ++c) { const v4u a = *(const v4u*)(qp + 8 * c);
                    q[8 * c + 0] = bflo(a.x); q[8 * c + 1] = bfhi(a.x); q[8 * c + 2] = bflo(a.y); q[8 * c + 3] = bfhi(a.y); q[8 * c + 4] = bflo(a.z); q[8 * c + 5] = bfhi(a.z); q[8 * c + 6] = bflo(a.w); q[8 * c + 7] = bfhi(a.w); }
#pragma unroll
                for (int d = 0; d < 64; ++d) s += q[d] * q[d];
                const float rstd = rsqrtf(s * (1.f / 64.f) + EPS) * 0.125f;
#pragma unroll
                for (int d = 0; d < 64; ++d) q[d] = q[d] * rstd * p.q_norm_w[d];
            }
            float mx = p.sinks[hq], l = 1.0f, o[64];
#pragma unroll
            for (int d = 0; d < 64; ++d) o[d] = 0.f;
            const int jlo = (n == 0) ? 128 : qi + 1;
            for (int j = jlo; j <= qi + 128; ++j) {
                const LAS f32x4* kr = (const LAS f32x4*)(Ks + j * 68);
                float s = 0.f;
#pragma unroll
                for (int c = 0; c < 16; ++c) { const f32x4 kk = kr[c]; s += q[4 * c] * kk[0] + q[4 * c + 1] * kk[1] + q[4 * c + 2] * kk[2] + q[4 * c + 3] * kk[3]; }
                const float mn = fmaxf(mx, s), corr = __expf(mx - mn), pj = __expf(s - mn);
                l = l * corr + pj; mx = mn;
                const LAS f32x4* vr = (const LAS f32x4*)(Vs + j * 68);
#pragma unroll
                for (int c = 0; c < 16; ++c) { const f32x4 vv = vr[c]; o[4 * c] = o[4 * c] * corr + pj * vv[0]; o[4 * c + 1] = o[4 * c + 1] * corr + pj * vv[1]; o[4 * c + 2] = o[4 * c + 2] * corr + pj * vv[2]; o[4 * c + 3] = o[4 * c + 3] * corr + pj * vv[3]; }
            }
            const float inv = 1.0f / l;
            float* op = att + (size_t)tok * 1024 + hq * 64;
#pragma unroll
            for (int c = 0; c < 16; ++c) *(f32x4*)(op + 4 * c) = (f32x4){o[4 * c] * inv, o[4 * c + 1] * inv, o[4 * c + 2] * inv, o[4 * c + 3] * inv};
        }
    }
}

__device__ __forceinline__ void phase_ssd_seq(const Params& p, LAS unsigned char* lds, int G) {
    const float* xbc = (const float*)(p.ws + WS_XBC); const float* dts = (const float*)(p.ws + WS_DTS); float* ys = (float*)(p.ws + WS_YS);
    constexpr int TT = 64;
    LAS float* Bs = (LAS float*)lds;
    LAS float* Cs = Bs + TT * 128;
    LAS float* xs = Cs + TT * 128;
    LAS float* dl = xs + TT * 16;
    LAS float* yo = dl + TT;
    const int tid = threadIdx.x, pl = tid >> 5, ns = tid & 31;
    for (int item = blockIdx.x; item < NB * 16 * 4; item += G) {
        const int b = item >> 6, h = (item >> 2) & 15, pq = item & 3, g = h >> 3;
        const float a = -__expf(p.a_log[h]), dsk = p.d_skip[h];
        f32x4 st = (f32x4){0.f, 0.f, 0.f, 0.f};
        for (int tc = 0; tc < SEQ; tc += TT) {
            __syncthreads();
            const size_t tb = (size_t)b * SEQ + tc;
            for (int i = tid; i < TT * 32; i += NTHREADS) { const int tt = i >> 5, c = (i & 31) * 4;
                *(LAS f32x4*)(Bs + tt * 128 + c) = *(const f32x4*)(xbc + (tb + tt) * NXBC + 1024 + g * 128 + c);
                *(LAS f32x4*)(Cs + tt * 128 + c) = *(const f32x4*)(xbc + (tb + tt) * NXBC + 1280 + g * 128 + c); }
            for (int i = tid; i < TT * 16; i += NTHREADS) { const int tt = i >> 4, c = i & 15; xs[i] = xbc[(tb + tt) * NXBC + h * 64 + pq * 16 + c]; }
            if (tid < TT) dl[tid] = dts[(tb + tid) * 16 + h];
            __syncthreads();
            for (int tt = 0; tt < TT; ++tt) {
                const float dt = dl[tt], xv = xs[tt * 16 + pl];
                const float dA = __expf(dt * a), xd = xv * dt;
                const f32x4 bv = *(const LAS f32x4*)(Bs + tt * 128 + ns * 4), cv = *(const LAS f32x4*)(Cs + tt * 128 + ns * 4);
                st = st * dA + bv * xd;
                float y = (cv[0] * st[0] + cv[1] * st[1]) + (cv[2] * st[2] + cv[3] * st[3]);
                y += __shfl_xor(y, 1); y += __shfl_xor(y, 2); y += __shfl_xor(y, 4); y += __shfl_xor(y, 8); y += __shfl_xor(y, 16);
                if (ns == 0) yo[tt * 16 + pl] = y + dsk * xv;
            }
            __syncthreads();
            for (int i = tid; i < TT * 16; i += NTHREADS) { const int tt = i >> 4, c = i & 15; ys[(tb + tt) * 1024 + h * 64 + pq * 16 + c] = yo[i]; }
        }
    }
}


typedef float f32x16 __attribute__((ext_vector_type(16)));
#define MFMA32(a, b, c) __builtin_amdgcn_mfma_f32_32x32x16_bf16(a, b, c, 0, 0, 0)
constexpr int SPT = 136;
__device__ __forceinline__ float softplus_f(float v) { return fmaxf(v, 0.f) + log1pf(__expf(-fabsf(v))); }

__device__ __forceinline__ void ssd_tables(const Params& p, LAS float* dtl, LAS float* csl, LAS float* wtot, size_t trow0, int h0, int nh, int lane, int wave) {
    const float* dtraw = (const float*)(p.ws + WS_DT);
    for (int rnd = 0; rnd < nh / 4; ++rnd) {
        const int hh = rnd * 4 + (wave >> 1), l = (wave & 1) * 64 + lane, h = h0 + hh;
        const float dt = softplus_f(dtraw[(trow0 + l) * 16 + h] + p.dt_bias[h]);
        float v = dt * (-expf(p.a_log[h]));
#pragma unroll
        for (int o = 1; o < 64; o <<= 1) { const float u = __shfl_up(v, o); v = (lane >= o) ? v + u : v; }
        if (lane == 63) wtot[rnd * 8 + wave] = v;
        __syncthreads();
        if (wave & 1) v += wtot[rnd * 8 + wave - 1];
        dtl[hh * 128 + l] = dt; csl[hh * 128 + l] = v;
    }
    __syncthreads();
}
template <bool TR, bool SCALE>
__device__ __forceinline__ void conv_task(const Params& p, const bf16* proj, size_t trow0, int tl0, int run, int xcol, LAS bf16* dst, int d0, const LAS float* sc) {
    float w[4][8], bb[8];
#pragma unroll
    for (int k = 0; k < 4; ++k) { const f32x4 a = *(const f32x4*)(p.conv_w + k * NXBC + xcol), b = *(const f32x4*)(p.conv_w + k * NXBC + xcol + 4);
        w[k][0] = a[0]; w[k][1] = a[1]; w[k][2] = a[2]; w[k][3] = a[3]; w[k][4] = b[0]; w[k][5] = b[1]; w[k][6] = b[2]; w[k][7] = b[3]; }
    { const f32x4 a = *(const f32x4*)(p.conv_b + xcol), b = *(const f32x4*)(p.conv_b + xcol + 4); bb[0] = a[0]; bb[1] = a[1]; bb[2] = a[2]; bb[3] = a[3]; bb[4] = b[0]; bb[5] = b[1]; bb[6] = b[2]; bb[7] = b[3]; }
    const int l0 = run * 8; const bf16* src = proj + (trow0 + l0) * PROJ_LD + COL_XBC + xcol;
    float r0[8], r1[8], r2[8];
    { const int pos = tl0 + l0; v4u q0 = (v4u){0u, 0u, 0u, 0u}, q1 = q0, q2 = q0;
      if (pos - 3 >= 0) q0 = *(const v4u*)(src - 3 * PROJ_LD);
      if (pos - 2 >= 0) q1 = *(const v4u*)(src - 2 * PROJ_LD);
      if (pos - 1 >= 0) q2 = *(const v4u*)(src - 1 * PROJ_LD);
      unpack8(q0, r0); unpack8(q1, r1); unpack8(q2, r2); }
#pragma unroll
    for (int i = 0; i < 8; i += 2) {
        float r3[8], r4[8], o0[8], o1[8];
        unpack8(*(const v4u*)(src + (size_t)i * PROJ_LD), r3); unpack8(*(const v4u*)(src + (size_t)(i + 1) * PROJ_LD), r4);
#pragma unroll
        for (int j = 0; j < 8; ++j) { const float a0 = bb[j] + w[0][j] * r0[j] + w[1][j] * r1[j] + w[2][j] * r2[j] + w[3][j] * r3[j];
            const float a1 = bb[j] + w[0][j] * r1[j] + w[1][j] * r2[j] + w[2][j] * r3[j] + w[3][j] * r4[j];
            o0[j] = a0 * fsigmoid(a0); o1[j] = a1 * fsigmoid(a1); }
        if constexpr (TR) {
            float s0 = 1.f, s1 = 1.f; if constexpr (SCALE) { s0 = sc[l0 + i]; s1 = sc[l0 + i + 1]; }
#pragma unroll
            for (int j = 0; j < 8; ++j) *(LAS unsigned*)(dst + (d0 + j) * SPT + l0 + i) = pk2(o0[j] * s0, o1[j] * s1);
        } else {
            *(LAS v4u*)(dst + (l0 + i) * SPT + d0) = (v4u){pk2(o0[0], o0[1]), pk2(o0[2], o0[3]), pk2(o0[4], o0[5]), pk2(o0[6], o0[7])};
            *(LAS v4u*)(dst + (l0 + i + 1) * SPT + d0) = (v4u){pk2(o1[0], o1[1]), pk2(o1[2], o1[3]), pk2(o1[4], o1[5]), pk2(o1[6], o1[7])};
        }
#pragma unroll
        for (int j = 0; j < 8; ++j) { r0[j] = r2[j]; r1[j] = r3[j]; r2[j] = r4[j]; }
    }
}

__device__ __forceinline__ void phase_ssd_states(const Params& p, LAS unsigned char* lds, int G, int lane, int wave) {
    const bf16* proj = (const bf16*)(p.ws + WS_PROJ); float* states = (float*)(p.ws + WS_STATES); float* cdec = (float*)(p.ws + WS_CDEC);
    LAS bf16* BT = (LAS bf16*)lds;
    LAS bf16* XdT = BT + 128 * SPT;
    LAS float* dtl = (LAS float*)(lds + 384 * SPT * 2);
    LAS float* csl = dtl + 512; LAS float* scl = csl + 512; LAS float* wtot = scl + 512;
    const int tid = threadIdx.x, r = lane & 31, hf = lane >> 5;
    for (int item = blockIdx.x; item < NB * 64 * 4; item += G) {
        const int b = item >> 8, c = (item >> 2) & 63, g = (item >> 1) & 1, hh2 = item & 1;
        const int h0 = g * 8 + hh2 * 4; const size_t trow0 = (size_t)b * SEQ + c * 128; const int tl0 = c * 128;
        __syncthreads();
        ssd_tables(p, dtl, csl, wtot, trow0, h0, 4, lane, wave);
        scl[tid] = dtl[tid] * __expf(csl[(tid & ~127) + 127] - csl[tid]);
        if ((tid & 127) == 127) cdec[((size_t)b * 64 + c) * 16 + h0 + (tid >> 7)] = __expf(csl[tid]);
        __syncthreads();
        for (int task = tid; task < 48 * 16; task += NTHREADS) { const int cg = task >> 4, run = task & 15;
            if (cg < 16) conv_task<true, false>(p, proj, trow0, tl0, run, 1024 + g * 128 + cg * 8, BT, cg * 8, nullptr);
            else { const int cx = cg - 16; conv_task<true, true>(p, proj, trow0, tl0, run, h0 * 64 + cx * 8, XdT, cx * 8, scl + (cx >> 3) * 128); } }
        __syncthreads();
        const int hh = wave >> 1, nh_ = wave & 1;
        f32x16 acc[2][2];
#pragma unroll
        for (int a = 0; a < 2; ++a)
#pragma unroll
            for (int bq = 0; bq < 2; ++bq)
#pragma unroll
                for (int e = 0; e < 16; ++e) acc[a][bq][e] = 0.f;
#pragma unroll
        for (int ks = 0; ks < 8; ++ks) {
            bf16x8 af[2], bfm[2];
#pragma unroll
            for (int pt = 0; pt < 2; ++pt) af[pt] = *(const LAS bf16x8*)(XdT + (hh * 64 + pt * 32 + r) * SPT + ks * 16 + 8 * hf);
#pragma unroll
            for (int nt = 0; nt < 2; ++nt) bfm[nt] = *(const LAS bf16x8*)(BT + (nh_ * 64 + nt * 32 + r) * SPT + ks * 16 + 8 * hf);
#pragma unroll
            for (int pt = 0; pt < 2; ++pt)
#pragma unroll
                for (int nt = 0; nt < 2; ++nt) acc[pt][nt] = MFMA32(af[pt], bfm[nt], acc[pt][nt]);
        }
        float* sp = states + (((size_t)b * 64 + c) * 16 + h0 + hh) * 64 * 128;
#pragma unroll
        for (int pt = 0; pt < 2; ++pt)
#pragma unroll
            for (int nt = 0; nt < 2; ++nt)
#pragma unroll
                for (int e = 0; e < 16; ++e) sp[(pt * 32 + (e & 3) + 8 * (e >> 2) + 4 * hf) * 128 + nh_ * 64 + nt * 32 + r] = acc[pt][nt][e];
    }
}
__device__ __forceinline__ void phase_ssd_scan(const Params& p, int G) {
    const float* states = (const float*)(p.ws + WS_STATES); const float* cdec = (const float*)(p.ws + WS_CDEC); bf16* sin = (bf16*)(p.ws + WS_SIN);
    for (int idx = blockIdx.x * NTHREADS + threadIdx.x; idx < NB * 16 * 64 * 32; idx += G * NTHREADS) {
        const int n4 = idx & 31, pp = (idx >> 5) & 63, h = (idx >> 11) & 15, b = idx >> 15;
        f32x4 run = (f32x4){0.f, 0.f, 0.f, 0.f};
#pragma unroll 8
        for (int c = 0; c < 64; ++c) {
            const size_t off = ((((size_t)b * 64 + c) * 16 + h) * 64 + pp) * 128 + n4 * 4;
            const f32x4 st = *(const f32x4*)(states + off); const float dec = cdec[((size_t)b * 64 + c) * 16 + h];
            *(v2u*)(sin + off) = (v2u){pk2(run[0], run[1]), pk2(run[2], run[3])};
            run = run * dec + st;
        }
    }
}
__device__ __forceinline__ void ssd_out_pass(const Params& p, const bf16* proj, const bf16* sinp  , const LAS bf16* Cs, const LAS bf16* CB, const LAS bf16* XT,
                                             const LAS float* dth, const LAS float* csh  , LAS float* ssqh  , float Dh, size_t trow0, int h, int hh, int lsel, int r, int hf,
                                             unsigned (&yp)[2][2][8]) {
    f32x16 acc[2][2];
#pragma unroll
    for (int a = 0; a < 2; ++a)
#pragma unroll
        for (int bq = 0; bq < 2; ++bq)
#pragma unroll
            for (int e = 0; e < 16; ++e) acc[a][bq][e] = 0.f;
#pragma unroll
    for (int pt = 0; pt < 2; ++pt) {
        bf16x8 af[8];
#pragma unroll
        for (int ks = 0; ks < 8; ++ks) af[ks] = *(const bf16x8*)(sinp + (pt * 32 + r) * 128 + ks * 16 + 8 * hf);
#pragma unroll
        for (int j = 0; j < 2; ++j) { const int lt = j == 0 ? (lsel ? 1 : 0) : (lsel ? 2 : 3);
#pragma unroll
            for (int ks = 0; ks < 8; ++ks) { const bf16x8 bq = *(const LAS bf16x8*)(Cs + (lt * 32 + r) * SPT + ks * 16 + 8 * hf); acc[pt][j] = MFMA32(af[ks], bq, acc[pt][j]); } }
    }
#pragma unroll
    for (int j = 0; j < 2; ++j) { const int lt = j == 0 ? (lsel ? 1 : 0) : (lsel ? 2 : 3); const float el = __expf(csh[lt * 32 + r]);
#pragma unroll
        for (int pt = 0; pt < 2; ++pt) acc[pt][j] = acc[pt][j] * el; }
#pragma unroll
    for (int j = 0; j < 2; ++j) { const int lt = j == 0 ? (lsel ? 1 : 0) : (lsel ? 2 : 3); const int lcol = lt * 32 + r; const float csL = csh[lcol]; const int nks = 2 * lt + 2;
        for (int ks = 0; ks < nks; ++ks) { const int s0 = ks * 16 + 8 * hf;
            const v4u cbv = *(const LAS v4u*)(CB + lcol * SPT + s0);
            const f32x4 c0 = *(const LAS f32x4*)(csh + s0), c1 = *(const LAS f32x4*)(csh + s0 + 4), d0 = *(const LAS f32x4*)(dth + s0), d1 = *(const LAS f32x4*)(dth + s0 + 4);
            float cbf[8]; unpack8(cbv, cbf); float m[8];
#pragma unroll
            for (int jj = 0; jj < 8; ++jj) { const float cs_s = jj < 4 ? c0[jj & 3] : c1[jj & 3], dt_s = jj < 4 ? d0[jj & 3] : d1[jj & 3];
                float v = cbf[jj] * __expf(fminf(csL - cs_s, 0.f)) * dt_s; v = (s0 + jj <= lcol) ? v : 0.f; m[jj] = (s0 + jj == lcol) ? v + Dh : v; }
            v4u mp; mp.x = pk2(m[0], m[1]); mp.y = pk2(m[2], m[3]); mp.z = pk2(m[4], m[5]); mp.w = pk2(m[6], m[7]);
            const bf16x8 mf = __builtin_bit_cast(bf16x8, mp);
#pragma unroll
            for (int pt = 0; pt < 2; ++pt) { const bf16x8 a = *(const LAS bf16x8*)(XT + (hh * 64 + pt * 32 + r) * SPT + s0); acc[pt][j] = MFMA32(a, mf, acc[pt][j]); }
        } }
#pragma unroll
    for (int j = 0; j < 2; ++j) { const int lt = j == 0 ? (lsel ? 1 : 0) : (lsel ? 2 : 3); const size_t t = trow0 + lt * 32 + r; float ss = 0.f;
#pragma unroll
        for (int pt = 0; pt < 2; ++pt)
#pragma unroll
            for (int q = 0; q < 4; ++q) { const v2u zz = *(const v2u*)(proj + t * PROJ_LD + COL_Z + h * 64 + pt * 32 + 8 * q + 4 * hf);
                const float z0 = bflo(zz.x), z1 = bfhi(zz.x), z2 = bflo(zz.y), z3 = bfhi(zz.y);
                const float g0 = acc[pt][j][4 * q] * (z0 * fsigmoid(z0)), g1 = acc[pt][j][4 * q + 1] * (z1 * fsigmoid(z1)), g2 = acc[pt][j][4 * q + 2] * (z2 * fsigmoid(z2)), g3 = acc[pt][j][4 * q + 3] * (z3 * fsigmoid(z3));
                yp[pt][j][2 * q] = pk2(g0, g1); yp[pt][j][2 * q + 1] = pk2(g2, g3);
                ss += (g0 * g0 + g1 * g1) + (g2 * g2 + g3 * g3); }
        ss += __shfl_xor(ss, 32);
        if (hf == 0) ssqh[lt * 32 + r] = ss; }
}
__device__ __forceinline__ void ssd_out_store(const Params& p, bf16* mix, const LAS float* ssqp, size_t trow0, int h, int lsel, int r, int hf, const unsigned (&yp)[2][2][8]) {
    f32x4 w4[2][4];
#pragma unroll
    for (int pt = 0; pt < 2; ++pt)
#pragma unroll
        for (int q = 0; q < 4; ++q) w4[pt][q] = *(const f32x4*)(p.ssm_norm_w + h * 64 + pt * 32 + 8 * q + 4 * hf);
#pragma unroll
    for (int pt = 0; pt < 2; ++pt) { asm volatile("" : "+v"(w4[pt][0]), "+v"(w4[pt][1]), "+v"(w4[pt][2]), "+v"(w4[pt][3])); }
#pragma unroll
    for (int j = 0; j < 2; ++j) { const int lt = j == 0 ? (lsel ? 1 : 0) : (lsel ? 2 : 3); const int l = lt * 32 + r; const size_t t = trow0 + l;
        float tot = 0.f;
#pragma unroll
        for (int hd = 0; hd < 8; ++hd) tot += ssqp[hd * 128 + l];
        const float rstd = rsqrtf(tot * (1.f / 512.f) + EPS);
#pragma unroll
        for (int pt = 0; pt < 2; ++pt)
#pragma unroll
            for (int q = 0; q < 4; ++q) { const int col = h * 64 + pt * 32 + 8 * q + 4 * hf;
                const unsigned u0 = yp[pt][j][2 * q], u1 = yp[pt][j][2 * q + 1];
                v2u o; o.x = pk2(bflo(u0) * rstd * w4[pt][q][0], bfhi(u0) * rstd * w4[pt][q][1]); o.y = pk2(bflo(u1) * rstd * w4[pt][q][2], bfhi(u1) * rstd * w4[pt][q][3]);
                *(v2u*)(mix + t * D + 1024 + col) = o; } }
}
__device__ __forceinline__ void phase_ssd_out(const Params& p, LAS unsigned char* lds, int G, int lane, int wave) {
    const bf16* proj = (const bf16*)(p.ws + WS_PROJ); const bf16* sin = (const bf16*)(p.ws + WS_SIN); bf16* mix = (bf16*)(p.ws + WS_MIX);
    LAS bf16* Cs = (LAS bf16*)lds;
    LAS bf16* Bs = Cs + 128 * SPT;
    LAS bf16* XT = Bs + 128 * SPT;
    LAS float* dtl = (LAS float*)(lds + 512 * SPT * 2);
    LAS float* csl = dtl + 1024; LAS float* ssqp = csl + 1024; LAS float* wtot = ssqp + 1024;
    const int tid = threadIdx.x, r = lane & 31, hf = lane >> 5;
    for (int item = blockIdx.x; item < NB * 64 * 2; item += G) {
        const int b = item >> 7, c = (item >> 1) & 63, g = item & 1;
        const int h0 = g * 8; const size_t trow0 = (size_t)b * SEQ + c * 128; const int tl0 = c * 128;
        __syncthreads();
        { int tz_ = threadIdx.x; asm volatile("" : "+v"(tz_)); ssd_tables(p, dtl, csl, wtot, trow0, h0, 8, tz_ & 63, __builtin_amdgcn_readfirstlane(tz_ >> 6)); }
        int tq = threadIdx.x; asm volatile("" : "+v"(tq));
        for (int task = tq; task < 64 * 16; task += NTHREADS) { const int cg = task >> 4, run = task & 15;
            if (cg < 16) conv_task<false, false>(p, proj, trow0, tl0, run, 1280 + g * 128 + cg * 8, Cs, cg * 8, nullptr);
            else if (cg < 32) conv_task<false, false>(p, proj, trow0, tl0, run, 1024 + g * 128 + (cg - 16) * 8, Bs, (cg - 16) * 8, nullptr);
            else conv_task<true, false>(p, proj, trow0, tl0, run, h0 * 64 + (cg - 32) * 8, XT, (cg - 32) * 8, nullptr); }
        __syncthreads();
        {
            int tz_ = threadIdx.x; asm volatile("" : "+v"(tz_)); const int wave = __builtin_amdgcn_readfirstlane(tz_ >> 6), r = tz_ & 31, hf = (tz_ >> 5) & 1;
            f32x16 cb[2];
#pragma unroll
            for (int q = 0; q < 2; ++q) { const int tile = 2 * wave + q, lt = tile >> 2, st = tile & 3;
#pragma unroll
                for (int e = 0; e < 16; ++e) cb[q][e] = 0.f;
                if (st <= lt) {
#pragma unroll
                    for (int ks = 0; ks < 8; ++ks) { const bf16x8 a = *(const LAS bf16x8*)(Cs + (lt * 32 + r) * SPT + ks * 16 + 8 * hf), bq = *(const LAS bf16x8*)(Bs + (st * 32 + r) * SPT + ks * 16 + 8 * hf);
                        cb[q] = MFMA32(a, bq, cb[q]); } } }
            __syncthreads();
#pragma unroll
            for (int q = 0; q < 2; ++q) { const int tile = 2 * wave + q, lt = tile >> 2, st = tile & 3;
                if (st <= lt) {
#pragma unroll
                    for (int e = 0; e < 16; ++e) Bs[(lt * 32 + (e & 3) + 8 * (e >> 2) + 4 * hf) * SPT + st * 32 + r] = (bf16)f2bf(cb[q][e]); } }
        }
        __syncthreads();
        unsigned y0[2][2][8], y1[2][2][8];
#define FRESH_IDS() int tz_ = threadIdx.x; asm volatile("" : "+v"(tz_)); const int wv_ = __builtin_amdgcn_readfirstlane(tz_ >> 6), hh = wv_ >> 1, lsel = wv_ & 1, r_ = tz_ & 31, hf_ = (tz_ >> 5) & 1
        { FRESH_IDS(); const int h = h0 + hh;
          ssd_out_pass(p, proj, sin + (((size_t)b * 64 + c) * 16 + h) * 64 * 128, Cs, Bs, XT, dtl + hh * 128, csl + hh * 128, ssqp + hh * 128, p.d_skip[h], trow0, h, hh, lsel, r_, hf_, y0); }
        __syncthreads();
        { int tz_ = threadIdx.x; asm volatile("" : "+v"(tz_)); const int cg = tz_ >> 4, run = tz_ & 15; conv_task<true, false>(p, proj, trow0, tl0, run, (h0 + 4) * 64 + cg * 8, XT, cg * 8, nullptr); }
        __syncthreads();
        { FRESH_IDS(); const int h = h0 + 4 + hh;
          ssd_out_pass(p, proj, sin + (((size_t)b * 64 + c) * 16 + h) * 64 * 128, Cs, Bs, XT, dtl + (4 + hh) * 128, csl + (4 + hh) * 128, ssqp + (4 + hh) * 128, p.d_skip[h], trow0, h, hh, lsel, r_, hf_, y1); }
        __syncthreads();
        { FRESH_IDS(); ssd_out_store(p, mix, ssqp, trow0, h0 + hh, lsel, r_, hf_, y0); }
        { FRESH_IDS(); ssd_out_store(p, mix, ssqp, trow0, h0 + 4 + hh, lsel, r_, hf_, y1); }
#undef FRESH_IDS
    }
}


__device__ __forceinline__ void phase_attn(const Params& p, LAS unsigned char* lds, int G) {
    const bf16* proj = (const bf16*)(p.ws + WS_PROJ); bf16* mix = (bf16*)(p.ws + WS_MIX);
    constexpr int KP = 72, VP = 260; constexpr float NEG = -1.0e30f;
    LAS bf16* Ks = (LAS bf16*)lds;
    LAS bf16* VT = Ks + 2 * 256 * KP;
    LAS float* ssqp = (LAS float*)(lds + 2 * 256 * KP * 2 + 2 * 64 * VP * 2);
    for (int item = blockIdx.x; item < NB * 64; item += G) {
        const int b = item >> 6, n = item & 63;
        __syncthreads();
        {
            int tz = threadIdx.x; asm volatile("" : "+v"(tz));
            const int j = tz >> 1, hk = tz & 1, pos = n * 128 - 128 + j;
            LAS bf16* kd = Ks + (hk * 256 + j) * KP; LAS bf16* vd = VT + hk * 64 * VP + j;
            if (pos >= 0) {
                const bf16* kp = proj + (size_t)(b * SEQ + pos) * PROJ_LD + COL_K + hk * 64;
                v4u kq[8]; float ss = 0.f;
#pragma unroll
                for (int c = 0; c < 8; ++c) { kq[c] = *(const v4u*)(kp + 8 * c); float f[8]; unpack8(kq[c], f);
#pragma unroll
                    for (int e = 0; e < 8; ++e) ss += f[e] * f[e]; }
                const float rstd = rsqrtf(ss * (1.f / 64.f) + EPS);
#pragma unroll
                for (int c = 0; c < 8; ++c) { float f[8]; unpack8(kq[c], f); const f32x4 w0 = *(const f32x4*)(p.k_norm_w + 8 * c), w1 = *(const f32x4*)(p.k_norm_w + 8 * c + 4);
                    *(LAS v4u*)(kd + 8 * c) = (v4u){pk2(f[0] * rstd * w0[0], f[1] * rstd * w0[1]), pk2(f[2] * rstd * w0[2], f[3] * rstd * w0[3]), pk2(f[4] * rstd * w1[0], f[5] * rstd * w1[1]), pk2(f[6] * rstd * w1[2], f[7] * rstd * w1[3])}; }
                const bf16* vp = kp + (COL_V - COL_K);
#pragma unroll
                for (int c = 0; c < 8; ++c) { const v4u q = *(const v4u*)(vp + 8 * c);
                    vd[(8 * c + 0) * VP] = (bf16)(q.x & 0xffffu); vd[(8 * c + 1) * VP] = (bf16)(q.x >> 16); vd[(8 * c + 2) * VP] = (bf16)(q.y & 0xffffu); vd[(8 * c + 3) * VP] = (bf16)(q.y >> 16);
                    vd[(8 * c + 4) * VP] = (bf16)(q.z & 0xffffu); vd[(8 * c + 5) * VP] = (bf16)(q.z >> 16); vd[(8 * c + 6) * VP] = (bf16)(q.w & 0xffffu); vd[(8 * c + 7) * VP] = (bf16)(q.w >> 16); }
            } else {
#pragma unroll
                for (int c = 0; c < 8; ++c) *(LAS v4u*)(kd + 8 * c) = (v4u){0u, 0u, 0u, 0u};
#pragma unroll
                for (int d = 0; d < 64; ++d) vd[d * VP] = (bf16)0;
            }
        }
        __syncthreads();
        {
            int tz = threadIdx.x; asm volatile("" : "+v"(tz));
            const int wave = __builtin_amdgcn_readfirstlane(tz >> 6), r = tz & 31, hf = (tz >> 5) & 1, hk = wave >> 2, wl = wave & 3;
            const LAS bf16* Kh = Ks + hk * 256 * KP; const LAS bf16* Vh = VT + hk * 64 * VP;
            f32x4 qw[4][2];
#pragma unroll
            for (int ks = 0; ks < 4; ++ks) { qw[ks][0] = *(const f32x4*)(p.q_norm_w + 16 * ks + 8 * hf); qw[ks][1] = *(const f32x4*)(p.q_norm_w + 16 * ks + 8 * hf + 4); }
            v4u qn[4];
            { const bf16* qp0 = proj + ((size_t)b * SEQ + n * 128 + r) * PROJ_LD + COL_Q + (hk * 8 + wl * 2) * 64 + 8 * hf;
#pragma unroll
              for (int ks = 0; ks < 4; ++ks) qn[ks] = *(const v4u*)(qp0 + 16 * ks); }
            for (int it = 0; it < 8; ++it) {
                const int hsel = it >> 2, qt = it & 3;
                const int hq = hk * 8 + wl * 2 + hsel; const float sink = p.sinks[hq];
                {
                    const size_t tok = (size_t)b * SEQ + n * 128 + qt * 32 + r;
                    bf16x8 qf[4];
                    {
                        v4u qv[4]; float ss = 0.f;
#pragma unroll
                        for (int ks = 0; ks < 4; ++ks) { qv[ks] = qn[ks]; float f[8]; unpack8(qv[ks], f);
#pragma unroll
                            for (int e = 0; e < 8; ++e) ss += f[e] * f[e]; }
                        if (it < 7) { const int it2 = it + 1, hq2 = hk * 8 + wl * 2 + (it2 >> 2);
                            const bf16* qp2 = proj + ((size_t)b * SEQ + n * 128 + (it2 & 3) * 32 + r) * PROJ_LD + COL_Q + hq2 * 64 + 8 * hf;
#pragma unroll
                            for (int ks = 0; ks < 4; ++ks) qn[ks] = *(const v4u*)(qp2 + 16 * ks); }
                        ss += __shfl_xor(ss, 32);
                        const float rstd = rsqrtf(ss * (1.f / 64.f) + EPS) * 0.125f;
#pragma unroll
                        for (int ks = 0; ks < 4; ++ks) { float f[8]; unpack8(qv[ks], f); const f32x4 w0 = qw[ks][0], w1 = qw[ks][1];
                            const v4u o = (v4u){pk2(f[0] * rstd * w0[0], f[1] * rstd * w0[1]), pk2(f[2] * rstd * w0[2], f[3] * rstd * w0[3]), pk2(f[4] * rstd * w1[0], f[5] * rstd * w1[1]), pk2(f[6] * rstd * w1[2], f[7] * rstd * w1[3])};
                            qf[ks] = __builtin_bit_cast(bf16x8, o); }
                    }
                    f32x16 sc[5];
#pragma unroll
                    for (int jt = 0; jt < 5; ++jt) {
#pragma unroll
                        for (int e = 0; e < 16; ++e) sc[jt][e] = 0.f;
#pragma unroll
                        for (int ks = 0; ks < 4; ++ks) { const bf16x8 a = *(const LAS bf16x8*)(Kh + ((qt + jt) * 32 + r) * KP + ks * 16 + 8 * hf); sc[jt] = MFMA32(a, qf[ks], sc[jt]); } }
#pragma unroll
                    for (int e = 0; e < 16; ++e) { const int kk = (e & 3) + 8 * (e >> 2) + 4 * hf;
                        sc[0][e] = (kk > r) ? sc[0][e] : NEG; sc[4][e] = (kk <= r) ? sc[4][e] : NEG; }
                    if (n == 0) {
#pragma unroll
                        for (int jt = 0; jt < 4; ++jt) if (qt + jt < 4) {
#pragma unroll
                            for (int e = 0; e < 16; ++e) sc[jt][e] = NEG; } }
                    float m = sink;
#pragma unroll
                    for (int jt = 0; jt < 5; ++jt)
#pragma unroll
                        for (int e = 0; e < 16; ++e) m = fmaxf(m, sc[jt][e]);
                    m = fmaxf(m, __shfl_xor(m, 32));
                    float l = 0.f;
#pragma unroll
                    for (int jt = 0; jt < 5; ++jt)
#pragma unroll
                        for (int e = 0; e < 16; ++e) { const float pv = __expf(sc[jt][e] - m); sc[jt][e] = pv; l += pv; }
                    l += __shfl_xor(l, 32); l += __expf(sink - m);
                    f32x16 o[2];
#pragma unroll
                    for (int dt = 0; dt < 2; ++dt)
#pragma unroll
                        for (int e = 0; e < 16; ++e) o[dt][e] = 0.f;
#pragma unroll
                    for (int jt = 0; jt < 5; ++jt)
#pragma unroll
                        for (int s2 = 0; s2 < 2; ++s2) {
                            const v4u pp = (v4u){pk2(sc[jt][8 * s2], sc[jt][8 * s2 + 1]), pk2(sc[jt][8 * s2 + 2], sc[jt][8 * s2 + 3]), pk2(sc[jt][8 * s2 + 4], sc[jt][8 * s2 + 5]), pk2(sc[jt][8 * s2 + 6], sc[jt][8 * s2 + 7])};
                            const bf16x8 pf = __builtin_bit_cast(bf16x8, pp);
                            const int kb = (qt + jt) * 32 + 16 * s2 + 4 * hf;
#pragma unroll
                            for (int dt = 0; dt < 2; ++dt) { const LAS bf16* vr = Vh + (dt * 32 + r) * VP + kb;
                                const v2u a0 = *(const LAS v2u*)vr, a1 = *(const LAS v2u*)(vr + 8);
                                const v4u av = (v4u){a0.x, a0.y, a1.x, a1.y};
                                o[dt] = MFMA32(__builtin_bit_cast(bf16x8, av), pf, o[dt]); }
                        }
                    const float inv = 1.0f / l; float ss = 0.f;
#pragma unroll
                    for (int dt = 0; dt < 2; ++dt)
#pragma unroll
                        for (int q = 0; q < 4; ++q) { const float g0 = o[dt][4 * q] * inv, g1 = o[dt][4 * q + 1] * inv, g2 = o[dt][4 * q + 2] * inv, g3 = o[dt][4 * q + 3] * inv;
                            ss += (g0 * g0 + g1 * g1) + (g2 * g2 + g3 * g3);
                            *(v2u*)(mix + tok * D + hq * 64 + dt * 32 + 8 * q + 4 * hf) = (v2u){pk2(g0, g1), pk2(g2, g3)}; }
                    ss += __shfl_xor(ss, 32);
                    if (hf == 0) ssqp[hq * 128 + qt * 32 + r] = ss;
                }
            }
        }
        __syncthreads();
        {
            int tz = threadIdx.x; asm volatile("" : "+v"(tz));
            const int wave = __builtin_amdgcn_readfirstlane(tz >> 6), r = tz & 31, hf = (tz >> 5) & 1, hk = wave >> 2, wl = wave & 3;
            for (int qt = 0; qt < 4; ++qt) {
                const size_t tok = (size_t)b * SEQ + n * 128 + qt * 32 + r;
                float tot = 0.f;
#pragma unroll
                for (int hd = 0; hd < 16; ++hd) tot += ssqp[hd * 128 + qt * 32 + r];
                const float rstd = rsqrtf(tot * (1.f / 1024.f) + EPS);
                v2u uu[2][2][4];
#pragma unroll
                for (int hsel = 0; hsel < 2; ++hsel)
#pragma unroll
                    for (int dt = 0; dt < 2; ++dt)
#pragma unroll
                        for (int q = 0; q < 4; ++q) uu[hsel][dt][q] = *(const v2u*)(mix + tok * D + (hk * 8 + wl * 2 + hsel) * 64 + dt * 32 + 8 * q + 4 * hf);
#pragma unroll
                for (int hsel = 0; hsel < 2; ++hsel)
#pragma unroll
                    for (int dt = 0; dt < 2; ++dt) { asm volatile("" : "+v"(uu[hsel][dt][0]), "+v"(uu[hsel][dt][1]), "+v"(uu[hsel][dt][2]), "+v"(uu[hsel][dt][3])); }
#pragma unroll
                for (int hsel = 0; hsel < 2; ++hsel)
#pragma unroll
                    for (int dt = 0; dt < 2; ++dt)
#pragma unroll
                        for (int q = 0; q < 4; ++q) { const int col = (hk * 8 + wl * 2 + hsel) * 64 + dt * 32 + 8 * q + 4 * hf;
                            const v2u u = uu[hsel][dt][q]; const f32x4 w4 = *(const f32x4*)(p.attn_out_norm_w + col);
                            *(v2u*)(mix + tok * D + col) = (v2u){pk2(bflo(u.x) * rstd * w4[0], bfhi(u.x) * rstd * w4[1]), pk2(bflo(u.y) * rstd * w4[2], bfhi(u.y) * rstd * w4[3])}; }
            }
        }
    }
}

__device__ __forceinline__ void phase_router(const Params& p, LAS unsigned char* lds, unsigned* ctl, int G, int wave, int lane) {
    const bf16* x1 = (const bf16*)(p.ws + WS_X1); const float* ssq = (const float*)(p.ws + WS_SSQ); unsigned char* hf = p.ws + WS_HF;
    int* stok = (int*)(p.ws + WS_STOK); float* sgate = (float*)(p.ws + WS_SGATE); int* toke = (int*)(p.ws + WS_TOKE); int* tokp = (int*)(p.ws + WS_TOKP);
    LAS float* lg = (LAS float*)lds + wave * (16 * 33);
    LAS int* hist = (LAS int*)(lds + 32768); LAS int* gbase = hist + 32;
    const int tid = threadIdx.x, i16 = lane & 15, kq = lane >> 4;
    for (int tb = blockIdx.x * 8; tb < T / 16; tb += G * 8) {
        if (tid < 32) hist[tid] = 0;
        __syncthreads();
        const int tok = (tb + wave) * 16 + i16;
        float s = 0.f;
        { const f32x4* sp = (const f32x4*)(ssq + (size_t)tok * 32 + kq * 8); const f32x4 a = sp[0], b = sp[1]; s = ((a[0] + a[1]) + (a[2] + a[3])) + ((b[0] + b[1]) + (b[2] + b[3])); }
        s += __shfl_xor(s, 16); s += __shfl_xor(s, 32);
        const float rstd = rsqrtf(s * (1.f / D) + EPS);
        f32x4 acc0 = (f32x4){0.f, 0.f, 0.f, 0.f}, acc1 = (f32x4){0.f, 0.f, 0.f, 0.f};
        const bf16* xr = x1 + (size_t)tok * D + 8 * kq;
        unsigned char* hr = hf + (size_t)tok * D + 8 * kq;
        const float* wrp = p.w_router + (size_t)(8 * kq) * NE + i16;
        v4u xq[4];
#pragma unroll
        for (int u = 0; u < 4; ++u) xq[u] = *(const v4u*)(xr + 32 * u);
        for (int j4 = 0; j4 < 64; j4 += 4) {
            f32x4 xc[4][2], gq[4][2]; float wv[4][8][2];
#pragma unroll
            for (int u = 0; u < 4; ++u) { float f[8]; unpack8(xq[u], f); xc[u][0] = (f32x4){f[0], f[1], f[2], f[3]}; xc[u][1] = (f32x4){f[4], f[5], f[6], f[7]}; }
            if (j4 + 4 < 64) {
#pragma unroll
                for (int u = 0; u < 4; ++u) xq[u] = *(const v4u*)(xr + 32 * (j4 + 4 + u)); }
#pragma unroll
            for (int u = 0; u < 4; ++u) { gq[u][0] = *(const f32x4*)(p.ffn_norm_w + 32 * (j4 + u) + 8 * kq); gq[u][1] = *(const f32x4*)(p.ffn_norm_w + 32 * (j4 + u) + 8 * kq + 4);
#pragma unroll
                for (int m = 0; m < 8; ++m) { wv[u][m][0] = wrp[(size_t)(32 * (j4 + u) + m) * NE]; wv[u][m][1] = wrp[(size_t)(32 * (j4 + u) + m) * NE + 16]; } }
#pragma unroll
            for (int u = 0; u < 4; ++u) {
                float hv[8];
#pragma unroll
                for (int k = 0; k < 4; ++k) { hv[k] = xc[u][0][k] * rstd * gq[u][0][k]; hv[4 + k] = xc[u][1][k] * rstd * gq[u][1][k]; }
                *(v2u*)(hr + 32 * (j4 + u)) = (v2u){pk4_fp8(sat8(hv[0] * FP8_SA), sat8(hv[1] * FP8_SA), sat8(hv[2] * FP8_SA), sat8(hv[3] * FP8_SA)), pk4_fp8(sat8(hv[4] * FP8_SA), sat8(hv[5] * FP8_SA), sat8(hv[6] * FP8_SA), sat8(hv[7] * FP8_SA))};
#pragma unroll
                for (int m = 0; m < 8; ++m) { acc0 = __builtin_amdgcn_mfma_f32_16x16x4f32(hv[m], wv[u][m][0], acc0, 0, 0, 0);
                    acc1 = __builtin_amdgcn_mfma_f32_16x16x4f32(hv[m], wv[u][m][1], acc1, 0, 0, 0); }
            }
        }
        { const float bb0 = p.b_router[i16], bb1 = p.b_router[16 + i16];
#pragma unroll
          for (int r = 0; r < 4; ++r) { lg[(4 * kq + r) * 33 + i16] = acc0[r] + bb0; lg[(4 * kq + r) * 33 + 16 + i16] = acc1[r] + bb1; } }
        LDS_WAIT(); asm volatile("" ::: "memory");
        int se[4]; float sv[4], gt[4]; int rk[4];
        if (lane < 16) {
            float v[32];
#pragma unroll
            for (int e = 0; e < 32; ++e) v[e] = lg[lane * 33 + e];
#pragma unroll
            for (int k = 0; k < 4; ++k) { float best = -3.0e38f; int bi = 0;
#pragma unroll
                for (int e = 0; e < 32; ++e) { const bool tk = v[e] > best; best = tk ? v[e] : best; bi = tk ? e : bi; }
                se[k] = bi; sv[k] = best;
#pragma unroll
                for (int e = 0; e < 32; ++e) v[e] = (e == bi) ? -3.0e38f : v[e]; }
            const float e1 = __expf(sv[1] - sv[0]), e2 = __expf(sv[2] - sv[0]), e3 = __expf(sv[3] - sv[0]);
            const float inv = 1.0f / (1.0f + e1 + e2 + e3);
            gt[0] = inv; gt[1] = e1 * inv; gt[2] = e2 * inv; gt[3] = e3 * inv;
#pragma unroll
            for (int k = 0; k < 4; ++k) rk[k] = __hip_atomic_fetch_add(&hist[se[k]], 1, __ATOMIC_RELAXED, __HIP_MEMORY_SCOPE_WORKGROUP);
        }
        __syncthreads();
        if (tid < 32) gbase[tid] = (int)__hip_atomic_fetch_add(ctl + CW_CNT + 64 * tid, (unsigned)hist[tid], __ATOMIC_RELAXED, __HIP_MEMORY_SCOPE_AGENT);
        __syncthreads();
        if (lane < 16) {
            const int tk = (tb + wave) * 16 + lane;
#pragma unroll
            for (int k = 0; k < 4; ++k) { const int pos = gbase[se[k]] + rk[k];
                stok[(size_t)se[k] * T + pos] = tk; sgate[(size_t)se[k] * T + pos] = gt[k]; toke[tk * 4 + k] = se[k]; tokp[tk * 4 + k] = pos; }
        }
        __syncthreads();
    }
}

__device__ __forceinline__ void moe_table(unsigned* ctl, LAS int* tstart, LAS int* lcnt) {
    __syncthreads();
    if (threadIdx.x < 32) lcnt[threadIdx.x] = (int)__hip_atomic_load(ctl + CW_CNT + 64 * threadIdx.x, __ATOMIC_RELAXED, __HIP_MEMORY_SCOPE_AGENT);
    __syncthreads();
    if (threadIdx.x == 0) { int a = 0; for (int e = 0; e < NE; ++e) { tstart[e] = a; a += (lcnt[e] + 255) >> 8; } tstart[NE] = a; }
    __syncthreads();
}

__device__ __forceinline__ void phase_combine(const Params& p, const LAS int* tstart, int gw, int NGW, int lane) {
    const unsigned char* y2 = p.ws + WS_Y2; const int* toke = (const int*)(p.ws + WS_TOKE); const int* tokp = (const int*)(p.ws + WS_TOKP);
    constexpr float DY = 1.0f / FP8_SY;
    typedef int i32x4v __attribute__((ext_vector_type(4)));
    i32x4v ne = (i32x4v){0, 0, 0, 0}, np = ne;
    if (gw < T) { ne = *(const i32x4v*)(toke + gw * 4); np = *(const i32x4v*)(tokp + gw * 4); }
    for (int m = gw; m < T; m += NGW) {
        const i32x4v ce = ne, cp = np;
        if (m + NGW < T) { ne = *(const i32x4v*)(toke + (m + NGW) * 4); np = *(const i32x4v*)(tokp + (m + NGW) * 4); }
        const unsigned char* yr[4];
#pragma unroll
        for (int k = 0; k < 4; ++k) yr[k] = y2 + ((size_t)tstart[ce[k]] * 256 + cp[k]) * D;
        float* op = p.out + (size_t)m * D; const bf16* xp = (const bf16*)(p.ws + WS_X1) + (size_t)m * D;
#pragma unroll
        for (int j = 0; j < 2; ++j) { const int c = (j * 64 + lane) * 16;
            v4u w[4];
#pragma unroll
            for (int k = 0; k < 4; ++k) w[k] = *(const v4u*)(yr[k] + c);
            f32x4 a[4];
            { const v4u xa = *(const v4u*)(xp + c), xb = *(const v4u*)(xp + c + 8); float fa[8], fb[8]; unpack8(xa, fa); unpack8(xb, fb);
              a[0] = (f32x4){fa[0], fa[1], fa[2], fa[3]}; a[1] = (f32x4){fa[4], fa[5], fa[6], fa[7]}; a[2] = (f32x4){fb[0], fb[1], fb[2], fb[3]}; a[3] = (f32x4){fb[4], fb[5], fb[6], fb[7]}; }
#pragma unroll
            for (int q = 0; q < 4; ++q) { float s0 = 0.f, s1 = 0.f, s2 = 0.f, s3 = 0.f;
#pragma unroll
                for (int k = 0; k < 4; ++k) { const int wd = (int)(q == 0 ? w[k].x : q == 1 ? w[k].y : q == 2 ? w[k].z : w[k].w);
                    const f32x2 lo = __builtin_amdgcn_cvt_pk_f32_fp8(wd, false), hi = __builtin_amdgcn_cvt_pk_f32_fp8(wd, true);
                    s0 += lo.x; s1 += lo.y; s2 += hi.x; s3 += hi.y; }
                a[q][0] += s0 * DY; a[q][1] += s1 * DY; a[q][2] += s2 * DY; a[q][3] += s3 * DY;
                *(f32x4*)(op + c + 4 * q) = a[q]; }
        }
    }
}

constexpr int N_PHASES = 10;
__global__ void __launch_bounds__(NTHREADS, 2) hymba_fwd(Params p) {
    extern __shared__ __attribute__((aligned(16))) unsigned char lds_raw[];
    LAS unsigned char* lds = (LAS unsigned char*)lds_raw;
    volatile LAS unsigned* MISC = (volatile LAS unsigned*)(lds + MISC_OFF);
    LAS int* tstart = (LAS int*)(lds + MISC_OFF + 256);
    LAS int* lcnt = (LAS int*)(lds + MISC_OFF + 512);
    const int tid = threadIdx.x, lane = tid & 63, wave = __builtin_amdgcn_readfirstlane(tid >> 6);
    const int G = gridDim.x;
    const int vcu = (G % 8 == 0) ? (blockIdx.x % 8) * (G / 8) + blockIdx.x / 8 : blockIdx.x;
    const int gw = vcu * NWAVES + wave, NGW = G * NWAVES;
    unsigned* ctl = (unsigned*)(p.ws + WS_CTL);
    if (tid < 64) MISC[tid] = 0u;
    __syncthreads();
    const int lo = p.ph_lo, hi = p.ph_hi;
    XcdBarrier bar; bar.bar = ctl + CW_BAR; bar.x = 0; bar.st = nullptr;
    if (hi - lo > 1) bar = xcd_barrier_post(ctl + CW_BAR, MISC + 8);
#ifndef PHMASK
#define PHMASK 0x3ff
#endif
#define IN(k) (((PHMASK >> (k)) & 1) && lo <= (k) && (k) < hi)
#define SEAM(k) do { if (IN(k) && IN((k) + 1)) xcd_barrier(bar); } while (0)

    if (IN(0)) { phase_prologue(p, lds, gw, NGW, wave, lane); }
    SEAM(0);
    int cid = (int)blockIdx.x;
    if (hi - lo > 1 && lo == 0) {
        if (tid == 0) {
            bool ok = (G % 8 == 0);
            for (unsigned j = 0; j < 16; ++j) { const unsigned cj = xb_ld(&bar.bar[XB_XCNT(j)]); ok = ok && (j < 8 ? cj == (unsigned)(G / 8) : cj == 0u); }
            MISC[12] = ok ? (MISC[10] * 8u + bar.x) : (unsigned)blockIdx.x;
        }
        __syncthreads();
        cid = (int)MISC[12];
    }
    if (IN(1)) {
        const int ncw = (G < 8 * NCV) ? G : 8 * NCV;
        if (cid < ncw) convert_experts(p, cid * NWAVES + wave, ncw * NWAVES, lane);
        LAS int* tk = (LAS int*)(lds + MISC_OFF + 768);
        unsigned* tick = ctl + CW_TICK + 64 * (cid & 7);
        __syncthreads();
        if (tid == 0) { tk[0] = (int)__hip_atomic_fetch_add(tick, 1u, __ATOMIC_RELAXED, __HIP_MEMORY_SCOPE_AGENT); tk[1] = (int)__hip_atomic_fetch_add(tick, 1u, __ATOMIC_RELAXED, __HIP_MEMORY_SCOPE_AGENT); }
        __syncthreads();
        pg8::SchedQueue S{(const char*)(p.ws + WS_HN), (const char*)(p.ws + WS_WIN), T / 256, NIN_PAD / 256, (T / 256) * (NIN_PAD / 256) / 8, cid & 7, tick, tk};
        EpiInProj E{(bf16*)(p.ws + WS_PROJ), (float*)(p.ws + WS_DT)};
        pg8::gemm_phase<EpiInProj, pg8::SchedQueue>(lds, S, E);
    }
    SEAM(1);
    if (IN(2)) { if (!(p.variant & 2)) phase_attn(p, lds, G); if (!(p.variant & 1)) phase_ssd_states(p, lds, G, lane, wave); }
    SEAM(2);
    if (IN(3)) { phase_ssd_scan(p, G); }
    SEAM(3);
    if (IN(4)) { phase_ssd_out(p, lds, G, lane, wave); }
    SEAM(4);
    if (IN(5)) {
        EpiOutProj E{p.x, (bf16*)(p.ws + WS_X1), (float*)(p.ws + WS_SSQ)};
#if PROBE_CRIP5
        if (p.variant) { pg8::SchedDenseT<PROBE_CRIP5> S{(const char*)(p.ws + WS_MIX), (const char*)(p.ws + WS_WOUT), T / 256, D / 256, G, cid};
            pg8::gemm_phase<EpiOutProj, pg8::SchedDenseT<PROBE_CRIP5>>(lds, S, E); } else
#endif
        { pg8::SchedDense S{(const char*)(p.ws + WS_MIX), (const char*)(p.ws + WS_WOUT), T / 256, D / 256, G, cid};
          pg8::gemm_phase<EpiOutProj, pg8::SchedDense>(lds, S, E); }
    }
    SEAM(5);
    if (IN(6)) { phase_router(p, lds, ctl, G, wave, lane); }
    SEAM(6);
    if (IN(7)) {
        moe_table(ctl, tstart, lcnt);
        EpiGateUp E{p.ws + WS_HB, p.b_gate, p.b_up};
#if PROBE_CRIP7
        if (p.variant) { pg8::SchedMoE<true, PROBE_CRIP7> S{(const char*)(p.ws + WS_HF), (const char*)(p.ws + WS_WGU), (const int*)(p.ws + WS_STOK), tstart, lcnt, (2 * FF) / 256, 2 * FF, G, cid};
            pg8::gemm_phase<EpiGateUp, pg8::SchedMoE<true, PROBE_CRIP7>>(lds, S, E); } else
#endif
        { pg8::SchedMoE<true> S{(const char*)(p.ws + WS_HF), (const char*)(p.ws + WS_WGU), (const int*)(p.ws + WS_STOK), tstart, lcnt, (2 * FF) / 256, 2 * FF, G, cid};
          pg8::gemm_phase<EpiGateUp, pg8::SchedMoE<true>>(lds, S, E); }
    }
    SEAM(7);
    if (IN(8)) {
        moe_table(ctl, tstart, lcnt);
        EpiDown E{p.ws + WS_Y2, p.b_down, (const float*)(p.ws + WS_SGATE), tstart};
#if PROBE_CRIP
        if (p.variant) { pg8::SchedMoE<false, PROBE_CRIP> S{(const char*)(p.ws + WS_HB), (const char*)(p.ws + WS_WD), (const int*)(p.ws + WS_STOK), tstart, lcnt, D / 256, D, G, cid};
            pg8::gemm_phase<EpiDown, pg8::SchedMoE<false, PROBE_CRIP>>(lds, S, E); } else
#endif
        { pg8::SchedMoE<false> S{(const char*)(p.ws + WS_HB), (const char*)(p.ws + WS_WD), (const int*)(p.ws + WS_STOK), tstart, lcnt, D / 256, D, G, cid};
          pg8::gemm_phase<EpiDown, pg8::SchedMoE<false>>(lds, S, E); }
    }
    SEAM(8);
    if (IN(9)) { moe_table(ctl, tstart, lcnt); phase_combine(p, tstart, gw, NGW, lane); }
#undef IN
#undef SEAM
}

extern "C" void kernel_launch(void* const* d_in, const int* in_sizes, int n_in, void* d_out, int out_size, void* d_ws, size_t ws_size, hipStream_t stream) {
    static int grid = 0;
    if (grid == 0) {
        if (n_in != 23 || out_size != T * D || ws_size < WS_END) { fprintf(stderr, "kernel_launch: unexpected sizes n_in %d out %d ws %zu\n", n_in, out_size, ws_size); grid = -1; return; }
        int dev = 0, cus = 0;
        if (hipGetDevice(&dev) != hipSuccess || hipDeviceGetAttribute(&cus, hipDeviceAttributeMultiprocessorCount, dev) != hipSuccess) { grid = -1; return; }
        if (hipFuncSetAttribute((const void*)hymba_fwd, hipFuncAttributeMaxDynamicSharedMemorySize, LDS_BYTES) != hipSuccess) { fprintf(stderr, "kernel_launch: hipFuncSetAttribute failed\n"); grid = -1; return; }
        int per_cu = 0;
        if (hipOccupancyMaxActiveBlocksPerMultiprocessor(&per_cu, (const void*)hymba_fwd, NTHREADS, LDS_BYTES) != hipSuccess || per_cu < 1) fprintf(stderr, "kernel_launch: occupancy query says %d\n", per_cu);
        (void)hipGetLastError();
        grid = cus;
    }
    if (grid < 0) return;
    (void)hipMemsetAsync((char*)d_ws + WS_CTL, 0, CTL_BYTES, stream);
    Params p{};
    const float** pp = (const float**)&p;
    for (int i = 0; i < 23; ++i) pp[i] = (const float*)d_in[i];
    p.out = (float*)d_out; p.ws = (unsigned char*)d_ws;
#if MK_MULTI || (PROBE_REPEAT >= 0) || PROBE_CRIP || PROBE_P2 || PROBE_P6 || PROBE_CRIP7 || PROBE_CRIP5
    for (int ph = 0; ph < N_PHASES; ++ph) { p.ph_lo = ph; p.ph_hi = ph + 1;
        if (PROBE_P2 && ph == 2) { p.variant = PROBE_P2; hipLaunchKernelGGL(hymba_fwd, dim3(grid), dim3(NTHREADS), LDS_BYTES, stream, p); p.variant = 0; }
        if (PROBE_P6 && ph == 6) { hipLaunchKernelGGL(hymba_fwd, dim3(grid), dim3(NTHREADS), LDS_BYTES, stream, p); (void)hipMemsetAsync((char*)d_ws + WS_CTL + CW_CNT * 4, 0, 64 * 4 * NE, stream); }
        if (PROBE_CRIP5 && ph == 5) { p.variant = 1; hipLaunchKernelGGL(hymba_fwd, dim3(grid), dim3(NTHREADS), LDS_BYTES, stream, p); p.variant = 0; }
        if (PROBE_CRIP7 && ph == 7) { p.variant = 1; hipLaunchKernelGGL(hymba_fwd, dim3(grid), dim3(NTHREADS), LDS_BYTES, stream, p); p.variant = 0; }
        if (PROBE_CRIP && ph == 8) { p.variant = 1; hipLaunchKernelGGL(hymba_fwd, dim3(grid), dim3(NTHREADS), LDS_BYTES, stream, p); p.variant = 0; }
        for (int r = 0; r < (ph == PROBE_REPEAT ? 2 : 1); ++r) hipLaunchKernelGGL(hymba_fwd, dim3(grid), dim3(NTHREADS), LDS_BYTES, stream, p); }
#else
    p.ph_lo = 0; p.ph_hi = N_PHASES; hipLaunchKernelGGL(hymba_fwd, dim3(grid), dim3(NTHREADS), LDS_BYTES, stream, p);
#endif
}
```

```cpp
#include <hip/hip_runtime.h>
#include <cstdio>
#include <cstdint>

#ifndef MK_MULTI
#define MK_MULTI 0
#endif

#ifndef PROBE_CRIP
#define PROBE_CRIP 0
#endif
#ifndef PROBE_CRIP5
#define PROBE_CRIP5 0
#endif
#ifndef PROBE_CRIP7
#define PROBE_CRIP7 0
#endif
#ifndef PROBE_P6
#define PROBE_P6 0
#endif
#ifndef PROBE_P2
#define PROBE_P2 0
#endif
#ifndef PROBE_REPEAT
#define PROBE_REPEAT -1
#endif
#define GAS __attribute__((address_space(1)))
#define LAS __attribute__((address_space(3)))
typedef unsigned short bf16;
typedef unsigned v4u __attribute__((ext_vector_type(4)));
typedef unsigned v2u __attribute__((ext_vector_type(2)));
typedef float f32x4 __attribute__((ext_vector_type(4)));
typedef float f32x2 __attribute__((ext_vector_type(2)));
typedef short bf16x8 __attribute__((ext_vector_type(8)));
typedef int i32x4 __attribute__((ext_vector_type(4)));
typedef int i32x8 __attribute__((ext_vector_type(8)));

constexpr int NB = 4, SEQ = 8192, T = NB * SEQ, D = 2048;
constexpr int PROJ_LD = 3840;
constexpr int COL_Q = 0, COL_K = 1024, COL_V = 1152, COL_Z = 1280, COL_XBC = 2304;
constexpr int NIN = 3856, NIN_PAD = 4096;
constexpr int NXBC = 1536;
constexpr int NE = 32, FF = 2048, TOPK = 4;
constexpr int SLOT_ROWS = T * TOPK + NE * 256;
constexpr float EPS = 1e-6f;

constexpr size_t MiB = 1u << 20;
constexpr size_t WS_CTL = 0, CTL_BYTES = 1 * MiB;
constexpr size_t WS_WGU = 16 * MiB;
constexpr size_t WS_WIN = 528 * MiB;
constexpr size_t WS_WOUT = 544 * MiB;
constexpr size_t WS_HF = 552 * MiB;
constexpr size_t WS_Y2 = 16 * MiB;
constexpr size_t WS_WD = 680 * MiB;
constexpr size_t WS_HN = 936 * MiB;
constexpr size_t WS_MIX = WS_HN;
constexpr size_t WS_PROJ = 1064 * MiB;
constexpr size_t WS_XBC = 1304 * MiB;
constexpr size_t WS_ATT = 1496 * MiB;
constexpr size_t WS_X1 = WS_ATT;
constexpr size_t WS_YS = 1624 * MiB;
constexpr size_t WS_HB = 936 * MiB;
constexpr size_t WS_STATES = WS_XBC;
constexpr size_t WS_SIN = WS_YS;
constexpr size_t WS_CDEC = WS_YS + 64 * MiB;
constexpr size_t WS_DT = 1752 * MiB;
constexpr size_t WS_DTS = 1754 * MiB;
constexpr size_t WS_SSQ = 1756 * MiB;
constexpr size_t WS_STOK = 1760 * MiB;
constexpr size_t WS_SGATE = 1764 * MiB;
constexpr size_t WS_TOKE = 1768 * MiB;
constexpr size_t WS_TOKP = 1769 * MiB;
constexpr size_t WS_END = 1770 * MiB;
static_assert(WS_Y2 + (size_t)SLOT_ROWS * 2048 <= WS_WD, "y2 overlay");
static_assert(WS_HB + (size_t)SLOT_ROWS * 2048 * 2 <= WS_ATT, "hb overlay");
constexpr int CW_CNT = 1024;
constexpr int CW_BAR = 4096;
constexpr int CW_TICK = 2048 + 1024;
constexpr int NCV = 16;

constexpr int RING_BYTES = 131072;
constexpr int MISC_OFF = 162816;
constexpr int LDS_BYTES = 163840;
constexpr int NWAVES = 8, NTHREADS = 512;

typedef __bf16 hwbf16x2 __attribute__((ext_vector_type(2)));
__device__ __forceinline__ unsigned f2bf(float f) { return (unsigned)__builtin_bit_cast(unsigned short, (__bf16)f); }
__device__ __forceinline__ unsigned pk2(float lo, float hi) { const f32x2 v = {lo, hi}; return __builtin_bit_cast(unsigned, __builtin_convertvector(v, hwbf16x2)); }
__device__ __forceinline__ float bflo(unsigned w) { return __builtin_bit_cast(float, w << 16); }
__device__ __forceinline__ float bfhi(unsigned w) { return __builtin_bit_cast(float, w & 0xffff0000u); }
__device__ __forceinline__ float wave_sum(float v) {
#pragma unroll
    for (int o = 1; o < 64; o <<= 1) v += __shfl_xor(v, o);
    return v;
}
__device__ __forceinline__ float sat8(float x) { return __builtin_amdgcn_fmed3f(x, -448.0f, 448.0f); }
__device__ __forceinline__ unsigned pk4_fp8(float a, float b, float c, float d) { int v = 0; v = __builtin_amdgcn_cvt_pk_fp8_f32(a, b, v, false); v = __builtin_amdgcn_cvt_pk_fp8_f32(c, d, v, true); return (unsigned)v; }
constexpr float FP8_SW = 256.f;
constexpr float FP8_SA = 16.f;
constexpr float FP8_SH = 4.f;
constexpr float FP8_SY = 32.f;
__device__ __forceinline__ float fsigmoid(float x) { return __builtin_amdgcn_rcpf(1.0f + __expf(-x)); }
__device__ __forceinline__ void unpack8(const v4u q, float (&d)[8]) { d[0] = bflo(q.x); d[1] = bfhi(q.x); d[2] = bflo(q.y); d[3] = bfhi(q.y); d[4] = bflo(q.z); d[5] = bfhi(q.z); d[6] = bflo(q.w); d[7] = bfhi(q.w); }
#define LDS_WAIT() asm volatile("s_waitcnt lgkmcnt(0)" ::: "memory")

#define XB_TMO      128
#define XB_XCNT(j)  (256  + 64 * (j))
#define XB_XSUB(j)  (1280 + 64 * (j))
#define XB_XGEN(j)  (2304 + 64 * (j))
#define XB_TOP      3328
#define XB_TOPGEN   3392
#define XCD_BAR_WORDS 3456
#define XB_SPIN_CAP (1u << 18)
__device__ __forceinline__ unsigned xb_ld(unsigned* p)              { return __hip_atomic_load(p, __ATOMIC_RELAXED, __HIP_MEMORY_SCOPE_AGENT); }
__device__ __forceinline__ unsigned xb_add(unsigned* p, unsigned v) { return __hip_atomic_fetch_add(p, v, __ATOMIC_RELAXED, __HIP_MEMORY_SCOPE_AGENT); }
__device__ __forceinline__ unsigned xb_xcc_id() { return (unsigned)__builtin_amdgcn_s_getreg((3 << 11) | 20) & 0xFu; }
#define XB_SPIN(cond, bar) do { unsigned _sp = 0; while (cond) { __builtin_amdgcn_s_sleep(1); \
    if ((++_sp & 255u) == 0u) { if (xb_ld(&(bar)[XB_TMO])) break; if (_sp > XB_SPIN_CAP) { atomicAdd(&(bar)[XB_TMO], 1u); break; } } } } while (0)
struct XcdBarrier { unsigned* bar; unsigned x; volatile LAS unsigned* st; };
__device__ __forceinline__ XcdBarrier xcd_barrier_post(unsigned* bar, volatile LAS unsigned* st) {
    XcdBarrier b; b.bar = bar; b.x = xb_xcc_id(); b.st = st;
    if (threadIdx.x == 0) st[2] = xb_add(&bar[XB_XCNT(b.x)], 1u);
    return b;
}
__device__ __forceinline__ void xcd_barrier_complete(unsigned* bar, unsigned x, unsigned& nloc, unsigned& nx) {
    const unsigned G = gridDim.x * gridDim.y * gridDim.z;
    unsigned sum, cnt, mine, sp = 0u;
    for (;;) {
        sum = 0u; cnt = 0u; mine = 0u;
#pragma unroll
        for (unsigned j = 0; j < 16; ++j) { const unsigned c = xb_ld(&bar[XB_XCNT(j)]); sum += c; cnt += (c > 0u) ? 1u : 0u; mine = (j == x) ? c : mine; }
        if (sum == G) break;
        __builtin_amdgcn_s_sleep(1);
        if ((++sp & 255u) == 0u) { if (xb_ld(&bar[XB_TMO])) break; if (sp > XB_SPIN_CAP) { atomicAdd(&bar[XB_TMO], 1u); break; } }
    }
    nloc = mine > 0u ? mine : 1u; nx = cnt > 0u ? cnt : 1u;
}
__device__ __forceinline__ void xcd_barrier(const XcdBarrier& b) {
    asm volatile("s_waitcnt vmcnt(0)" ::: "memory");
    __syncthreads();
    if (threadIdx.x == 0) {
        unsigned* bar = b.bar;
        __builtin_amdgcn_s_waitcnt(0);
        unsigned nloc = b.st[0], nx = b.st[1];
        if (nloc == 0u) { xcd_barrier_complete(bar, b.x, nloc, nx); b.st[0] = nloc; b.st[1] = nx; }
        const unsigned old = xb_add(&bar[XB_XSUB(b.x)], 1u);
        const unsigned gen = old / nloc;
        if (old + 1u == (gen + 1u) * nloc) {
            __builtin_amdgcn_fence(__ATOMIC_RELEASE, "agent");
            asm volatile("s_waitcnt vmcnt(0)" ::: "memory");
            const unsigned og = xb_add(&bar[XB_TOP], 1u);
            const unsigned tg = og / nx;
            if (og + 1u == (tg + 1u) * nx) xb_add(&bar[XB_TOPGEN], 1u);
            else XB_SPIN(xb_ld(&bar[XB_TOPGEN]) == tg, bar);
            __builtin_amdgcn_fence(__ATOMIC_ACQUIRE, "agent");
            xb_add(&bar[XB_XGEN(b.x)], 1u);
            asm volatile("s_waitcnt vmcnt(0)" ::: "memory");
        } else {
            XB_SPIN(xb_ld(&bar[XB_XGEN(b.x)]) == gen, bar);
            __builtin_amdgcn_fence(__ATOMIC_ACQUIRE, "agent");
            asm volatile("s_waitcnt vmcnt(0)" ::: "memory");
        }
    }
    __syncthreads();
}

struct Params {
    const float* x; const float* attn_norm_w; const float* w_in; const float* q_norm_w; const float* k_norm_w; const float* sinks;
    const float* conv_w; const float* conv_b; const float* dt_bias; const float* a_log; const float* d_skip; const float* ssm_norm_w;
    const float* attn_out_norm_w; const float* w_out; const float* ffn_norm_w; const float* w_router; const float* b_router;
    const float* w_gate; const float* b_gate; const float* w_up; const float* b_up; const float* w_down; const float* b_down;
    float* out; unsigned char* ws; int ph_lo, ph_hi, variant, pad;
};

namespace pg8 {
constexpr int BM = 256, BK = 64, HALF = 128, HTB = HALF * BK * 2, GK = 2048;
__device__ __forceinline__ int lds_byte(int r, int c) { const int st = (r >> 4) * 2 + (c >> 5), rr = r & 15, cc = c & 31, ob = rr * 64 + cc * 2; return st * 1024 + (ob ^ (((ob >> 9) & 1) << 5)); }
__device__ __forceinline__ void stage_rc(int b, int& R, int& C) { const int st = b / 1024, sb = b % 1024, swz = sb ^ (((sb >> 9) & 1) << 5); R = (st >> 1) * 16 + swz / 64; C = (st & 1) * 32 + (swz % 64) / 2; }
__device__ __forceinline__ int perm32(int rho) { const int n = rho >> 4, i = rho & 15; return 8 * (i >> 2) + 4 * n + (i & 3); }

struct Unit { const char* aBase; const char* bBase; const int* aidx; int avalid; int pm, pn, e; };

template <class Epi, class Sched>
__device__ __forceinline__ void gemm_phase(LAS unsigned char* lds, const Sched& S, const Epi& E) {
    constexpr int RP = Sched::ROWB, nt = RP / 128;
    constexpr bool F8 = Sched::FP8;
    const int tid = threadIdx.x, wid = __builtin_amdgcn_readfirstlane(tid >> 6), lane = tid & 63, wr = wid >> 2, wc = wid & 3, fr = lane & 15, fq = lane >> 4;
    int sR[2], sC[2];
    unsigned voffB[2], vA[2][2];
#pragma unroll
    for (int i = 0; i < 2; ++i) { stage_rc(tid * 16 + i * 8192, sR[i], sC[i]); const int Rb = Epi::PERM ? ((sR[i] & ~31) + perm32(sR[i] & 31)) : sR[i];
        voffB[i] = (unsigned)(Rb * RP + sC[i] * 2); }
    const size_t kstep = (size_t)(BK * 2);
    const size_t hstep = (size_t)HALF * RP;
    const unsigned ldsw = (unsigned)wid * 1024u;
    const int aoff = lds_byte(wr * 64 + fr, fq * 8), boff = lds_byte(wc * 32 + fr, fq * 8);
#define PG8_SA(b, h) (((b) * 2 + (h)) * HTB)
#define PG8_SB(b, h) ((4 + (b) * 2 + (h)) * HTB)
#define PG8_STAGE(bufoff, gbase, voff) do { if constexpr (!(Sched::CRIP & 2)) _Pragma("unroll") for (int _i = 0; _i < 2; ++_i) { unsigned _o = (voff)[_i]; asm volatile("" : "+v"(_o)); \
        __builtin_amdgcn_global_load_lds((const unsigned*)((const char*)(gbase) + _o), (LAS unsigned*)(lds + (bufoff) + ldsw + _i * 8192), 16, 0, 0); } } while (0)
#define PG8_CAT(x, y) __builtin_shufflevector(x, y, 0, 1, 2, 3, 4, 5, 6, 7)
#define PG8_LO(v) __builtin_bit_cast(bf16x8, __builtin_shufflevector(v, v, 0, 1, 2, 3))
#define PG8_HI(v) __builtin_bit_cast(bf16x8, __builtin_shufflevector(v, v, 4, 5, 6, 7))
#define PG8_LDA(dst, b, h) do { if constexpr (!(Sched::CRIP & 4)) _Pragma("unroll") for (int m = 0; m < 4; ++m) dst[m] = PG8_CAT(*(const LAS i32x4*)(lds + PG8_SA(b, h) + aoff + m * 2048), *(const LAS i32x4*)(lds + PG8_SA(b, h) + aoff + m * 2048 + 1024)); } while (0)
#define PG8_LDB(dst, b, h) do { if constexpr (!(Sched::CRIP & 4)) _Pragma("unroll") for (int n = 0; n < 2; ++n) dst[n] = PG8_CAT(*(const LAS i32x4*)(lds + PG8_SB(b, h) + boff + n * 2048), *(const LAS i32x4*)(lds + PG8_SB(b, h) + boff + n * 2048 + 1024)); } while (0)
#define PG8_MMA(ai, bj, At, Bt) do { __builtin_amdgcn_s_setprio(1); \
        if constexpr (Sched::CRIP & 1) {} else if constexpr (F8) { asm volatile("s_nop 1\n\t" \
            "v_mfma_scale_f32_16x16x128_f8f6f4 %0, %8, %10, %0, %14, %14 op_sel_hi:[0,0,0]\n\t" "v_mfma_scale_f32_16x16x128_f8f6f4 %1, %9, %10, %1, %14, %14 op_sel_hi:[0,0,0]\n\t" \
            "v_mfma_scale_f32_16x16x128_f8f6f4 %2, %8, %11, %2, %14, %14 op_sel_hi:[0,0,0]\n\t" "v_mfma_scale_f32_16x16x128_f8f6f4 %3, %9, %11, %3, %14, %14 op_sel_hi:[0,0,0]\n\t" \
            "v_mfma_scale_f32_16x16x128_f8f6f4 %4, %8, %12, %4, %14, %14 op_sel_hi:[0,0,0]\n\t" "v_mfma_scale_f32_16x16x128_f8f6f4 %5, %9, %12, %5, %14, %14 op_sel_hi:[0,0,0]\n\t" \
            "v_mfma_scale_f32_16x16x128_f8f6f4 %6, %8, %13, %6, %14, %14 op_sel_hi:[0,0,0]\n\t" "v_mfma_scale_f32_16x16x128_f8f6f4 %7, %9, %13, %7, %14, %14 op_sel_hi:[0,0,0]" \
            : "+v"(acc[ai][bj][0][0]), "+v"(acc[ai][bj][0][1]), "+v"(acc[ai][bj][1][0]), "+v"(acc[ai][bj][1][1]), "+v"(acc[ai][bj][2][0]), "+v"(acc[ai][bj][2][1]), "+v"(acc[ai][bj][3][0]), "+v"(acc[ai][bj][3][1]) \
            : "v"(Bt[0]), "v"(Bt[1]), "v"(At[0]), "v"(At[1]), "v"(At[2]), "v"(At[3]), "v"(f8scale)); } \
        else { _Pragma("unroll") for (int m = 0; m < 4; ++m) _Pragma("unroll") for (int n = 0; n < 2; ++n) { \
               acc[ai][bj][m][n] = __builtin_amdgcn_mfma_f32_16x16x32_bf16(PG8_LO(Bt[n]), PG8_LO(At[m]), acc[ai][bj][m][n], 0, 0, 0); \
               acc[ai][bj][m][n] = __builtin_amdgcn_mfma_f32_16x16x32_bf16(PG8_HI(Bt[n]), PG8_HI(At[m]), acc[ai][bj][m][n], 0, 0, 0); } } \
        __builtin_amdgcn_s_setprio(0); } while (0)
#define PG8_WAIT_V(n) asm volatile("s_waitcnt vmcnt(" #n ")" ::: "memory")
#define PG8_WAIT_L(n) asm volatile("s_waitcnt lgkmcnt(" #n ")" ::: "memory")
#define PG8_BAR __builtin_amdgcn_s_barrier()
#define PG8_BAR2 do { if constexpr (!(Sched::CRIP & 16)) __builtin_amdgcn_s_barrier(); } while (0)
#define PG8_SCHED __builtin_amdgcn_sched_barrier(0)
    Unit cur, nxt; int ui = 0;
    if (!S.next(0, cur)) return;
    typename Epi::Pre epre;
    E.prefetch(cur, epre);
    LAS int* lidx = (LAS int*)(lds + 8 * HTB);
    if constexpr (Sched::GATHER) {
        if (tid < 256) { const int v = cur.aidx[tid]; lidx[tid] = (tid < cur.avalid) ? v : 0; }
        __syncthreads();
    }
#pragma unroll
    for (int h = 0; h < 2; ++h)
#pragma unroll
        for (int i = 0; i < 2; ++i) {
            const int r = h * HALF + sR[i];
            if constexpr (Sched::GATHER) vA[h][i] = (unsigned)(lidx[r] * RP + sC[i] * 2);
            else vA[h][i] = (unsigned)(r * RP + sC[i] * 2);
        }
    f32x4 acc[2][2][4][2];
#pragma unroll
    for (int a = 0; a < 2; ++a)
#pragma unroll
        for (int b = 0; b < 2; ++b)
#pragma unroll
            for (int m = 0; m < 4; ++m)
#pragma unroll
                for (int n = 0; n < 2; ++n) acc[a][b][m][n] = (f32x4){0.f, 0.f, 0.f, 0.f};
    i32x8 At[4], B0[2], B1[2];
    if constexpr (Sched::CRIP & 4) { _Pragma("unroll") for (int m = 0; m < 4; ++m) At[m] = (i32x8){0, 0, 0, 0, 0, 0, 0, 0}; _Pragma("unroll") for (int n = 0; n < 2; ++n) { B0[n] = At[0]; B1[n] = At[0]; } }
    int f8scale = 0x7f7f7f7f; asm volatile("" : "+v"(f8scale));
    const char* cA = cur.aBase; const char* cB = cur.bBase;
#ifndef KROT
#define KROT(pm, pn) (((F8 ? 0 : (pm)) + (pn)) & (nt - 1))
#endif
#define PG8_KT(rot, tau) ((size_t)(((tau) + (rot)) & (nt - 1)) * kstep)
    int crot = KROT(cur.pm, cur.pn);
    PG8_STAGE(PG8_SB(0, 0), cB + PG8_KT(crot, 0), voffB); PG8_STAGE(PG8_SB(0, 1), cB + hstep + PG8_KT(crot, 0), voffB); PG8_STAGE(PG8_SA(0, 0), cA + PG8_KT(crot, 0), vA[0]); PG8_STAGE(PG8_SA(0, 1), cA + PG8_KT(crot, 0), vA[1]);
    if (wr == 1) PG8_BAR;
    PG8_WAIT_V(2); PG8_BAR;
    PG8_STAGE(PG8_SB(1, 0), cB + PG8_KT(crot, 1), voffB); PG8_STAGE(PG8_SA(1, 0), cA + PG8_KT(crot, 1), vA[0]); PG8_STAGE(PG8_SB(1, 1), cB + hstep + PG8_KT(crot, 1), voffB);
    PG8_WAIT_V(6); PG8_BAR;
    for (;;) {
        const bool has_next = S.next(ui + 1, nxt);
        const char* nA = has_next ? nxt.aBase : cA; const char* nB = has_next ? nxt.bBase : cB;
        const int nrot = has_next ? KROT(nxt.pm, nxt.pn) : crot;
        for (int t = 0; t < nt; t += 2) {
            const bool last = (t == nt - 2);
            const char* a1 = cA + PG8_KT(crot, t + 1);
            const char* a2 = last ? nA + PG8_KT(nrot, 0) : cA + PG8_KT(crot, t + 2); const char* b2 = last ? nB + PG8_KT(nrot, 0) : cB + PG8_KT(crot, t + 2);
            const char* a3 = last ? nA + PG8_KT(nrot, 1) : cA + PG8_KT(crot, t + 3); const char* b3 = last ? nB + PG8_KT(nrot, 1) : cB + PG8_KT(crot, t + 3);
            int gi = 0;
            if constexpr (Sched::GATHER) { if (t == 0 && has_next && tid < 256) gi = nxt.aidx[tid]; }
            PG8_LDB(B0, 0, 0); PG8_LDB(B1, 0, 1); PG8_SCHED; PG8_LDA(At, 0, 0); PG8_STAGE(PG8_SA(1, 1), a1, vA[1]);
            PG8_WAIT_V(8); PG8_WAIT_L(0); PG8_BAR; PG8_MMA(0, 0, At, B0); PG8_MMA(0, 1, At, B1); PG8_BAR2; PG8_SCHED;
            if constexpr (Sched::GATHER) { if (last && has_next) {
                int tz = threadIdx.x; asm volatile("" : "+v"(tz));
#pragma unroll
                for (int i = 0; i < 2; ++i) { int R, C; stage_rc(tz * 16 + i * 8192, R, C);
#pragma unroll
                    for (int h = 0; h < 2; ++h) vA[h][i] = (unsigned)(lidx[h * HALF + R] * RP + C * 2); } } }
            PG8_LDA(At, 0, 1); PG8_STAGE(PG8_SB(0, 0), b2, voffB); PG8_STAGE(PG8_SB(0, 1), b2 + hstep, voffB); PG8_STAGE(PG8_SA(0, 0), a2, vA[0]);
            PG8_WAIT_V(8); PG8_WAIT_L(0); PG8_BAR; PG8_MMA(1, 0, At, B0); PG8_MMA(1, 1, At, B1); PG8_BAR2; PG8_SCHED;
            PG8_LDB(B0, 1, 0); PG8_LDB(B1, 1, 1); PG8_SCHED; PG8_LDA(At, 1, 0); PG8_STAGE(PG8_SA(0, 1), a2, vA[1]);
            PG8_WAIT_V(8); PG8_WAIT_L(0); PG8_BAR; PG8_MMA(0, 0, At, B0); PG8_MMA(0, 1, At, B1); PG8_BAR2; PG8_SCHED;
            PG8_LDA(At, 1, 1); PG8_STAGE(PG8_SB(1, 0), b3, voffB); PG8_STAGE(PG8_SB(1, 1), b3 + hstep, voffB); PG8_STAGE(PG8_SA(1, 0), a3, vA[0]);
            PG8_WAIT_V(8); PG8_WAIT_L(0); PG8_BAR; PG8_MMA(1, 0, At, B0); PG8_MMA(1, 1, At, B1); PG8_BAR2; PG8_SCHED;
            if constexpr (Sched::GATHER) { if (t == 0 && has_next && tid < 256) lidx[tid] = (tid < nxt.avalid) ? gi : 0; }
        }
        if constexpr (F8) asm volatile("s_nop 15\n\ts_nop 15" ::: "memory");
        if (wr == 0) PG8_BAR;
        { int tz = threadIdx.x; asm volatile("" : "+v"(tz)); const int ewid = __builtin_amdgcn_readfirstlane(tz >> 6), el = tz & 63;
          E(acc, cur, epre, ewid >> 2, ewid & 3, el & 15, el >> 4); }
        if (!has_next) break;
#pragma unroll
        for (int a = 0; a < 2; ++a)
#pragma unroll
            for (int b = 0; b < 2; ++b)
#pragma unroll
                for (int m = 0; m < 4; ++m)
#pragma unroll
                    for (int n = 0; n < 2; ++n) acc[a][b][m][n] = (f32x4){0.f, 0.f, 0.f, 0.f};
        cur = nxt; cA = nA; cB = nB; crot = nrot; ++ui;
        E.prefetch(cur, epre);
        if (wr == 1) PG8_BAR;
    }
    PG8_WAIT_V(0);
    PG8_BAR;
#undef PG8_KT
#undef PG8_SA
#undef PG8_SB
#undef PG8_STAGE
#undef PG8_LDA
#undef PG8_LDB
#undef PG8_MMA
#undef PG8_CAT
#undef PG8_LO
#undef PG8_HI
#undef PG8_WAIT_V
#undef PG8_WAIT_L
#undef PG8_BAR
#undef PG8_BAR2
#undef PG8_SCHED
}

__device__ __forceinline__ bool tile_order(long L, int nM, int nN, int& pm, int& pn) {
    const int nwg = nM * nN; if (L >= nwg) return false;
    int wgid = (int)L; { const int q = nwg / 8, r = nwg % 8, xcd = wgid % 8, off = wgid / 8; wgid = (xcd < r ? xcd * (q + 1) : r * (q + 1) + (xcd - r) * q) + off; }
    const int nig = 8 * nN, gid = wgid / nig, fm = gid * 8, gsz = (nM - fm) < 8 ? (nM - fm) : 8;
    pm = fm + ((wgid % nig) % gsz); pn = (wgid % nig) / gsz; return true;
}
template <int CRIP_ = 0> struct SchedDenseT {
    static constexpr bool GATHER = false, FP8 = false; static constexpr int ROWB = 4096, CRIP = CRIP_;
    const char* A; const char* Bt; int nM, nN, G, c;
    __device__ __forceinline__ bool next(int i, Unit& u) const {
        int pm, pn; if (!tile_order((long)i * G + c, nM, nN, pm, pn)) return false;
        u.pm = pm; u.pn = pn; u.e = 0; u.aidx = nullptr; u.avalid = 256;
        u.aBase = A + (size_t)pm * 256 * GK * 2; u.bBase = Bt + (size_t)pn * 256 * GK * 2;
        if constexpr ((CRIP_ & 64) != 0) u.bBase = Bt;
        if constexpr ((CRIP_ & 128) != 0) u.aBase = A;
        return true;
    }
};
typedef SchedDenseT<0> SchedDense;
struct SchedQueue {
    static constexpr bool GATHER = false, FP8 = false; static constexpr int ROWB = 4096, CRIP = 0;
    const char* A; const char* Bt; int nM, nN, q, xcd; unsigned* tick; LAS int* tk;
    __device__ __forceinline__ bool next(int i, Unit& u) const {
        const int t = __builtin_amdgcn_readfirstlane(tk[i & 1]);
        if (i > 0 && threadIdx.x == 0) tk[(i + 1) & 1] = (int)__hip_atomic_fetch_add(tick, 1u, __ATOMIC_RELAXED, __HIP_MEMORY_SCOPE_AGENT);
        if (t >= q) return false;
        const int id = xcd * q + t, nig = 8 * nN, gid = id / nig, fm = gid * 8, gsz = (nM - fm) < 8 ? (nM - fm) : 8;
        const int pm = fm + ((id % nig) % gsz), pn = (id % nig) / gsz;
        u.pm = pm; u.pn = pn; u.e = 0; u.aidx = nullptr; u.avalid = 256;
        u.aBase = A + (size_t)pm * 256 * ROWB; u.bBase = Bt + (size_t)pn * 256 * ROWB; return true;
    }
};
template <bool GATHER_, int CRIP_ = 0> struct SchedMoE {
    static constexpr bool GATHER = GATHER_ && !(CRIP_ & 32), FP8 = true; static constexpr int ROWB = 2048, CRIP = CRIP_;
    const char* A; const char* Bt; const int* stok; const LAS int* tstart; const LAS int* cnt; int nN, nrowsB  , G, c;
    __device__ __forceinline__ bool next(int i, Unit& u) const {
        const int nM = __builtin_amdgcn_readfirstlane(tstart[NE]); int pm, pn; if (!tile_order((long)i * G + c, nM, nN, pm, pn)) return false;
        int e = 0;
        for (int j = 1; j < NE; ++j) e += (tstart[j] <= pm) ? 1 : 0;
        e = __builtin_amdgcn_readfirstlane(e);
        const int mt = __builtin_amdgcn_readfirstlane(pm - tstart[e]);
        u.pm = pm; u.pn = pn; u.e = e;
        u.avalid = __builtin_amdgcn_readfirstlane(cnt[e]) - mt * 256;
        u.aidx = stok + (size_t)e * T + mt * 256;
        u.aBase = GATHER ? A : A + (size_t)(GATHER_ ? (pm & 127) : pm) * 256 * ROWB;
        u.bBase = Bt + ((size_t)e * nrowsB + (size_t)pn * 256) * ROWB;
        if constexpr ((CRIP_ & 8) != 0) { u.aBase = A; u.bBase = Bt; }
        return true;
    }
};
}

struct EpiNoPre { };
struct EpiInProj {
    static constexpr bool PERM = true; typedef EpiNoPre Pre;
    bf16* proj; float* dtraw;
    __device__ __forceinline__ void prefetch(const pg8::Unit&, Pre&) const {}
    __device__ __forceinline__ void operator()(const f32x4 (&acc)[2][2][4][2], const pg8::Unit& u, const Pre&, int wr, int wc, int fr, int fq) const {
        const int row0 = u.pm * 256 + wr * 64 + fr;
        if (u.pn < 15) {
            const int col0 = u.pn * 256 + wc * 32 + 8 * fq;
#pragma unroll
            for (int ai = 0; ai < 2; ++ai)
#pragma unroll
                for (int m = 0; m < 4; ++m) { bf16* rowp = proj + (size_t)(row0 + ai * 128 + m * 16) * PROJ_LD + col0;
#pragma unroll
                    for (int bj = 0; bj < 2; ++bj) { const f32x4 v0 = acc[ai][bj][m][0], v1 = acc[ai][bj][m][1];
                        v4u w; w.x = pk2(v0[0], v0[1]); w.y = pk2(v0[2], v0[3]); w.z = pk2(v1[0], v1[1]); w.w = pk2(v1[2], v1[3]);
                        *(v4u*)(rowp + bj * 128) = w; } }
        } else if (wc == 0 && fq < 2) {
#pragma unroll
            for (int ai = 0; ai < 2; ++ai)
#pragma unroll
                for (int m = 0; m < 4; ++m) { float* rowp = dtraw + (size_t)(row0 + ai * 128 + m * 16) * 16 + 8 * fq;
                    *(f32x4*)(rowp) = acc[ai][0][m][0]; *(f32x4*)(rowp + 4) = acc[ai][0][m][1]; }
        }
    }
};
struct EpiOutProj {
    static constexpr bool PERM = true; typedef EpiNoPre Pre;
    const float* x; bf16* x1; float* ssq;
    __device__ __forceinline__ void prefetch(const pg8::Unit&, Pre&) const {}
    __device__ __forceinline__ void operator()(const f32x4 (&acc)[2][2][4][2], const pg8::Unit& u, const Pre&, int wr, int wc, int fr, int fq) const {
        const int row0 = u.pm * 256 + wr * 64 + fr, col0 = u.pn * 256 + wc * 32 + 8 * fq;
#pragma unroll
        for (int ai = 0; ai < 2; ++ai) {
            f32x4 xv[4][2][2];
#pragma unroll
            for (int m = 0; m < 4; ++m)
#pragma unroll
                for (int bj = 0; bj < 2; ++bj)
#pragma unroll
                    for (int n = 0; n < 2; ++n) xv[m][bj][n] = *(const f32x4*)(x + (size_t)(row0 + ai * 128 + m * 16) * D + col0 + bj * 128 + n * 4);
#pragma unroll
            for (int m = 0; m < 4; ++m) { asm volatile("" : "+v"(xv[m][0][0]), "+v"(xv[m][0][1]), "+v"(xv[m][1][0]), "+v"(xv[m][1][1])); }
#pragma unroll
            for (int m = 0; m < 4; ++m) { const int row = row0 + ai * 128 + m * 16; const size_t off = (size_t)row * D + col0; float s = 0.f;
#pragma unroll
                for (int bj = 0; bj < 2; ++bj) { const f32x4 o0 = xv[m][bj][0] + acc[ai][bj][m][0], o1 = xv[m][bj][1] + acc[ai][bj][m][1];
                    *(v4u*)(x1 + off + bj * 128) = (v4u){pk2(o0[0], o0[1]), pk2(o0[2], o0[3]), pk2(o1[0], o1[1]), pk2(o1[2], o1[3])};
                    s += ((o0[0] * o0[0] + o0[1] * o0[1]) + (o0[2] * o0[2] + o0[3] * o0[3])) + ((o1[0] * o1[0] + o1[1] * o1[1]) + (o1[2] * o1[2] + o1[3] * o1[3])); }
                s += __shfl_xor(s, 16); s += __shfl_xor(s, 32);
                if (fq == 0) ssq[(size_t)row * 32 + u.pn * 4 + wc] = s; }
        }
    }
};
struct EpiGateUp {
    static constexpr bool PERM = true;
    struct Pre { f32x4 bg[2], bu[2]; };
    unsigned char* hb; const float* b_gate; const float* b_up;
    __device__ __forceinline__ void prefetch(const pg8::Unit& u, Pre& q) const {
        int tz = threadIdx.x; asm volatile("" : "+v"(tz)); const int wc = (tz >> 6) & 3, fq = (tz >> 4) & 3;
        const int f0 = u.pn * 128 + wc * 32 + 8 * fq;
#pragma unroll
        for (int n = 0; n < 2; ++n) { q.bg[n] = *(const f32x4*)(b_gate + (size_t)u.e * FF + f0 + 4 * n); q.bu[n] = *(const f32x4*)(b_up + (size_t)u.e * FF + f0 + 4 * n); }
    }
    __device__ __forceinline__ void operator()(const f32x4 (&acc)[2][2][4][2], const pg8::Unit& u, const Pre& q, int wr, int wc, int fr, int fq) const {
        const int row0 = u.pm * 256 + wr * 64 + fr, f0 = u.pn * 128 + wc * 32 + 8 * fq;
        constexpr float DS = 1.0f / (FP8_SA * FP8_SW);
#pragma unroll
        for (int ai = 0; ai < 2; ++ai)
#pragma unroll
            for (int m = 0; m < 4; ++m) { unsigned char* rowp = hb + (size_t)(row0 + ai * 128 + m * 16) * FF + f0; float h[8];
#pragma unroll
                for (int n = 0; n < 2; ++n)
#pragma unroll
                    for (int j = 0; j < 4; ++j) { const float g = acc[ai][0][m][n][j] * DS + q.bg[n][j], up = acc[ai][1][m][n][j] * DS + q.bu[n][j];
                        const float gl = fminf(g, 7.0f), li = __builtin_amdgcn_fmed3f(up, -7.0f, 7.0f);
                        const float sg = __builtin_amdgcn_rcpf(1.0f + __builtin_amdgcn_exp2f(gl * (-1.702f * 1.44269504f)));
                        h[n * 4 + j] = (gl * sg) * (li * FP8_SH + FP8_SH); }
                *(v2u*)rowp = (v2u){pk4_fp8(h[0], h[1], h[2], h[3]), pk4_fp8(h[4], h[5], h[6], h[7])}; }
    }
};
struct EpiDown {
    static constexpr bool PERM = true;
    struct Pre { f32x4 bv[2][2]; float gt[2][4]; };
    unsigned char* y2; const float* b_down; const float* sgate; const LAS int* tstart;
    __device__ __forceinline__ void prefetch(const pg8::Unit& u, Pre& q) const {
        int tz = threadIdx.x; asm volatile("" : "+v"(tz)); const int wid = tz >> 6, wr = wid >> 2, wc = wid & 3, fr = tz & 15, fq = (tz >> 4) & 3;
        const int rl0 = wr * 64 + fr, col0 = u.pn * 256 + wc * 32 + 8 * fq;
        const int mt = __builtin_amdgcn_readfirstlane(u.pm - tstart[u.e]);
        const float* gp = sgate + (size_t)u.e * T + mt * 256;
#pragma unroll
        for (int bj = 0; bj < 2; ++bj)
#pragma unroll
            for (int n = 0; n < 2; ++n) q.bv[bj][n] = *(const f32x4*)(b_down + (size_t)u.e * D + col0 + bj * 128 + 4 * n);
#pragma unroll
        for (int ai = 0; ai < 2; ++ai)
#pragma unroll
            for (int m = 0; m < 4; ++m) q.gt[ai][m] = gp[rl0 + ai * 128 + m * 16];
    }
    __device__ __forceinline__ void operator()(const f32x4 (&acc)[2][2][4][2], const pg8::Unit& u, const Pre& q, int wr, int wc, int fr, int fq) const {
        const int rl0 = wr * 64 + fr, col0 = u.pn * 256 + wc * 32 + 8 * fq;
        constexpr float DS = 1.0f / (FP8_SH * FP8_SW);
#pragma unroll
        for (int ai = 0; ai < 2; ++ai)
#pragma unroll
            for (int m = 0; m < 4; ++m) { const int rl = rl0 + ai * 128 + m * 16; const float gt = q.gt[ai][m] * FP8_SY; unsigned char* rowp = y2 + (size_t)(u.pm * 256 + rl) * D + col0;
#pragma unroll
                for (int bj = 0; bj < 2; ++bj) { const f32x4 v0 = (acc[ai][bj][m][0] * DS + q.bv[bj][0]) * gt, v1 = (acc[ai][bj][m][1] * DS + q.bv[bj][1]) * gt;
                    *(v2u*)(rowp + bj * 128) = (v2u){pk4_fp8(sat8(v0[0]), sat8(v0[1]), sat8(v0[2]), sat8(v0[3])), pk4_fp8(sat8(v1[0]), sat8(v1[1]), sat8(v1[2]), sat8(v1[3]))}; } }
    }
};

__device__ __forceinline__ void p0_tr_item(const float* W, int ldw, int k0, int n0, int nvalid, bf16* WT, int dst_row0, LAS float* scr, int lane) {
    const int c4 = (lane & 15) * 4, kr = lane >> 4;
#pragma unroll 4
    for (int i = 0; i < 16; ++i) { const int kk = 4 * i + kr;
        f32x4 v = (f32x4){0.f, 0.f, 0.f, 0.f};
        if (c4 < nvalid) v = *(const f32x4*)(W + (size_t)(k0 + kk) * ldw + n0 + c4);
        LAS float* d = scr + kk * 65 + c4; d[0] = v[0]; d[1] = v[1]; d[2] = v[2]; d[3] = v[3]; }
    LDS_WAIT(); asm volatile("" ::: "memory");
    const int c = lane >> 3, np = lane & 7;
#pragma unroll
    for (int j = 0; j < 8; ++j) { const int n = 8 * j + np; const LAS float* s = scr + (8 * c) * 65 + n;
        v4u o; o.x = pk2(s[0 * 65], s[1 * 65]); o.y = pk2(s[2 * 65], s[3 * 65]); o.z = pk2(s[4 * 65], s[5 * 65]); o.w = pk2(s[6 * 65], s[7 * 65]);
        *(v4u*)(WT + (size_t)(dst_row0 + n) * 2048 + k0 + 8 * c) = o; }
    LDS_WAIT(); asm volatile("" ::: "memory");
}
__device__ __forceinline__ void f8_tile_load(const float* src, f32x4 (&v)[16], int lane) {
    const float* s0 = src + (size_t)(16 * (lane >> 3)) * 2048 + 4 * (lane & 7);
#pragma unroll
    for (int i = 0; i < 16; ++i) v[i] = __builtin_nontemporal_load((const f32x4*)(s0 + (size_t)i * 2048));
}
__device__ __forceinline__ void f8_tile_store(const f32x4 (&v)[16], unsigned char* dst, int lane) {
    unsigned d[16];
#pragma unroll
    for (int i = 0; i < 16; ++i) d[i] = pk4_fp8(sat8(v[i][0] * FP8_SW), sat8(v[i][1] * FP8_SW), sat8(v[i][2] * FP8_SW), sat8(v[i][3] * FP8_SW));
    unsigned o[4][4];
#pragma unroll
    for (int w = 0; w < 4; ++w) {
        const unsigned t0 = __builtin_amdgcn_perm(d[4 * w + 1], d[4 * w], 0x05010400u), t1 = __builtin_amdgcn_perm(d[4 * w + 1], d[4 * w], 0x07030602u);
        const unsigned t2 = __builtin_amdgcn_perm(d[4 * w + 3], d[4 * w + 2], 0x05010400u), t3 = __builtin_amdgcn_perm(d[4 * w + 3], d[4 * w + 2], 0x07030602u);
        o[0][w] = __builtin_amdgcn_perm(t2, t0, 0x05040100u); o[1][w] = __builtin_amdgcn_perm(t2, t0, 0x07060302u);
        o[2][w] = __builtin_amdgcn_perm(t3, t1, 0x05040100u); o[3][w] = __builtin_amdgcn_perm(t3, t1, 0x07060302u);
    }
    unsigned char* d0 = dst + (size_t)(4 * (lane & 7)) * 2048 + 16 * (lane >> 3);
#pragma unroll
    for (int b = 0; b < 4; ++b) __builtin_nontemporal_store((v4u){o[b][0], o[b][1], o[b][2], o[b][3]}, (v4u*)(d0 + (size_t)b * 2048));
}
__device__ __forceinline__ void f8_item(const Params& p, int it, const float*& src, unsigned char*& dst) {
    const int which = it >> 15, r = it & 32767, e = r >> 10, q = r & 1023, kb = q >> 6, nb = q & 63;
    if (which == 2) { src = p.w_down + (size_t)e * FF * D + (size_t)(kb * 128) * D + nb * 32; dst = p.ws + WS_WD + ((size_t)e * D + nb * 32) * 2048 + kb * 128; }
    else { const int f0 = nb * 32, drow = (f0 >> 7) * 256 + which * 128 + (f0 & 127);
        src = (which == 0 ? p.w_gate : p.w_up) + (size_t)e * D * FF + (size_t)(kb * 128) * FF + f0; dst = p.ws + WS_WGU + ((size_t)e * 4096 + drow) * 2048 + kb * 128; }
}
__device__ __forceinline__ void convert_experts(const Params& p, int first, int stride, int lane) {
    constexpr int NEXP = 3 * NE * 1024;
    f32x4 va[16], vb[16]; const float* sa; unsigned char* da; const float* sb; unsigned char* db;
    int ia = first, ib;
    if (ia < NEXP) { f8_item(p, ia, sa, da); f8_tile_load(sa, va, lane); }
    for (;;) {
        if (ia >= NEXP) break;
        ib = ia + stride; if (ib < NEXP) { f8_item(p, ib, sb, db); f8_tile_load(sb, vb, lane); }
        f8_tile_store(va, da, lane);
        if (ib >= NEXP) break;
        ia = ib + stride; if (ia < NEXP) { f8_item(p, ia, sa, da); f8_tile_load(sa, va, lane); }
        f8_tile_store(vb, db, lane);
    }
}
__device__ __forceinline__ void phase_prologue(const Params& p, LAS unsigned char* lds, int gw, int NGW, int wave, int lane) {
    LAS float* scr = (LAS float*)(lds + wave * 16896);
    bf16* WIN = (bf16*)(p.ws + WS_WIN); bf16* WOUT = (bf16*)(p.ws + WS_WOUT);
    constexpr int I_IN = 32 * 64, I_OUT = 32 * 32;
    for (int it = gw; it < I_IN + I_OUT; it += NGW) {
        int r = it;
        if (r < I_IN) { const int kb = r / 64, nb = r % 64; int nv = NIN - nb * 64; nv = nv < 0 ? 0 : (nv > 64 ? 64 : nv);
            p0_tr_item(p.w_in, NIN, kb * 64, nb * 64, nv, WIN, nb * 64, scr, lane); continue; }
        r -= I_IN;
        { const int kb = r / 32, nb = r % 32; p0_tr_item(p.w_out, D, kb * 64, nb * 64, 64, WOUT, nb * 64, scr, lane); }
    }
    bf16* HN = (bf16*)(p.ws + WS_HN);
    f32x4 gw4[8];
#pragma unroll
    for (int j = 0; j < 8; ++j) gw4[j] = *((const f32x4*)p.attn_norm_w + 64 * j + lane);
    f32x4 vn[8];
    if (gw < T) { const f32x4* xr = (const f32x4*)(p.x + (size_t)gw * D) + lane;
#pragma unroll
        for (int j = 0; j < 8; ++j) vn[j] = xr[64 * j]; }
    for (int m = gw; m < T; m += NGW) {
        f32x4 v[8]; float s = 0.f;
#pragma unroll
        for (int j = 0; j < 8; ++j) v[j] = vn[j];
        if (m + NGW < T) { const f32x4* xr = (const f32x4*)(p.x + (size_t)(m + NGW) * D) + lane;
#pragma unroll
            for (int j = 0; j < 8; ++j) vn[j] = xr[64 * j]; }
#pragma unroll
        for (int j = 0; j < 8; ++j) s += (v[j][0] * v[j][0] + v[j][1] * v[j][1]) + (v[j][2] * v[j][2] + v[j][3] * v[j][3]);
        const float rstd = rsqrtf(wave_sum(s) * (1.f / D) + EPS);
        v2u* o8 = (v2u*)(HN + (size_t)m * D) + lane;
#pragma unroll
        for (int j = 0; j < 8; ++j) { v2u w; w.x = pk2(v[j][0] * rstd * gw4[j][0], v[j][1] * rstd * gw4[j][1]); w.y = pk2(v[j][2] * rstd * gw4[j][2], v[j][3] * rstd * gw4[j][3]); o8[64 * j] = w; }
    }
}

__device__ __forceinline__ void phase_conv(const Params& p, int G) {
    const bf16* proj = (const bf16*)(p.ws + WS_PROJ); float* xbc = (float*)(p.ws + WS_XBC);
    const float* dtraw = (const float*)(p.ws + WS_DT); float* dts = (float*)(p.ws + WS_DTS);
    const int tid = threadIdx.x;
    for (int item = blockIdx.x; item < T / 64; item += G) {
        const int t0 = item * 64;
        if (tid < 384) {
            const int cg = tid % 192, half = tid / 192, c0 = cg * 8, ts = t0 + half * 32;
            float w[4][8], bb[8];
#pragma unroll
            for (int k = 0; k < 4; ++k)
#pragma unroll
                for (int j = 0; j < 8; ++j) w[k][j] = p.conv_w[k * NXBC + c0 + j];
#pragma unroll
            for (int j = 0; j < 8; ++j) bb[j] = p.conv_b[c0 + j];
            float r0[8], r1[8], r2[8];
            {
                const int tl = ts % SEQ;
                v4u q0 = (v4u){0u, 0u, 0u, 0u}, q1 = q0, q2 = q0;
                if (tl - 3 >= 0) q0 = *(const v4u*)(proj + (size_t)(ts - 3) * PROJ_LD + COL_XBC + c0);
                if (tl - 2 >= 0) q1 = *(const v4u*)(proj + (size_t)(ts - 2) * PROJ_LD + COL_XBC + c0);
                if (tl - 1 >= 0) q2 = *(const v4u*)(proj + (size_t)(ts - 1) * PROJ_LD + COL_XBC + c0);
                unpack8(q0, r0); unpack8(q1, r1); unpack8(q2, r2);
            }
            for (int i = 0; i < 32; ++i) {
                const int t = ts + i;
                const v4u q = *(const v4u*)(proj + (size_t)t * PROJ_LD + COL_XBC + c0);
                float r3[8]; unpack8(q, r3);
                float o[8];
#pragma unroll
                for (int j = 0; j < 8; ++j) { const float a = bb[j] + w[0][j] * r0[j] + w[1][j] * r1[j] + w[2][j] * r2[j] + w[3][j] * r3[j]; o[j] = a * fsigmoid(a); }
                float* dp = xbc + (size_t)t * NXBC + c0;
                *(f32x4*)dp = (f32x4){o[0], o[1], o[2], o[3]}; *(f32x4*)(dp + 4) = (f32x4){o[4], o[5], o[6], o[7]};
#pragma unroll
                for (int j = 0; j < 8; ++j) { r0[j] = r1[j]; r1[j] = r2[j]; r2[j] = r3[j]; }
            }
        } else {
            const int u = tid - 384;
#pragma unroll
            for (int i = 0; i < 8; ++i) { const int idx = u + 128 * i; const int t = t0 + (idx >> 4), h = idx & 15;
                const float v = dtraw[(size_t)t * 16 + h] + p.dt_bias[h];
                dts[(size_t)t * 16 + h] = fmaxf(v, 0.f) + log1pf(__expf(-fabsf(v))); }
        }
    }
}

__device__ __forceinline__ void phase_attn_simple(const Params& p, LAS unsigned char* lds, int G) {
    const bf16* proj = (const bf16*)(p.ws + WS_PROJ); float* att = (float*)(p.ws + WS_ATT);
    LAS float* Ks = (LAS float*)lds; LAS float* Vs = (LAS float*)(lds + 256 * 68 * 4);
    const int tid = threadIdx.x;
    for (int item = blockIdx.x; item < NB * 64 * 2; item += G) {
        const int b = item >> 7, n = (item >> 1) & 63, hk = item & 1;
        __syncthreads();
        {
            const int j = tid >> 1, hf = tid & 1, pos = n * 128 - 128 + j;
            float kv[32], vv[32];
            if (pos >= 0) {
                const bf16* kp = proj + (size_t)(b * SEQ + pos) * PROJ_LD + COL_K + hk * 64 + hf * 32;
                const bf16* vp = proj + (size_t)(b * SEQ + pos) * PROJ_LD + COL_V + hk * 64 + hf * 32;
#pragma unroll
                for (int c = 0; c < 4; ++c) { const v4u a = *(const v4u*)(kp + 8 * c), bq = *(const v4u*)(vp + 8 * c);
                    kv[8 * c + 0] = bflo(a.x); kv[8 * c + 1] = bfhi(a.x); kv[8 * c + 2] = bflo(a.y); kv[8 * c + 3] = bfhi(a.y); kv[8 * c + 4] = bflo(a.z); kv[8 * c + 5] = bfhi(a.z); kv[8 * c + 6] = bflo(a.w); kv[8 * c + 7] = bfhi(a.w);
                    vv[8 * c + 0] = bflo(bq.x); vv[8 * c + 1] = bfhi(bq.x); vv[8 * c + 2] = bflo(bq.y); vv[8 * c + 3] = bfhi(bq.y); vv[8 * c + 4] = bflo(bq.z); vv[8 * c + 5] = bfhi(bq.z); vv[8 * c + 6] = bflo(bq.w); vv[8 * c + 7] = bfhi(bq.w); }
            } else {
#pragma unroll
                for (int d = 0; d < 32; ++d) { kv[d] = 0.f; vv[d] = 0.f; }
            }
            float s = 0.f;
#pragma unroll
            for (int d = 0; d < 32; ++d) s += kv[d] * kv[d];
            s += __shfl_xor(s, 1);
            const float rstd = rsqrtf(s * (1.f / 64.f) + EPS);
#pragma unroll
            for (int d = 0; d < 32; ++d) { Ks[j * 68 + hf * 32 + d] = kv[d] * rstd * p.k_norm_w[hf * 32 + d]; Vs[j * 68 + hf * 32 + d] = vv[d]; }
        }
        __syncthreads();
        const int qi = tid & 127, grp = tid >> 7;
        const int tok = b * SEQ + n * 128 + qi;
        for (int hh = 0; hh < 2; ++hh) {
            const int hq = hk * 8 + grp * 2 + hh;
            float q[64];
            {
                const bf16* qp = proj + (size_t)tok * PROJ_LD + COL_Q + hq * 64;
                float s = 0.f;
#pragma unroll
                for (int c = 0; c < 8; ++c) { const v4u a = *(const v4u*)(qp + 8 * c);
                    q[8 * c + 0] = bflo(a.x); q[8 * c + 1] = bfhi(a.x); q[8 * c + 2] = bflo(a.y); q[8 * c + 3] = bfhi(a.y); q[8 * c + 4] = bflo(a.z); q[8 * c + 5] = bfhi(a.z); q[8 * c + 6] = bflo(a.w); q[8 * c + 7] = bfhi(a.w); }
#pragma unroll
                for (int d = 0; d < 64; ++d) s += q[d] * q[d];
                const float rstd = rsqrtf(s * (1.f / 64.f) + EPS) * 0.125f;
#pragma unroll
                for (int d = 0; d < 64; ++d) q[d] = q[d] * rstd * p.q_norm_w[d];
            }
            float mx = p.sinks[hq], l = 1.0f, o[64];
#pragma unroll
            for (int d = 0; d < 64; ++d) o[d] = 0.f;
            const int jlo = (n == 0) ? 128 : qi + 1;
            for (int j = jlo; j <= qi + 128; ++j) {
                const LAS f32x4* kr = (const LAS f32x4*)(Ks + j * 68);
                float s = 0.f;
#pragma unroll
                for (int c = 0; c < 16; ++c) { const f32x4 kk = kr[c]; s += q[4 * c] * kk[0] + q[4 * c + 1] * kk[1] + q[4 * c + 2] * kk[2] + q[4 * c + 3] * kk[3]; }
                const float mn = fmaxf(mx, s), corr = __expf(mx - mn), pj = __expf(s - mn);
                l = l * corr + pj; mx = mn;
                const LAS f32x4* vr = (const LAS f32x4*)(Vs + j * 68);
#pragma unroll
                for (int c = 0; c < 16; ++c) { const f32x4 vv = vr[c]; o[4 * c] = o[4 * c] * corr + pj * vv[0]; o[4 * c + 1] = o[4 * c + 1] * corr + pj * vv[1]; o[4 * c + 2] = o[4 * c + 2] * corr + pj * vv[2]; o[4 * c + 3] = o[4 * c + 3] * corr + pj * vv[3]; }
            }
            const float inv = 1.0f / l;
            float* op = att + (size_t)tok * 1024 + hq * 64;
#pragma unroll
            for (int c = 0; c < 16; ++c) *(f32x4*)(op + 4 * c) = (f32x4){o[4 * c] * inv, o[4 * c + 1] * inv, o[4 * c + 2] * inv, o[4 * c + 3] * inv};
        }
    }
}

__device__ __forceinline__ void phase_ssd_seq(const Params& p, LAS unsigned char* lds, int G) {
    const float* xbc = (const float*)(p.ws + WS_XBC); const float* dts = (const float*)(p.ws + WS_DTS); float* ys = (float*)(p.ws + WS_YS);
    constexpr int TT = 64;
    LAS float* Bs = (LAS float*)lds;
    LAS float* Cs = Bs + TT * 128;
    LAS float* xs = Cs + TT * 128;
    LAS float* dl = xs + TT * 16;
    LAS float* yo = dl + TT;
    const int tid = threadIdx.x, pl = tid >> 5, ns = tid & 31;
    for (int item = blockIdx.x; item < NB * 16 * 4; item += G) {
        const int b = item >> 6, h = (item >> 2) & 15, pq = item & 3, g = h >> 3;
        const float a = -__expf(p.a_log[h]), dsk = p.d_skip[h];
        f32x4 st = (f32x4){0.f, 0.f, 0.f, 0.f};
        for (int tc = 0; tc < SEQ; tc += TT) {
            __syncthreads();
            const size_t tb = (size_t)b * SEQ + tc;
            for (int i = tid; i < TT * 32; i += NTHREADS) { const int tt = i >> 5, c = (i & 31) * 4;
                *(LAS f32x4*)(Bs + tt * 128 + c) = *(const f32x4*)(xbc + (tb + tt) * NXBC + 1024 + g * 128 + c);
                *(LAS f32x4*)(Cs + tt * 128 + c) = *(const f32x4*)(xbc + (tb + tt) * NXBC + 1280 + g * 128 + c); }
            for (int i = tid; i < TT * 16; i += NTHREADS) { const int tt = i >> 4, c = i & 15; xs[i] = xbc[(tb + tt) * NXBC + h * 64 + pq * 16 + c]; }
            if (tid < TT) dl[tid] = dts[(tb + tid) * 16 + h];
            __syncthreads();
            for (int tt = 0; tt < TT; ++tt) {
                const float dt = dl[tt], xv = xs[tt * 16 + pl];
                const float dA = __expf(dt * a), xd = xv * dt;
                const f32x4 bv = *(const LAS f32x4*)(Bs + tt * 128 + ns * 4), cv = *(const LAS f32x4*)(Cs + tt * 128 + ns * 4);
                st = st * dA + bv * xd;
                float y = (cv[0] * st[0] + cv[1] * st[1]) + (cv[2] * st[2] + cv[3] * st[3]);
                y += __shfl_xor(y, 1); y += __shfl_xor(y, 2); y += __shfl_xor(y, 4); y += __shfl_xor(y, 8); y += __shfl_xor(y, 16);
                if (ns == 0) yo[tt * 16 + pl] = y + dsk * xv;
            }
            __syncthreads();
            for (int i = tid; i < TT * 16; i += NTHREADS) { const int tt = i >> 4, c = i & 15; ys[(tb + tt) * 1024 + h * 64 + pq * 16 + c] = yo[i]; }
        }
    }
}


typedef float f32x16 __attribute__((ext_vector_type(16)));
#define MFMA32(a, b, c) __builtin_amdgcn_mfma_f32_32x32x16_bf16(a, b, c, 0, 0, 0)
constexpr int SPT = 136;
__device__ __forceinline__ float softplus_f(float v) { return fmaxf(v, 0.f) + log1pf(__expf(-fabsf(v))); }

__device__ __forceinline__ void ssd_tables(const Params& p, LAS float* dtl, LAS float* csl, LAS float* wtot, size_t trow0, int h0, int nh, int lane, int wave) {
    const float* dtraw = (const float*)(p.ws + WS_DT);
    for (int rnd = 0; rnd < nh / 4; ++rnd) {
        const int hh = rnd * 4 + (wave >> 1), l = (wave & 1) * 64 + lane, h = h0 + hh;
        const float dt = softplus_f(dtraw[(trow0 + l) * 16 + h] + p.dt_bias[h]);
        float v = dt * (-expf(p.a_log[h]));
#pragma unroll
        for (int o = 1; o < 64; o <<= 1) { const float u = __shfl_up(v, o); v = (lane >= o) ? v + u : v; }
        if (lane == 63) wtot[rnd * 8 + wave] = v;
        __syncthreads();
        if (wave & 1) v += wtot[rnd * 8 + wave - 1];
        dtl[hh * 128 + l] = dt; csl[hh * 128 + l] = v;
    }
    __syncthreads();
}
template <bool TR, bool SCALE>
__device__ __forceinline__ void conv_task(const Params& p, const bf16* proj, size_t trow0, int tl0, int run, int xcol, LAS bf16* dst, int d0, const LAS float* sc) {
    float w[4][8], bb[8];
#pragma unroll
    for (int k = 0; k < 4; ++k) { const f32x4 a = *(const f32x4*)(p.conv_w + k * NXBC + xcol), b = *(const f32x4*)(p.conv_w + k * NXBC + xcol + 4);
        w[k][0] = a[0]; w[k][1] = a[1]; w[k][2] = a[2]; w[k][3] = a[3]; w[k][4] = b[0]; w[k][5] = b[1]; w[k][6] = b[2]; w[k][7] = b[3]; }
    { const f32x4 a = *(const f32x4*)(p.conv_b + xcol), b = *(const f32x4*)(p.conv_b + xcol + 4); bb[0] = a[0]; bb[1] = a[1]; bb[2] = a[2]; bb[3] = a[3]; bb[4] = b[0]; bb[5] = b[1]; bb[6] = b[2]; bb[7] = b[3]; }
    const int l0 = run * 8; const bf16* src = proj + (trow0 + l0) * PROJ_LD + COL_XBC + xcol;
    float r0[8], r1[8], r2[8];
    { const int pos = tl0 + l0; v4u q0 = (v4u){0u, 0u, 0u, 0u}, q1 = q0, q2 = q0;
      if (pos - 3 >= 0) q0 = *(const v4u*)(src - 3 * PROJ_LD);
      if (pos - 2 >= 0) q1 = *(const v4u*)(src - 2 * PROJ_LD);
      if (pos - 1 >= 0) q2 = *(const v4u*)(src - 1 * PROJ_LD);
      unpack8(q0, r0); unpack8(q1, r1); unpack8(q2, r2); }
#pragma unroll
    for (int i = 0; i < 8; i += 2) {
        float r3[8], r4[8], o0[8], o1[8];
        unpack8(*(const v4u*)(src + (size_t)i * PROJ_LD), r3); unpack8(*(const v4u*)(src + (size_t)(i + 1) * PROJ_LD), r4);
#pragma unroll
        for (int j = 0; j < 8; ++j) { const float a0 = bb[j] + w[0][j] * r0[j] + w[1][j] * r1[j] + w[2][j] * r2[j] + w[3][j] * r3[j];
            const float a1 = bb[j] + w[0][j] * r1[j] + w[1][j] * r2[j] + w[2][j] * r3[j] + w[3][j] * r4[j];
            o0[j] = a0 * fsigmoid(a0); o1[j] = a1 * fsigmoid(a1); }
        if constexpr (TR) {
            float s0 = 1.f, s1 = 1.f; if constexpr (SCALE) { s0 = sc[l0 + i]; s1 = sc[l0 + i + 1]; }
#pragma unroll
            for (int j = 0; j < 8; ++j) *(LAS unsigned*)(dst + (d0 + j) * SPT + l0 + i) = pk2(o0[j] * s0, o1[j] * s1);
        } else {
            *(LAS v4u*)(dst + (l0 + i) * SPT + d0) = (v4u){pk2(o0[0], o0[1]), pk2(o0[2], o0[3]), pk2(o0[4], o0[5]), pk2(o0[6], o0[7])};
            *(LAS v4u*)(dst + (l0 + i + 1) * SPT + d0) = (v4u){pk2(o1[0], o1[1]), pk2(o1[2], o1[3]), pk2(o1[4], o1[5]), pk2(o1[6], o1[7])};
        }
#pragma unroll
        for (int j = 0; j < 8; ++j) { r0[j] = r2[j]; r1[j] = r3[j]; r2[j] = r4[j]; }
    }
}

__device__ __forceinline__ void phase_ssd_states(const Params& p, LAS unsigned char* lds, int G, int lane, int wave) {
    const bf16* proj = (const bf16*)(p.ws + WS_PROJ); float* states = (float*)(p.ws + WS_STATES); float* cdec = (float*)(p.ws + WS_CDEC);
    LAS bf16* BT = (LAS bf16*)lds;
    LAS bf16* XdT = BT + 128 * SPT;
    LAS float* dtl = (LAS float*)(lds + 384 * SPT * 2);
    LAS float* csl = dtl + 512; LAS float* scl = csl + 512; LAS float* wtot = scl + 512;
    const int tid = threadIdx.x, r = lane & 31, hf = lane >> 5;
    for (int item = blockIdx.x; item < NB * 64 * 4; item += G) {
        const int b = item >> 8, c = (item >> 2) & 63, g = (item >> 1) & 1, hh2 = item & 1;
        const int h0 = g * 8 + hh2 * 4; const size_t trow0 = (size_t)b * SEQ + c * 128; const int tl0 = c * 128;
        __syncthreads();
        ssd_tables(p, dtl, csl, wtot, trow0, h0, 4, lane, wave);
        scl[tid] = dtl[tid] * __expf(csl[(tid & ~127) + 127] - csl[tid]);
        if ((tid & 127) == 127) cdec[((size_t)b * 64 + c) * 16 + h0 + (tid >> 7)] = __expf(csl[tid]);
        __syncthreads();
        for (int task = tid; task < 48 * 16; task += NTHREADS) { const int cg = task >> 4, run = task & 15;
            if (cg < 16) conv_task<true, false>(p, proj, trow0, tl0, run, 1024 + g * 128 + cg * 8, BT, cg * 8, nullptr);
            else { const int cx = cg - 16; conv_task<true, true>(p, proj, trow0, tl0, run, h0 * 64 + cx * 8, XdT, cx * 8, scl + (cx >> 3) * 128); } }
        __syncthreads();
        const int hh = wave >> 1, nh_ = wave & 1;
        f32x16 acc[2][2];
#pragma unroll
        for (int a = 0; a < 2; ++a)
#pragma unroll
            for (int bq = 0; bq < 2; ++bq)
#pragma unroll
                for (int e = 0; e < 16; ++e) acc[a][bq][e] = 0.f;
#pragma unroll
        for (int ks = 0; ks < 8; ++ks) {
            bf16x8 af[2], bfm[2];
#pragma unroll
            for (int pt = 0; pt < 2; ++pt) af[pt] = *(const LAS bf16x8*)(XdT + (hh * 64 + pt * 32 + r) * SPT + ks * 16 + 8 * hf);
#pragma unroll
            for (int nt = 0; nt < 2; ++nt) bfm[nt] = *(const LAS bf16x8*)(BT + (nh_ * 64 + nt * 32 + r) * SPT + ks * 16 + 8 * hf);
#pragma unroll
            for (int pt = 0; pt < 2; ++pt)
#pragma unroll
                for (int nt = 0; nt < 2; ++nt) acc[pt][nt] = MFMA32(af[pt], bfm[nt], acc[pt][nt]);
        }
        float* sp = states + (((size_t)b * 64 + c) * 16 + h0 + hh) * 64 * 128;
#pragma unroll
        for (int pt = 0; pt < 2; ++pt)
#pragma unroll
            for (int nt = 0; nt < 2; ++nt)
#pragma unroll
                for (int e = 0; e < 16; ++e) sp[(pt * 32 + (e & 3) + 8 * (e >> 2) + 4 * hf) * 128 + nh_ * 64 + nt * 32 + r] = acc[pt][nt][e];
    }
}
__device__ __forceinline__ void phase_ssd_scan(const Params& p, int G) {
    const float* states = (const float*)(p.ws + WS_STATES); const float* cdec = (const float*)(p.ws + WS_CDEC); bf16* sin = (bf16*)(p.ws + WS_SIN);
    for (int idx = blockIdx.x * NTHREADS + threadIdx.x; idx < NB * 16 * 64 * 32; idx += G * NTHREADS) {
        const int n4 = idx & 31, pp = (idx >> 5) & 63, h = (idx >> 11) & 15, b = idx >> 15;
        f32x4 run = (f32x4){0.f, 0.f, 0.f, 0.f};
#pragma unroll 8
        for (int c = 0; c < 64; ++c) {
            const size_t off = ((((size_t)b * 64 + c) * 16 + h) * 64 + pp) * 128 + n4 * 4;
            const f32x4 st = *(const f32x4*)(states + off); const float dec = cdec[((size_t)b * 64 + c) * 16 + h];
            *(v2u*)(sin + off) = (v2u){pk2(run[0], run[1]), pk2(run[2], run[3])};
            run = run * dec + st;
        }
    }
}
__device__ __forceinline__ void ssd_out_pass(const Params& p, const bf16* proj, const bf16* sinp  , const LAS bf16* Cs, const LAS bf16* CB, const LAS bf16* XT,
                                             const LAS float* dth, const LAS float* csh  , LAS float* ssqh  , float Dh, size_t trow0, int h, int hh, int lsel, int r, int hf,
                                             unsigned (&yp)[2][2][8]) {
    f32x16 acc[2][2];
#pragma unroll
    for (int a = 0; a < 2; ++a)
#pragma unroll
        for (int bq = 0; bq < 2; ++bq)
#pragma unroll
            for (int e = 0; e < 16; ++e) acc[a][bq][e] = 0.f;
#pragma unroll
    for (int pt = 0; pt < 2; ++pt) {
        bf16x8 af[8];
#pragma unroll
        for (int ks = 0; ks < 8; ++ks) af[ks] = *(const bf16x8*)(sinp + (pt * 32 + r) * 128 + ks * 16 + 8 * hf);
#pragma unroll
        for (int j = 0; j < 2; ++j) { const int lt = j == 0 ? (lsel ? 1 : 0) : (lsel ? 2 : 3);
#pragma unroll
            for (int ks = 0; ks < 8; ++ks) { const bf16x8 bq = *(const LAS bf16x8*)(Cs + (lt * 32 + r) * SPT + ks * 16 + 8 * hf); acc[pt][j] = MFMA32(af[ks], bq, acc[pt][j]); } }
    }
#pragma unroll
    for (int j = 0; j < 2; ++j) { const int lt = j == 0 ? (lsel ? 1 : 0) : (lsel ? 2 : 3); const float el = __expf(csh[lt * 32 + r]);
#pragma unroll
        for (int pt = 0; pt < 2; ++pt) acc[pt][j] = acc[pt][j] * el; }
#pragma unroll
    for (int j = 0; j < 2; ++j) { const int lt = j == 0 ? (lsel ? 1 : 0) : (lsel ? 2 : 3); const int lcol = lt * 32 + r; const float csL = csh[lcol]; const int nks = 2 * lt + 2;
        for (int ks = 0; ks < nks; ++ks) { const int s0 = ks * 16 + 8 * hf;
            const v4u cbv = *(const LAS v4u*)(CB + lcol * SPT + s0);
            const f32x4 c0 = *(const LAS f32x4*)(csh + s0), c1 = *(const LAS f32x4*)(csh + s0 + 4), d0 = *(const LAS f32x4*)(dth + s0), d1 = *(const LAS f32x4*)(dth + s0 + 4);
            float cbf[8]; unpack8(cbv, cbf); float m[8];
#pragma unroll
            for (int jj = 0; jj < 8; ++jj) { const float cs_s = jj < 4 ? c0[jj & 3] : c1[jj & 3], dt_s = jj < 4 ? d0[jj & 3] : d1[jj & 3];
                float v = cbf[jj] * __expf(fminf(csL - cs_s, 0.f)) * dt_s; v = (s0 + jj <= lcol) ? v : 0.f; m[jj] = (s0 + jj == lcol) ? v + Dh : v; }
            v4u mp; mp.x = pk2(m[0], m[1]); mp.y = pk2(m[2], m[3]); mp.z = pk2(m[4], m[5]); mp.w = pk2(m[6], m[7]);
            const bf16x8 mf = __builtin_bit_cast(bf16x8, mp);
#pragma unroll
            for (int pt = 0; pt < 2; ++pt) { const bf16x8 a = *(const LAS bf16x8*)(XT + (hh * 64 + pt * 32 + r) * SPT + s0); acc[pt][j] = MFMA32(a, mf, acc[pt][j]); }
        } }
#pragma unroll
    for (int j = 0; j < 2; ++j) { const int lt = j == 0 ? (lsel ? 1 : 0) : (lsel ? 2 : 3); const size_t t = trow0 + lt * 32 + r; float ss = 0.f;
#pragma unroll
        for (int pt = 0; pt < 2; ++pt)
#pragma unroll
            for (int q = 0; q < 4; ++q) { const v2u zz = *(const v2u*)(proj + t * PROJ_LD + COL_Z + h * 64 + pt * 32 + 8 * q + 4 * hf);
                const float z0 = bflo(zz.x), z1 = bfhi(zz.x), z2 = bflo(zz.y), z3 = bfhi(zz.y);
                const float g0 = acc[pt][j][4 * q] * (z0 * fsigmoid(z0)), g1 = acc[pt][j][4 * q + 1] * (z1 * fsigmoid(z1)), g2 = acc[pt][j][4 * q + 2] * (z2 * fsigmoid(z2)), g3 = acc[pt][j][4 * q + 3] * (z3 * fsigmoid(z3));
                yp[pt][j][2 * q] = pk2(g0, g1); yp[pt][j][2 * q + 1] = pk2(g2, g3);
                ss += (g0 * g0 + g1 * g1) + (g2 * g2 + g3 * g3); }
        ss += __shfl_xor(ss, 32);
        if (hf == 0) ssqh[lt * 32 + r] = ss; }
}
__device__ __forceinline__ void ssd_out_store(const Params& p, bf16* mix, const LAS float* ssqp, size_t trow0, int h, int lsel, int r, int hf, const unsigned (&yp)[2][2][8]) {
    f32x4 w4[2][4];
#pragma unroll
    for (int pt = 0; pt < 2; ++pt)
#pragma unroll
        for (int q = 0; q < 4; ++q) w4[pt][q] = *(const f32x4*)(p.ssm_norm_w + h * 64 + pt * 32 + 8 * q + 4 * hf);
#pragma unroll
    for (int pt = 0; pt < 2; ++pt) { asm volatile("" : "+v"(w4[pt][0]), "+v"(w4[pt][1]), "+v"(w4[pt][2]), "+v"(w4[pt][3])); }
#pragma unroll
    for (int j = 0; j < 2; ++j) { const int lt = j == 0 ? (lsel ? 1 : 0) : (lsel ? 2 : 3); const int l = lt * 32 + r; const size_t t = trow0 + l;
        float tot = 0.f;
#pragma unroll
        for (int hd = 0; hd < 8; ++hd) tot += ssqp[hd * 128 + l];
        const float rstd = rsqrtf(tot * (1.f / 512.f) + EPS);
#pragma unroll
        for (int pt = 0; pt < 2; ++pt)
#pragma unroll
            for (int q = 0; q < 4; ++q) { const int col = h * 64 + pt * 32 + 8 * q + 4 * hf;
                const unsigned u0 = yp[pt][j][2 * q], u1 = yp[pt][j][2 * q + 1];
                v2u o; o.x = pk2(bflo(u0) * rstd * w4[pt][q][0], bfhi(u0) * rstd * w4[pt][q][1]); o.y = pk2(bflo(u1) * rstd * w4[pt][q][2], bfhi(u1) * rstd * w4[pt][q][3]);
                *(v2u*)(mix + t * D + 1024 + col) = o; } }
}
__device__ __forceinline__ void phase_ssd_out(const Params& p, LAS unsigned char* lds, int G, int lane, int wave) {
    const bf16* proj = (const bf16*)(p.ws + WS_PROJ); const bf16* sin = (const bf16*)(p.ws + WS_SIN); bf16* mix = (bf16*)(p.ws + WS_MIX);
    LAS bf16* Cs = (LAS bf16*)lds;
    LAS bf16* Bs = Cs + 128 * SPT;
    LAS bf16* XT = Bs + 128 * SPT;
    LAS float* dtl = (LAS float*)(lds + 512 * SPT * 2);
    LAS float* csl = dtl + 1024; LAS float* ssqp = csl + 1024; LAS float* wtot = ssqp + 1024;
    const int tid = threadIdx.x, r = lane & 31, hf = lane >> 5;
    for (int item = blockIdx.x; item < NB * 64 * 2; item += G) {
        const int b = item >> 7, c = (item >> 1) & 63, g = item & 1;
        const int h0 = g * 8; const size_t trow0 = (size_t)b * SEQ + c * 128; const int tl0 = c * 128;
        __syncthreads();
        { int tz_ = threadIdx.x; asm volatile("" : "+v"(tz_)); ssd_tables(p, dtl, csl, wtot, trow0, h0, 8, tz_ & 63, __builtin_amdgcn_readfirstlane(tz_ >> 6)); }
        int tq = threadIdx.x; asm volatile("" : "+v"(tq));
        for (int task = tq; task < 64 * 16; task += NTHREADS) { const int cg = task >> 4, run = task & 15;
            if (cg < 16) conv_task<false, false>(p, proj, trow0, tl0, run, 1280 + g * 128 + cg * 8, Cs, cg * 8, nullptr);
            else if (cg < 32) conv_task<false, false>(p, proj, trow0, tl0, run, 1024 + g * 128 + (cg - 16) * 8, Bs, (cg - 16) * 8, nullptr);
            else conv_task<true, false>(p, proj, trow0, tl0, run, h0 * 64 + (cg - 32) * 8, XT, (cg - 32) * 8, nullptr); }
        __syncthreads();
        {
            int tz_ = threadIdx.x; asm volatile("" : "+v"(tz_)); const int wave = __builtin_amdgcn_readfirstlane(tz_ >> 6), r = tz_ & 31, hf = (tz_ >> 5) & 1;
            f32x16 cb[2];
#pragma unroll
            for (int q = 0; q < 2; ++q) { const int tile = 2 * wave + q, lt = tile >> 2, st = tile & 3;
#pragma unroll
                for (int e = 0; e < 16; ++e) cb[q][e] = 0.f;
                if (st <= lt) {
#pragma unroll
                    for (int ks = 0; ks < 8; ++ks) { const bf16x8 a = *(const LAS bf16x8*)(Cs + (lt * 32 + r) * SPT + ks * 16 + 8 * hf), bq = *(const LAS bf16x8*)(Bs + (st * 32 + r) * SPT + ks * 16 + 8 * hf);
                        cb[q] = MFMA32(a, bq, cb[q]); } } }
            __syncthreads();
#pragma unroll
            for (int q = 0; q < 2; ++q) { const int tile = 2 * wave + q, lt = tile >> 2, st = tile & 3;
                if (st <= lt) {
#pragma unroll
                    for (int e = 0; e < 16; ++e) Bs[(lt * 32 + (e & 3) + 8 * (e >> 2) + 4 * hf) * SPT + st * 32 + r] = (bf16)f2bf(cb[q][e]); } }
        }
        __syncthreads();
        unsigned y0[2][2][8], y1[2][2][8];
#define FRESH_IDS() int tz_ = threadIdx.x; asm volatile("" : "+v"(tz_)); const int wv_ = __builtin_amdgcn_readfirstlane(tz_ >> 6), hh = wv_ >> 1, lsel = wv_ & 1, r_ = tz_ & 31, hf_ = (tz_ >> 5) & 1
        { FRESH_IDS(); const int h = h0 + hh;
          ssd_out_pass(p, proj, sin + (((size_t)b * 64 + c) * 16 + h) * 64 * 128, Cs, Bs, XT, dtl + hh * 128, csl + hh * 128, ssqp + hh * 128, p.d_skip[h], trow0, h, hh, lsel, r_, hf_, y0); }
        __syncthreads();
        { int tz_ = threadIdx.x; asm volatile("" : "+v"(tz_)); const int cg = tz_ >> 4, run = tz_ & 15; conv_task<true, false>(p, proj, trow0, tl0, run, (h0 + 4) * 64 + cg * 8, XT, cg * 8, nullptr); }
        __syncthreads();
        { FRESH_IDS(); const int h = h0 + 4 + hh;
          ssd_out_pass(p, proj, sin + (((size_t)b * 64 + c) * 16 + h) * 64 * 128, Cs, Bs, XT, dtl + (4 + hh) * 128, csl + (4 + hh) * 128, ssqp + (4 + hh) * 128, p.d_skip[h], trow0, h, hh, lsel, r_, hf_, y1); }
        __syncthreads();
        { FRESH_IDS(); ssd_out_store(p, mix, ssqp, trow0, h0 + hh, lsel, r_, hf_, y0); }
        { FRESH_IDS(); ssd_out_store(p, mix, ssqp, trow0, h0 + 4 + hh, lsel, r_, hf_, y1); }
#undef FRESH_IDS
    }
}


__device__ __forceinline__ void phase_attn(const Params& p, LAS unsigned char* lds, int G) {
    const bf16* proj = (const bf16*)(p.ws + WS_PROJ); bf16* mix = (bf16*)(p.ws + WS_MIX);
    constexpr int KP = 72, VP = 260; constexpr float NEG = -1.0e30f;
    LAS bf16* Ks = (LAS bf16*)lds;
    LAS bf16* VT = Ks + 2 * 256 * KP;
    LAS float* ssqp = (LAS float*)(lds + 2 * 256 * KP * 2 + 2 * 64 * VP * 2);
    for (int item = blockIdx.x; item < NB * 64; item += G) {
        const int b = item >> 6, n = item & 63;
        __syncthreads();
        {
            int tz = threadIdx.x; asm volatile("" : "+v"(tz));
            const int j = tz >> 1, hk = tz & 1, pos = n * 128 - 128 + j;
            LAS bf16* kd = Ks + (hk * 256 + j) * KP; LAS bf16* vd = VT + hk * 64 * VP + j;
            if (pos >= 0) {
                const bf16* kp = proj + (size_t)(b * SEQ + pos) * PROJ_LD + COL_K + hk * 64;
                v4u kq[8]; float ss = 0.f;
#pragma unroll
                for (int c = 0; c < 8; ++c) { kq[c] = *(const v4u*)(kp + 8 * c); float f[8]; unpack8(kq[c], f);
#pragma unroll
                    for (int e = 0; e < 8; ++e) ss += f[e] * f[e]; }
                const float rstd = rsqrtf(ss * (1.f / 64.f) + EPS);
#pragma unroll
                for (int c = 0; c < 8; ++c) { float f[8]; unpack8(kq[c], f); const f32x4 w0 = *(const f32x4*)(p.k_norm_w + 8 * c), w1 = *(const f32x4*)(p.k_norm_w + 8 * c + 4);
                    *(LAS v4u*)(kd + 8 * c) = (v4u){pk2(f[0] * rstd * w0[0], f[1] * rstd * w0[1]), pk2(f[2] * rstd * w0[2], f[3] * rstd * w0[3]), pk2(f[4] * rstd * w1[0], f[5] * rstd * w1[1]), pk2(f[6] * rstd * w1[2], f[7] * rstd * w1[3])}; }
                const bf16* vp = kp + (COL_V - COL_K);
#pragma unroll
                for (int c = 0; c < 8; ++c) { const v4u q = *(const v4u*)(vp + 8 * c);
                    vd[(8 * c + 0) * VP] = (bf16)(q.x & 0xffffu); vd[(8 * c + 1) * VP] = (bf16)(q.x >> 16); vd[(8 * c + 2) * VP] = (bf16)(q.y & 0xffffu); vd[(8 * c + 3) * VP] = (bf16)(q.y >> 16);
                    vd[(8 * c + 4) * VP] = (bf16)(q.z & 0xffffu); vd[(8 * c + 5) * VP] = (bf16)(q.z >> 16); vd[(8 * c + 6) * VP] = (bf16)(q.w & 0xffffu); vd[(8 * c + 7) * VP] = (bf16)(q.w >> 16); }
            } else {
#pragma unroll
                for (int c = 0; c < 8; ++c) *(LAS v4u*)(kd + 8 * c) = (v4u){0u, 0u, 0u, 0u};
#pragma unroll
                for (int d = 0; d < 64; ++d) vd[d * VP] = (bf16)0;
            }
        }
        __syncthreads();
        {
            int tz = threadIdx.x; asm volatile("" : "+v"(tz));
            const int wave = __builtin_amdgcn_readfirstlane(tz >> 6), r = tz & 31, hf = (tz >> 5) & 1, hk = wave >> 2, wl = wave & 3;
            const LAS bf16* Kh = Ks + hk * 256 * KP; const LAS bf16* Vh = VT + hk * 64 * VP;
            f32x4 qw[4][2];
#pragma unroll
            for (int ks = 0; ks < 4; ++ks) { qw[ks][0] = *(const f32x4*)(p.q_norm_w + 16 * ks + 8 * hf); qw[ks][1] = *(const f32x4*)(p.q_norm_w + 16 * ks + 8 * hf + 4); }
            v4u qn[4];
            { const bf16* qp0 = proj + ((size_t)b * SEQ + n * 128 + r) * PROJ_LD + COL_Q + (hk * 8 + wl * 2) * 64 + 8 * hf;
#pragma unroll
              for (int ks = 0; ks < 4; ++ks) qn[ks] = *(const v4u*)(qp0 + 16 * ks); }
            for (int it = 0; it < 8; ++it) {
                const int hsel = it >> 2, qt = it & 3;
                const int hq = hk * 8 + wl * 2 + hsel; const float sink = p.sinks[hq];
                {
                    const size_t tok = (size_t)b * SEQ + n * 128 + qt * 32 + r;
                    bf16x8 qf[4];
                    {
                        v4u qv[4]; float ss = 0.f;
#pragma unroll
                        for (int ks = 0; ks < 4; ++ks) { qv[ks] = qn[ks]; float f[8]; unpack8(qv[ks], f);
#pragma unroll
                            for (int e = 0; e < 8; ++e) ss += f[e] * f[e]; }
                        if (it < 7) { const int it2 = it + 1, hq2 = hk * 8 + wl * 2 + (it2 >> 2);
                            const bf16* qp2 = proj + ((size_t)b * SEQ + n * 128 + (it2 & 3) * 32 + r) * PROJ_LD + COL_Q + hq2 * 64 + 8 * hf;
#pragma unroll
                            for (int ks = 0; ks < 4; ++ks) qn[ks] = *(const v4u*)(qp2 + 16 * ks); }
                        ss += __shfl_xor(ss, 32);
                        const float rstd = rsqrtf(ss * (1.f / 64.f) + EPS) * 0.125f;
#pragma unroll
                        for (int ks = 0; ks < 4; ++ks) { float f[8]; unpack8(qv[ks], f); const f32x4 w0 = qw[ks][0], w1 = qw[ks][1];
                            const v4u o = (v4u){pk2(f[0] * rstd * w0[0], f[1] * rstd * w0[1]), pk2(f[2] * rstd * w0[2], f[3] * rstd * w0[3]), pk2(f[4] * rstd * w1[0], f[5] * rstd * w1[1]), pk2(f[6] * rstd * w1[2], f[7] * rstd * w1[3])};
                            qf[ks] = __builtin_bit_cast(bf16x8, o); }
                    }
                    f32x16 sc[5];
#pragma unroll
                    for (int jt = 0; jt < 5; ++jt) {
#pragma unroll
                        for (int e = 0; e < 16; ++e) sc[jt][e] = 0.f;
#pragma unroll
                        for (int ks = 0; ks < 4; ++ks) { const bf16x8 a = *(const LAS bf16x8*)(Kh + ((qt + jt) * 32 + r) * KP + ks * 16 + 8 * hf); sc[jt] = MFMA32(a, qf[ks], sc[jt]); } }
#pragma unroll
                    for (int e = 0; e < 16; ++e) { const int kk = (e & 3) + 8 * (e >> 2) + 4 * hf;
                        sc[0][e] = (kk > r) ? sc[0][e] : NEG; sc[4][e] = (kk <= r) ? sc[4][e] : NEG; }
                    if (n == 0) {
#pragma unroll
                        for (int jt = 0; jt < 4; ++jt) if (qt + jt < 4) {
#pragma unroll
                            for (int e = 0; e < 16; ++e) sc[jt][e] = NEG; } }
                    float m = sink;
#pragma unroll
                    for (int jt = 0; jt < 5; ++jt)
#pragma unroll
                        for (int e = 0; e < 16; ++e) m = fmaxf(m, sc[jt][e]);
                    m = fmaxf(m, __shfl_xor(m, 32));
                    float l = 0.f;
#pragma unroll
                    for (int jt = 0; jt < 5; ++jt)
#pragma unroll
                        for (int e = 0; e < 16; ++e) { const float pv = __expf(sc[jt][e] - m); sc[jt][e] = pv; l += pv; }
                    l += __shfl_xor(l, 32); l += __expf(sink - m);
                    f32x16 o[2];
#pragma unroll
                    for (int dt = 0; dt < 2; ++dt)
#pragma unroll
                        for (int e = 0; e < 16; ++e) o[dt][e] = 0.f;
#pragma unroll
                    for (int jt = 0; jt < 5; ++jt)
#pragma unroll
                        for (int s2 = 0; s2 < 2; ++s2) {
                            const v4u pp = (v4u){pk2(sc[jt][8 * s2], sc[jt][8 * s2 + 1]), pk2(sc[jt][8 * s2 + 2], sc[jt][8 * s2 + 3]), pk2(sc[jt][8 * s2 + 4], sc[jt][8 * s2 + 5]), pk2(sc[jt][8 * s2 + 6], sc[jt][8 * s2 + 7])};
                            const bf16x8 pf = __builtin_bit_cast(bf16x8, pp);
                            const int kb = (qt + jt) * 32 + 16 * s2 + 4 * hf;
#pragma unroll
                            for (int dt = 0; dt < 2; ++dt) { const LAS bf16* vr = Vh + (dt * 32 + r) * VP + kb;
                                const v2u a0 = *(const LAS v2u*)vr, a1 = *(const LAS v2u*)(vr + 8);
                                const v4u av = (v4u){a0.x, a0.y, a1.x, a1.y};
                                o[dt] = MFMA32(__builtin_bit_cast(bf16x8, av), pf, o[dt]); }
                        }
                    const float inv = 1.0f / l; float ss = 0.f;
#pragma unroll
                    for (int dt = 0; dt < 2; ++dt)
#pragma unroll
                        for (int q = 0; q < 4; ++q) { const float g0 = o[dt][4 * q] * inv, g1 = o[dt][4 * q + 1] * inv, g2 = o[dt][4 * q + 2] * inv, g3 = o[dt][4 * q + 3] * inv;
                            ss += (g0 * g0 + g1 * g1) + (g2 * g2 + g3 * g3);
                            *(v2u*)(mix + tok * D + hq * 64 + dt * 32 + 8 * q + 4 * hf) = (v2u){pk2(g0, g1), pk2(g2, g3)}; }
                    ss += __shfl_xor(ss, 32);
                    if (hf == 0) ssqp[hq * 128 + qt * 32 + r] = ss;
                }
            }
        }
        __syncthreads();
        {
            int tz = threadIdx.x; asm volatile("" : "+v"(tz));
            const int wave = __builtin_amdgcn_readfirstlane(tz >> 6), r = tz & 31, hf = (tz >> 5) & 1, hk = wave >> 2, wl = wave & 3;
            for (int qt = 0; qt < 4; ++qt) {
                const size_t tok = (size_t)b * SEQ + n * 128 + qt * 32 + r;
                float tot = 0.f;
#pragma unroll
                for (int hd = 0; hd < 16; ++hd) tot += ssqp[hd * 128 + qt * 32 + r];
                const float rstd = rsqrtf(tot * (1.f / 1024.f) + EPS);
                v2u uu[2][2][4];
#pragma unroll
                for (int hsel = 0; hsel < 2; ++hsel)
#pragma unroll
                    for (int dt = 0; dt < 2; ++dt)
#pragma unroll
                        for (int q = 0; q < 4; ++q) uu[hsel][dt][q] = *(const v2u*)(mix + tok * D + (hk * 8 + wl * 2 + hsel) * 64 + dt * 32 + 8 * q + 4 * hf);
#pragma unroll
                for (int hsel = 0; hsel < 2; ++hsel)
#pragma unroll
                    for (int dt = 0; dt < 2; ++dt) { asm volatile("" : "+v"(uu[hsel][dt][0]), "+v"(uu[hsel][dt][1]), "+v"(uu[hsel][dt][2]), "+v"(uu[hsel][dt][3])); }
#pragma unroll
                for (int hsel = 0; hsel < 2; ++hsel)
#pragma unroll
                    for (int dt = 0; dt < 2; ++dt)
#pragma unroll
                        for (int q = 0; q < 4; ++q) { const int col = (hk * 8 + wl * 2 + hsel) * 64 + dt * 32 + 8 * q + 4 * hf;
                            const v2u u = uu[hsel][dt][q]; const f32x4 w4 = *(const f32x4*)(p.attn_out_norm_w + col);
                            *(v2u*)(mix + tok * D + col) = (v2u){pk2(bflo(u.x) * rstd * w4[0], bfhi(u.x) * rstd * w4[1]), pk2(bflo(u.y) * rstd * w4[2], bfhi(u.y) * rstd * w4[3])}; }
            }
        }
    }
}

__device__ __forceinline__ void phase_router(const Params& p, LAS unsigned char* lds, unsigned* ctl, int G, int wave, int lane) {
    const bf16* x1 = (const bf16*)(p.ws + WS_X1); const float* ssq = (const float*)(p.ws + WS_SSQ); unsigned char* hf = p.ws + WS_HF;
    int* stok = (int*)(p.ws + WS_STOK); float* sgate = (float*)(p.ws + WS_SGATE); int* toke = (int*)(p.ws + WS_TOKE); int* tokp = (int*)(p.ws + WS_TOKP);
    LAS float* lg = (LAS float*)lds + wave * (16 * 33);
    LAS int* hist = (LAS int*)(lds + 32768); LAS int* gbase = hist + 32;
    const int tid = threadIdx.x, i16 = lane & 15, kq = lane >> 4;
    for (int tb = blockIdx.x * 8; tb < T / 16; tb += G * 8) {
        if (tid < 32) hist[tid] = 0;
        __syncthreads();
        const int tok = (tb + wave) * 16 + i16;
        float s = 0.f;
        { const f32x4* sp = (const f32x4*)(ssq + (size_t)tok * 32 + kq * 8); const f32x4 a = sp[0], b = sp[1]; s = ((a[0] + a[1]) + (a[2] + a[3])) + ((b[0] + b[1]) + (b[2] + b[3])); }
        s += __shfl_xor(s, 16); s += __shfl_xor(s, 32);
        const float rstd = rsqrtf(s * (1.f / D) + EPS);
        f32x4 acc0 = (f32x4){0.f, 0.f, 0.f, 0.f}, acc1 = (f32x4){0.f, 0.f, 0.f, 0.f};
        const bf16* xr = x1 + (size_t)tok * D + 8 * kq;
        unsigned char* hr = hf + (size_t)tok * D + 8 * kq;
        const float* wrp = p.w_router + (size_t)(8 * kq) * NE + i16;
        v4u xq[4];
#pragma unroll
        for (int u = 0; u < 4; ++u) xq[u] = *(const v4u*)(xr + 32 * u);
        for (int j4 = 0; j4 < 64; j4 += 4) {
            f32x4 xc[4][2], gq[4][2]; float wv[4][8][2];
#pragma unroll
            for (int u = 0; u < 4; ++u) { float f[8]; unpack8(xq[u], f); xc[u][0] = (f32x4){f[0], f[1], f[2], f[3]}; xc[u][1] = (f32x4){f[4], f[5], f[6], f[7]}; }
            if (j4 + 4 < 64) {
#pragma unroll
                for (int u = 0; u < 4; ++u) xq[u] = *(const v4u*)(xr + 32 * (j4 + 4 + u)); }
#pragma unroll
            for (int u = 0; u < 4; ++u) { gq[u][0] = *(const f32x4*)(p.ffn_norm_w + 32 * (j4 + u) + 8 * kq); gq[u][1] = *(const f32x4*)(p.ffn_norm_w + 32 * (j4 + u) + 8 * kq + 4);
#pragma unroll
                for (int m = 0; m < 8; ++m) { wv[u][m][0] = wrp[(size_t)(32 * (j4 + u) + m) * NE]; wv[u][m][1] = wrp[(size_t)(32 * (j4 + u) + m) * NE + 16]; } }
#pragma unroll
            for (int u = 0; u < 4; ++u) {
                float hv[8];
#pragma unroll
                for (int k = 0; k < 4; ++k) { hv[k] = xc[u][0][k] * rstd * gq[u][0][k]; hv[4 + k] = xc[u][1][k] * rstd * gq[u][1][k]; }
                *(v2u*)(hr + 32 * (j4 + u)) = (v2u){pk4_fp8(sat8(hv[0] * FP8_SA), sat8(hv[1] * FP8_SA), sat8(hv[2] * FP8_SA), sat8(hv[3] * FP8_SA)), pk4_fp8(sat8(hv[4] * FP8_SA), sat8(hv[5] * FP8_SA), sat8(hv[6] * FP8_SA), sat8(hv[7] * FP8_SA))};
#pragma unroll
                for (int m = 0; m < 8; ++m) { acc0 = __builtin_amdgcn_mfma_f32_16x16x4f32(hv[m], wv[u][m][0], acc0, 0, 0, 0);
                    acc1 = __builtin_amdgcn_mfma_f32_16x16x4f32(hv[m], wv[u][m][1], acc1, 0, 0, 0); }
            }
        }
        { const float bb0 = p.b_router[i16], bb1 = p.b_router[16 + i16];
#pragma unroll
          for (int r = 0; r < 4; ++r) { lg[(4 * kq + r) * 33 + i16] = acc0[r] + bb0; lg[(4 * kq + r) * 33 + 16 + i16] = acc1[r] + bb1; } }
        LDS_WAIT(); asm volatile("" ::: "memory");
        int se[4]; float sv[4], gt[4]; int rk[4];
        if (lane < 16) {
            float v[32];
#pragma unroll
            for (int e = 0; e < 32; ++e) v[e] = lg[lane * 33 + e];
#pragma unroll
            for (int k = 0; k < 4; ++k) { float best = -3.0e38f; int bi = 0;
#pragma unroll
                for (int e = 0; e < 32; ++e) { const bool tk = v[e] > best; best = tk ? v[e] : best; bi = tk ? e : bi; }
                se[k] = bi; sv[k] = best;
#pragma unroll
                for (int e = 0; e < 32; ++e) v[e] = (e == bi) ? -3.0e38f : v[e]; }
            const float e1 = __expf(sv[1] - sv[0]), e2 = __expf(sv[2] - sv[0]), e3 = __expf(sv[3] - sv[0]);
            const float inv = 1.0f / (1.0f + e1 + e2 + e3);
            gt[0] = inv; gt[1] = e1 * inv; gt[2] = e2 * inv; gt[3] = e3 * inv;
#pragma unroll
            for (int k = 0; k < 4; ++k) rk[k] = __hip_atomic_fetch_add(&hist[se[k]], 1, __ATOMIC_RELAXED, __HIP_MEMORY_SCOPE_WORKGROUP);
        }
        __syncthreads();
        if (tid < 32) gbase[tid] = (int)__hip_atomic_fetch_add(ctl + CW_CNT + 64 * tid, (unsigned)hist[tid], __ATOMIC_RELAXED, __HIP_MEMORY_SCOPE_AGENT);
        __syncthreads();
        if (lane < 16) {
            const int tk = (tb + wave) * 16 + lane;
#pragma unroll
            for (int k = 0; k < 4; ++k) { const int pos = gbase[se[k]] + rk[k];
                stok[(size_t)se[k] * T + pos] = tk; sgate[(size_t)se[k] * T + pos] = gt[k]; toke[tk * 4 + k] = se[k]; tokp[tk * 4 + k] = pos; }
        }
        __syncthreads();
    }
}

__device__ __forceinline__ void moe_table(unsigned* ctl, LAS int* tstart, LAS int* lcnt) {
    __syncthreads();
    if (threadIdx.x < 32) lcnt[threadIdx.x] = (int)__hip_atomic_load(ctl + CW_CNT + 64 * threadIdx.x, __ATOMIC_RELAXED, __HIP_MEMORY_SCOPE_AGENT);
    __syncthreads();
    if (threadIdx.x == 0) { int a = 0; for (int e = 0; e < NE; ++e) { tstart[e] = a; a += (lcnt[e] + 255) >> 8; } tstart[NE] = a; }
    __syncthreads();
}

__device__ __forceinline__ void phase_combine(const Params& p, const LAS int* tstart, int gw, int NGW, int lane) {
    const unsigned char* y2 = p.ws + WS_Y2; const int* toke = (const int*)(p.ws + WS_TOKE); const int* tokp = (const int*)(p.ws + WS_TOKP);
    constexpr float DY = 1.0f / FP8_SY;
    typedef int i32x4v __attribute__((ext_vector_type(4)));
    i32x4v ne = (i32x4v){0, 0, 0, 0}, np = ne;
    if (gw < T) { ne = *(const i32x4v*)(toke + gw * 4); np = *(const i32x4v*)(tokp + gw * 4); }
    for (int m = gw; m < T; m += NGW) {
        const i32x4v ce = ne, cp = np;
        if (m + NGW < T) { ne = *(const i32x4v*)(toke + (m + NGW) * 4); np = *(const i32x4v*)(tokp + (m + NGW) * 4); }
        const unsigned char* yr[4];
#pragma unroll
        for (int k = 0; k < 4; ++k) yr[k] = y2 + ((size_t)tstart[ce[k]] * 256 + cp[k]) * D;
        float* op = p.out + (size_t)m * D; const bf16* xp = (const bf16*)(p.ws + WS_X1) + (size_t)m * D;
#pragma unroll
        for (int j = 0; j < 2; ++j) { const int c = (j * 64 + lane) * 16;
            v4u w[4];
#pragma unroll
            for (int k = 0; k < 4; ++k) w[k] = *(const v4u*)(yr[k] + c);
            f32x4 a[4];
            { const v4u xa = *(const v4u*)(xp + c), xb = *(const v4u*)(xp + c + 8); float fa[8], fb[8]; unpack8(xa, fa); unpack8(xb, fb);
              a[0] = (f32x4){fa[0], fa[1], fa[2], fa[3]}; a[1] = (f32x4){fa[4], fa[5], fa[6], fa[7]}; a[2] = (f32x4){fb[0], fb[1], fb[2], fb[3]}; a[3] = (f32x4){fb[4], fb[5], fb[6], fb[7]}; }
#pragma unroll
            for (int q = 0; q < 4; ++q) { float s0 = 0.f, s1 = 0.f, s2 = 0.f, s3 = 0.f;
#pragma unroll
                for (int k = 0; k < 4; ++k) { const int wd = (int)(q == 0 ? w[k].x : q == 1 ? w[k].y : q == 2 ? w[k].z : w[k].w);
                    const f32x2 lo = __builtin_amdgcn_cvt_pk_f32_fp8(wd, false), hi = __builtin_amdgcn_cvt_pk_f32_fp8(wd, true);
                    s0 += lo.x; s1 += lo.y; s2 += hi.x; s3 += hi.y; }
                a[q][0] += s0 * DY; a[q][1] += s1 * DY; a[q][2] += s2 * DY; a[q][3] += s3 * DY;
                *(f32x4*)(op + c + 4 * q) = a[q]; }
        }
    }
}

constexpr int N_PHASES = 10;
__global__ void __launch_bounds__(NTHREADS, 2) hymba_fwd(Params p) {
    extern __shared__ __attribute__((aligned(16))) unsigned char lds_raw[];
    LAS unsigned char* lds = (LAS unsigned char*)lds_raw;
    volatile LAS unsigned* MISC = (volatile LAS unsigned*)(lds + MISC_OFF);
    LAS int* tstart = (LAS int*)(lds + MISC_OFF + 256);
    LAS int* lcnt = (LAS int*)(lds + MISC_OFF + 512);
    const int tid = threadIdx.x, lane = tid & 63, wave = __builtin_amdgcn_readfirstlane(tid >> 6);
    const int G = gridDim.x;
    const int vcu = (G % 8 == 0) ? (blockIdx.x % 8) * (G / 8) + blockIdx.x / 8 : blockIdx.x;
    const int gw = vcu * NWAVES + wave, NGW = G * NWAVES;
    unsigned* ctl = (unsigned*)(p.ws + WS_CTL);
    if (tid < 64) MISC[tid] = 0u;
    __syncthreads();
    const int lo = p.ph_lo, hi = p.ph_hi;
    XcdBarrier bar; bar.bar = ctl + CW_BAR; bar.x = 0; bar.st = nullptr;
    if (hi - lo > 1) bar = xcd_barrier_post(ctl + CW_BAR, MISC + 8);
#ifndef PHMASK
#define PHMASK 0x3ff
#endif
#define IN(k) (((PHMASK >> (k)) & 1) && lo <= (k) && (k) < hi)
#define SEAM(k) do { if (IN(k) && IN((k) + 1)) xcd_barrier(bar); } while (0)

    if (IN(0)) { phase_prologue(p, lds, gw, NGW, wave, lane); }
    SEAM(0);
    int cid = (int)blockIdx.x;
    if (hi - lo > 1 && lo == 0) {
        if (tid == 0) {
            bool ok = (G % 8 == 0);
            for (unsigned j = 0; j < 16; ++j) { const unsigned cj = xb_ld(&bar.bar[XB_XCNT(j)]); ok = ok && (j < 8 ? cj == (unsigned)(G / 8) : cj == 0u); }
            MISC[12] = ok ? (MISC[10] * 8u + bar.x) : (unsigned)blockIdx.x;
        }
        __syncthreads();
        cid = (int)MISC[12];
    }
    if (IN(1)) {
        const int ncw = (G < 8 * NCV) ? G : 8 * NCV;
        if (cid < ncw) convert_experts(p, cid * NWAVES + wave, ncw * NWAVES, lane);
        LAS int* tk = (LAS int*)(lds + MISC_OFF + 768);
        unsigned* tick = ctl + CW_TICK + 64 * (cid & 7);
        __syncthreads();
        if (tid == 0) { tk[0] = (int)__hip_atomic_fetch_add(tick, 1u, __ATOMIC_RELAXED, __HIP_MEMORY_SCOPE_AGENT); tk[1] = (int)__hip_atomic_fetch_add(tick, 1u, __ATOMIC_RELAXED, __HIP_MEMORY_SCOPE_AGENT); }
        __syncthreads();
        pg8::SchedQueue S{(const char*)(p.ws + WS_HN), (const char*)(p.ws + WS_WIN), T / 256, NIN_PAD / 256, (T / 256) * (NIN_PAD / 256) / 8, cid & 7, tick, tk};
        EpiInProj E{(bf16*)(p.ws + WS_PROJ), (float*)(p.ws + WS_DT)};
        pg8::gemm_phase<EpiInProj, pg8::SchedQueue>(lds, S, E);
    }
    SEAM(1);
    if (IN(2)) { if (!(p.variant & 2)) phase_attn(p, lds, G); if (!(p.variant & 1)) phase_ssd_states(p, lds, G, lane, wave); }
    SEAM(2);
    if (IN(3)) { phase_ssd_scan(p, G); }
    SEAM(3);
    if (IN(4)) { phase_ssd_out(p, lds, G, lane, wave); }
    SEAM(4);
    if (IN(5)) {
        EpiOutProj E{p.x, (bf16*)(p.ws + WS_X1), (float*)(p.ws + WS_SSQ)};
#if PROBE_CRIP5
        if (p.variant) { pg8::SchedDenseT<PROBE_CRIP5> S{(const char*)(p.ws + WS_MIX), (const char*)(p.ws + WS_WOUT), T / 256, D / 256, G, cid};
            pg8::gemm_phase<EpiOutProj, pg8::SchedDenseT<PROBE_CRIP5>>(lds, S, E); } else
#endif
        { pg8::SchedDense S{(const char*)(p.ws + WS_MIX), (const char*)(p.ws + WS_WOUT), T / 256, D / 256, G, cid};
          pg8::gemm_phase<EpiOutProj, pg8::SchedDense>(lds, S, E); }
    }
    SEAM(5);
    if (IN(6)) { phase_router(p, lds, ctl, G, wave, lane); }
    SEAM(6);
    if (IN(7)) {
        moe_table(ctl, tstart, lcnt);
        EpiGateUp E{p.ws + WS_HB, p.b_gate, p.b_up};
#if PROBE_CRIP7
        if (p.variant) { pg8::SchedMoE<true, PROBE_CRIP7> S{(const char*)(p.ws + WS_HF), (const char*)(p.ws + WS_WGU), (const int*)(p.ws + WS_STOK), tstart, lcnt, (2 * FF) / 256, 2 * FF, G, cid};
            pg8::gemm_phase<EpiGateUp, pg8::SchedMoE<true, PROBE_CRIP7>>(lds, S, E); } else
#endif
        { pg8::SchedMoE<true> S{(const char*)(p.ws + WS_HF), (const char*)(p.ws + WS_WGU), (const int*)(p.ws + WS_STOK), tstart, lcnt, (2 * FF) / 256, 2 * FF, G, cid};
          pg8::gemm_phase<EpiGateUp, pg8::SchedMoE<true>>(lds, S, E); }
    }
    SEAM(7);
    if (IN(8)) {
        moe_table(ctl, tstart, lcnt);
        EpiDown E{p.ws + WS_Y2, p.b_down, (const float*)(p.ws + WS_SGATE), tstart};
#if PROBE_CRIP
        if (p.variant) { pg8::SchedMoE<false, PROBE_CRIP> S{(const char*)(p.ws + WS_HB), (const char*)(p.ws + WS_WD), (const int*)(p.ws + WS_STOK), tstart, lcnt, D / 256, D, G, cid};
            pg8::gemm_phase<EpiDown, pg8::SchedMoE<false, PROBE_CRIP>>(lds, S, E); } else
#endif
        { pg8::SchedMoE<false> S{(const char*)(p.ws + WS_HB), (const char*)(p.ws + WS_WD), (const int*)(p.ws + WS_STOK), tstart, lcnt, D / 256, D, G, cid};
          pg8::gemm_phase<EpiDown, pg8::SchedMoE<false>>(lds, S, E); }
    }
    SEAM(8);
    if (IN(9)) { moe_table(ctl, tstart, lcnt); phase_combine(p, tstart, gw, NGW, lane); }
#undef IN
#undef SEAM
}

extern "C" void kernel_launch(void* const* d_in, const int* in_sizes, int n_in, void* d_out, int out_size, void* d_ws, size_t ws_size, hipStream_t stream) {
    static int grid = 0;
    if (grid == 0) {
        if (n_in != 23 || out_size != T * D || ws_size < WS_END) { fprintf(stderr, "kernel_launch: unexpected sizes n_in %d out %d ws %zu\n", n_in, out_size, ws_size); grid = -1; return; }
        int dev = 0, cus = 0;
        if (hipGetDevice(&dev) != hipSuccess || hipDeviceGetAttribute(&cus, hipDeviceAttributeMultiprocessorCount, dev) != hipSuccess) { grid = -1; return; }
        if (hipFuncSetAttribute((const void*)hymba_fwd, hipFuncAttributeMaxDynamicSharedMemorySize, LDS_BYTES) != hipSuccess) { fprintf(stderr, "kernel_launch: hipFuncSetAttribute failed\n"); grid = -1; return; }
        int per_cu = 0;
        if (hipOccupancyMaxActiveBlocksPerMultiprocessor(&per_cu, (const void*)hymba_fwd, NTHREADS, LDS_BYTES) != hipSuccess || per_cu < 1) fprintf(stderr, "kernel_launch: occupancy query says %d\n", per_cu);
        (void)hipGetLastError();
        grid = cus;
    }
    if (grid < 0) return;
    (void)hipMemsetAsync((char*)d_ws + WS_CTL, 0, CTL_BYTES, stream);
    Params p{};
    const float** pp = (const float**)&p;
    for (int i = 0; i < 23; ++i) pp[i] = (const float*)d_in[i];
    p.out = (float*)d_out; p.ws = (unsigned char*)d_ws;
#if MK_MULTI || (PROBE_REPEAT >= 0) || PROBE_CRIP || PROBE_P2 || PROBE_P6 || PROBE_CRIP7 || PROBE_CRIP5
    for (int ph = 0; ph < N_PHASES; ++ph) { p.ph_lo = ph; p.ph_hi = ph + 1;
        if (PROBE_P2 && ph == 2) { p.variant = PROBE_P2; hipLaunchKernelGGL(hymba_fwd, dim3(grid), dim3(NTHREADS), LDS_BYTES, stream, p); p.variant = 0; }
        if (PROBE_P6 && ph == 6) { hipLaunchKernelGGL(hymba_fwd, dim3(grid), dim3(NTHREADS), LDS_BYTES, stream, p); (void)hipMemsetAsync((char*)d_ws + WS_CTL + CW_CNT * 4, 0, 64 * 4 * NE, stream); }
        if (PROBE_CRIP5 && ph == 5) { p.variant = 1; hipLaunchKernelGGL(hymba_fwd, dim3(grid), dim3(NTHREADS), LDS_BYTES, stream, p); p.variant = 0; }
        if (PROBE_CRIP7 && ph == 7) { p.variant = 1; hipLaunchKernelGGL(hymba_fwd, dim3(grid), dim3(NTHREADS), LDS_BYTES, stream, p); p.variant = 0; }
        if (PROBE_CRIP && ph == 8) { p.variant = 1; hipLaunchKernelGGL(hymba_fwd, dim3(grid), dim3(NTHREADS), LDS_BYTES, stream, p); p.variant = 0; }
        for (int r = 0; r < (ph == PROBE_REPEAT ? 2 : 1); ++r) hipLaunchKernelGGL(hymba_fwd, dim3(grid), dim3(NTHREADS), LDS_BYTES, stream, p); }
#else
    p.ph_lo = 0; p.ph_hi = N_PHASES; hipLaunchKernelGGL(hymba_fwd, dim3(grid), dim3(NTHREADS), LDS_BYTES, stream, p);
#endif
}
```

```cpp
#include <hip/hip_runtime.h>
#include <cstdio>
#include <cstdint>

#ifndef MK_MULTI
#define MK_MULTI 0
#endif

#ifndef PROBE_CRIP
#define PROBE_CRIP 0
#endif
#ifndef PROBE_CRIP5
#define PROBE_CRIP5 0
#endif
#ifndef PROBE_CRIP7
#define PROBE_CRIP7 0
#endif
#ifndef PROBE_P6
#define PROBE_P6 0
#endif
#ifndef PROBE_P2
#define PROBE_P2 0
#endif
#ifndef PROBE_REPEAT
#define PROBE_REPEAT -1
#endif
#define GAS __attribute__((address_space(1)))
#define LAS __attribute__((address_space(3)))
typedef unsigned short bf16;
typedef unsigned v4u __attribute__((ext_vector_type(4)));
typedef unsigned v2u __attribute__((ext_vector_type(2)));
typedef float f32x4 __attribute__((ext_vector_type(4)));
typedef float f32x2 __attribute__((ext_vector_type(2)));
typedef short bf16x8 __attribute__((ext_vector_type(8)));
typedef int i32x4 __attribute__((ext_vector_type(4)));
typedef int i32x8 __attribute__((ext_vector_type(8)));

constexpr int NB = 4, SEQ = 8192, T = NB * SEQ, D = 2048;
constexpr int PROJ_LD = 3840;
constexpr int COL_Q = 0, COL_K = 1024, COL_V = 1152, COL_Z = 1280, COL_XBC = 2304;
constexpr int NIN = 3856, NIN_PAD = 4096;
constexpr int NXBC = 1536;
constexpr int NE = 32, FF = 2048, TOPK = 4;
constexpr int SLOT_ROWS = T * TOPK + NE * 256;
constexpr float EPS = 1e-6f;

constexpr size_t MiB = 1u << 20;
constexpr size_t WS_CTL = 0, CTL_BYTES = 1 * MiB;
constexpr size_t WS_WGU = 16 * MiB;
constexpr size_t WS_WIN = 528 * MiB;
constexpr size_t WS_WOUT = 544 * MiB;
constexpr size_t WS_HF = 552 * MiB;
constexpr size_t WS_Y2 = 16 * MiB;
constexpr size_t WS_WD = 680 * MiB;
constexpr size_t WS_HN = 936 * MiB;
constexpr size_t WS_MIX = WS_HN;
constexpr size_t WS_PROJ = 1064 * MiB;
constexpr size_t WS_XBC = 1304 * MiB;
constexpr size_t WS_ATT = 1496 * MiB;
constexpr size_t WS_X1 = WS_ATT;
constexpr size_t WS_YS = 1624 * MiB;
constexpr size_t WS_HB = 936 * MiB;
constexpr size_t WS_STATES = WS_XBC;
constexpr size_t WS_SIN = WS_YS;
constexpr size_t WS_CDEC = WS_YS + 64 * MiB;
constexpr size_t WS_DT = 1752 * MiB;
constexpr size_t WS_DTS = 1754 * MiB;
constexpr size_t WS_SSQ = 1756 * MiB;
constexpr size_t WS_STOK = 1760 * MiB;
constexpr size_t WS_SGATE = 1764 * MiB;
constexpr size_t WS_TOKE = 1768 * MiB;
constexpr size_t WS_TOKP = 1769 * MiB;
constexpr size_t WS_WRB = 1770 * MiB;
constexpr size_t WS_END = 1771 * MiB;
static_assert(WS_Y2 + (size_t)SLOT_ROWS * 2048 <= WS_WD, "y2 overlay");
static_assert(WS_HB + (size_t)SLOT_ROWS * 2048 * 2 <= WS_ATT, "hb overlay");
constexpr int CW_CNT = 1024;
constexpr int CW_BAR = 4096;
constexpr int CW_TICK = 2048 + 1024;
constexpr int NCV = 16;

constexpr int RING_BYTES = 131072;
constexpr int MISC_OFF = 162816;
constexpr int LDS_BYTES = 163840;
constexpr int NWAVES = 8, NTHREADS = 512;

typedef __bf16 hwbf16x2 __attribute__((ext_vector_type(2)));
__device__ __forceinline__ unsigned f2bf(float f) { return (unsigned)__builtin_bit_cast(unsigned short, (__bf16)f); }
__device__ __forceinline__ unsigned pk2(float lo, float hi) { const f32x2 v = {lo, hi}; return __builtin_bit_cast(unsigned, __builtin_convertvector(v, hwbf16x2)); }
__device__ __forceinline__ float bflo(unsigned w) { return __builtin_bit_cast(float, w << 16); }
__device__ __forceinline__ float bfhi(unsigned w) { return __builtin_bit_cast(float, w & 0xffff0000u); }
__device__ __forceinline__ float wave_sum(float v) {
#pragma unroll
    for (int o = 1; o < 64; o <<= 1) v += __shfl_xor(v, o);
    return v;
}
__device__ __forceinline__ float sat8(float x) { return __builtin_amdgcn_fmed3f(x, -448.0f, 448.0f); }
__device__ __forceinline__ unsigned pk4_fp8(float a, float b, float c, float d) { int v = 0; v = __builtin_amdgcn_cvt_pk_fp8_f32(a, b, v, false); v = __builtin_amdgcn_cvt_pk_fp8_f32(c, d, v, true); return (unsigned)v; }
constexpr float FP8_SW = 256.f;
constexpr float FP8_SA = 16.f;
constexpr float FP8_SH = 4.f;
constexpr float FP8_SY = 32.f;
__device__ __forceinline__ float fsigmoid(float x) { return __builtin_amdgcn_rcpf(1.0f + __expf(-x)); }
__device__ __forceinline__ void unpack8(const v4u q, float (&d)[8]) { d[0] = bflo(q.x); d[1] = bfhi(q.x); d[2] = bflo(q.y); d[3] = bfhi(q.y); d[4] = bflo(q.z); d[5] = bfhi(q.z); d[6] = bflo(q.w); d[7] = bfhi(q.w); }
#define LDS_WAIT() asm volatile("s_waitcnt lgkmcnt(0)" ::: "memory")

#define XB_TMO      128
#define XB_XCNT(j)  (256  + 64 * (j))
#define XB_XSUB(j)  (1280 + 64 * (j))
#define XB_XGEN(j)  (2304 + 64 * (j))
#define XB_TOP      3328
#define XB_TOPGEN   3392
#define XCD_BAR_WORDS 3456
#define XB_SPIN_CAP (1u << 18)
__device__ __forceinline__ unsigned xb_ld(unsigned* p)              { return __hip_atomic_load(p, __ATOMIC_RELAXED, __HIP_MEMORY_SCOPE_AGENT); }
__device__ __forceinline__ unsigned xb_add(unsigned* p, unsigned v) { return __hip_atomic_fetch_add(p, v, __ATOMIC_RELAXED, __HIP_MEMORY_SCOPE_AGENT); }
__device__ __forceinline__ unsigned xb_xcc_id() { return (unsigned)__builtin_amdgcn_s_getreg((3 << 11) | 20) & 0xFu; }
#define XB_SPIN(cond, bar) do { unsigned _sp = 0; while (cond) { __builtin_amdgcn_s_sleep(1); \
    if ((++_sp & 255u) == 0u) { if (xb_ld(&(bar)[XB_TMO])) break; if (_sp > XB_SPIN_CAP) { atomicAdd(&(bar)[XB_TMO], 1u); break; } } } } while (0)
struct XcdBarrier { unsigned* bar; unsigned x; volatile LAS unsigned* st; };
__device__ __forceinline__ XcdBarrier xcd_barrier_post(unsigned* bar, volatile LAS unsigned* st) {
    XcdBarrier b; b.bar = bar; b.x = xb_xcc_id(); b.st = st;
    if (threadIdx.x == 0) st[2] = xb_add(&bar[XB_XCNT(b.x)], 1u);
    return b;
}
__device__ __forceinline__ void xcd_barrier_complete(unsigned* bar, unsigned x, unsigned& nloc, unsigned& nx) {
    const unsigned G = gridDim.x * gridDim.y * gridDim.z;
    unsigned sum, cnt, mine, sp = 0u;
    for (;;) {
        sum = 0u; cnt = 0u; mine = 0u;
#pragma unroll
        for (unsigned j = 0; j < 16; ++j) { const unsigned c = xb_ld(&bar[XB_XCNT(j)]); sum += c; cnt += (c > 0u) ? 1u : 0u; mine = (j == x) ? c : mine; }
        if (sum == G) break;
        __builtin_amdgcn_s_sleep(1);
        if ((++sp & 255u) == 0u) { if (xb_ld(&bar[XB_TMO])) break; if (sp > XB_SPIN_CAP) { atomicAdd(&bar[XB_TMO], 1u); break; } }
    }
    nloc = mine > 0u ? mine : 1u; nx = cnt > 0u ? cnt : 1u;
}
__device__ __forceinline__ void xcd_barrier(const XcdBarrier& b) {
    asm volatile("s_waitcnt vmcnt(0)" ::: "memory");
    __syncthreads();
    if (threadIdx.x == 0) {
        unsigned* bar = b.bar;
        __builtin_amdgcn_s_waitcnt(0);
        unsigned nloc = b.st[0], nx = b.st[1];
        if (nloc == 0u) { xcd_barrier_complete(bar, b.x, nloc, nx); b.st[0] = nloc; b.st[1] = nx; }
        const unsigned old = xb_add(&bar[XB_XSUB(b.x)], 1u);
        const unsigned gen = old / nloc;
        if (old + 1u == (gen + 1u) * nloc) {
            __builtin_amdgcn_fence(__ATOMIC_RELEASE, "agent");
            asm volatile("s_waitcnt vmcnt(0)" ::: "memory");
            const unsigned og = xb_add(&bar[XB_TOP], 1u);
            const unsigned tg = og / nx;
            if (og + 1u == (tg + 1u) * nx) xb_add(&bar[XB_TOPGEN], 1u);
            else XB_SPIN(xb_ld(&bar[XB_TOPGEN]) == tg, bar);
            __builtin_amdgcn_fence(__ATOMIC_ACQUIRE, "agent");
            xb_add(&bar[XB_XGEN(b.x)], 1u);
            asm volatile("s_waitcnt vmcnt(0)" ::: "memory");
        } else {
            XB_SPIN(xb_ld(&bar[XB_XGEN(b.x)]) == gen, bar);
            __builtin_amdgcn_fence(__ATOMIC_ACQUIRE, "agent");
            asm volatile("s_waitcnt vmcnt(0)" ::: "memory");
        }
    }
    __syncthreads();
}

struct Params {
    const float* x; const float* attn_norm_w; const float* w_in; const float* q_norm_w; const float* k_norm_w; const float* sinks;
    const float* conv_w; const float* conv_b; const float* dt_bias; const float* a_log; const float* d_skip; const float* ssm_norm_w;
    const float* attn_out_norm_w; const float* w_out; const float* ffn_norm_w; const float* w_router; const float* b_router;
    const float* w_gate; const float* b_gate; const float* w_up; const float* b_up; const float* w_down; const float* b_down;
    float* out; unsigned char* ws; int ph_lo, ph_hi, variant, pad;
};

namespace pg8 {
constexpr int BM = 256, BK = 64, HALF = 128, HTB = HALF * BK * 2, GK = 2048;
__device__ __forceinline__ int lds_byte(int r, int c) { const int st = (r >> 4) * 2 + (c >> 5), rr = r & 15, cc = c & 31, ob = rr * 64 + cc * 2; return st * 1024 + (ob ^ (((ob >> 9) & 1) << 5)); }
__device__ __forceinline__ void stage_rc(int b, int& R, int& C) { const int st = b / 1024, sb = b % 1024, swz = sb ^ (((sb >> 9) & 1) << 5); R = (st >> 1) * 16 + swz / 64; C = (st & 1) * 32 + (swz % 64) / 2; }
__device__ __forceinline__ int perm32(int rho) { const int n = rho >> 4, i = rho & 15; return 8 * (i >> 2) + 4 * n + (i & 3); }

struct Unit { const char* aBase; const char* bBase; const int* aidx; int avalid; int pm, pn, e; };

template <class Epi, class Sched>
__device__ __forceinline__ void gemm_phase(LAS unsigned char* lds, const Sched& S, const Epi& E) {
    constexpr int RP = Sched::ROWB, nt = RP / 128;
    constexpr bool F8 = Sched::FP8;
    const int tid = threadIdx.x, wid = __builtin_amdgcn_readfirstlane(tid >> 6), lane = tid & 63, wr = wid >> 2, wc = wid & 3, fr = lane & 15, fq = lane >> 4;
    int sR[2], sC[2];
    unsigned voffB[2], vA[2][2];
#pragma unroll
    for (int i = 0; i < 2; ++i) { stage_rc(tid * 16 + i * 8192, sR[i], sC[i]); const int Rb = Epi::PERM ? ((sR[i] & ~31) + perm32(sR[i] & 31)) : sR[i];
        voffB[i] = (unsigned)(Rb * RP + sC[i] * 2); }
    const size_t kstep = (size_t)(BK * 2);
    const size_t hstep = (size_t)HALF * RP;
    const unsigned ldsw = (unsigned)wid * 1024u;
    const int aoff = lds_byte(wr * 64 + fr, fq * 8), boff = lds_byte(wc * 32 + fr, fq * 8);
#define PG8_SA(b, h) (((b) * 2 + (h)) * HTB)
#define PG8_SB(b, h) ((4 + (b) * 2 + (h)) * HTB)
#define PG8_STAGE(bufoff, gbase, voff) do { if constexpr (!(Sched::CRIP & 2)) _Pragma("unroll") for (int _i = 0; _i < 2; ++_i) { unsigned _o = (voff)[_i]; asm volatile("" : "+v"(_o)); \
        __builtin_amdgcn_global_load_lds((const unsigned*)((const char*)(gbase) + _o), (LAS unsigned*)(lds + (bufoff) + ldsw + _i * 8192), 16, 0, 0); } } while (0)
#define PG8_CAT(x, y) __builtin_shufflevector(x, y, 0, 1, 2, 3, 4, 5, 6, 7)
#define PG8_LO(v) __builtin_bit_cast(bf16x8, __builtin_shufflevector(v, v, 0, 1, 2, 3))
#define PG8_HI(v) __builtin_bit_cast(bf16x8, __builtin_shufflevector(v, v, 4, 5, 6, 7))
#define PG8_LDA(dst, b, h) do { if constexpr (!(Sched::CRIP & 4)) _Pragma("unroll") for (int m = 0; m < 4; ++m) dst[m] = PG8_CAT(*(const LAS i32x4*)(lds + PG8_SA(b, h) + aoff + m * 2048), *(const LAS i32x4*)(lds + PG8_SA(b, h) + aoff + m * 2048 + 1024)); } while (0)
#define PG8_LDB(dst, b, h) do { if constexpr (!(Sched::CRIP & 4)) _Pragma("unroll") for (int n = 0; n < 2; ++n) dst[n] = PG8_CAT(*(const LAS i32x4*)(lds + PG8_SB(b, h) + boff + n * 2048), *(const LAS i32x4*)(lds + PG8_SB(b, h) + boff + n * 2048 + 1024)); } while (0)
#define PG8_MMA(ai, bj, At, Bt) do { __builtin_amdgcn_s_setprio(1); \
        if constexpr (Sched::CRIP & 1) {} else if constexpr (F8) { asm volatile("s_nop 1\n\t" \
            "v_mfma_scale_f32_16x16x128_f8f6f4 %0, %8, %10, %0, %14, %14 op_sel_hi:[0,0,0]\n\t" "v_mfma_scale_f32_16x16x128_f8f6f4 %1, %9, %10, %1, %14, %14 op_sel_hi:[0,0,0]\n\t" \
            "v_mfma_scale_f32_16x16x128_f8f6f4 %2, %8, %11, %2, %14, %14 op_sel_hi:[0,0,0]\n\t" "v_mfma_scale_f32_16x16x128_f8f6f4 %3, %9, %11, %3, %14, %14 op_sel_hi:[0,0,0]\n\t" \
            "v_mfma_scale_f32_16x16x128_f8f6f4 %4, %8, %12, %4, %14, %14 op_sel_hi:[0,0,0]\n\t" "v_mfma_scale_f32_16x16x128_f8f6f4 %5, %9, %12, %5, %14, %14 op_sel_hi:[0,0,0]\n\t" \
            "v_mfma_scale_f32_16x16x128_f8f6f4 %6, %8, %13, %6, %14, %14 op_sel_hi:[0,0,0]\n\t" "v_mfma_scale_f32_16x16x128_f8f6f4 %7, %9, %13, %7, %14, %14 op_sel_hi:[0,0,0]" \
            : "+v"(acc[ai][bj][0][0]), "+v"(acc[ai][bj][0][1]), "+v"(acc[ai][bj][1][0]), "+v"(acc[ai][bj][1][1]), "+v"(acc[ai][bj][2][0]), "+v"(acc[ai][bj][2][1]), "+v"(acc[ai][bj][3][0]), "+v"(acc[ai][bj][3][1]) \
            : "v"(Bt[0]), "v"(Bt[1]), "v"(At[0]), "v"(At[1]), "v"(At[2]), "v"(At[3]), "v"(f8scale)); } \
        else { _Pragma("unroll") for (int m = 0; m < 4; ++m) _Pragma("unroll") for (int n = 0; n < 2; ++n) { \
               acc[ai][bj][m][n] = __builtin_amdgcn_mfma_f32_16x16x32_bf16(PG8_LO(Bt[n]), PG8_LO(At[m]), acc[ai][bj][m][n], 0, 0, 0); \
               acc[ai][bj][m][n] = __builtin_amdgcn_mfma_f32_16x16x32_bf16(PG8_HI(Bt[n]), PG8_HI(At[m]), acc[ai][bj][m][n], 0, 0, 0); } } \
        __builtin_amdgcn_s_setprio(0); } while (0)
#define PG8_WAIT_V(n) asm volatile("s_waitcnt vmcnt(" #n ")" ::: "memory")
#define PG8_WAIT_L(n) asm volatile("s_waitcnt lgkmcnt(" #n ")" ::: "memory")
#define PG8_BAR __builtin_amdgcn_s_barrier()
#define PG8_BAR2 do { if constexpr (!(Sched::CRIP & 16)) __builtin_amdgcn_s_barrier(); } while (0)
#define PG8_SCHED __builtin_amdgcn_sched_barrier(0)
    Unit cur, nxt; int ui = 0;
    if (!S.next(0, cur)) return;
    typename Epi::Pre epre;
    E.prefetch(cur, epre);
    LAS int* lidx = (LAS int*)(lds + 8 * HTB);
    if constexpr (Sched::GATHER) {
        if (tid < 256) { const int v = cur.aidx[tid]; lidx[tid] = (tid < cur.avalid) ? v : 0; }
        __syncthreads();
    }
#pragma unroll
    for (int h = 0; h < 2; ++h)
#pragma unroll
        for (int i = 0; i < 2; ++i) {
            const int r = h * HALF + sR[i];
            if constexpr (Sched::GATHER) vA[h][i] = (unsigned)(lidx[r] * RP + sC[i] * 2);
            else vA[h][i] = (unsigned)(r * RP + sC[i] * 2);
        }
    f32x4 acc[2][2][4][2];
#pragma unroll
    for (int a = 0; a < 2; ++a)
#pragma unroll
        for (int b = 0; b < 2; ++b)
#pragma unroll
            for (int m = 0; m < 4; ++m)
#pragma unroll
                for (int n = 0; n < 2; ++n) acc[a][b][m][n] = (f32x4){0.f, 0.f, 0.f, 0.f};
    i32x8 At[4], B0[2], B1[2];
    if constexpr (Sched::CRIP & 4) { _Pragma("unroll") for (int m = 0; m < 4; ++m) At[m] = (i32x8){0, 0, 0, 0, 0, 0, 0, 0}; _Pragma("unroll") for (int n = 0; n < 2; ++n) { B0[n] = At[0]; B1[n] = At[0]; } }
    int f8scale = 0x7f7f7f7f; asm volatile("" : "+v"(f8scale));
    const char* cA = cur.aBase; const char* cB = cur.bBase;
#ifndef KROT
#define KROT(pm, pn) (((F8 ? 0 : (pm)) + (pn)) & (nt - 1))
#endif
#define PG8_KT(rot, tau) ((size_t)(((tau) + (rot)) & (nt - 1)) * kstep)
    int crot = KROT(cur.pm, cur.pn);
    PG8_STAGE(PG8_SB(0, 0), cB + PG8_KT(crot, 0), voffB); PG8_STAGE(PG8_SB(0, 1), cB + hstep + PG8_KT(crot, 0), voffB); PG8_STAGE(PG8_SA(0, 0), cA + PG8_KT(crot, 0), vA[0]); PG8_STAGE(PG8_SA(0, 1), cA + PG8_KT(crot, 0), vA[1]);
    if (wr == 1) PG8_BAR;
    PG8_WAIT_V(2); PG8_BAR;
    PG8_STAGE(PG8_SB(1, 0), cB + PG8_KT(crot, 1), voffB); PG8_STAGE(PG8_SA(1, 0), cA + PG8_KT(crot, 1), vA[0]); PG8_STAGE(PG8_SB(1, 1), cB + hstep + PG8_KT(crot, 1), voffB);
    PG8_WAIT_V(6); PG8_BAR;
    for (;;) {
        const bool has_next = S.next(ui + 1, nxt);
        const char* nA = has_next ? nxt.aBase : cA; const char* nB = has_next ? nxt.bBase : cB;
        const int nrot = has_next ? KROT(nxt.pm, nxt.pn) : crot;
        for (int t = 0; t < nt; t += 2) {
            const bool last = (t == nt - 2);
            const char* a1 = cA + PG8_KT(crot, t + 1);
            const char* a2 = last ? nA + PG8_KT(nrot, 0) : cA + PG8_KT(crot, t + 2); const char* b2 = last ? nB + PG8_KT(nrot, 0) : cB + PG8_KT(crot, t + 2);
            const char* a3 = last ? nA + PG8_KT(nrot, 1) : cA + PG8_KT(crot, t + 3); const char* b3 = last ? nB + PG8_KT(nrot, 1) : cB + PG8_KT(crot, t + 3);
            int gi = 0;
            if constexpr (Sched::GATHER) { if (t == 0 && has_next && tid < 256) gi = nxt.aidx[tid]; }
            PG8_LDB(B0, 0, 0); PG8_LDB(B1, 0, 1); PG8_SCHED; PG8_LDA(At, 0, 0); PG8_STAGE(PG8_SA(1, 1), a1, vA[1]);
            PG8_WAIT_V(8); PG8_WAIT_L(0); PG8_BAR; PG8_MMA(0, 0, At, B0); PG8_MMA(0, 1, At, B1); PG8_BAR2; PG8_SCHED;
            if constexpr (Sched::GATHER) { if (last && has_next) {
                int tz = threadIdx.x; asm volatile("" : "+v"(tz));
#pragma unroll
                for (int i = 0; i < 2; ++i) { int R, C; stage_rc(tz * 16 + i * 8192, R, C);
#pragma unroll
                    for (int h = 0; h < 2; ++h) vA[h][i] = (unsigned)(lidx[h * HALF + R] * RP + C * 2); } } }
            PG8_LDA(At, 0, 1); PG8_STAGE(PG8_SB(0, 0), b2, voffB); PG8_STAGE(PG8_SB(0, 1), b2 + hstep, voffB); PG8_STAGE(PG8_SA(0, 0), a2, vA[0]);
            PG8_WAIT_V(8); PG8_WAIT_L(0); PG8_BAR; PG8_MMA(1, 0, At, B0); PG8_MMA(1, 1, At, B1); PG8_BAR2; PG8_SCHED;
            PG8_LDB(B0, 1, 0); PG8_LDB(B1, 1, 1); PG8_SCHED; PG8_LDA(At, 1, 0); PG8_STAGE(PG8_SA(0, 1), a2, vA[1]);
            PG8_WAIT_V(8); PG8_WAIT_L(0); PG8_BAR; PG8_MMA(0, 0, At, B0); PG8_MMA(0, 1, At, B1); PG8_BAR2; PG8_SCHED;
            PG8_LDA(At, 1, 1); PG8_STAGE(PG8_SB(1, 0), b3, voffB); PG8_STAGE(PG8_SB(1, 1), b3 + hstep, voffB); PG8_STAGE(PG8_SA(1, 0), a3, vA[0]);
            PG8_WAIT_V(8); PG8_WAIT_L(0); PG8_BAR; PG8_MMA(1, 0, At, B0); PG8_MMA(1, 1, At, B1); PG8_BAR2; PG8_SCHED;
            if constexpr (Sched::GATHER) { if (t == 0 && has_next && tid < 256) lidx[tid] = (tid < nxt.avalid) ? gi : 0; }
        }
        if constexpr (F8) asm volatile("s_nop 15\n\ts_nop 15" ::: "memory");
        if (wr == 0) PG8_BAR;
        { int tz = threadIdx.x; asm volatile("" : "+v"(tz)); const int ewid = __builtin_amdgcn_readfirstlane(tz >> 6), el = tz & 63;
          E(acc, cur, epre, ewid >> 2, ewid & 3, el & 15, el >> 4); }
        if (!has_next) break;
#pragma unroll
        for (int a = 0; a < 2; ++a)
#pragma unroll
            for (int b = 0; b < 2; ++b)
#pragma unroll
                for (int m = 0; m < 4; ++m)
#pragma unroll
                    for (int n = 0; n < 2; ++n) acc[a][b][m][n] = (f32x4){0.f, 0.f, 0.f, 0.f};
        cur = nxt; cA = nA; cB = nB; crot = nrot; ++ui;
        E.prefetch(cur, epre);
        if (wr == 1) PG8_BAR;
    }
    PG8_WAIT_V(0);
    PG8_BAR;
#undef PG8_KT
#undef PG8_SA
#undef PG8_SB
#undef PG8_STAGE
#undef PG8_LDA
#undef PG8_LDB
#undef PG8_MMA
#undef PG8_CAT
#undef PG8_LO
#undef PG8_HI
#undef PG8_WAIT_V
#undef PG8_WAIT_L
#undef PG8_BAR
#undef PG8_BAR2
#undef PG8_SCHED
}

__device__ __forceinline__ bool tile_order(long L, int nM, int nN, int& pm, int& pn) {
    const int nwg = nM * nN; if (L >= nwg) return false;
    int wgid = (int)L; { const int q = nwg / 8, r = nwg % 8, xcd = wgid % 8, off = wgid / 8; wgid = (xcd < r ? xcd * (q + 1) : r * (q + 1) + (xcd - r) * q) + off; }
    const int nig = 8 * nN, gid = wgid / nig, fm = gid * 8, gsz = (nM - fm) < 8 ? (nM - fm) : 8;
    pm = fm + ((wgid % nig) % gsz); pn = (wgid % nig) / gsz; return true;
}
template <int CRIP_ = 0> struct SchedDenseT {
    static constexpr bool GATHER = false, FP8 = false; static constexpr int ROWB = 4096, CRIP = CRIP_;
    const char* A; const char* Bt; int nM, nN, G, c;
    __device__ __forceinline__ bool next(int i, Unit& u) const {
        int pm, pn; if (!tile_order((long)i * G + c, nM, nN, pm, pn)) return false;
        u.pm = pm; u.pn = pn; u.e = 0; u.aidx = nullptr; u.avalid = 256;
        u.aBase = A + (size_t)pm * 256 * GK * 2; u.bBase = Bt + (size_t)pn * 256 * GK * 2;
        if constexpr ((CRIP_ & 64) != 0) u.bBase = Bt;
        if constexpr ((CRIP_ & 128) != 0) u.aBase = A;
        return true;
    }
};
typedef SchedDenseT<0> SchedDense;
struct SchedQueue {
    static constexpr bool GATHER = false, FP8 = false; static constexpr int ROWB = 4096, CRIP = 0;
    const char* A; const char* Bt; int nM, nN, q, xcd; unsigned* tick; LAS int* tk;
    __device__ __forceinline__ bool next(int i, Unit& u) const {
        const int t = __builtin_amdgcn_readfirstlane(tk[i & 1]);
        if (i > 0 && threadIdx.x == 0) tk[(i + 1) & 1] = (int)__hip_atomic_fetch_add(tick, 1u, __ATOMIC_RELAXED, __HIP_MEMORY_SCOPE_AGENT);
        if (t >= q) return false;
        const int id = xcd * q + t, nig = 8 * nN, gid = id / nig, fm = gid * 8, gsz = (nM - fm) < 8 ? (nM - fm) : 8;
        const int pm = fm + ((id % nig) % gsz), pn = (id % nig) / gsz;
        u.pm = pm; u.pn = pn; u.e = 0; u.aidx = nullptr; u.avalid = 256;
        u.aBase = A + (size_t)pm * 256 * ROWB; u.bBase = Bt + (size_t)pn * 256 * ROWB; return true;
    }
};
template <bool GATHER_, int CRIP_ = 0> struct SchedMoE {
    static constexpr bool GATHER = GATHER_ && !(CRIP_ & 32), FP8 = true; static constexpr int ROWB = 2048, CRIP = CRIP_;
    const char* A; const char* Bt; const int* stok; const LAS int* tstart; const LAS int* cnt; int nN, nrowsB  , G, c;
    __device__ __forceinline__ bool next(int i, Unit& u) const {
        const int nM = __builtin_amdgcn_readfirstlane(tstart[NE]); int pm, pn; if (!tile_order((long)i * G + c, nM, nN, pm, pn)) return false;
        int e = 0;
        for (int j = 1; j < NE; ++j) e += (tstart[j] <= pm) ? 1 : 0;
        e = __builtin_amdgcn_readfirstlane(e);
        const int mt = __builtin_amdgcn_readfirstlane(pm - tstart[e]);
        u.pm = pm; u.pn = pn; u.e = e;
        u.avalid = __builtin_amdgcn_readfirstlane(cnt[e]) - mt * 256;
        u.aidx = stok + (size_t)e * T + mt * 256;
        u.aBase = GATHER ? A : A + (size_t)(GATHER_ ? (pm & 127) : pm) * 256 * ROWB;
        u.bBase = Bt + ((size_t)e * nrowsB + (size_t)pn * 256) * ROWB;
        if constexpr ((CRIP_ & 8) != 0) { u.aBase = A; u.bBase = Bt; }
        return true;
    }
};
}

struct EpiNoPre { };
struct EpiInProj {
    static constexpr bool PERM = true; typedef EpiNoPre Pre;
    bf16* proj; float* dtraw;
    __device__ __forceinline__ void prefetch(const pg8::Unit&, Pre&) const {}
    __device__ __forceinline__ void operator()(const f32x4 (&acc)[2][2][4][2], const pg8::Unit& u, const Pre&, int wr, int wc, int fr, int fq) const {
        const int row0 = u.pm * 256 + wr * 64 + fr;
        if (u.pn < 15) {
            const int col0 = u.pn * 256 + wc * 32 + 8 * fq;
#pragma unroll
            for (int ai = 0; ai < 2; ++ai)
#pragma unroll
                for (int m = 0; m < 4; ++m) { bf16* rowp = proj + (size_t)(row0 + ai * 128 + m * 16) * PROJ_LD + col0;
#pragma unroll
                    for (int bj = 0; bj < 2; ++bj) { const f32x4 v0 = acc[ai][bj][m][0], v1 = acc[ai][bj][m][1];
                        v4u w; w.x = pk2(v0[0], v0[1]); w.y = pk2(v0[2], v0[3]); w.z = pk2(v1[0], v1[1]); w.w = pk2(v1[2], v1[3]);
                        *(v4u*)(rowp + bj * 128) = w; } }
        } else if (wc == 0 && fq < 2) {
#pragma unroll
            for (int ai = 0; ai < 2; ++ai)
#pragma unroll
                for (int m = 0; m < 4; ++m) { float* rowp = dtraw + (size_t)(row0 + ai * 128 + m * 16) * 16 + 8 * fq;
                    *(f32x4*)(rowp) = acc[ai][0][m][0]; *(f32x4*)(rowp + 4) = acc[ai][0][m][1]; }
        }
    }
};
struct EpiOutProj {
    static constexpr bool PERM = true; typedef EpiNoPre Pre;
    const float* x; bf16* x1; float* ssq;
    __device__ __forceinline__ void prefetch(const pg8::Unit&, Pre&) const {}
    __device__ __forceinline__ void operator()(const f32x4 (&acc)[2][2][4][2], const pg8::Unit& u, const Pre&, int wr, int wc, int fr, int fq) const {
        const int row0 = u.pm * 256 + wr * 64 + fr, col0 = u.pn * 256 + wc * 32 + 8 * fq;
#pragma unroll
        for (int ai = 0; ai < 2; ++ai) {
            f32x4 xv[4][2][2];
#pragma unroll
            for (int m = 0; m < 4; ++m)
#pragma unroll
                for (int bj = 0; bj < 2; ++bj)
#pragma unroll
                    for (int n = 0; n < 2; ++n) xv[m][bj][n] = *(const f32x4*)(x + (size_t)(row0 + ai * 128 + m * 16) * D + col0 + bj * 128 + n * 4);
#pragma unroll
            for (int m = 0; m < 4; ++m) { asm volatile("" : "+v"(xv[m][0][0]), "+v"(xv[m][0][1]), "+v"(xv[m][1][0]), "+v"(xv[m][1][1])); }
#pragma unroll
            for (int m = 0; m < 4; ++m) { const int row = row0 + ai * 128 + m * 16; const size_t off = (size_t)row * D + col0; float s = 0.f;
#pragma unroll
                for (int bj = 0; bj < 2; ++bj) { const f32x4 o0 = xv[m][bj][0] + acc[ai][bj][m][0], o1 = xv[m][bj][1] + acc[ai][bj][m][1];
                    *(v4u*)(x1 + off + bj * 128) = (v4u){pk2(o0[0], o0[1]), pk2(o0[2], o0[3]), pk2(o1[0], o1[1]), pk2(o1[2], o1[3])};
                    s += ((o0[0] * o0[0] + o0[1] * o0[1]) + (o0[2] * o0[2] + o0[3] * o0[3])) + ((o1[0] * o1[0] + o1[1] * o1[1]) + (o1[2] * o1[2] + o1[3] * o1[3])); }
                s += __shfl_xor(s, 16); s += __shfl_xor(s, 32);
                if (fq == 0) ssq[(size_t)row * 32 + u.pn * 4 + wc] = s; }
        }
    }
};
struct EpiGateUp {
    static constexpr bool PERM = true;
    struct Pre { f32x4 bg[2], bu[2]; };
    unsigned char* hb; const float* b_gate; const float* b_up;
    __device__ __forceinline__ void prefetch(const pg8::Unit& u, Pre& q) const {
        int tz = threadIdx.x; asm volatile("" : "+v"(tz)); const int wc = (tz >> 6) & 3, fq = (tz >> 4) & 3;
        const int f0 = u.pn * 128 + wc * 32 + 8 * fq;
#pragma unroll
        for (int n = 0; n < 2; ++n) { q.bg[n] = *(const f32x4*)(b_gate + (size_t)u.e * FF + f0 + 4 * n); q.bu[n] = *(const f32x4*)(b_up + (size_t)u.e * FF + f0 + 4 * n); }
    }
    __device__ __forceinline__ void operator()(const f32x4 (&acc)[2][2][4][2], const pg8::Unit& u, const Pre& q, int wr, int wc, int fr, int fq) const {
        const int row0 = u.pm * 256 + wr * 64 + fr, f0 = u.pn * 128 + wc * 32 + 8 * fq;
        constexpr float DS = 1.0f / (FP8_SA * FP8_SW);
#pragma unroll
        for (int ai = 0; ai < 2; ++ai)
#pragma unroll
            for (int m = 0; m < 4; ++m) { unsigned char* rowp = hb + (size_t)(row0 + ai * 128 + m * 16) * FF + f0; float h[8];
#pragma unroll
                for (int n = 0; n < 2; ++n)
#pragma unroll
                    for (int j = 0; j < 4; ++j) { const float g = acc[ai][0][m][n][j] * DS + q.bg[n][j], up = acc[ai][1][m][n][j] * DS + q.bu[n][j];
                        const float gl = fminf(g, 7.0f), li = __builtin_amdgcn_fmed3f(up, -7.0f, 7.0f);
                        const float sg = __builtin_amdgcn_rcpf(1.0f + __builtin_amdgcn_exp2f(gl * (-1.702f * 1.44269504f)));
                        h[n * 4 + j] = (gl * sg) * (li * FP8_SH + FP8_SH); }
                *(v2u*)rowp = (v2u){pk4_fp8(h[0], h[1], h[2], h[3]), pk4_fp8(h[4], h[5], h[6], h[7])}; }
    }
};
struct EpiDown {
    static constexpr bool PERM = true;
    struct Pre { f32x4 bv[2][2]; float gt[2][4]; };
    unsigned char* y2; const float* b_down; const float* sgate; const LAS int* tstart;
    __device__ __forceinline__ void prefetch(const pg8::Unit& u, Pre& q) const {
        int tz = threadIdx.x; asm volatile("" : "+v"(tz)); const int wid = tz >> 6, wr = wid >> 2, wc = wid & 3, fr = tz & 15, fq = (tz >> 4) & 3;
        const int rl0 = wr * 64 + fr, col0 = u.pn * 256 + wc * 32 + 8 * fq;
        const int mt = __builtin_amdgcn_readfirstlane(u.pm - tstart[u.e]);
        const float* gp = sgate + (size_t)u.e * T + mt * 256;
#pragma unroll
        for (int bj = 0; bj < 2; ++bj)
#pragma unroll
            for (int n = 0; n < 2; ++n) q.bv[bj][n] = *(const f32x4*)(b_down + (size_t)u.e * D + col0 + bj * 128 + 4 * n);
#pragma unroll
        for (int ai = 0; ai < 2; ++ai)
#pragma unroll
            for (int m = 0; m < 4; ++m) q.gt[ai][m] = gp[rl0 + ai * 128 + m * 16];
    }
    __device__ __forceinline__ void operator()(const f32x4 (&acc)[2][2][4][2], const pg8::Unit& u, const Pre& q, int wr, int wc, int fr, int fq) const {
        const int rl0 = wr * 64 + fr, col0 = u.pn * 256 + wc * 32 + 8 * fq;
        constexpr float DS = 1.0f / (FP8_SH * FP8_SW);
#pragma unroll
        for (int ai = 0; ai < 2; ++ai)
#pragma unroll
            for (int m = 0; m < 4; ++m) { const int rl = rl0 + ai * 128 + m * 16; const float gt = q.gt[ai][m] * FP8_SY; unsigned char* rowp = y2 + (size_t)(u.pm * 256 + rl) * D + col0;
#pragma unroll
                for (int bj = 0; bj < 2; ++bj) { const f32x4 v0 = (acc[ai][bj][m][0] * DS + q.bv[bj][0]) * gt, v1 = (acc[ai][bj][m][1] * DS + q.bv[bj][1]) * gt;
                    *(v2u*)(rowp + bj * 128) = (v2u){pk4_fp8(sat8(v0[0]), sat8(v0[1]), sat8(v0[2]), sat8(v0[3])), pk4_fp8(sat8(v1[0]), sat8(v1[1]), sat8(v1[2]), sat8(v1[3]))}; } }
    }
};

__device__ __forceinline__ void p0_tr_item(const float* W, int ldw, int k0, int n0, int nvalid, bf16* WT, int dst_row0, LAS float* scr, int lane) {
    const int c4 = (lane & 15) * 4, kr = lane >> 4;
#pragma unroll 4
    for (int i = 0; i < 16; ++i) { const int kk = 4 * i + kr;
        f32x4 v = (f32x4){0.f, 0.f, 0.f, 0.f};
        if (c4 < nvalid) v = *(const f32x4*)(W + (size_t)(k0 + kk) * ldw + n0 + c4);
        LAS float* d = scr + kk * 65 + c4; d[0] = v[0]; d[1] = v[1]; d[2] = v[2]; d[3] = v[3]; }
    LDS_WAIT(); asm volatile("" ::: "memory");
    const int c = lane >> 3, np = lane & 7;
#pragma unroll
    for (int j = 0; j < 8; ++j) { const int n = 8 * j + np; const LAS float* s = scr + (8 * c) * 65 + n;
        v4u o; o.x = pk2(s[0 * 65], s[1 * 65]); o.y = pk2(s[2 * 65], s[3 * 65]); o.z = pk2(s[4 * 65], s[5 * 65]); o.w = pk2(s[6 * 65], s[7 * 65]);
        *(v4u*)(WT + (size_t)(dst_row0 + n) * 2048 + k0 + 8 * c) = o; }
    LDS_WAIT(); asm volatile("" ::: "memory");
}
__device__ __forceinline__ void f8_tile_load(const float* src, f32x4 (&v)[16], int lane) {
    const float* s0 = src + (size_t)(16 * (lane >> 3)) * 2048 + 4 * (lane & 7);
#pragma unroll
    for (int i = 0; i < 16; ++i) v[i] = __builtin_nontemporal_load((const f32x4*)(s0 + (size_t)i * 2048));
}
__device__ __forceinline__ void f8_tile_store(const f32x4 (&v)[16], unsigned char* dst, int lane) {
    unsigned d[16];
#pragma unroll
    for (int i = 0; i < 16; ++i) d[i] = pk4_fp8(sat8(v[i][0] * FP8_SW), sat8(v[i][1] * FP8_SW), sat8(v[i][2] * FP8_SW), sat8(v[i][3] * FP8_SW));
    unsigned o[4][4];
#pragma unroll
    for (int w = 0; w < 4; ++w) {
        const unsigned t0 = __builtin_amdgcn_perm(d[4 * w + 1], d[4 * w], 0x05010400u), t1 = __builtin_amdgcn_perm(d[4 * w + 1], d[4 * w], 0x07030602u);
        const unsigned t2 = __builtin_amdgcn_perm(d[4 * w + 3], d[4 * w + 2], 0x05010400u), t3 = __builtin_amdgcn_perm(d[4 * w + 3], d[4 * w + 2], 0x07030602u);
        o[0][w] = __builtin_amdgcn_perm(t2, t0, 0x05040100u); o[1][w] = __builtin_amdgcn_perm(t2, t0, 0x07060302u);
        o[2][w] = __builtin_amdgcn_perm(t3, t1, 0x05040100u); o[3][w] = __builtin_amdgcn_perm(t3, t1, 0x07060302u);
    }
    unsigned char* d0 = dst + (size_t)(4 * (lane & 7)) * 2048 + 16 * (lane >> 3);
#pragma unroll
    for (int b = 0; b < 4; ++b) __builtin_nontemporal_store((v4u){o[b][0], o[b][1], o[b][2], o[b][3]}, (v4u*)(d0 + (size_t)b * 2048));
}
__device__ __forceinline__ void f8_item(const Params& p, int it, const float*& src, unsigned char*& dst) {
    const int which = it >> 15, r = it & 32767, e = r >> 10, q = r & 1023, kb = q >> 6, nb = q & 63;
    if (which == 2) { src = p.w_down + (size_t)e * FF * D + (size_t)(kb * 128) * D + nb * 32; dst = p.ws + WS_WD + ((size_t)e * D + nb * 32) * 2048 + kb * 128; }
    else { const int f0 = nb * 32, drow = (f0 >> 7) * 256 + which * 128 + (f0 & 127);
        src = (which == 0 ? p.w_gate : p.w_up) + (size_t)e * D * FF + (size_t)(kb * 128) * FF + f0; dst = p.ws + WS_WGU + ((size_t)e * 4096 + drow) * 2048 + kb * 128; }
}
__device__ __forceinline__ void convert_experts(const Params& p, int first, int stride, int lane) {
    constexpr int NEXP = 3 * NE * 1024;
    f32x4 va[16], vb[16]; const float* sa; unsigned char* da; const float* sb; unsigned char* db;
    int ia = first, ib;
    if (ia < NEXP) { f8_item(p, ia, sa, da); f8_tile_load(sa, va, lane); }
    for (;;) {
        if (ia >= NEXP) break;
        ib = ia + stride; if (ib < NEXP) { f8_item(p, ib, sb, db); f8_tile_load(sb, vb, lane); }
        f8_tile_store(va, da, lane);
        if (ib >= NEXP) break;
        ia = ib + stride; if (ia < NEXP) { f8_item(p, ia, sa, da); f8_tile_load(sa, va, lane); }
        f8_tile_store(vb, db, lane);
    }
}
__device__ __forceinline__ void phase_prologue(const Params& p, LAS unsigned char* lds, int gw, int NGW, int wave, int lane) {
    LAS float* scr = (LAS float*)(lds + wave * 16896);
    bf16* WIN = (bf16*)(p.ws + WS_WIN); bf16* WOUT = (bf16*)(p.ws + WS_WOUT);
    constexpr int I_IN = 32 * 64, I_OUT = 32 * 32;
    for (int it = gw; it < I_IN + I_OUT; it += NGW) {
        int r = it;
        if (r < I_IN) { const int kb = r / 64, nb = r % 64; int nv = NIN - nb * 64; nv = nv < 0 ? 0 : (nv > 64 ? 64 : nv);
            p0_tr_item(p.w_in, NIN, kb * 64, nb * 64, nv, WIN, nb * 64, scr, lane); continue; }
        r -= I_IN;
        { const int kb = r / 32, nb = r % 32; p0_tr_item(p.w_out, D, kb * 64, nb * 64, 64, WOUT, nb * 64, scr, lane); }
    }
    {
        bf16* wrb = (bf16*)(p.ws + WS_WRB);
        for (int idx = gw * 64 + lane; idx < D * NE; idx += NGW * 64) { const int k = idx >> 5, n = idx & 31, j = k >> 5, kq = (k >> 3) & 3, m = k & 7, half = n >> 4, l64 = kq * 16 + (n & 15);
            const float w = p.w_router[idx]; const unsigned hi = f2bf(w); const float lo = w - bflo(hi);
            wrb[((((size_t)j * 2 + half) * 2 + 0) * 64 + l64) * 8 + m] = (bf16)hi; wrb[((((size_t)j * 2 + half) * 2 + 1) * 64 + l64) * 8 + m] = (bf16)f2bf(lo); }
    }
    bf16* HN = (bf16*)(p.ws + WS_HN);
    f32x4 gw4[8];
#pragma unroll
    for (int j = 0; j < 8; ++j) gw4[j] = *((const f32x4*)p.attn_norm_w + 64 * j + lane);
    f32x4 vn[8];
    if (gw < T) { const f32x4* xr = (const f32x4*)(p.x + (size_t)gw * D) + lane;
#pragma unroll
        for (int j = 0; j < 8; ++j) vn[j] = xr[64 * j]; }
    for (int m = gw; m < T; m += NGW) {
        f32x4 v[8]; float s = 0.f;
#pragma unroll
        for (int j = 0; j < 8; ++j) v[j] = vn[j];
        if (m + NGW < T) { const f32x4* xr = (const f32x4*)(p.x + (size_t)(m + NGW) * D) + lane;
#pragma unroll
            for (int j = 0; j < 8; ++j) vn[j] = xr[64 * j]; }
#pragma unroll
        for (int j = 0; j < 8; ++j) s += (v[j][0] * v[j][0] + v[j][1] * v[j][1]) + (v[j][2] * v[j][2] + v[j][3] * v[j][3]);
        const float rstd = rsqrtf(wave_sum(s) * (1.f / D) + EPS);
        v2u* o8 = (v2u*)(HN + (size_t)m * D) + lane;
#pragma unroll
        for (int j = 0; j < 8; ++j) { v2u w; w.x = pk2(v[j][0] * rstd * gw4[j][0], v[j][1] * rstd * gw4[j][1]); w.y = pk2(v[j][2] * rstd * gw4[j][2], v[j][3] * rstd * gw4[j][3]); o8[64 * j] = w; }
    }
}

__device__ __forceinline__ void phase_conv(const Params& p, int G) {
    const bf16* proj = (const bf16*)(p.ws + WS_PROJ); float* xbc = (float*)(p.ws + WS_XBC);
    const float* dtraw = (const float*)(p.ws + WS_DT); float* dts = (float*)(p.ws + WS_DTS);
    const int tid = threadIdx.x;
    for (int item = blockIdx.x; item < T / 64; item += G) {
        const int t0 = item * 64;
        if (tid < 384) {
            const int cg = tid % 192, half = tid / 192, c0 = cg * 8, ts = t0 + half * 32;
            float w[4][8], bb[8];
#pragma unroll
            for (int k = 0; k < 4; ++k)
#pragma unroll
                for (int j = 0; j < 8; ++j) w[k][j] = p.conv_w[k * NXBC + c0 + j];
#pragma unroll
            for (int j = 0; j < 8; ++j) bb[j] = p.conv_b[c0 + j];
            float r0[8], r1[8], r2[8];
            {
                const int tl = ts % SEQ;
                v4u q0 = (v4u){0u, 0u, 0u, 0u}, q1 = q0, q2 = q0;
                if (tl - 3 >= 0) q0 = *(const v4u*)(proj + (size_t)(ts - 3) * PROJ_LD + COL_XBC + c0);
                if (tl - 2 >= 0) q1 = *(const v4u*)(proj + (size_t)(ts - 2) * PROJ_LD + COL_XBC + c0);
                if (tl - 1 >= 0) q2 = *(const v4u*)(proj + (size_t)(ts - 1) * PROJ_LD + COL_XBC + c0);
                unpack8(q0, r0); unpack8(q1, r1); unpack8(q2, r2);
            }
            for (int i = 0; i < 32; ++i) {
                const int t = ts + i;
                const v4u q = *(const v4u*)(proj + (size_t)t * PROJ_LD + COL_XBC + c0);
                float r3[8]; unpack8(q, r3);
                float o[8];
#pragma unroll
                for (int j = 0; j < 8; ++j) { const float a = bb[j] + w[0][j] * r0[j] + w[1][j] * r1[j] + w[2][j] * r2[j] + w[3][j] * r3[j]; o[j] = a * fsigmoid(a); }
                float* dp = xbc + (size_t)t * NXBC + c0;
                *(f32x4*)dp = (f32x4){o[0], o[1], o[2], o[3]}; *(f32x4*)(dp + 4) = (f32x4){o[4], o[5], o[6], o[7]};
#pragma unroll
                for (int j = 0; j < 8; ++j) { r0[j] = r1[j]; r1[j] = r2[j]; r2[j] = r3[j]; }
            }
        } else {
            const int u = tid - 384;
#pragma unroll
            for (int i = 0; i < 8; ++i) { const int idx = u + 128 * i; const int t = t0 + (idx >> 4), h = idx & 15;
                const float v = dtraw[(size_t)t * 16 + h] + p.dt_bias[h];
                dts[(size_t)t * 16 + h] = fmaxf(v, 0.f) + log1pf(__expf(-fabsf(v))); }
        }
    }
}

__device__ __forceinline__ void phase_attn_simple(const Params& p, LAS unsigned char* lds, int G) {
    const bf16* proj = (const bf16*)(p.ws + WS_PROJ); float* att = (float*)(p.ws + WS_ATT);
    LAS float* Ks = (LAS float*)lds; LAS float* Vs = (LAS float*)(lds + 256 * 68 * 4);
    const int tid = threadIdx.x;
    for (int item = blockIdx.x; item < NB * 64 * 2; item += G) {
        const int b = item >> 7, n = (item >> 1) & 63, hk = item & 1;
        __syncthreads();
        {
            const int j = tid >> 1, hf = tid & 1, pos = n * 128 - 128 + j;
            float kv[32], vv[32];
            if (pos >= 0) {
                const bf16* kp = proj + (size_t)(b * SEQ + pos) * PROJ_LD + COL_K + hk * 64 + hf * 32;
                const bf16* vp = proj + (size_t)(b * SEQ + pos) * PROJ_LD + COL_V + hk * 64 + hf * 32;
#pragma unroll
                for (int c = 0; c < 4; ++c) { const v4u a = *(const v4u*)(kp + 8 * c), bq = *(const v4u*)(vp + 8 * c);
                    kv[8 * c + 0] = bflo(a.x); kv[8 * c + 1] = bfhi(a.x); kv[8 * c + 2] = bflo(a.y); kv[8 * c + 3] = bfhi(a.y); kv[8 * c + 4] = bflo(a.z); kv[8 * c + 5] = bfhi(a.z); kv[8 * c + 6] = bflo(a.w); kv[8 * c + 7] = bfhi(a.w);
                    vv[8 * c + 0] = bflo(bq.x); vv[8 * c + 1] = bfhi(bq.x); vv[8 * c + 2] = bflo(bq.y); vv[8 * c + 3] = bfhi(bq.y); vv[8 * c + 4] = bflo(bq.z); vv[8 * c + 5] = bfhi(bq.z); vv[8 * c + 6] = bflo(bq.w); vv[8 * c + 7] = bfhi(bq.w); }
            } else {
#pragma unroll
                for (int d = 0; d < 32; ++d) { kv[d] = 0.f; vv[d] = 0.f; }
            }
            float s = 0.f;
#pragma unroll
            for (int d = 0; d < 32; ++d) s += kv[d] * kv[d];
            s += __shfl_xor(s, 1);
            const float rstd = rsqrtf(s * (1.f / 64.f) + EPS);
#pragma unroll
            for (int d = 0; d < 32; ++d) { Ks[j * 68 + hf * 32 + d] = kv[d] * rstd * p.k_norm_w[hf * 32 + d]; Vs[j * 68 + hf * 32 + d] = vv[d]; }
        }
        __syncthreads();
        const int qi = tid & 127, grp = tid >> 7;
        const int tok = b * SEQ + n * 128 + qi;
        for (int hh = 0; hh < 2; ++hh) {
            const int hq = hk * 8 + grp * 2 + hh;
            float q[64];
            {
                const bf16* qp = proj + (size_t)tok * PROJ_LD + COL_Q + hq * 64;
                float s = 0.f;
#pragma unroll
                for (int c = 0; c < 8; ++c) { const v4u a = *(const v4u*)(qp + 8 * c);
                    q[8 * c + 0] = bflo(a.x); q[8 * c + 1] = bfhi(a.x); q[8 * c + 2] = bflo(a.y); q[8 * c + 3] = bfhi(a.y); q[8 * c + 4] = bflo(a.z); q[8 * c + 5] = bfhi(a.z); q[8 * c + 6] = bflo(a.w); q[8 * c + 7] = bfhi(a.w); }
#pragma unroll
                for (int d = 0; d < 64; ++d) s += q[d] * q[d];
                const float rstd = rsqrtf(s * (1.f / 64.f) + EPS) * 0.125f;
#pragma unroll
                for (int d = 0; d < 64; ++d) q[d] = q[d] * rstd * p.q_norm_w[d];
            }
            float mx = p.sinks[hq], l = 1.0f, o[64];
#pragma unroll
            for (int d = 0; d < 64; ++d) o[d] = 0.f;
            const int jlo = (n == 0) ? 128 : qi + 1;
            for (int j = jlo; j <= qi + 128; ++j) {
                const LAS f32x4* kr = (const LAS f32x4*)(Ks + j * 68);
                float s = 0.f;
#pragma unroll
                for (int c = 0; c < 16; ++c) { const f32x4 kk = kr[c]; s += q[4 * c] * kk[0] + q[4 * c + 1] * kk[1] + q[4 * c + 2] * kk[2] + q[4 * c + 3] * kk[3]; }
                const float mn = fmaxf(mx, s), corr = __expf(mx - mn), pj = __expf(s - mn);
                l = l * corr + pj; mx = mn;
                const LAS f32x4* vr = (const LAS f32x4*)(Vs + j * 68);
#pragma unroll
                for (int c = 0; c < 16; ++c) { const f32x4 vv = vr[c]; o[4 * c] = o[4 * c] * corr + pj * vv[0]; o[4 * c + 1] = o[4 * c + 1] * corr + pj * vv[1]; o[4 * c + 2] = o[4 * c + 2] * corr + pj * vv[2]; o[4 * c + 3] = o[4 * c + 3] * corr + pj * vv[3]; }
            }
            const float inv = 1.0f / l;
            float* op = att + (size_t)tok * 1024 + hq * 64;
#pragma unroll
            for (int c = 0; c < 16; ++c) *(f32x4*)(op + 4 * c) = (f32x4){o[4 * c] * inv, o[4 * c + 1] * inv, o[4 * c + 2] * inv, o[4 * c + 3] * inv};
        }
    }
}

__device__ __forceinline__ void phase_ssd_seq(const Params& p, LAS unsigned char* lds, int G) {
    const float* xbc = (const float*)(p.ws + WS_XBC); const float* dts = (const float*)(p.ws + WS_DTS); float* ys = (float*)(p.ws + WS_YS);
    constexpr int TT = 64;
    LAS float* Bs = (LAS float*)lds;
    LAS float* Cs = Bs + TT * 128;
    LAS float* xs = Cs + TT * 128;
    LAS float* dl = xs + TT * 16;
    LAS float* yo = dl + TT;
    const int tid = threadIdx.x, pl = tid >> 5, ns = tid & 31;
    for (int item = blockIdx.x; item < NB * 16 * 4; item += G) {
        const int b = item >> 6, h = (item >> 2) & 15, pq = item & 3, g = h >> 3;
        const float a = -__expf(p.a_log[h]), dsk = p.d_skip[h];
        f32x4 st = (f32x4){0.f, 0.f, 0.f, 0.f};
        for (int tc = 0; tc < SEQ; tc += TT) {
            __syncthreads();
            const size_t tb = (size_t)b * SEQ + tc;
            for (int i = tid; i < TT * 32; i += NTHREADS) { const int tt = i >> 5, c = (i & 31) * 4;
                *(LAS f32x4*)(Bs + tt * 128 + c) = *(const f32x4*)(xbc + (tb + tt) * NXBC + 1024 + g * 128 + c);
                *(LAS f32x4*)(Cs + tt * 128 + c) = *(const f32x4*)(xbc + (tb + tt) * NXBC + 1280 + g * 128 + c); }
            for (int i = tid; i < TT * 16; i += NTHREADS) { const int tt = i >> 4, c = i & 15; xs[i] = xbc[(tb + tt) * NXBC + h * 64 + pq * 16 + c]; }
            if (tid < TT) dl[tid] = dts[(tb + tid) * 16 + h];
            __syncthreads();
            for (int tt = 0; tt < TT; ++tt) {
                const float dt = dl[tt], xv = xs[tt * 16 + pl];
                const float dA = __expf(dt * a), xd = xv * dt;
                const f32x4 bv = *(const LAS f32x4*)(Bs + tt * 128 + ns * 4), cv = *(const LAS f32x4*)(Cs + tt * 128 + ns * 4);
                st = st * dA + bv * xd;
                float y = (cv[0] * st[0] + cv[1] * st[1]) + (cv[2] * st[2] + cv[3] * st[3]);
                y += __shfl_xor(y, 1); y += __shfl_xor(y, 2); y += __shfl_xor(y, 4); y += __shfl_xor(y, 8); y += __shfl_xor(y, 16);
                if (ns == 0) yo[tt * 16 + pl] = y + dsk * xv;
            }
            __syncthreads();
            for (int i = tid; i < TT * 16; i += NTHREADS) { const int tt = i >> 4, c = i & 15; ys[(tb + tt) * 1024 + h * 64 + pq * 16 + c] = yo[i]; }
        }
    }
}


typedef float f32x16 __attribute__((ext_vector_type(16)));
#define MFMA32(a, b, c) __builtin_amdgcn_mfma_f32_32x32x16_bf16(a, b, c, 0, 0, 0)
constexpr int SPT = 136;
__device__ __forceinline__ float softplus_f(float v) { return fmaxf(v, 0.f) + log1pf(__expf(-fabsf(v))); }

__device__ __forceinline__ void ssd_tables(const Params& p, LAS float* dtl, LAS float* csl, LAS float* wtot, size_t trow0, int h0, int nh, int lane, int wave) {
    const float* dtraw = (const float*)(p.ws + WS_DT);
    for (int rnd = 0; rnd < nh / 4; ++rnd) {
        const int hh = rnd * 4 + (wave >> 1), l = (wave & 1) * 64 + lane, h = h0 + hh;
        const float dt = softplus_f(dtraw[(trow0 + l) * 16 + h] + p.dt_bias[h]);
        float v = dt * (-expf(p.a_log[h]));
#pragma unroll
        for (int o = 1; o < 64; o <<= 1) { const float u = __shfl_up(v, o); v = (lane >= o) ? v + u : v; }
        if (lane == 63) wtot[rnd * 8 + wave] = v;
        __syncthreads();
        if (wave & 1) v += wtot[rnd * 8 + wave - 1];
        dtl[hh * 128 + l] = dt; csl[hh * 128 + l] = v;
    }
    __syncthreads();
}
template <bool TR, bool SCALE>
__device__ __forceinline__ void conv_task(const Params& p, const bf16* proj, size_t trow0, int tl0, int run, int xcol, LAS bf16* dst, int d0, const LAS float* sc) {
    float w[4][8], bb[8];
#pragma unroll
    for (int k = 0; k < 4; ++k) { const f32x4 a = *(const f32x4*)(p.conv_w + k * NXBC + xcol), b = *(const f32x4*)(p.conv_w + k * NXBC + xcol + 4);
        w[k][0] = a[0]; w[k][1] = a[1]; w[k][2] = a[2]; w[k][3] = a[3]; w[k][4] = b[0]; w[k][5] = b[1]; w[k][6] = b[2]; w[k][7] = b[3]; }
    { const f32x4 a = *(const f32x4*)(p.conv_b + xcol), b = *(const f32x4*)(p.conv_b + xcol + 4); bb[0] = a[0]; bb[1] = a[1]; bb[2] = a[2]; bb[3] = a[3]; bb[4] = b[0]; bb[5] = b[1]; bb[6] = b[2]; bb[7] = b[3]; }
    const int l0 = run * 8; const bf16* src = proj + (trow0 + l0) * PROJ_LD + COL_XBC + xcol;
    float r0[8], r1[8], r2[8];
    { const int pos = tl0 + l0; v4u q0 = (v4u){0u, 0u, 0u, 0u}, q1 = q0, q2 = q0;
      if (pos - 3 >= 0) q0 = *(const v4u*)(src - 3 * PROJ_LD);
      if (pos - 2 >= 0) q1 = *(const v4u*)(src - 2 * PROJ_LD);
      if (pos - 1 >= 0) q2 = *(const v4u*)(src - 1 * PROJ_LD);
      unpack8(q0, r0); unpack8(q1, r1); unpack8(q2, r2); }
#pragma unroll
    for (int i = 0; i < 8; i += 2) {
        float r3[8], r4[8], o0[8], o1[8];
        unpack8(*(const v4u*)(src + (size_t)i * PROJ_LD), r3); unpack8(*(const v4u*)(src + (size_t)(i + 1) * PROJ_LD), r4);
#pragma unroll
        for (int j = 0; j < 8; ++j) { const float a0 = bb[j] + w[0][j] * r0[j] + w[1][j] * r1[j] + w[2][j] * r2[j] + w[3][j] * r3[j];
            const float a1 = bb[j] + w[0][j] * r1[j] + w[1][j] * r2[j] + w[2][j] * r3[j] + w[3][j] * r4[j];
            o0[j] = a0 * fsigmoid(a0); o1[j] = a1 * fsigmoid(a1); }
        if constexpr (TR) {
            float s0 = 1.f, s1 = 1.f; if constexpr (SCALE) { s0 = sc[l0 + i]; s1 = sc[l0 + i + 1]; }
#pragma unroll
            for (int j = 0; j < 8; ++j) *(LAS unsigned*)(dst + (d0 + j) * SPT + l0 + i) = pk2(o0[j] * s0, o1[j] * s1);
        } else {
            *(LAS v4u*)(dst + (l0 + i) * SPT + d0) = (v4u){pk2(o0[0], o0[1]), pk2(o0[2], o0[3]), pk2(o0[4], o0[5]), pk2(o0[6], o0[7])};
            *(LAS v4u*)(dst + (l0 + i + 1) * SPT + d0) = (v4u){pk2(o1[0], o1[1]), pk2(o1[2], o1[3]), pk2(o1[4], o1[5]), pk2(o1[6], o1[7])};
        }
#pragma unroll
        for (int j = 0; j < 8; ++j) { r0[j] = r2[j]; r1[j] = r3[j]; r2[j] = r4[j]; }
    }
}

__device__ __forceinline__ void phase_ssd_states(const Params& p, LAS unsigned char* lds, int G, int lane, int wave) {
    const bf16* proj = (const bf16*)(p.ws + WS_PROJ); float* states = (float*)(p.ws + WS_STATES); float* cdec = (float*)(p.ws + WS_CDEC);
    LAS bf16* BT = (LAS bf16*)lds;
    LAS bf16* XdT = BT + 128 * SPT;
    LAS float* dtl = (LAS float*)(lds + 384 * SPT * 2);
    LAS float* csl = dtl + 512; LAS float* scl = csl + 512; LAS float* wtot = scl + 512;
    const int tid = threadIdx.x, r = lane & 31, hf = lane >> 5;
    for (int item = blockIdx.x; item < NB * 64 * 4; item += G) {
        const int b = item >> 8, c = (item >> 2) & 63, g = (item >> 1) & 1, hh2 = item & 1;
        const int h0 = g * 8 + hh2 * 4; const size_t trow0 = (size_t)b * SEQ + c * 128; const int tl0 = c * 128;
        __syncthreads();
        ssd_tables(p, dtl, csl, wtot, trow0, h0, 4, lane, wave);
        scl[tid] = dtl[tid] * __expf(csl[(tid & ~127) + 127] - csl[tid]);
        if ((tid & 127) == 127) cdec[((size_t)b * 64 + c) * 16 + h0 + (tid >> 7)] = __expf(csl[tid]);
        __syncthreads();
        for (int task = tid; task < 48 * 16; task += NTHREADS) { const int cg = task >> 4, run = task & 15;
            if (cg < 16) conv_task<true, false>(p, proj, trow0, tl0, run, 1024 + g * 128 + cg * 8, BT, cg * 8, nullptr);
            else { const int cx = cg - 16; conv_task<true, true>(p, proj, trow0, tl0, run, h0 * 64 + cx * 8, XdT, cx * 8, scl + (cx >> 3) * 128); } }
        __syncthreads();
        const int hh = wave >> 1, nh_ = wave & 1;
        f32x16 acc[2][2];
#pragma unroll
        for (int a = 0; a < 2; ++a)
#pragma unroll
            for (int bq = 0; bq < 2; ++bq)
#pragma unroll
                for (int e = 0; e < 16; ++e) acc[a][bq][e] = 0.f;
#pragma unroll
        for (int ks = 0; ks < 8; ++ks) {
            bf16x8 af[2], bfm[2];
#pragma unroll
            for (int pt = 0; pt < 2; ++pt) af[pt] = *(const LAS bf16x8*)(XdT + (hh * 64 + pt * 32 + r) * SPT + ks * 16 + 8 * hf);
#pragma unroll
            for (int nt = 0; nt < 2; ++nt) bfm[nt] = *(const LAS bf16x8*)(BT + (nh_ * 64 + nt * 32 + r) * SPT + ks * 16 + 8 * hf);
#pragma unroll
            for (int pt = 0; pt < 2; ++pt)
#pragma unroll
                for (int nt = 0; nt < 2; ++nt) acc[pt][nt] = MFMA32(af[pt], bfm[nt], acc[pt][nt]);
        }
        float* sp = states + (((size_t)b * 64 + c) * 16 + h0 + hh) * 64 * 128;
#pragma unroll
        for (int pt = 0; pt < 2; ++pt)
#pragma unroll
            for (int nt = 0; nt < 2; ++nt)
#pragma unroll
                for (int e = 0; e < 16; ++e) sp[(pt * 32 + (e & 3) + 8 * (e >> 2) + 4 * hf) * 128 + nh_ * 64 + nt * 32 + r] = acc[pt][nt][e];
    }
}
__device__ __forceinline__ void phase_ssd_scan(const Params& p, int G) {
    const float* states = (const float*)(p.ws + WS_STATES); const float* cdec = (const float*)(p.ws + WS_CDEC); bf16* sin = (bf16*)(p.ws + WS_SIN);
    for (int idx = blockIdx.x * NTHREADS + threadIdx.x; idx < NB * 16 * 64 * 32; idx += G * NTHREADS) {
        const int n4 = idx & 31, pp = (idx >> 5) & 63, h = (idx >> 11) & 15, b = idx >> 15;
        f32x4 run = (f32x4){0.f, 0.f, 0.f, 0.f};
#pragma unroll 8
        for (int c = 0; c < 64; ++c) {
            const size_t off = ((((size_t)b * 64 + c) * 16 + h) * 64 + pp) * 128 + n4 * 4;
            const f32x4 st = *(const f32x4*)(states + off); const float dec = cdec[((size_t)b * 64 + c) * 16 + h];
            *(v2u*)(sin + off) = (v2u){pk2(run[0], run[1]), pk2(run[2], run[3])};
            run = run * dec + st;
        }
    }
}
__device__ __forceinline__ void ssd_out_pass(const Params& p, const bf16* proj, const bf16* sinp  , const LAS bf16* Cs, const LAS bf16* CB, const LAS bf16* XT,
                                             const LAS float* dth, const LAS float* csh  , LAS float* ssqh  , float Dh, size_t trow0, int h, int hh, int lsel, int r, int hf,
                                             unsigned (&yp)[2][2][8]) {
    f32x16 acc[2][2];
#pragma unroll
    for (int a = 0; a < 2; ++a)
#pragma unroll
        for (int bq = 0; bq < 2; ++bq)
#pragma unroll
            for (int e = 0; e < 16; ++e) acc[a][bq][e] = 0.f;
#pragma unroll
    for (int pt = 0; pt < 2; ++pt) {
        bf16x8 af[8];
#pragma unroll
        for (int ks = 0; ks < 8; ++ks) af[ks] = *(const bf16x8*)(sinp + (pt * 32 + r) * 128 + ks * 16 + 8 * hf);
#pragma unroll
        for (int j = 0; j < 2; ++j) { const int lt = j == 0 ? (lsel ? 1 : 0) : (lsel ? 2 : 3);
#pragma unroll
            for (int ks = 0; ks < 8; ++ks) { const bf16x8 bq = *(const LAS bf16x8*)(Cs + (lt * 32 + r) * SPT + ks * 16 + 8 * hf); acc[pt][j] = MFMA32(af[ks], bq, acc[pt][j]); } }
    }
#pragma unroll
    for (int j = 0; j < 2; ++j) { const int lt = j == 0 ? (lsel ? 1 : 0) : (lsel ? 2 : 3); const float el = __expf(csh[lt * 32 + r]);
#pragma unroll
        for (int pt = 0; pt < 2; ++pt) acc[pt][j] = acc[pt][j] * el; }
#pragma unroll
    for (int j = 0; j < 2; ++j) { const int lt = j == 0 ? (lsel ? 1 : 0) : (lsel ? 2 : 3); const int lcol = lt * 32 + r; const float csL = csh[lcol]; const int nks = 2 * lt + 2;
        for (int ks = 0; ks < nks; ++ks) { const int s0 = ks * 16 + 8 * hf;
            const v4u cbv = *(const LAS v4u*)(CB + lcol * SPT + s0);
            const f32x4 c0 = *(const LAS f32x4*)(csh + s0), c1 = *(const LAS f32x4*)(csh + s0 + 4), d0 = *(const LAS f32x4*)(dth + s0), d1 = *(const LAS f32x4*)(dth + s0 + 4);
            float cbf[8]; unpack8(cbv, cbf); float m[8];
#pragma unroll
            for (int jj = 0; jj < 8; ++jj) { const float cs_s = jj < 4 ? c0[jj & 3] : c1[jj & 3], dt_s = jj < 4 ? d0[jj & 3] : d1[jj & 3];
                float v = cbf[jj] * __expf(fminf(csL - cs_s, 0.f)) * dt_s; v = (s0 + jj <= lcol) ? v : 0.f; m[jj] = (s0 + jj == lcol) ? v + Dh : v; }
            v4u mp; mp.x = pk2(m[0], m[1]); mp.y = pk2(m[2], m[3]); mp.z = pk2(m[4], m[5]); mp.w = pk2(m[6], m[7]);
            const bf16x8 mf = __builtin_bit_cast(bf16x8, mp);
#pragma unroll
            for (int pt = 0; pt < 2; ++pt) { const bf16x8 a = *(const LAS bf16x8*)(XT + (hh * 64 + pt * 32 + r) * SPT + s0); acc[pt][j] = MFMA32(a, mf, acc[pt][j]); }
        } }
#pragma unroll
    for (int j = 0; j < 2; ++j) { const int lt = j == 0 ? (lsel ? 1 : 0) : (lsel ? 2 : 3); const size_t t = trow0 + lt * 32 + r; float ss = 0.f;
#pragma unroll
        for (int pt = 0; pt < 2; ++pt)
#pragma unroll
            for (int q = 0; q < 4; ++q) { const v2u zz = *(const v2u*)(proj + t * PROJ_LD + COL_Z + h * 64 + pt * 32 + 8 * q + 4 * hf);
                const float z0 = bflo(zz.x), z1 = bfhi(zz.x), z2 = bflo(zz.y), z3 = bfhi(zz.y);
                const float g0 = acc[pt][j][4 * q] * (z0 * fsigmoid(z0)), g1 = acc[pt][j][4 * q + 1] * (z1 * fsigmoid(z1)), g2 = acc[pt][j][4 * q + 2] * (z2 * fsigmoid(z2)), g3 = acc[pt][j][4 * q + 3] * (z3 * fsigmoid(z3));
                yp[pt][j][2 * q] = pk2(g0, g1); yp[pt][j][2 * q + 1] = pk2(g2, g3);
                ss += (g0 * g0 + g1 * g1) + (g2 * g2 + g3 * g3); }
        ss += __shfl_xor(ss, 32);
        if (hf == 0) ssqh[lt * 32 + r] = ss; }
}
__device__ __forceinline__ void ssd_out_store(const Params& p, bf16* mix, const LAS float* ssqp, size_t trow0, int h, int lsel, int r, int hf, const unsigned (&yp)[2][2][8]) {
    f32x4 w4[2][4];
#pragma unroll
    for (int pt = 0; pt < 2; ++pt)
#pragma unroll
        for (int q = 0; q < 4; ++q) w4[pt][q] = *(const f32x4*)(p.ssm_norm_w + h * 64 + pt * 32 + 8 * q + 4 * hf);
#pragma unroll
    for (int pt = 0; pt < 2; ++pt) { asm volatile("" : "+v"(w4[pt][0]), "+v"(w4[pt][1]), "+v"(w4[pt][2]), "+v"(w4[pt][3])); }
#pragma unroll
    for (int j = 0; j < 2; ++j) { const int lt = j == 0 ? (lsel ? 1 : 0) : (lsel ? 2 : 3); const int l = lt * 32 + r; const size_t t = trow0 + l;
        float tot = 0.f;
#pragma unroll
        for (int hd = 0; hd < 8; ++hd) tot += ssqp[hd * 128 + l];
        const float rstd = rsqrtf(tot * (1.f / 512.f) + EPS);
#pragma unroll
        for (int pt = 0; pt < 2; ++pt)
#pragma unroll
            for (int q = 0; q < 4; ++q) { const int col = h * 64 + pt * 32 + 8 * q + 4 * hf;
                const unsigned u0 = yp[pt][j][2 * q], u1 = yp[pt][j][2 * q + 1];
                v2u o; o.x = pk2(bflo(u0) * rstd * w4[pt][q][0], bfhi(u0) * rstd * w4[pt][q][1]); o.y = pk2(bflo(u1) * rstd * w4[pt][q][2], bfhi(u1) * rstd * w4[pt][q][3]);
                *(v2u*)(mix + t * D + 1024 + col) = o; } }
}
__device__ __forceinline__ void phase_ssd_out(const Params& p, LAS unsigned char* lds, int G, int lane, int wave) {
    const bf16* proj = (const bf16*)(p.ws + WS_PROJ); const bf16* sin = (const bf16*)(p.ws + WS_SIN); bf16* mix = (bf16*)(p.ws + WS_MIX);
    LAS bf16* Cs = (LAS bf16*)lds;
    LAS bf16* Bs = Cs + 128 * SPT;
    LAS bf16* XT = Bs + 128 * SPT;
    LAS float* dtl = (LAS float*)(lds + 512 * SPT * 2);
    LAS float* csl = dtl + 1024; LAS float* ssqp = csl + 1024; LAS float* wtot = ssqp + 1024;
    const int tid = threadIdx.x, r = lane & 31, hf = lane >> 5;
    for (int item = blockIdx.x; item < NB * 64 * 2; item += G) {
        const int b = item >> 7, c = (item >> 1) & 63, g = item & 1;
        const int h0 = g * 8; const size_t trow0 = (size_t)b * SEQ + c * 128; const int tl0 = c * 128;
        __syncthreads();
        { int tz_ = threadIdx.x; asm volatile("" : "+v"(tz_)); ssd_tables(p, dtl, csl, wtot, trow0, h0, 8, tz_ & 63, __builtin_amdgcn_readfirstlane(tz_ >> 6)); }
        int tq = threadIdx.x; asm volatile("" : "+v"(tq));
        for (int task = tq; task < 64 * 16; task += NTHREADS) { const int cg = task >> 4, run = task & 15;
            if (cg < 16) conv_task<false, false>(p, proj, trow0, tl0, run, 1280 + g * 128 + cg * 8, Cs, cg * 8, nullptr);
            else if (cg < 32) conv_task<false, false>(p, proj, trow0, tl0, run, 1024 + g * 128 + (cg - 16) * 8, Bs, (cg - 16) * 8, nullptr);
            else conv_task<true, false>(p, proj, trow0, tl0, run, h0 * 64 + (cg - 32) * 8, XT, (cg - 32) * 8, nullptr); }
        __syncthreads();
        {
            int tz_ = threadIdx.x; asm volatile("" : "+v"(tz_)); const int wave = __builtin_amdgcn_readfirstlane(tz_ >> 6), r = tz_ & 31, hf = (tz_ >> 5) & 1;
            f32x16 cb[2];
#pragma unroll
            for (int q = 0; q < 2; ++q) { const int tile = 2 * wave + q, lt = tile >> 2, st = tile & 3;
#pragma unroll
                for (int e = 0; e < 16; ++e) cb[q][e] = 0.f;
                if (st <= lt) {
#pragma unroll
                    for (int ks = 0; ks < 8; ++ks) { const bf16x8 a = *(const LAS bf16x8*)(Cs + (lt * 32 + r) * SPT + ks * 16 + 8 * hf), bq = *(const LAS bf16x8*)(Bs + (st * 32 + r) * SPT + ks * 16 + 8 * hf);
                        cb[q] = MFMA32(a, bq, cb[q]); } } }
            __syncthreads();
#pragma unroll
            for (int q = 0; q < 2; ++q) { const int tile = 2 * wave + q, lt = tile >> 2, st = tile & 3;
                if (st <= lt) {
#pragma unroll
                    for (int e = 0; e < 16; ++e) Bs[(lt * 32 + (e & 3) + 8 * (e >> 2) + 4 * hf) * SPT + st * 32 + r] = (bf16)f2bf(cb[q][e]); } }
        }
        __syncthreads();
        unsigned y0[2][2][8], y1[2][2][8];
#define FRESH_IDS() int tz_ = threadIdx.x; asm volatile("" : "+v"(tz_)); const int wv_ = __builtin_amdgcn_readfirstlane(tz_ >> 6), hh = wv_ >> 1, lsel = wv_ & 1, r_ = tz_ & 31, hf_ = (tz_ >> 5) & 1
        { FRESH_IDS(); const int h = h0 + hh;
          ssd_out_pass(p, proj, sin + (((size_t)b * 64 + c) * 16 + h) * 64 * 128, Cs, Bs, XT, dtl + hh * 128, csl + hh * 128, ssqp + hh * 128, p.d_skip[h], trow0, h, hh, lsel, r_, hf_, y0); }
        __syncthreads();
        { int tz_ = threadIdx.x; asm volatile("" : "+v"(tz_)); const int cg = tz_ >> 4, run = tz_ & 15; conv_task<true, false>(p, proj, trow0, tl0, run, (h0 + 4) * 64 + cg * 8, XT, cg * 8, nullptr); }
        __syncthreads();
        { FRESH_IDS(); const int h = h0 + 4 + hh;
          ssd_out_pass(p, proj, sin + (((size_t)b * 64 + c) * 16 + h) * 64 * 128, Cs, Bs, XT, dtl + (4 + hh) * 128, csl + (4 + hh) * 128, ssqp + (4 + hh) * 128, p.d_skip[h], trow0, h, hh, lsel, r_, hf_, y1); }
        __syncthreads();
        { FRESH_IDS(); ssd_out_store(p, mix, ssqp, trow0, h0 + hh, lsel, r_, hf_, y0); }
        { FRESH_IDS(); ssd_out_store(p, mix, ssqp, trow0, h0 + 4 + hh, lsel, r_, hf_, y1); }
#undef FRESH_IDS
    }
}


__device__ __forceinline__ void phase_attn(const Params& p, LAS unsigned char* lds, int G) {
    const bf16* proj = (const bf16*)(p.ws + WS_PROJ); bf16* mix = (bf16*)(p.ws + WS_MIX);
    constexpr int KP = 72, VP = 260; constexpr float NEG = -1.0e30f;
    LAS bf16* Ks = (LAS bf16*)lds;
    LAS bf16* VT = Ks + 2 * 256 * KP;
    LAS float* ssqp = (LAS float*)(lds + 2 * 256 * KP * 2 + 2 * 64 * VP * 2);
    for (int item = blockIdx.x; item < NB * 64; item += G) {
        const int b = item >> 6, n = item & 63;
        __syncthreads();
        {
            int tz = threadIdx.x; asm volatile("" : "+v"(tz));
            const int j = tz >> 1, hk = tz & 1, pos = n * 128 - 128 + j;
            LAS bf16* kd = Ks + (hk * 256 + j) * KP; LAS bf16* vd = VT + hk * 64 * VP + j;
            if (pos >= 0) {
                const bf16* kp = proj + (size_t)(b * SEQ + pos) * PROJ_LD + COL_K + hk * 64;
                v4u kq[8]; float ss = 0.f;
#pragma unroll
                for (int c = 0; c < 8; ++c) { kq[c] = *(const v4u*)(kp + 8 * c); float f[8]; unpack8(kq[c], f);
#pragma unroll
                    for (int e = 0; e < 8; ++e) ss += f[e] * f[e]; }
                const float rstd = rsqrtf(ss * (1.f / 64.f) + EPS);
#pragma unroll
                for (int c = 0; c < 8; ++c) { float f[8]; unpack8(kq[c], f); const f32x4 w0 = *(const f32x4*)(p.k_norm_w + 8 * c), w1 = *(const f32x4*)(p.k_norm_w + 8 * c + 4);
                    *(LAS v4u*)(kd + 8 * c) = (v4u){pk2(f[0] * rstd * w0[0], f[1] * rstd * w0[1]), pk2(f[2] * rstd * w0[2], f[3] * rstd * w0[3]), pk2(f[4] * rstd * w1[0], f[5] * rstd * w1[1]), pk2(f[6] * rstd * w1[2], f[7] * rstd * w1[3])}; }
                const bf16* vp = kp + (COL_V - COL_K);
#pragma unroll
                for (int c = 0; c < 8; ++c) { const v4u q = *(const v4u*)(vp + 8 * c);
                    vd[(8 * c + 0) * VP] = (bf16)(q.x & 0xffffu); vd[(8 * c + 1) * VP] = (bf16)(q.x >> 16); vd[(8 * c + 2) * VP] = (bf16)(q.y & 0xffffu); vd[(8 * c + 3) * VP] = (bf16)(q.y >> 16);
                    vd[(8 * c + 4) * VP] = (bf16)(q.z & 0xffffu); vd[(8 * c + 5) * VP] = (bf16)(q.z >> 16); vd[(8 * c + 6) * VP] = (bf16)(q.w & 0xffffu); vd[(8 * c + 7) * VP] = (bf16)(q.w >> 16); }
            } else {
#pragma unroll
                for (int c = 0; c < 8; ++c) *(LAS v4u*)(kd + 8 * c) = (v4u){0u, 0u, 0u, 0u};
#pragma unroll
                for (int d = 0; d < 64; ++d) vd[d * VP] = (bf16)0;
            }
        }
        __syncthreads();
        {
            int tz = threadIdx.x; asm volatile("" : "+v"(tz));
            const int wave = __builtin_amdgcn_readfirstlane(tz >> 6), r = tz & 31, hf = (tz >> 5) & 1, hk = wave >> 2, wl = wave & 3;
            const LAS bf16* Kh = Ks + hk * 256 * KP; const LAS bf16* Vh = VT + hk * 64 * VP;
            f32x4 qw[4][2];
#pragma unroll
            for (int ks = 0; ks < 4; ++ks) { qw[ks][0] = *(const f32x4*)(p.q_norm_w + 16 * ks + 8 * hf); qw[ks][1] = *(const f32x4*)(p.q_norm_w + 16 * ks + 8 * hf + 4); }
            v4u qn[4];
            { const bf16* qp0 = proj + ((size_t)b * SEQ + n * 128 + r) * PROJ_LD + COL_Q + (hk * 8 + wl * 2) * 64 + 8 * hf;
#pragma unroll
              for (int ks = 0; ks < 4; ++ks) qn[ks] = *(const v4u*)(qp0 + 16 * ks); }
            for (int it = 0; it < 8; ++it) {
                const int hsel = it >> 2, qt = it & 3;
                const int hq = hk * 8 + wl * 2 + hsel; const float sink = p.sinks[hq];
                {
                    const size_t tok = (size_t)b * SEQ + n * 128 + qt * 32 + r;
                    bf16x8 qf[4];
                    {
                        v4u qv[4]; float ss = 0.f;
#pragma unroll
                        for (int ks = 0; ks < 4; ++ks) { qv[ks] = qn[ks]; float f[8]; unpack8(qv[ks], f);
#pragma unroll
                            for (int e = 0; e < 8; ++e) ss += f[e] * f[e]; }
                        if (it < 7) { const int it2 = it + 1, hq2 = hk * 8 + wl * 2 + (it2 >> 2);
                            const bf16* qp2 = proj + ((size_t)b * SEQ + n * 128 + (it2 & 3) * 32 + r) * PROJ_LD + COL_Q + hq2 * 64 + 8 * hf;
#pragma unroll
                            for (int ks = 0; ks < 4; ++ks) qn[ks] = *(const v4u*)(qp2 + 16 * ks); }
                        ss += __shfl_xor(ss, 32);
                        const float rstd = rsqrtf(ss * (1.f / 64.f) + EPS) * 0.125f;
#pragma unroll
                        for (int ks = 0; ks < 4; ++ks) { float f[8]; unpack8(qv[ks], f); const f32x4 w0 = qw[ks][0], w1 = qw[ks][1];
                            const v4u o = (v4u){pk2(f[0] * rstd * w0[0], f[1] * rstd * w0[1]), pk2(f[2] * rstd * w0[2], f[3] * rstd * w0[3]), pk2(f[4] * rstd * w1[0], f[5] * rstd * w1[1]), pk2(f[6] * rstd * w1[2], f[7] * rstd * w1[3])};
                            qf[ks] = __builtin_bit_cast(bf16x8, o); }
                    }
                    f32x16 sc[5];
#pragma unroll
                    for (int jt = 0; jt < 5; ++jt) {
#pragma unroll
                        for (int e = 0; e < 16; ++e) sc[jt][e] = 0.f;
#pragma unroll
                        for (int ks = 0; ks < 4; ++ks) { const bf16x8 a = *(const LAS bf16x8*)(Kh + ((qt + jt) * 32 + r) * KP + ks * 16 + 8 * hf); sc[jt] = MFMA32(a, qf[ks], sc[jt]); } }
#pragma unroll
                    for (int e = 0; e < 16; ++e) { const int kk = (e & 3) + 8 * (e >> 2) + 4 * hf;
                        sc[0][e] = (kk > r) ? sc[0][e] : NEG; sc[4][e] = (kk <= r) ? sc[4][e] : NEG; }
                    if (n == 0) {
#pragma unroll
                        for (int jt = 0; jt < 4; ++jt) if (qt + jt < 4) {
#pragma unroll
                            for (int e = 0; e < 16; ++e) sc[jt][e] = NEG; } }
                    float m = sink;
#pragma unroll
                    for (int jt = 0; jt < 5; ++jt)
#pragma unroll
                        for (int e = 0; e < 16; ++e) m = fmaxf(m, sc[jt][e]);
                    m = fmaxf(m, __shfl_xor(m, 32));
                    float l = 0.f;
#pragma unroll
                    for (int jt = 0; jt < 5; ++jt)
#pragma unroll
                        for (int e = 0; e < 16; ++e) { const float pv = __expf(sc[jt][e] - m); sc[jt][e] = pv; l += pv; }
                    l += __shfl_xor(l, 32); l += __expf(sink - m);
                    f32x16 o[2];
#pragma unroll
                    for (int dt = 0; dt < 2; ++dt)
#pragma unroll
                        for (int e = 0; e < 16; ++e) o[dt][e] = 0.f;
#pragma unroll
                    for (int jt = 0; jt < 5; ++jt)
#pragma unroll
                        for (int s2 = 0; s2 < 2; ++s2) {
                            const v4u pp = (v4u){pk2(sc[jt][8 * s2], sc[jt][8 * s2 + 1]), pk2(sc[jt][8 * s2 + 2], sc[jt][8 * s2 + 3]), pk2(sc[jt][8 * s2 + 4], sc[jt][8 * s2 + 5]), pk2(sc[jt][8 * s2 + 6], sc[jt][8 * s2 + 7])};
                            const bf16x8 pf = __builtin_bit_cast(bf16x8, pp);
                            const int kb = (qt + jt) * 32 + 16 * s2 + 4 * hf;
#pragma unroll
                            for (int dt = 0; dt < 2; ++dt) { const LAS bf16* vr = Vh + (dt * 32 + r) * VP + kb;
                                const v2u a0 = *(const LAS v2u*)vr, a1 = *(const LAS v2u*)(vr + 8);
                                const v4u av = (v4u){a0.x, a0.y, a1.x, a1.y};
                                o[dt] = MFMA32(__builtin_bit_cast(bf16x8, av), pf, o[dt]); }
                        }
                    const float inv = 1.0f / l; float ss = 0.f;
#pragma unroll
                    for (int dt = 0; dt < 2; ++dt)
#pragma unroll
                        for (int q = 0; q < 4; ++q) { const float g0 = o[dt][4 * q] * inv, g1 = o[dt][4 * q + 1] * inv, g2 = o[dt][4 * q + 2] * inv, g3 = o[dt][4 * q + 3] * inv;
                            ss += (g0 * g0 + g1 * g1) + (g2 * g2 + g3 * g3);
                            *(v2u*)(mix + tok * D + hq * 64 + dt * 32 + 8 * q + 4 * hf) = (v2u){pk2(g0, g1), pk2(g2, g3)}; }
                    ss += __shfl_xor(ss, 32);
                    if (hf == 0) ssqp[hq * 128 + qt * 32 + r] = ss;
                }
            }
        }
        __syncthreads();
        {
            int tz = threadIdx.x; asm volatile("" : "+v"(tz));
            const int wave = __builtin_amdgcn_readfirstlane(tz >> 6), r = tz & 31, hf = (tz >> 5) & 1, hk = wave >> 2, wl = wave & 3;
            for (int qt = 0; qt < 4; ++qt) {
                const size_t tok = (size_t)b * SEQ + n * 128 + qt * 32 + r;
                float tot = 0.f;
#pragma unroll
                for (int hd = 0; hd < 16; ++hd) tot += ssqp[hd * 128 + qt * 32 + r];
                const float rstd = rsqrtf(tot * (1.f / 1024.f) + EPS);
                v2u uu[2][2][4];
#pragma unroll
                for (int hsel = 0; hsel < 2; ++hsel)
#pragma unroll
                    for (int dt = 0; dt < 2; ++dt)
#pragma unroll
                        for (int q = 0; q < 4; ++q) uu[hsel][dt][q] = *(const v2u*)(mix + tok * D + (hk * 8 + wl * 2 + hsel) * 64 + dt * 32 + 8 * q + 4 * hf);
#pragma unroll
                for (int hsel = 0; hsel < 2; ++hsel)
#pragma unroll
                    for (int dt = 0; dt < 2; ++dt) { asm volatile("" : "+v"(uu[hsel][dt][0]), "+v"(uu[hsel][dt][1]), "+v"(uu[hsel][dt][2]), "+v"(uu[hsel][dt][3])); }
#pragma unroll
                for (int hsel = 0; hsel < 2; ++hsel)
#pragma unroll
                    for (int dt = 0; dt < 2; ++dt)
#pragma unroll
                        for (int q = 0; q < 4; ++q) { const int col = (hk * 8 + wl * 2 + hsel) * 64 + dt * 32 + 8 * q + 4 * hf;
                            const v2u u = uu[hsel][dt][q]; const f32x4 w4 = *(const f32x4*)(p.attn_out_norm_w + col);
                            *(v2u*)(mix + tok * D + col) = (v2u){pk2(bflo(u.x) * rstd * w4[0], bfhi(u.x) * rstd * w4[1]), pk2(bflo(u.y) * rstd * w4[2], bfhi(u.y) * rstd * w4[3])}; }
            }
        }
    }
}

__device__ __forceinline__ void phase_router(const Params& p, LAS unsigned char* lds, unsigned* ctl, int G, int wave, int lane) {
    const bf16* x1 = (const bf16*)(p.ws + WS_X1); const float* ssq = (const float*)(p.ws + WS_SSQ); unsigned char* hf = p.ws + WS_HF;
    int* stok = (int*)(p.ws + WS_STOK); float* sgate = (float*)(p.ws + WS_SGATE); int* toke = (int*)(p.ws + WS_TOKE); int* tokp = (int*)(p.ws + WS_TOKP);
    LAS float* lg = (LAS float*)lds + wave * (16 * 33);
    LAS int* hist = (LAS int*)(lds + 32768); LAS int* gbase = hist + 32;
    const int tid = threadIdx.x, i16 = lane & 15, kq = lane >> 4;
    for (int tb = blockIdx.x * 8; tb < T / 16; tb += G * 8) {
        if (tid < 32) hist[tid] = 0;
        __syncthreads();
        const int tok = (tb + wave) * 16 + i16;
        float s = 0.f;
        { const f32x4* sp = (const f32x4*)(ssq + (size_t)tok * 32 + kq * 8); const f32x4 a = sp[0], b = sp[1]; s = ((a[0] + a[1]) + (a[2] + a[3])) + ((b[0] + b[1]) + (b[2] + b[3])); }
        s += __shfl_xor(s, 16); s += __shfl_xor(s, 32);
        const float rstd = rsqrtf(s * (1.f / D) + EPS);
        f32x4 acc0 = (f32x4){0.f, 0.f, 0.f, 0.f}, acc1 = (f32x4){0.f, 0.f, 0.f, 0.f};
        const bf16* xr = x1 + (size_t)tok * D + 8 * kq;
        unsigned char* hr = hf + (size_t)tok * D + 8 * kq;
        const v4u* wb = (const v4u*)(p.ws + WS_WRB) + lane;
        v4u xq[4];
#pragma unroll
        for (int u = 0; u < 4; ++u) xq[u] = *(const v4u*)(xr + 32 * u);
        for (int j4 = 0; j4 < 64; j4 += 4) {
            f32x4 xc[4][2], gq[4][2]; v4u wf[4][2][2];
#pragma unroll
            for (int u = 0; u < 4; ++u) { float f[8]; unpack8(xq[u], f); xc[u][0] = (f32x4){f[0], f[1], f[2], f[3]}; xc[u][1] = (f32x4){f[4], f[5], f[6], f[7]}; }
            if (j4 + 4 < 64) {
#pragma unroll
                for (int u = 0; u < 4; ++u) xq[u] = *(const v4u*)(xr + 32 * (j4 + 4 + u)); }
#pragma unroll
            for (int u = 0; u < 4; ++u) { gq[u][0] = *(const f32x4*)(p.ffn_norm_w + 32 * (j4 + u) + 8 * kq); gq[u][1] = *(const f32x4*)(p.ffn_norm_w + 32 * (j4 + u) + 8 * kq + 4);
#pragma unroll
                for (int hfl = 0; hfl < 2; ++hfl)
#pragma unroll
                    for (int hl = 0; hl < 2; ++hl) wf[u][hfl][hl] = wb[(((j4 + u) * 2 + hfl) * 2 + hl) * 64]; }
#pragma unroll
            for (int u = 0; u < 4; ++u) {
                float hv[8];
#pragma unroll
                for (int k = 0; k < 4; ++k) { hv[k] = xc[u][0][k] * rstd * gq[u][0][k]; hv[4 + k] = xc[u][1][k] * rstd * gq[u][1][k]; }
                *(v2u*)(hr + 32 * (j4 + u)) = (v2u){pk4_fp8(sat8(hv[0] * FP8_SA), sat8(hv[1] * FP8_SA), sat8(hv[2] * FP8_SA), sat8(hv[3] * FP8_SA)), pk4_fp8(sat8(hv[4] * FP8_SA), sat8(hv[5] * FP8_SA), sat8(hv[6] * FP8_SA), sat8(hv[7] * FP8_SA))};
                v4u ah, al;
                ah.x = pk2(hv[0], hv[1]); ah.y = pk2(hv[2], hv[3]); ah.z = pk2(hv[4], hv[5]); ah.w = pk2(hv[6], hv[7]);
                al.x = pk2(hv[0] - bflo(ah.x), hv[1] - bfhi(ah.x)); al.y = pk2(hv[2] - bflo(ah.y), hv[3] - bfhi(ah.y)); al.z = pk2(hv[4] - bflo(ah.z), hv[5] - bfhi(ah.z)); al.w = pk2(hv[6] - bflo(ah.w), hv[7] - bfhi(ah.w));
                const bf16x8 fah = __builtin_bit_cast(bf16x8, ah), fal = __builtin_bit_cast(bf16x8, al);
                acc0 = __builtin_amdgcn_mfma_f32_16x16x32_bf16(fah, __builtin_bit_cast(bf16x8, wf[u][0][0]), acc0, 0, 0, 0);
                acc0 = __builtin_amdgcn_mfma_f32_16x16x32_bf16(fah, __builtin_bit_cast(bf16x8, wf[u][0][1]), acc0, 0, 0, 0);
                acc0 = __builtin_amdgcn_mfma_f32_16x16x32_bf16(fal, __builtin_bit_cast(bf16x8, wf[u][0][0]), acc0, 0, 0, 0);
                acc1 = __builtin_amdgcn_mfma_f32_16x16x32_bf16(fah, __builtin_bit_cast(bf16x8, wf[u][1][0]), acc1, 0, 0, 0);
                acc1 = __builtin_amdgcn_mfma_f32_16x16x32_bf16(fah, __builtin_bit_cast(bf16x8, wf[u][1][1]), acc1, 0, 0, 0);
                acc1 = __builtin_amdgcn_mfma_f32_16x16x32_bf16(fal, __builtin_bit_cast(bf16x8, wf[u][1][0]), acc1, 0, 0, 0);
            }
        }
        { const float bb0 = p.b_router[i16], bb1 = p.b_router[16 + i16];
#pragma unroll
          for (int r = 0; r < 4; ++r) { lg[(4 * kq + r) * 33 + i16] = acc0[r] + bb0; lg[(4 * kq + r) * 33 + 16 + i16] = acc1[r] + bb1; } }
        LDS_WAIT(); asm volatile("" ::: "memory");
        int se[4]; float sv[4], gt[4]; int rk[4];
        if (lane < 16) {
            float v[32];
#pragma unroll
            for (int e = 0; e < 32; ++e) v[e] = lg[lane * 33 + e];
#pragma unroll
            for (int k = 0; k < 4; ++k) { float best = -3.0e38f; int bi = 0;
#pragma unroll
                for (int e = 0; e < 32; ++e) { const bool tk = v[e] > best; best = tk ? v[e] : best; bi = tk ? e : bi; }
                se[k] = bi; sv[k] = best;
#pragma unroll
                for (int e = 0; e < 32; ++e) v[e] = (e == bi) ? -3.0e38f : v[e]; }
            const float e1 = __expf(sv[1] - sv[0]), e2 = __expf(sv[2] - sv[0]), e3 = __expf(sv[3] - sv[0]);
            const float inv = 1.0f / (1.0f + e1 + e2 + e3);
            gt[0] = inv; gt[1] = e1 * inv; gt[2] = e2 * inv; gt[3] = e3 * inv;
#pragma unroll
            for (int k = 0; k < 4; ++k) rk[k] = __hip_atomic_fetch_add(&hist[se[k]], 1, __ATOMIC_RELAXED, __HIP_MEMORY_SCOPE_WORKGROUP);
        }
        __syncthreads();
        if (tid < 32) gbase[tid] = (int)__hip_atomic_fetch_add(ctl + CW_CNT + 64 * tid, (unsigned)hist[tid], __ATOMIC_RELAXED, __HIP_MEMORY_SCOPE_AGENT);
        __syncthreads();
        if (lane < 16) {
            const int tk = (tb + wave) * 16 + lane;
#pragma unroll
            for (int k = 0; k < 4; ++k) { const int pos = gbase[se[k]] + rk[k];
                stok[(size_t)se[k] * T + pos] = tk; sgate[(size_t)se[k] * T + pos] = gt[k]; toke[tk * 4 + k] = se[k]; tokp[tk * 4 + k] = pos; }
        }
        __syncthreads();
    }
}

__device__ __forceinline__ void moe_table(unsigned* ctl, LAS int* tstart, LAS int* lcnt) {
    __syncthreads();
    if (threadIdx.x < 32) lcnt[threadIdx.x] = (int)__hip_atomic_load(ctl + CW_CNT + 64 * threadIdx.x, __ATOMIC_RELAXED, __HIP_MEMORY_SCOPE_AGENT);
    __syncthreads();
    if (threadIdx.x == 0) { int a = 0; for (int e = 0; e < NE; ++e) { tstart[e] = a; a += (lcnt[e] + 255) >> 8; } tstart[NE] = a; }
    __syncthreads();
}

__device__ __forceinline__ void phase_combine(const Params& p, const LAS int* tstart, int gw, int NGW, int lane) {
    const unsigned char* y2 = p.ws + WS_Y2; const int* toke = (const int*)(p.ws + WS_TOKE); const int* tokp = (const int*)(p.ws + WS_TOKP);
    constexpr float DY = 1.0f / FP8_SY;
    typedef int i32x4v __attribute__((ext_vector_type(4)));
    i32x4v ne = (i32x4v){0, 0, 0, 0}, np = ne;
    if (gw < T) { ne = *(const i32x4v*)(toke + gw * 4); np = *(const i32x4v*)(tokp + gw * 4); }
    for (int m = gw; m < T; m += NGW) {
        const i32x4v ce = ne, cp = np;
        if (m + NGW < T) { ne = *(const i32x4v*)(toke + (m + NGW) * 4); np = *(const i32x4v*)(tokp + (m + NGW) * 4); }
        const unsigned char* yr[4];
#pragma unroll
        for (int k = 0; k < 4; ++k) yr[k] = y2 + ((size_t)tstart[ce[k]] * 256 + cp[k]) * D;
        float* op = p.out + (size_t)m * D; const bf16* xp = (const bf16*)(p.ws + WS_X1) + (size_t)m * D;
#pragma unroll
        for (int j = 0; j < 2; ++j) { const int c = (j * 64 + lane) * 16;
            v4u w[4];
#pragma unroll
            for (int k = 0; k < 4; ++k) w[k] = *(const v4u*)(yr[k] + c);
            f32x4 a[4];
            { const v4u xa = *(const v4u*)(xp + c), xb = *(const v4u*)(xp + c + 8); float fa[8], fb[8]; unpack8(xa, fa); unpack8(xb, fb);
              a[0] = (f32x4){fa[0], fa[1], fa[2], fa[3]}; a[1] = (f32x4){fa[4], fa[5], fa[6], fa[7]}; a[2] = (f32x4){fb[0], fb[1], fb[2], fb[3]}; a[3] = (f32x4){fb[4], fb[5], fb[6], fb[7]}; }
#pragma unroll
            for (int q = 0; q < 4; ++q) { float s0 = 0.f, s1 = 0.f, s2 = 0.f, s3 = 0.f;
#pragma unroll
                for (int k = 0; k < 4; ++k) { const int wd = (int)(q == 0 ? w[k].x : q == 1 ? w[k].y : q == 2 ? w[k].z : w[k].w);
                    const f32x2 lo = __builtin_amdgcn_cvt_pk_f32_fp8(wd, false), hi = __builtin_amdgcn_cvt_pk_f32_fp8(wd, true);
                    s0 += lo.x; s1 += lo.y; s2 += hi.x; s3 += hi.y; }
                a[q][0] += s0 * DY; a[q][1] += s1 * DY; a[q][2] += s2 * DY; a[q][3] += s3 * DY;
                *(f32x4*)(op + c + 4 * q) = a[q]; }
        }
    }
}

constexpr int N_PHASES = 10;
__global__ void __launch_bounds__(NTHREADS, 2) hymba_fwd(Params p) {
    extern __shared__ __attribute__((aligned(16))) unsigned char lds_raw[];
    LAS unsigned char* lds = (LAS unsigned char*)lds_raw;
    volatile LAS unsigned* MISC = (volatile LAS unsigned*)(lds + MISC_OFF);
    LAS int* tstart = (LAS int*)(lds + MISC_OFF + 256);
    LAS int* lcnt = (LAS int*)(lds + MISC_OFF + 512);
    const int tid = threadIdx.x, lane = tid & 63, wave = __builtin_amdgcn_readfirstlane(tid >> 6);
    const int G = gridDim.x;
    const int vcu = (G % 8 == 0) ? (blockIdx.x % 8) * (G / 8) + blockIdx.x / 8 : blockIdx.x;
    const int gw = vcu * NWAVES + wave, NGW = G * NWAVES;
    unsigned* ctl = (unsigned*)(p.ws + WS_CTL);
    if (tid < 64) MISC[tid] = 0u;
    __syncthreads();
    const int lo = p.ph_lo, hi = p.ph_hi;
    XcdBarrier bar; bar.bar = ctl + CW_BAR; bar.x = 0; bar.st = nullptr;
    if (hi - lo > 1) bar = xcd_barrier_post(ctl + CW_BAR, MISC + 8);
#ifndef PHMASK
#define PHMASK 0x3ff
#endif
#define IN(k) (((PHMASK >> (k)) & 1) && lo <= (k) && (k) < hi)
#define SEAM(k) do { if (IN(k) && IN((k) + 1)) xcd_barrier(bar); } while (0)

    if (IN(0)) { phase_prologue(p, lds, gw, NGW, wave, lane); }
    SEAM(0);
    int cid = (int)blockIdx.x;
    if (hi - lo > 1 && lo == 0) {
        if (tid == 0) {
            bool ok = (G % 8 == 0);
            for (unsigned j = 0; j < 16; ++j) { const unsigned cj = xb_ld(&bar.bar[XB_XCNT(j)]); ok = ok && (j < 8 ? cj == (unsigned)(G / 8) : cj == 0u); }
            MISC[12] = ok ? (MISC[10] * 8u + bar.x) : (unsigned)blockIdx.x;
        }
        __syncthreads();
        cid = (int)MISC[12];
    }
    if (IN(1)) {
        const int ncw = (G < 8 * NCV) ? G : 8 * NCV;
        if (cid < ncw) convert_experts(p, cid * NWAVES + wave, ncw * NWAVES, lane);
        LAS int* tk = (LAS int*)(lds + MISC_OFF + 768);
        unsigned* tick = ctl + CW_TICK + 64 * (cid & 7);
        __syncthreads();
        if (tid == 0) { tk[0] = (int)__hip_atomic_fetch_add(tick, 1u, __ATOMIC_RELAXED, __HIP_MEMORY_SCOPE_AGENT); tk[1] = (int)__hip_atomic_fetch_add(tick, 1u, __ATOMIC_RELAXED, __HIP_MEMORY_SCOPE_AGENT); }
        __syncthreads();
        pg8::SchedQueue S{(const char*)(p.ws + WS_HN), (const char*)(p.ws + WS_WIN), T / 256, NIN_PAD / 256, (T / 256) * (NIN_PAD / 256) / 8, cid & 7, tick, tk};
        EpiInProj E{(bf16*)(p.ws + WS_PROJ), (float*)(p.ws + WS_DT)};
        pg8::gemm_phase<EpiInProj, pg8::SchedQueue>(lds, S, E);
    }
    SEAM(1);
    if (IN(2)) { if (!(p.variant & 2)) phase_attn(p, lds, G); if (!(p.variant & 1)) phase_ssd_states(p, lds, G, lane, wave); }
    SEAM(2);
    if (IN(3)) { phase_ssd_scan(p, G); }
    SEAM(3);
    if (IN(4)) { phase_ssd_out(p, lds, G, lane, wave); }
    SEAM(4);
    if (IN(5)) {
        EpiOutProj E{p.x, (bf16*)(p.ws + WS_X1), (float*)(p.ws + WS_SSQ)};
#if PROBE_CRIP5
        if (p.variant) { pg8::SchedDenseT<PROBE_CRIP5> S{(const char*)(p.ws + WS_MIX), (const char*)(p.ws + WS_WOUT), T / 256, D / 256, G, cid};
            pg8::gemm_phase<EpiOutProj, pg8::SchedDenseT<PROBE_CRIP5>>(lds, S, E); } else
#endif
        { pg8::SchedDense S{(const char*)(p.ws + WS_MIX), (const char*)(p.ws + WS_WOUT), T / 256, D / 256, G, cid};
          pg8::gemm_phase<EpiOutProj, pg8::SchedDense>(lds, S, E); }
    }
    SEAM(5);
    if (IN(6)) { phase_router(p, lds, ctl, G, wave, lane); }
    SEAM(6);
    if (IN(7)) {
        moe_table(ctl, tstart, lcnt);
        EpiGateUp E{p.ws + WS_HB, p.b_gate, p.b_up};
#if PROBE_CRIP7
        if (p.variant) { pg8::SchedMoE<true, PROBE_CRIP7> S{(const char*)(p.ws + WS_HF), (const char*)(p.ws + WS_WGU), (const int*)(p.ws + WS_STOK), tstart, lcnt, (2 * FF) / 256, 2 * FF, G, cid};
            pg8::gemm_phase<EpiGateUp, pg8::SchedMoE<true, PROBE_CRIP7>>(lds, S, E); } else
#endif
        { pg8::SchedMoE<true> S{(const char*)(p.ws + WS_HF), (const char*)(p.ws + WS_WGU), (const int*)(p.ws + WS_STOK), tstart, lcnt, (2 * FF) / 256, 2 * FF, G, cid};
          pg8::gemm_phase<EpiGateUp, pg8::SchedMoE<true>>(lds, S, E); }
    }
    SEAM(7);
    if (IN(8)) {
        moe_table(ctl, tstart, lcnt);
        EpiDown E{p.ws + WS_Y2, p.b_down, (const float*)(p.ws + WS_SGATE), tstart};
#if PROBE_CRIP
        if (p.variant) { pg8::SchedMoE<false, PROBE_CRIP> S{(const char*)(p.ws + WS_HB), (const char*)(p.ws + WS_WD), (const int*)(p.ws + WS_STOK), tstart, lcnt, D / 256, D, G, cid};
            pg8::gemm_phase<EpiDown, pg8::SchedMoE<false, PROBE_CRIP>>(lds, S, E); } else
#endif
        { pg8::SchedMoE<false> S{(const char*)(p.ws + WS_HB), (const char*)(p.ws + WS_WD), (const int*)(p.ws + WS_STOK), tstart, lcnt, D / 256, D, G, cid};
          pg8::gemm_phase<EpiDown, pg8::SchedMoE<false>>(lds, S, E); }
    }
    SEAM(8);
    if (IN(9)) { moe_table(ctl, tstart, lcnt); phase_combine(p, tstart, gw, NGW, lane); }
#undef IN
#undef SEAM
}

extern "C" void kernel_launch(void* const* d_in, const int* in_sizes, int n_in, void* d_out, int out_size, void* d_ws, size_t ws_size, hipStream_t stream) {
    static int grid = 0;
    if (grid == 0) {
        if (n_in != 23 || out_size != T * D || ws_size < WS_END) { fprintf(stderr, "kernel_launch: unexpected sizes n_in %d out %d ws %zu\n", n_in, out_size, ws_size); grid = -1; return; }
        int dev = 0, cus = 0;
        if (hipGetDevice(&dev) != hipSuccess || hipDeviceGetAttribute(&cus, hipDeviceAttributeMultiprocessorCount, dev) != hipSuccess) { grid = -1; return; }
        if (hipFuncSetAttribute((const void*)hymba_fwd, hipFuncAttributeMaxDynamicSharedMemorySize, LDS_BYTES) != hipSuccess) { fprintf(stderr, "kernel_launch: hipFuncSetAttribute failed\n"); grid = -1; return; }
        int per_cu = 0;
        if (hipOccupancyMaxActiveBlocksPerMultiprocessor(&per_cu, (const void*)hymba_fwd, NTHREADS, LDS_BYTES) != hipSuccess || per_cu < 1) fprintf(stderr, "kernel_launch: occupancy query says %d\n", per_cu);
        (void)hipGetLastError();
        grid = cus;
    }
    if (grid < 0) return;
    (void)hipMemsetAsync((char*)d_ws + WS_CTL, 0, CTL_BYTES, stream);
    Params p{};
    const float** pp = (const float**)&p;
    for (int i = 0; i < 23; ++i) pp[i] = (const float*)d_in[i];
    p.out = (float*)d_out; p.ws = (unsigned char*)d_ws;
#if MK_MULTI || (PROBE_REPEAT >= 0) || PROBE_CRIP || PROBE_P2 || PROBE_P6 || PROBE_CRIP7 || PROBE_CRIP5
    for (int ph = 0; ph < N_PHASES; ++ph) { p.ph_lo = ph; p.ph_hi = ph + 1;
        if (PROBE_P2 && ph == 2) { p.variant = PROBE_P2; hipLaunchKernelGGL(hymba_fwd, dim3(grid), dim3(NTHREADS), LDS_BYTES, stream, p); p.variant = 0; }
        if (PROBE_P6 && ph == 6) { hipLaunchKernelGGL(hymba_fwd, dim3(grid), dim3(NTHREADS), LDS_BYTES, stream, p); (void)hipMemsetAsync((char*)d_ws + WS_CTL + CW_CNT * 4, 0, 64 * 4 * NE, stream); }
        if (PROBE_CRIP5 && ph == 5) { p.variant = 1; hipLaunchKernelGGL(hymba_fwd, dim3(grid), dim3(NTHREADS), LDS_BYTES, stream, p); p.variant = 0; }
        if (PROBE_CRIP7 && ph == 7) { p.variant = 1; hipLaunchKernelGGL(hymba_fwd, dim3(grid), dim3(NTHREADS), LDS_BYTES, stream, p); p.variant = 0; }
        if (PROBE_CRIP && ph == 8) { p.variant = 1; hipLaunchKernelGGL(hymba_fwd, dim3(grid), dim3(NTHREADS), LDS_BYTES, stream, p); p.variant = 0; }
        for (int r = 0; r < (ph == PROBE_REPEAT ? 2 : 1); ++r) hipLaunchKernelGGL(hymba_fwd, dim3(grid), dim3(NTHREADS), LDS_BYTES, stream, p); }
#else
    p.ph_lo = 0; p.ph_hi = N_PHASES; hipLaunchKernelGGL(hymba_fwd, dim3(grid), dim3(NTHREADS), LDS_BYTES, stream, p);
#endif
}
```

```cpp
#include <hip/hip_runtime.h>
#include <cstdio>
#include <cstdint>

#ifndef MK_MULTI
#define MK_MULTI 0
#endif

#ifndef PROBE_CRIP
#define PROBE_CRIP 0
#endif
#ifndef PROBE_CRIP5
#define PROBE_CRIP5 0
#endif
#ifndef PROBE_CRIP7
#define PROBE_CRIP7 0
#endif
#ifndef PROBE_P6
#define PROBE_P6 0
#endif
#ifndef PROBE_P2
#define PROBE_P2 0
#endif
#ifndef PROBE_REPEAT
#define PROBE_REPEAT -1
#endif
#define GAS __attribute__((address_space(1)))
#define LAS __attribute__((address_space(3)))
typedef unsigned short bf16;
typedef unsigned v4u __attribute__((ext_vector_type(4)));
typedef unsigned v2u __attribute__((ext_vector_type(2)));
typedef float f32x4 __attribute__((ext_vector_type(4)));
typedef float f32x2 __attribute__((ext_vector_type(2)));
typedef short bf16x8 __attribute__((ext_vector_type(8)));
typedef int i32x4 __attribute__((ext_vector_type(4)));
typedef int i32x8 __attribute__((ext_vector_type(8)));

constexpr int NB = 4, SEQ = 8192, T = NB * SEQ, D = 2048;
constexpr int PROJ_LD = 3840;
constexpr int COL_Q = 0, COL_K = 1024, COL_V = 1152, COL_Z = 1280, COL_XBC = 2304;
constexpr int NIN = 3856, NIN_PAD = 4096;
constexpr int NXBC = 1536;
constexpr int NE = 32, FF = 2048, TOPK = 4;
constexpr int SLOT_ROWS = T * TOPK + NE * 256;
constexpr float EPS = 1e-6f;

constexpr size_t MiB = 1u << 20;
constexpr size_t WS_CTL = 0, CTL_BYTES = 1 * MiB;
constexpr size_t WS_WGU = 16 * MiB;
constexpr size_t WS_WIN = 528 * MiB;
constexpr size_t WS_WOUT = 544 * MiB;
constexpr size_t WS_HF = 552 * MiB;
constexpr size_t WS_Y2 = 16 * MiB;
constexpr size_t WS_WD = 680 * MiB;
constexpr size_t WS_HN = 936 * MiB;
constexpr size_t WS_MIX = WS_HN;
constexpr size_t WS_PROJ = 1064 * MiB;
constexpr size_t WS_XBC = 1304 * MiB;
constexpr size_t WS_ATT = 1496 * MiB;
constexpr size_t WS_X1 = WS_ATT;
constexpr size_t WS_YS = 1624 * MiB;
constexpr size_t WS_HB = 936 * MiB;
constexpr size_t WS_STATES = WS_XBC;
constexpr size_t WS_SIN = WS_YS;
constexpr size_t WS_CDEC = WS_YS + 64 * MiB;
constexpr size_t WS_DT = 1752 * MiB;
constexpr size_t WS_DTS = 1754 * MiB;
constexpr size_t WS_SSQ = 1756 * MiB;
constexpr size_t WS_STOK = 1760 * MiB;
constexpr size_t WS_SGATE = 1764 * MiB;
constexpr size_t WS_TOKE = 1768 * MiB;
constexpr size_t WS_TOKP = 1769 * MiB;
constexpr size_t WS_WRB = 1770 * MiB;
constexpr size_t WS_END = 1771 * MiB;
static_assert(WS_Y2 + (size_t)SLOT_ROWS * 2048 <= WS_WD, "y2 overlay");
static_assert(WS_HB + (size_t)SLOT_ROWS * 2048 * 2 <= WS_ATT, "hb overlay");
constexpr int CW_CNT = 1024;
constexpr int CW_BAR = 4096;
constexpr int CW_TICK = 2048 + 1024;
constexpr int NCV = 16;

constexpr int RING_BYTES = 131072;
constexpr int MISC_OFF = 162816;
constexpr int LDS_BYTES = 163840;
constexpr int NWAVES = 8, NTHREADS = 512;

typedef __bf16 hwbf16x2 __attribute__((ext_vector_type(2)));
__device__ __forceinline__ unsigned f2bf(float f) { return (unsigned)__builtin_bit_cast(unsigned short, (__bf16)f); }
__device__ __forceinline__ unsigned pk2(float lo, float hi) { const f32x2 v = {lo, hi}; return __builtin_bit_cast(unsigned, __builtin_convertvector(v, hwbf16x2)); }
__device__ __forceinline__ float bflo(unsigned w) { return __builtin_bit_cast(float, w << 16); }
__device__ __forceinline__ float bfhi(unsigned w) { return __builtin_bit_cast(float, w & 0xffff0000u); }
__device__ __forceinline__ float wave_sum(float v) {
#pragma unroll
    for (int o = 1; o < 64; o <<= 1) v += __shfl_xor(v, o);
    return v;
}
__device__ __forceinline__ float sat8(float x) { return __builtin_amdgcn_fmed3f(x, -448.0f, 448.0f); }
__device__ __forceinline__ unsigned pk4_fp8(float a, float b, float c, float d) { int v = 0; v = __builtin_amdgcn_cvt_pk_fp8_f32(a, b, v, false); v = __builtin_amdgcn_cvt_pk_fp8_f32(c, d, v, true); return (unsigned)v; }
constexpr float FP8_SW = 256.f;
constexpr float FP8_SA = 16.f;
constexpr float FP8_SH = 4.f;
constexpr float FP8_SY = 32.f;
__device__ __forceinline__ float fsigmoid(float x) { return __builtin_amdgcn_rcpf(1.0f + __expf(-x)); }
__device__ __forceinline__ void unpack8(const v4u q, float (&d)[8]) { d[0] = bflo(q.x); d[1] = bfhi(q.x); d[2] = bflo(q.y); d[3] = bfhi(q.y); d[4] = bflo(q.z); d[5] = bfhi(q.z); d[6] = bflo(q.w); d[7] = bfhi(q.w); }
#define LDS_WAIT() asm volatile("s_waitcnt lgkmcnt(0)" ::: "memory")

#define XB_TMO      128
#define XB_XCNT(j)  (256  + 64 * (j))
#define XB_XSUB(j)  (1280 + 64 * (j))
#define XB_XGEN(j)  (2304 + 64 * (j))
#define XB_TOP      3328
#define XB_TOPGEN   3392
#define XCD_BAR_WORDS 3456
#define XB_SPIN_CAP (1u << 18)
__device__ __forceinline__ unsigned xb_ld(unsigned* p)              { return __hip_atomic_load(p, __ATOMIC_RELAXED, __HIP_MEMORY_SCOPE_AGENT); }
__device__ __forceinline__ unsigned xb_add(unsigned* p, unsigned v) { return __hip_atomic_fetch_add(p, v, __ATOMIC_RELAXED, __HIP_MEMORY_SCOPE_AGENT); }
__device__ __forceinline__ unsigned xb_xcc_id() { return (unsigned)__builtin_amdgcn_s_getreg((3 << 11) | 20) & 0xFu; }
#define XB_SPIN(cond, bar) do { unsigned _sp = 0; while (cond) { __builtin_amdgcn_s_sleep(1); \
    if ((++_sp & 255u) == 0u) { if (xb_ld(&(bar)[XB_TMO])) break; if (_sp > XB_SPIN_CAP) { atomicAdd(&(bar)[XB_TMO], 1u); break; } } } } while (0)
struct XcdBarrier { unsigned* bar; unsigned x; volatile LAS unsigned* st; };
__device__ __forceinline__ XcdBarrier xcd_barrier_post(unsigned* bar, volatile LAS unsigned* st) {
    XcdBarrier b; b.bar = bar; b.x = xb_xcc_id(); b.st = st;
    if (threadIdx.x == 0) st[2] = xb_add(&bar[XB_XCNT(b.x)], 1u);
    return b;
}
__device__ __forceinline__ void xcd_barrier_complete(unsigned* bar, unsigned x, unsigned& nloc, unsigned& nx) {
    const unsigned G = gridDim.x * gridDim.y * gridDim.z;
    unsigned sum, cnt, mine, sp = 0u;
    for (;;) {
        sum = 0u; cnt = 0u; mine = 0u;
#pragma unroll
        for (unsigned j = 0; j < 16; ++j) { const unsigned c = xb_ld(&bar[XB_XCNT(j)]); sum += c; cnt += (c > 0u) ? 1u : 0u; mine = (j == x) ? c : mine; }
        if (sum == G) break;
        __builtin_amdgcn_s_sleep(1);
        if ((++sp & 255u) == 0u) { if (xb_ld(&bar[XB_TMO])) break; if (sp > XB_SPIN_CAP) { atomicAdd(&bar[XB_TMO], 1u); break; } }
    }
    nloc = mine > 0u ? mine : 1u; nx = cnt > 0u ? cnt : 1u;
}
__device__ __forceinline__ void xcd_barrier(const XcdBarrier& b) {
    asm volatile("s_waitcnt vmcnt(0)" ::: "memory");
    __syncthreads();
    if (threadIdx.x == 0) {
        unsigned* bar = b.bar;
        __builtin_amdgcn_s_waitcnt(0);
        unsigned nloc = b.st[0], nx = b.st[1];
        if (nloc == 0u) { xcd_barrier_complete(bar, b.x, nloc, nx); b.st[0] = nloc; b.st[1] = nx; }
        const unsigned old = xb_add(&bar[XB_XSUB(b.x)], 1u);
        const unsigned gen = old / nloc;
        if (old + 1u == (gen + 1u) * nloc) {
            __builtin_amdgcn_fence(__ATOMIC_RELEASE, "agent");
            asm volatile("s_waitcnt vmcnt(0)" ::: "memory");
            const unsigned og = xb_add(&bar[XB_TOP], 1u);
            const unsigned tg = og / nx;
            if (og + 1u == (tg + 1u) * nx) xb_add(&bar[XB_TOPGEN], 1u);
            else XB_SPIN(xb_ld(&bar[XB_TOPGEN]) == tg, bar);
            __builtin_amdgcn_fence(__ATOMIC_ACQUIRE, "agent");
            xb_add(&bar[XB_XGEN(b.x)], 1u);
            asm volatile("s_waitcnt vmcnt(0)" ::: "memory");
        } else {
            XB_SPIN(xb_ld(&bar[XB_XGEN(b.x)]) == gen, bar);
            __builtin_amdgcn_fence(__ATOMIC_ACQUIRE, "agent");
            asm volatile("s_waitcnt vmcnt(0)" ::: "memory");
        }
    }
    __syncthreads();
}

struct Params {
    const float* x; const float* attn_norm_w; const float* w_in; const float* q_norm_w; const float* k_norm_w; const float* sinks;
    const float* conv_w; const float* conv_b; const float* dt_bias; const float* a_log; const float* d_skip; const float* ssm_norm_w;
    const float* attn_out_norm_w; const float* w_out; const float* ffn_norm_w; const float* w_router; const float* b_router;
    const float* w_gate; const float* b_gate; const float* w_up; const float* b_up; const float* w_down; const float* b_down;
    float* out; unsigned char* ws; int ph_lo, ph_hi, variant, pad;
};

namespace pg8 {
constexpr int BM = 256, BK = 64, HALF = 128, HTB = HALF * BK * 2, GK = 2048;
__device__ __forceinline__ int lds_byte(int r, int c) { const int st = (r >> 4) * 2 + (c >> 5), rr = r & 15, cc = c & 31, ob = rr * 64 + cc * 2; return st * 1024 + (ob ^ (((ob >> 9) & 1) << 5)); }
__device__ __forceinline__ void stage_rc(int b, int& R, int& C) { const int st = b / 1024, sb = b % 1024, swz = sb ^ (((sb >> 9) & 1) << 5); R = (st >> 1) * 16 + swz / 64; C = (st & 1) * 32 + (swz % 64) / 2; }
__device__ __forceinline__ int perm32(int rho) { const int n = rho >> 4, i = rho & 15; return 8 * (i >> 2) + 4 * n + (i & 3); }

struct Unit { const char* aBase; const char* bBase; const int* aidx; int avalid; int pm, pn, e; };

template <class Epi, class Sched>
__device__ __forceinline__ void gemm_phase(LAS unsigned char* lds, const Sched& S, const Epi& E) {
    constexpr int RP = Sched::ROWB, nt = RP / 128;
    constexpr bool F8 = Sched::FP8;
    const int tid = threadIdx.x, wid = __builtin_amdgcn_readfirstlane(tid >> 6), lane = tid & 63, wr = wid >> 2, wc = wid & 3, fr = lane & 15, fq = lane >> 4;
    int sR[2], sC[2];
    unsigned voffB[2], vA[2][2];
#pragma unroll
    for (int i = 0; i < 2; ++i) { stage_rc(tid * 16 + i * 8192, sR[i], sC[i]); const int Rb = Epi::PERM ? ((sR[i] & ~31) + perm32(sR[i] & 31)) : sR[i];
        voffB[i] = (unsigned)(Rb * RP + sC[i] * 2); }
    const size_t kstep = (size_t)(BK * 2);
    const size_t hstep = (size_t)HALF * RP;
    const unsigned ldsw = (unsigned)wid * 1024u;
    const int aoff = lds_byte(wr * 64 + fr, fq * 8), boff = lds_byte(wc * 32 + fr, fq * 8);
#define PG8_SA(b, h) (((b) * 2 + (h)) * HTB)
#define PG8_SB(b, h) ((4 + (b) * 2 + (h)) * HTB)
#define PG8_STAGE(bufoff, gbase, voff) do { if constexpr (!(Sched::CRIP & 2)) _Pragma("unroll") for (int _i = 0; _i < 2; ++_i) { unsigned _o = (voff)[_i]; asm volatile("" : "+v"(_o)); \
        __builtin_amdgcn_global_load_lds((const unsigned*)((const char*)(gbase) + _o), (LAS unsigned*)(lds + (bufoff) + ldsw + _i * 8192), 16, 0, 0); } } while (0)
#define PG8_CAT(x, y) __builtin_shufflevector(x, y, 0, 1, 2, 3, 4, 5, 6, 7)
#define PG8_LO(v) __builtin_bit_cast(bf16x8, __builtin_shufflevector(v, v, 0, 1, 2, 3))
#define PG8_HI(v) __builtin_bit_cast(bf16x8, __builtin_shufflevector(v, v, 4, 5, 6, 7))
#define PG8_LDA(dst, b, h) do { if constexpr (!(Sched::CRIP & 4)) _Pragma("unroll") for (int m = 0; m < 4; ++m) dst[m] = PG8_CAT(*(const LAS i32x4*)(lds + PG8_SA(b, h) + aoff + m * 2048), *(const LAS i32x4*)(lds + PG8_SA(b, h) + aoff + m * 2048 + 1024)); } while (0)
#define PG8_LDB(dst, b, h) do { if constexpr (!(Sched::CRIP & 4)) _Pragma("unroll") for (int n = 0; n < 2; ++n) dst[n] = PG8_CAT(*(const LAS i32x4*)(lds + PG8_SB(b, h) + boff + n * 2048), *(const LAS i32x4*)(lds + PG8_SB(b, h) + boff + n * 2048 + 1024)); } while (0)
#define PG8_MMA(ai, bj, At, Bt) do { __builtin_amdgcn_s_setprio(1); \
        if constexpr (Sched::CRIP & 1) {} else if constexpr (F8) { asm volatile("s_nop 1\n\t" \
            "v_mfma_scale_f32_16x16x128_f8f6f4 %0, %8, %10, %0, %14, %14 op_sel_hi:[0,0,0]\n\t" "v_mfma_scale_f32_16x16x128_f8f6f4 %1, %9, %10, %1, %14, %14 op_sel_hi:[0,0,0]\n\t" \
            "v_mfma_scale_f32_16x16x128_f8f6f4 %2, %8, %11, %2, %14, %14 op_sel_hi:[0,0,0]\n\t" "v_mfma_scale_f32_16x16x128_f8f6f4 %3, %9, %11, %3, %14, %14 op_sel_hi:[0,0,0]\n\t" \
            "v_mfma_scale_f32_16x16x128_f8f6f4 %4, %8, %12, %4, %14, %14 op_sel_hi:[0,0,0]\n\t" "v_mfma_scale_f32_16x16x128_f8f6f4 %5, %9, %12, %5, %14, %14 op_sel_hi:[0,0,0]\n\t" \
            "v_mfma_scale_f32_16x16x128_f8f6f4 %6, %8, %13, %6, %14, %14 op_sel_hi:[0,0,0]\n\t" "v_mfma_scale_f32_16x16x128_f8f6f4 %7, %9, %13, %7, %14, %14 op_sel_hi:[0,0,0]" \
            : "+v"(acc[ai][bj][0][0]), "+v"(acc[ai][bj][0][1]), "+v"(acc[ai][bj][1][0]), "+v"(acc[ai][bj][1][1]), "+v"(acc[ai][bj][2][0]), "+v"(acc[ai][bj][2][1]), "+v"(acc[ai][bj][3][0]), "+v"(acc[ai][bj][3][1]) \
            : "v"(Bt[0]), "v"(Bt[1]), "v"(At[0]), "v"(At[1]), "v"(At[2]), "v"(At[3]), "v"(f8scale)); } \
        else { _Pragma("unroll") for (int m = 0; m < 4; ++m) _Pragma("unroll") for (int n = 0; n < 2; ++n) { \
               acc[ai][bj][m][n] = __builtin_amdgcn_mfma_f32_16x16x32_bf16(PG8_LO(Bt[n]), PG8_LO(At[m]), acc[ai][bj][m][n], 0, 0, 0); \
               acc[ai][bj][m][n] = __builtin_amdgcn_mfma_f32_16x16x32_bf16(PG8_HI(Bt[n]), PG8_HI(At[m]), acc[ai][bj][m][n], 0, 0, 0); } } \
        __builtin_amdgcn_s_setprio(0); } while (0)
#define PG8_WAIT_V(n) asm volatile("s_waitcnt vmcnt(" #n ")" ::: "memory")
#define PG8_WAIT_L(n) asm volatile("s_waitcnt lgkmcnt(" #n ")" ::: "memory")
#define PG8_BAR __builtin_amdgcn_s_barrier()
#define PG8_BAR2 do { if constexpr (!(Sched::CRIP & 16)) __builtin_amdgcn_s_barrier(); } while (0)
#define PG8_SCHED __builtin_amdgcn_sched_barrier(0)
    Unit cur, nxt; int ui = 0;
    if (!S.next(0, cur)) return;
    typename Epi::Pre epre;
    E.prefetch(cur, epre);
    LAS int* lidx = (LAS int*)(lds + 8 * HTB);
    if constexpr (Sched::GATHER) {
        if (tid < 256) { const int v = cur.aidx[tid]; lidx[tid] = (tid < cur.avalid) ? v : 0; }
        __syncthreads();
    }
#pragma unroll
    for (int h = 0; h < 2; ++h)
#pragma unroll
        for (int i = 0; i < 2; ++i) {
            const int r = h * HALF + sR[i];
            if constexpr (Sched::GATHER) vA[h][i] = (unsigned)(lidx[r] * RP + sC[i] * 2);
            else vA[h][i] = (unsigned)(r * RP + sC[i] * 2);
        }
    f32x4 acc[2][2][4][2];
#pragma unroll
    for (int a = 0; a < 2; ++a)
#pragma unroll
        for (int b = 0; b < 2; ++b)
#pragma unroll
            for (int m = 0; m < 4; ++m)
#pragma unroll
                for (int n = 0; n < 2; ++n) acc[a][b][m][n] = (f32x4){0.f, 0.f, 0.f, 0.f};
    i32x8 At[4], B0[2], B1[2];
    if constexpr (Sched::CRIP & 4) { _Pragma("unroll") for (int m = 0; m < 4; ++m) At[m] = (i32x8){0, 0, 0, 0, 0, 0, 0, 0}; _Pragma("unroll") for (int n = 0; n < 2; ++n) { B0[n] = At[0]; B1[n] = At[0]; } }
    int f8scale = 0x7f7f7f7f; asm volatile("" : "+v"(f8scale));
    const char* cA = cur.aBase; const char* cB = cur.bBase;
#ifndef KROT
#define KROT(pm, pn) (((F8 ? 0 : (pm)) + (pn)) & (nt - 1))
#endif
#define PG8_KT(rot, tau) ((size_t)(((tau) + (rot)) & (nt - 1)) * kstep)
    int crot = KROT(cur.pm, cur.pn);
    PG8_STAGE(PG8_SB(0, 0), cB + PG8_KT(crot, 0), voffB); PG8_STAGE(PG8_SB(0, 1), cB + hstep + PG8_KT(crot, 0), voffB); PG8_STAGE(PG8_SA(0, 0), cA + PG8_KT(crot, 0), vA[0]); PG8_STAGE(PG8_SA(0, 1), cA + PG8_KT(crot, 0), vA[1]);
    if (wr == 1) PG8_BAR;
    PG8_WAIT_V(2); PG8_BAR;
    PG8_STAGE(PG8_SB(1, 0), cB + PG8_KT(crot, 1), voffB); PG8_STAGE(PG8_SA(1, 0), cA + PG8_KT(crot, 1), vA[0]); PG8_STAGE(PG8_SB(1, 1), cB + hstep + PG8_KT(crot, 1), voffB);
    PG8_WAIT_V(6); PG8_BAR;
    for (;;) {
        const bool has_next = S.next(ui + 1, nxt);
        const char* nA = has_next ? nxt.aBase : cA; const char* nB = has_next ? nxt.bBase : cB;
        const int nrot = has_next ? KROT(nxt.pm, nxt.pn) : crot;
        for (int t = 0; t < nt; t += 2) {
            const bool last = (t == nt - 2);
            const char* a1 = cA + PG8_KT(crot, t + 1);
            const char* a2 = last ? nA + PG8_KT(nrot, 0) : cA + PG8_KT(crot, t + 2); const char* b2 = last ? nB + PG8_KT(nrot, 0) : cB + PG8_KT(crot, t + 2);
            const char* a3 = last ? nA + PG8_KT(nrot, 1) : cA + PG8_KT(crot, t + 3); const char* b3 = last ? nB + PG8_KT(nrot, 1) : cB + PG8_KT(crot, t + 3);
            int gi = 0;
            if constexpr (Sched::GATHER) { if (t == 0 && has_next && tid < 256) gi = nxt.aidx[tid]; }
            PG8_LDB(B0, 0, 0); PG8_LDB(B1, 0, 1); PG8_SCHED; PG8_LDA(At, 0, 0); PG8_STAGE(PG8_SA(1, 1), a1, vA[1]);
            PG8_WAIT_V(8); PG8_WAIT_L(0); PG8_BAR; PG8_MMA(0, 0, At, B0); PG8_MMA(0, 1, At, B1); PG8_BAR2; PG8_SCHED;
            if constexpr (Sched::GATHER) { if (last && has_next) {
                int tz = threadIdx.x; asm volatile("" : "+v"(tz));
#pragma unroll
                for (int i = 0; i < 2; ++i) { int R, C; stage_rc(tz * 16 + i * 8192, R, C);
#pragma unroll
                    for (int h = 0; h < 2; ++h) vA[h][i] = (unsigned)(lidx[h * HALF + R] * RP + C * 2); } } }
            PG8_LDA(At, 0, 1); PG8_STAGE(PG8_SB(0, 0), b2, voffB); PG8_STAGE(PG8_SB(0, 1), b2 + hstep, voffB); PG8_STAGE(PG8_SA(0, 0), a2, vA[0]);
            PG8_WAIT_V(8); PG8_WAIT_L(0); PG8_BAR; PG8_MMA(1, 0, At, B0); PG8_MMA(1, 1, At, B1); PG8_BAR2; PG8_SCHED;
            PG8_LDB(B0, 1, 0); PG8_LDB(B1, 1, 1); PG8_SCHED; PG8_LDA(At, 1, 0); PG8_STAGE(PG8_SA(0, 1), a2, vA[1]);
            PG8_WAIT_V(8); PG8_WAIT_L(0); PG8_BAR; PG8_MMA(0, 0, At, B0); PG8_MMA(0, 1, At, B1); PG8_BAR2; PG8_SCHED;
            PG8_LDA(At, 1, 1); PG8_STAGE(PG8_SB(1, 0), b3, voffB); PG8_STAGE(PG8_SB(1, 1), b3 + hstep, voffB); PG8_STAGE(PG8_SA(1, 0), a3, vA[0]);
            PG8_WAIT_V(8); PG8_WAIT_L(0); PG8_BAR; PG8_MMA(1, 0, At, B0); PG8_MMA(1, 1, At, B1); PG8_BAR2; PG8_SCHED;
            if constexpr (Sched::GATHER) { if (t == 0 && has_next && tid < 256) lidx[tid] = (tid < nxt.avalid) ? gi : 0; }
        }
        if constexpr (F8) asm volatile("s_nop 15\n\ts_nop 15" ::: "memory");
        if (wr == 0) PG8_BAR;
        { int tz = threadIdx.x; asm volatile("" : "+v"(tz)); const int ewid = __builtin_amdgcn_readfirstlane(tz >> 6), el = tz & 63;
          E(acc, cur, epre, ewid >> 2, ewid & 3, el & 15, el >> 4); }
        if (!has_next) break;
#pragma unroll
        for (int a = 0; a < 2; ++a)
#pragma unroll
            for (int b = 0; b < 2; ++b)
#pragma unroll
                for (int m = 0; m < 4; ++m)
#pragma unroll
                    for (int n = 0; n < 2; ++n) acc[a][b][m][n] = (f32x4){0.f, 0.f, 0.f, 0.f};
        cur = nxt; cA = nA; cB = nB; crot = nrot; ++ui;
        E.prefetch(cur, epre);
        if (wr == 1) PG8_BAR;
    }
    PG8_WAIT_V(0);
    PG8_BAR;
#undef PG8_KT
#undef PG8_SA
#undef PG8_SB
#undef PG8_STAGE
#undef PG8_LDA
#undef PG8_LDB
#undef PG8_MMA
#undef PG8_CAT
#undef PG8_LO
#undef PG8_HI
#undef PG8_WAIT_V
#undef PG8_WAIT_L
#undef PG8_BAR
#undef PG8_BAR2
#undef PG8_SCHED
}

__device__ __forceinline__ bool tile_order(long L, int nM, int nN, int& pm, int& pn) {
    const int nwg = nM * nN; if (L >= nwg) return false;
    int wgid = (int)L; { const int q = nwg / 8, r = nwg % 8, xcd = wgid % 8, off = wgid / 8; wgid = (xcd < r ? xcd * (q + 1) : r * (q + 1) + (xcd - r) * q) + off; }
    const int nig = 8 * nN, gid = wgid / nig, fm = gid * 8, gsz = (nM - fm) < 8 ? (nM - fm) : 8;
    pm = fm + ((wgid % nig) % gsz); pn = (wgid % nig) / gsz; return true;
}
template <int CRIP_ = 0> struct SchedDenseT {
    static constexpr bool GATHER = false, FP8 = false; static constexpr int ROWB = 4096, CRIP = CRIP_;
    const char* A; const char* Bt; int nM, nN, G, c;
    __device__ __forceinline__ bool next(int i, Unit& u) const {
        int pm, pn; if (!tile_order((long)i * G + c, nM, nN, pm, pn)) return false;
        u.pm = pm; u.pn = pn; u.e = 0; u.aidx = nullptr; u.avalid = 256;
        u.aBase = A + (size_t)pm * 256 * GK * 2; u.bBase = Bt + (size_t)pn * 256 * GK * 2;
        if constexpr ((CRIP_ & 64) != 0) u.bBase = Bt;
        if constexpr ((CRIP_ & 128) != 0) u.aBase = A;
        return true;
    }
};
typedef SchedDenseT<0> SchedDense;
struct SchedQueue {
    static constexpr bool GATHER = false, FP8 = false; static constexpr int ROWB = 4096, CRIP = 0;
    const char* A; const char* Bt; int nM, nN, q, xcd; unsigned* tick; LAS int* tk;
    __device__ __forceinline__ bool next(int i, Unit& u) const {
        const int t = __builtin_amdgcn_readfirstlane(tk[i & 1]);
        if (i > 0 && threadIdx.x == 0) tk[(i + 1) & 1] = (int)__hip_atomic_fetch_add(tick, 1u, __ATOMIC_RELAXED, __HIP_MEMORY_SCOPE_AGENT);
        if (t >= q) return false;
        const int id = xcd * q + t, nig = 8 * nN, gid = id / nig, fm = gid * 8, gsz = (nM - fm) < 8 ? (nM - fm) : 8;
        const int pm = fm + ((id % nig) % gsz), pn = (id % nig) / gsz;
        u.pm = pm; u.pn = pn; u.e = 0; u.aidx = nullptr; u.avalid = 256;
        u.aBase = A + (size_t)pm * 256 * ROWB; u.bBase = Bt + (size_t)pn * 256 * ROWB; return true;
    }
};
template <bool GATHER_, int CRIP_ = 0> struct SchedMoE {
    static constexpr bool GATHER = GATHER_ && !(CRIP_ & 32), FP8 = true; static constexpr int ROWB = 2048, CRIP = CRIP_;
    const char* A; const char* Bt; const int* stok; const LAS int* tstart; const LAS int* cnt; int nN, nrowsB  , G, c;
    __device__ __forceinline__ bool next(int i, Unit& u) const {
        const int nM = __builtin_amdgcn_readfirstlane(tstart[NE]); int pm, pn; if (!tile_order((long)i * G + c, nM, nN, pm, pn)) return false;
        int e = 0;
        for (int j = 1; j < NE; ++j) e += (tstart[j] <= pm) ? 1 : 0;
        e = __builtin_amdgcn_readfirstlane(e);
        const int mt = __builtin_amdgcn_readfirstlane(pm - tstart[e]);
        u.pm = pm; u.pn = pn; u.e = e;
        u.avalid = __builtin_amdgcn_readfirstlane(cnt[e]) - mt * 256;
        u.aidx = stok + (size_t)e * T + mt * 256;
        u.aBase = GATHER ? A : A + (size_t)(GATHER_ ? (pm & 127) : pm) * 256 * ROWB;
        u.bBase = Bt + ((size_t)e * nrowsB + (size_t)pn * 256) * ROWB;
        if constexpr ((CRIP_ & 8) != 0) { u.aBase = A; u.bBase = Bt; }
        return true;
    }
};
}

struct EpiNoPre { };
struct EpiInProj {
    static constexpr bool PERM = true; typedef EpiNoPre Pre;
    bf16* proj; float* dtraw;
    __device__ __forceinline__ void prefetch(const pg8::Unit&, Pre&) const {}
    __device__ __forceinline__ void operator()(const f32x4 (&acc)[2][2][4][2], const pg8::Unit& u, const Pre&, int wr, int wc, int fr, int fq) const {
        const int row0 = u.pm * 256 + wr * 64 + fr;
        if (u.pn < 15) {
            const int col0 = u.pn * 256 + wc * 32 + 8 * fq;
#pragma unroll
            for (int ai = 0; ai < 2; ++ai)
#pragma unroll
                for (int m = 0; m < 4; ++m) { bf16* rowp = proj + (size_t)(row0 + ai * 128 + m * 16) * PROJ_LD + col0;
#pragma unroll
                    for (int bj = 0; bj < 2; ++bj) { const f32x4 v0 = acc[ai][bj][m][0], v1 = acc[ai][bj][m][1];
                        v4u w; w.x = pk2(v0[0], v0[1]); w.y = pk2(v0[2], v0[3]); w.z = pk2(v1[0], v1[1]); w.w = pk2(v1[2], v1[3]);
                        *(v4u*)(rowp + bj * 128) = w; } }
        } else if (wc == 0 && fq < 2) {
#pragma unroll
            for (int ai = 0; ai < 2; ++ai)
#pragma unroll
                for (int m = 0; m < 4; ++m) { float* rowp = dtraw + (size_t)(row0 + ai * 128 + m * 16) * 16 + 8 * fq;
                    *(f32x4*)(rowp) = acc[ai][0][m][0]; *(f32x4*)(rowp + 4) = acc[ai][0][m][1]; }
        }
    }
};
struct EpiOutProj {
    static constexpr bool PERM = true; typedef EpiNoPre Pre;
    const float* x; bf16* x1; float* ssq;
    __device__ __forceinline__ void prefetch(const pg8::Unit&, Pre&) const {}
    __device__ __forceinline__ void operator()(const f32x4 (&acc)[2][2][4][2], const pg8::Unit& u, const Pre&, int wr, int wc, int fr, int fq) const {
        const int row0 = u.pm * 256 + wr * 64 + fr, col0 = u.pn * 256 + wc * 32 + 8 * fq;
#pragma unroll
        for (int ai = 0; ai < 2; ++ai) {
            f32x4 xv[4][2][2];
#pragma unroll
            for (int m = 0; m < 4; ++m)
#pragma unroll
                for (int bj = 0; bj < 2; ++bj)
#pragma unroll
                    for (int n = 0; n < 2; ++n) xv[m][bj][n] = *(const f32x4*)(x + (size_t)(row0 + ai * 128 + m * 16) * D + col0 + bj * 128 + n * 4);
#pragma unroll
            for (int m = 0; m < 4; ++m) { asm volatile("" : "+v"(xv[m][0][0]), "+v"(xv[m][0][1]), "+v"(xv[m][1][0]), "+v"(xv[m][1][1])); }
#pragma unroll
            for (int m = 0; m < 4; ++m) { const int row = row0 + ai * 128 + m * 16; const size_t off = (size_t)row * D + col0; float s = 0.f;
#pragma unroll
                for (int bj = 0; bj < 2; ++bj) { const f32x4 o0 = xv[m][bj][0] + acc[ai][bj][m][0], o1 = xv[m][bj][1] + acc[ai][bj][m][1];
                    *(v4u*)(x1 + off + bj * 128) = (v4u){pk2(o0[0], o0[1]), pk2(o0[2], o0[3]), pk2(o1[0], o1[1]), pk2(o1[2], o1[3])};
                    s += ((o0[0] * o0[0] + o0[1] * o0[1]) + (o0[2] * o0[2] + o0[3] * o0[3])) + ((o1[0] * o1[0] + o1[1] * o1[1]) + (o1[2] * o1[2] + o1[3] * o1[3])); }
                s += __shfl_xor(s, 16); s += __shfl_xor(s, 32);
                if (fq == 0) ssq[(size_t)row * 32 + u.pn * 4 + wc] = s; }
        }
    }
};
struct EpiGateUp {
    static constexpr bool PERM = true;
    struct Pre { f32x4 bg[2], bu[2]; };
    unsigned char* hb; const float* b_gate; const float* b_up;
    __device__ __forceinline__ void prefetch(const pg8::Unit& u, Pre& q) const {
        int tz = threadIdx.x; asm volatile("" : "+v"(tz)); const int wc = (tz >> 6) & 3, fq = (tz >> 4) & 3;
        const int f0 = u.pn * 128 + wc * 32 + 8 * fq;
#pragma unroll
        for (int n = 0; n < 2; ++n) { q.bg[n] = *(const f32x4*)(b_gate + (size_t)u.e * FF + f0 + 4 * n); q.bu[n] = *(const f32x4*)(b_up + (size_t)u.e * FF + f0 + 4 * n); }
    }
    __device__ __forceinline__ void operator()(const f32x4 (&acc)[2][2][4][2], const pg8::Unit& u, const Pre& q, int wr, int wc, int fr, int fq) const {
        const int row0 = u.pm * 256 + wr * 64 + fr, f0 = u.pn * 128 + wc * 32 + 8 * fq;
        constexpr float DS = 1.0f / (FP8_SA * FP8_SW);
#pragma unroll
        for (int ai = 0; ai < 2; ++ai)
#pragma unroll
            for (int m = 0; m < 4; ++m) { unsigned char* rowp = hb + (size_t)(row0 + ai * 128 + m * 16) * FF + f0; float h[8];
#pragma unroll
                for (int n = 0; n < 2; ++n)
#pragma unroll
                    for (int j = 0; j < 4; ++j) { const float g = acc[ai][0][m][n][j] * DS + q.bg[n][j], up = acc[ai][1][m][n][j] * DS + q.bu[n][j];
                        const float gl = fminf(g, 7.0f), li = __builtin_amdgcn_fmed3f(up, -7.0f, 7.0f);
                        const float sg = __builtin_amdgcn_rcpf(1.0f + __builtin_amdgcn_exp2f(gl * (-1.702f * 1.44269504f)));
                        h[n * 4 + j] = (gl * sg) * (li * FP8_SH + FP8_SH); }
                *(v2u*)rowp = (v2u){pk4_fp8(h[0], h[1], h[2], h[3]), pk4_fp8(h[4], h[5], h[6], h[7])}; }
    }
};
struct EpiDown {
    static constexpr bool PERM = true;
    struct Pre { f32x4 bv[2][2]; float gt[2][4]; };
    unsigned char* y2; const float* b_down; const float* sgate; const LAS int* tstart;
    __device__ __forceinline__ void prefetch(const pg8::Unit& u, Pre& q) const {
        int tz = threadIdx.x; asm volatile("" : "+v"(tz)); const int wid = tz >> 6, wr = wid >> 2, wc = wid & 3, fr = tz & 15, fq = (tz >> 4) & 3;
        const int rl0 = wr * 64 + fr, col0 = u.pn * 256 + wc * 32 + 8 * fq;
        const int mt = __builtin_amdgcn_readfirstlane(u.pm - tstart[u.e]);
        const float* gp = sgate + (size_t)u.e * T + mt * 256;
#pragma unroll
        for (int bj = 0; bj < 2; ++bj)
#pragma unroll
            for (int n = 0; n < 2; ++n) q.bv[bj][n] = *(const f32x4*)(b_down + (size_t)u.e * D + col0 + bj * 128 + 4 * n);
#pragma unroll
        for (int ai = 0; ai < 2; ++ai)
#pragma unroll
            for (int m = 0; m < 4; ++m) q.gt[ai][m] = gp[rl0 + ai * 128 + m * 16];
    }
    __device__ __forceinline__ void operator()(const f32x4 (&acc)[2][2][4][2], const pg8::Unit& u, const Pre& q, int wr, int wc, int fr, int fq) const {
        const int rl0 = wr * 64 + fr, col0 = u.pn * 256 + wc * 32 + 8 * fq;
        constexpr float DS = 1.0f / (FP8_SH * FP8_SW);
#pragma unroll
        for (int ai = 0; ai < 2; ++ai)
#pragma unroll
            for (int m = 0; m < 4; ++m) { const int rl = rl0 + ai * 128 + m * 16; const float gt = q.gt[ai][m] * FP8_SY; unsigned char* rowp = y2 + (size_t)(u.pm * 256 + rl) * D + col0;
#pragma unroll
                for (int bj = 0; bj < 2; ++bj) { const f32x4 v0 = (acc[ai][bj][m][0] * DS + q.bv[bj][0]) * gt, v1 = (acc[ai][bj][m][1] * DS + q.bv[bj][1]) * gt;
                    *(v2u*)(rowp + bj * 128) = (v2u){pk4_fp8(sat8(v0[0]), sat8(v0[1]), sat8(v0[2]), sat8(v0[3])), pk4_fp8(sat8(v1[0]), sat8(v1[1]), sat8(v1[2]), sat8(v1[3]))}; } }
    }
};

__device__ __forceinline__ void p0_tr_item(const float* W, int ldw, int k0, int n0, int nvalid, bf16* WT, int dst_row0, LAS float* scr, int lane) {
    const int c4 = (lane & 15) * 4, kr = lane >> 4;
#pragma unroll 4
    for (int i = 0; i < 16; ++i) { const int kk = 4 * i + kr;
        f32x4 v = (f32x4){0.f, 0.f, 0.f, 0.f};
        if (c4 < nvalid) v = *(const f32x4*)(W + (size_t)(k0 + kk) * ldw + n0 + c4);
        LAS float* d = scr + kk * 65 + c4; d[0] = v[0]; d[1] = v[1]; d[2] = v[2]; d[3] = v[3]; }
    LDS_WAIT(); asm volatile("" ::: "memory");
    const int c = lane >> 3, np = lane & 7;
#pragma unroll
    for (int j = 0; j < 8; ++j) { const int n = 8 * j + np; const LAS float* s = scr + (8 * c) * 65 + n;
        v4u o; o.x = pk2(s[0 * 65], s[1 * 65]); o.y = pk2(s[2 * 65], s[3 * 65]); o.z = pk2(s[4 * 65], s[5 * 65]); o.w = pk2(s[6 * 65], s[7 * 65]);
        *(v4u*)(WT + (size_t)(dst_row0 + n) * 2048 + k0 + 8 * c) = o; }
    LDS_WAIT(); asm volatile("" ::: "memory");
}
__device__ __forceinline__ void f8_tile_load(const float* src, f32x4 (&v)[16], int lane) {
    const float* s0 = src + (size_t)(16 * (lane >> 3)) * 2048 + 4 * (lane & 7);
#pragma unroll
    for (int i = 0; i < 16; ++i) v[i] = __builtin_nontemporal_load((const f32x4*)(s0 + (size_t)i * 2048));
}
__device__ __forceinline__ void f8_tile_store(const f32x4 (&v)[16], unsigned char* dst, int lane) {
    unsigned d[16];
#pragma unroll
    for (int i = 0; i < 16; ++i) d[i] = pk4_fp8(sat8(v[i][0] * FP8_SW), sat8(v[i][1] * FP8_SW), sat8(v[i][2] * FP8_SW), sat8(v[i][3] * FP8_SW));
    unsigned o[4][4];
#pragma unroll
    for (int w = 0; w < 4; ++w) {
        const unsigned t0 = __builtin_amdgcn_perm(d[4 * w + 1], d[4 * w], 0x05010400u), t1 = __builtin_amdgcn_perm(d[4 * w + 1], d[4 * w], 0x07030602u);
        const unsigned t2 = __builtin_amdgcn_perm(d[4 * w + 3], d[4 * w + 2], 0x05010400u), t3 = __builtin_amdgcn_perm(d[4 * w + 3], d[4 * w + 2], 0x07030602u);
        o[0][w] = __builtin_amdgcn_perm(t2, t0, 0x05040100u); o[1][w] = __builtin_amdgcn_perm(t2, t0, 0x07060302u);
        o[2][w] = __builtin_amdgcn_perm(t3, t1, 0x05040100u); o[3][w] = __builtin_amdgcn_perm(t3, t1, 0x07060302u);
    }
    unsigned char* d0 = dst + (size_t)(4 * (lane & 7)) * 2048 + 16 * (lane >> 3);
#pragma unroll
    for (int b = 0; b < 4; ++b) __builtin_nontemporal_store((v4u){o[b][0], o[b][1], o[b][2], o[b][3]}, (v4u*)(d0 + (size_t)b * 2048));
}
__device__ __forceinline__ void f8_item(const Params& p, int it, const float*& src, unsigned char*& dst) {
    const int which = it >> 15, r = it & 32767, e = r >> 10, q = r & 1023, kb = q >> 6, nb = q & 63;
    if (which == 2) { src = p.w_down + (size_t)e * FF * D + (size_t)(kb * 128) * D + nb * 32; dst = p.ws + WS_WD + ((size_t)e * D + nb * 32) * 2048 + kb * 128; }
    else { const int f0 = nb * 32, drow = (f0 >> 7) * 256 + which * 128 + (f0 & 127);
        src = (which == 0 ? p.w_gate : p.w_up) + (size_t)e * D * FF + (size_t)(kb * 128) * FF + f0; dst = p.ws + WS_WGU + ((size_t)e * 4096 + drow) * 2048 + kb * 128; }
}
__device__ __forceinline__ void convert_experts(const Params& p, int first, int stride, int lane) {
    constexpr int NEXP = 3 * NE * 1024;
    f32x4 va[16], vb[16]; const float* sa; unsigned char* da; const float* sb; unsigned char* db;
    int ia = first, ib;
    if (ia < NEXP) { f8_item(p, ia, sa, da); f8_tile_load(sa, va, lane); }
    for (;;) {
        if (ia >= NEXP) break;
        ib = ia + stride; if (ib < NEXP) { f8_item(p, ib, sb, db); f8_tile_load(sb, vb, lane); }
        f8_tile_store(va, da, lane);
        if (ib >= NEXP) break;
        ia = ib + stride; if (ia < NEXP) { f8_item(p, ia, sa, da); f8_tile_load(sa, va, lane); }
        f8_tile_store(vb, db, lane);
    }
}
__device__ __forceinline__ void phase_prologue(const Params& p, LAS unsigned char* lds, int gw, int NGW, int wave, int lane) {
    LAS float* scr = (LAS float*)(lds + wave * 16896);
    bf16* WIN = (bf16*)(p.ws + WS_WIN); bf16* WOUT = (bf16*)(p.ws + WS_WOUT);
    constexpr int I_IN = 32 * 64, I_OUT = 32 * 32;
    for (int it = gw; it < I_IN + I_OUT; it += NGW) {
        int r = it;
        if (r < I_IN) { const int kb = r / 64, nb = r % 64; int nv = NIN - nb * 64; nv = nv < 0 ? 0 : (nv > 64 ? 64 : nv);
            p0_tr_item(p.w_in, NIN, kb * 64, nb * 64, nv, WIN, nb * 64, scr, lane); continue; }
        r -= I_IN;
        { const int kb = r / 32, nb = r % 32; p0_tr_item(p.w_out, D, kb * 64, nb * 64, 64, WOUT, nb * 64, scr, lane); }
    }
    {
        bf16* wrb = (bf16*)(p.ws + WS_WRB);
        for (int idx = gw * 64 + lane; idx < D * NE; idx += NGW * 64) { const int k = idx >> 5, n = idx & 31, j = k >> 5, kq = (k >> 3) & 3, m = k & 7, half = n >> 4, l64 = kq * 16 + (n & 15);
            const float w = p.w_router[idx]; const unsigned hi = f2bf(w); const float lo = w - bflo(hi);
            wrb[((((size_t)j * 2 + half) * 2 + 0) * 64 + l64) * 8 + m] = (bf16)hi; wrb[((((size_t)j * 2 + half) * 2 + 1) * 64 + l64) * 8 + m] = (bf16)f2bf(lo); }
    }
    bf16* HN = (bf16*)(p.ws + WS_HN);
    f32x4 gw4[8];
#pragma unroll
    for (int j = 0; j < 8; ++j) gw4[j] = *((const f32x4*)p.attn_norm_w + 64 * j + lane);
    f32x4 vn[8];
    if (gw < T) { const f32x4* xr = (const f32x4*)(p.x + (size_t)gw * D) + lane;
#pragma unroll
        for (int j = 0; j < 8; ++j) vn[j] = xr[64 * j]; }
    for (int m = gw; m < T; m += NGW) {
        f32x4 v[8]; float s = 0.f;
#pragma unroll
        for (int j = 0; j < 8; ++j) v[j] = vn[j];
        if (m + NGW < T) { const f32x4* xr = (const f32x4*)(p.x + (size_t)(m + NGW) * D) + lane;
#pragma unroll
            for (int j = 0; j < 8; ++j) vn[j] = xr[64 * j]; }
#pragma unroll
        for (int j = 0; j < 8; ++j) s += (v[j][0] * v[j][0] + v[j][1] * v[j][1]) + (v[j][2] * v[j][2] + v[j][3] * v[j][3]);
        const float rstd = rsqrtf(wave_sum(s) * (1.f / D) + EPS);
        v2u* o8 = (v2u*)(HN + (size_t)m * D) + lane;
#pragma unroll
        for (int j = 0; j < 8; ++j) { v2u w; w.x = pk2(v[j][0] * rstd * gw4[j][0], v[j][1] * rstd * gw4[j][1]); w.y = pk2(v[j][2] * rstd * gw4[j][2], v[j][3] * rstd * gw4[j][3]); o8[64 * j] = w; }
    }
}

__device__ __forceinline__ void phase_conv(const Params& p, int G) {
    const bf16* proj = (const bf16*)(p.ws + WS_PROJ); float* xbc = (float*)(p.ws + WS_XBC);
    const float* dtraw = (const float*)(p.ws + WS_DT); float* dts = (float*)(p.ws + WS_DTS);
    const int tid = threadIdx.x;
    for (int item = blockIdx.x; item < T / 64; item += G) {
        const int t0 = item * 64;
        if (tid < 384) {
            const int cg = tid % 192, half = tid / 192, c0 = cg * 8, ts = t0 + half * 32;
            float w[4][8], bb[8];
#pragma unroll
            for (int k = 0; k < 4; ++k)
#pragma unroll
                for (int j = 0; j < 8; ++j) w[k][j] = p.conv_w[k * NXBC + c0 + j];
#pragma unroll
            for (int j = 0; j < 8; ++j) bb[j] = p.conv_b[c0 + j];
            float r0[8], r1[8], r2[8];
            {
                const int tl = ts % SEQ;
                v4u q0 = (v4u){0u, 0u, 0u, 0u}, q1 = q0, q2 = q0;
                if (tl - 3 >= 0) q0 = *(const v4u*)(proj + (size_t)(ts - 3) * PROJ_LD + COL_XBC + c0);
                if (tl - 2 >= 0) q1 = *(const v4u*)(proj + (size_t)(ts - 2) * PROJ_LD + COL_XBC + c0);
                if (tl - 1 >= 0) q2 = *(const v4u*)(proj + (size_t)(ts - 1) * PROJ_LD + COL_XBC + c0);
                unpack8(q0, r0); unpack8(q1, r1); unpack8(q2, r2);
            }
            for (int i = 0; i < 32; ++i) {
                const int t = ts + i;
                const v4u q = *(const v4u*)(proj + (size_t)t * PROJ_LD + COL_XBC + c0);
                float r3[8]; unpack8(q, r3);
                float o[8];
#pragma unroll
                for (int j = 0; j < 8; ++j) { const float a = bb[j] + w[0][j] * r0[j] + w[1][j] * r1[j] + w[2][j] * r2[j] + w[3][j] * r3[j]; o[j] = a * fsigmoid(a); }
                float* dp = xbc + (size_t)t * NXBC + c0;
                *(f32x4*)dp = (f32x4){o[0], o[1], o[2], o[3]}; *(f32x4*)(dp + 4) = (f32x4){o[4], o[5], o[6], o[7]};
#pragma unroll
                for (int j = 0; j < 8; ++j) { r0[j] = r1[j]; r1[j] = r2[j]; r2[j] = r3[j]; }
            }
        } else {
            const int u = tid - 384;
#pragma unroll
            for (int i = 0; i < 8; ++i) { const int idx = u + 128 * i; const int t = t0 + (idx >> 4), h = idx & 15;
                const float v = dtraw[(size_t)t * 16 + h] + p.dt_bias[h];
                dts[(size_t)t * 16 + h] = fmaxf(v, 0.f) + log1pf(__expf(-fabsf(v))); }
        }
    }
}

__device__ __forceinline__ void phase_attn_simple(const Params& p, LAS unsigned char* lds, int G) {
    const bf16* proj = (const bf16*)(p.ws + WS_PROJ); float* att = (float*)(p.ws + WS_ATT);
    LAS float* Ks = (LAS float*)lds; LAS float* Vs = (LAS float*)(lds + 256 * 68 * 4);
    const int tid = threadIdx.x;
    for (int item = blockIdx.x; item < NB * 64 * 2; item += G) {
        const int b = item >> 7, n = (item >> 1) & 63, hk = item & 1;
        __syncthreads();
        {
            const int j = tid >> 1, hf = tid & 1, pos = n * 128 - 128 + j;
            float kv[32], vv[32];
            if (pos >= 0) {
                const bf16* kp = proj + (size_t)(b * SEQ + pos) * PROJ_LD + COL_K + hk * 64 + hf * 32;
                const bf16* vp = proj + (size_t)(b * SEQ + pos) * PROJ_LD + COL_V + hk * 64 + hf * 32;
#pragma unroll
                for (int c = 0; c < 4; ++c) { const v4u a = *(const v4u*)(kp + 8 * c), bq = *(const v4u*)(vp + 8 * c);
                    kv[8 * c + 0] = bflo(a.x); kv[8 * c + 1] = bfhi(a.x); kv[8 * c + 2] = bflo(a.y); kv[8 * c + 3] = bfhi(a.y); kv[8 * c + 4] = bflo(a.z); kv[8 * c + 5] = bfhi(a.z); kv[8 * c + 6] = bflo(a.w); kv[8 * c + 7] = bfhi(a.w);
                    vv[8 * c + 0] = bflo(bq.x); vv[8 * c + 1] = bfhi(bq.x); vv[8 * c + 2] = bflo(bq.y); vv[8 * c + 3] = bfhi(bq.y); vv[8 * c + 4] = bflo(bq.z); vv[8 * c + 5] = bfhi(bq.z); vv[8 * c + 6] = bflo(bq.w); vv[8 * c + 7] = bfhi(bq.w); }
            } else {
#pragma unroll
                for (int d = 0; d < 32; ++d) { kv[d] = 0.f; vv[d] = 0.f; }
            }
            float s = 0.f;
#pragma unroll
            for (int d = 0; d < 32; ++d) s += kv[d] * kv[d];
            s += __shfl_xor(s, 1);
            const float rstd = rsqrtf(s * (1.f / 64.f) + EPS);
#pragma unroll
            for (int d = 0; d < 32; ++d) { Ks[j * 68 + hf * 32 + d] = kv[d] * rstd * p.k_norm_w[hf * 32 + d]; Vs[j * 68 + hf * 32 + d] = vv[d]; }
        }
        __syncthreads();
        const int qi = tid & 127, grp = tid >> 7;
        const int tok = b * SEQ + n * 128 + qi;
        for (int hh = 0; hh < 2; ++hh) {
            const int hq = hk * 8 + grp * 2 + hh;
            float q[64];
            {
                const bf16* qp = proj + (size_t)tok * PROJ_LD + COL_Q + hq * 64;
                float s = 0.f;
#pragma unroll
                for (int c = 0; c < 8; ++c) { const v4u a = *(const v4u*)(qp + 8 * c);
                    q[8 * c + 0] = bflo(a.x); q[8 * c + 1] = bfhi(a.x); q[8 * c + 2] = bflo(a.y); q[8 * c + 3] = bfhi(a.y); q[8 * c + 4] = bflo(a.z); q[8 * c + 5] = bfhi(a.z); q[8 * c + 6] = bflo(a.w); q[8 * c + 7] = bfhi(a.w); }
#pragma unroll
                for (int d = 0; d < 64; ++d) s += q[d] * q[d];
                const float rstd = rsqrtf(s * (1.f / 64.f) + EPS) * 0.125f;
#pragma unroll
                for (int d = 0; d < 64; ++d) q[d] = q[d] * rstd * p.q_norm_w[d];
            }
            float mx = p.sinks[hq], l = 1.0f, o[64];
#pragma unroll
            for (int d = 0; d < 64; ++d) o[d] = 0.f;
            const int jlo = (n == 0) ? 128 : qi + 1;
            for (int j = jlo; j <= qi + 128; ++j) {
                const LAS f32x4* kr = (const LAS f32x4*)(Ks + j * 68);
                float s = 0.f;
#pragma unroll
                for (int c = 0; c < 16; ++c) { const f32x4 kk = kr[c]; s += q[4 * c] * kk[0] + q[4 * c + 1] * kk[1] + q[4 * c + 2] * kk[2] + q[4 * c + 3] * kk[3]; }
                const float mn = fmaxf(mx, s), corr = __expf(mx - mn), pj = __expf(s - mn);
                l = l * corr + pj; mx = mn;
                const LAS f32x4* vr = (const LAS f32x4*)(Vs + j * 68);
#pragma unroll
                for (int c = 0; c < 16; ++c) { const f32x4 vv = vr[c]; o[4 * c] = o[4 * c] * corr + pj * vv[0]; o[4 * c + 1] = o[4 * c + 1] * corr + pj * vv[1]; o[4 * c + 2] = o[4 * c + 2] * corr + pj * vv[2]; o[4 * c + 3] = o[4 * c + 3] * corr + pj * vv[3]; }
            }
            const float inv = 1.0f / l;
            float* op = att + (size_t)tok * 1024 + hq * 64;
#pragma unroll
            for (int c = 0; c < 16; ++c) *(f32x4*)(op + 4 * c) = (f32x4){o[4 * c] * inv, o[4 * c + 1] * inv, o[4 * c + 2] * inv, o[4 * c + 3] * inv};
        }
    }
}

__device__ __forceinline__ void phase_ssd_seq(const Params& p, LAS unsigned char* lds, int G) {
    const float* xbc = (const float*)(p.ws + WS_XBC); const float* dts = (const float*)(p.ws + WS_DTS); float* ys = (float*)(p.ws + WS_YS);
    constexpr int TT = 64;
    LAS float* Bs = (LAS float*)lds;
    LAS float* Cs = Bs + TT * 128;
    LAS float* xs = Cs + TT * 128;
    LAS float* dl = xs + TT * 16;
    LAS float* yo = dl + TT;
    const int tid = threadIdx.x, pl = tid >> 5, ns = tid & 31;
    for (int item = blockIdx.x; item < NB * 16 * 4; item += G) {
        const int b = item >> 6, h = (item >> 2) & 15, pq = item & 3, g = h >> 3;
        const float a = -__expf(p.a_log[h]), dsk = p.d_skip[h];
        f32x4 st = (f32x4){0.f, 0.f, 0.f, 0.f};
        for (int tc = 0; tc < SEQ; tc += TT) {
            __syncthreads();
            const size_t tb = (size_t)b * SEQ + tc;
            for (int i = tid; i < TT * 32; i += NTHREADS) { const int tt = i >> 5, c = (i & 31) * 4;
                *(LAS f32x4*)(Bs + tt * 128 + c) = *(const f32x4*)(xbc + (tb + tt) * NXBC + 1024 + g * 128 + c);
                *(LAS f32x4*)(Cs + tt * 128 + c) = *(const f32x4*)(xbc + (tb + tt) * NXBC + 1280 + g * 128 + c); }
            for (int i = tid; i < TT * 16; i += NTHREADS) { const int tt = i >> 4, c = i & 15; xs[i] = xbc[(tb + tt) * NXBC + h * 64 + pq * 16 + c]; }
            if (tid < TT) dl[tid] = dts[(tb + tid) * 16 + h];
            __syncthreads();
            for (int tt = 0; tt < TT; ++tt) {
                const float dt = dl[tt], xv = xs[tt * 16 + pl];
                const float dA = __expf(dt * a), xd = xv * dt;
                const f32x4 bv = *(const LAS f32x4*)(Bs + tt * 128 + ns * 4), cv = *(const LAS f32x4*)(Cs + tt * 128 + ns * 4);
                st = st * dA + bv * xd;
                float y = (cv[0] * st[0] + cv[1] * st[1]) + (cv[2] * st[2] + cv[3] * st[3]);
                y += __shfl_xor(y, 1); y += __shfl_xor(y, 2); y += __shfl_xor(y, 4); y += __shfl_xor(y, 8); y += __shfl_xor(y, 16);
                if (ns == 0) yo[tt * 16 + pl] = y + dsk * xv;
            }
            __syncthreads();
            for (int i = tid; i < TT * 16; i += NTHREADS) { const int tt = i >> 4, c = i & 15; ys[(tb + tt) * 1024 + h * 64 + pq * 16 + c] = yo[i]; }
        }
    }
}


typedef float f32x16 __attribute__((ext_vector_type(16)));
#define MFMA32(a, b, c) __builtin_amdgcn_mfma_f32_32x32x16_bf16(a, b, c, 0, 0, 0)
constexpr int SPT = 136;
__device__ __forceinline__ float softplus_f(float v) { return fmaxf(v, 0.f) + log1pf(__expf(-fabsf(v))); }

__device__ __forceinline__ void ssd_tables(const Params& p, LAS float* dtl, LAS float* csl, LAS float* wtot, size_t trow0, int h0, int nh, int lane, int wave) {
    const float* dtraw = (const float*)(p.ws + WS_DT);
    for (int rnd = 0; rnd < nh / 4; ++rnd) {
        const int hh = rnd * 4 + (wave >> 1), l = (wave & 1) * 64 + lane, h = h0 + hh;
        const float dt = softplus_f(dtraw[(trow0 + l) * 16 + h] + p.dt_bias[h]);
        float v = dt * (-expf(p.a_log[h]));
#pragma unroll
        for (int o = 1; o < 64; o <<= 1) { const float u = __shfl_up(v, o); v = (lane >= o) ? v + u : v; }
        if (lane == 63) wtot[rnd * 8 + wave] = v;
        __syncthreads();
        if (wave & 1) v += wtot[rnd * 8 + wave - 1];
        dtl[hh * 128 + l] = dt; csl[hh * 128 + l] = v;
    }
    __syncthreads();
}
template <bool TR, bool SCALE>
__device__ __forceinline__ void conv_task(const Params& p, const bf16* proj, size_t trow0, int tl0, int run, int xcol, LAS bf16* dst, int d0, const LAS float* sc) {
    float w[4][8], bb[8];
#pragma unroll
    for (int k = 0; k < 4; ++k) { const f32x4 a = *(const f32x4*)(p.conv_w + k * NXBC + xcol), b = *(const f32x4*)(p.conv_w + k * NXBC + xcol + 4);
        w[k][0] = a[0]; w[k][1] = a[1]; w[k][2] = a[2]; w[k][3] = a[3]; w[k][4] = b[0]; w[k][5] = b[1]; w[k][6] = b[2]; w[k][7] = b[3]; }
    { const f32x4 a = *(const f32x4*)(p.conv_b + xcol), b = *(const f32x4*)(p.conv_b + xcol + 4); bb[0] = a[0]; bb[1] = a[1]; bb[2] = a[2]; bb[3] = a[3]; bb[4] = b[0]; bb[5] = b[1]; bb[6] = b[2]; bb[7] = b[3]; }
    const int l0 = run * 8; const bf16* src = proj + (trow0 + l0) * PROJ_LD + COL_XBC + xcol;
    float r0[8], r1[8], r2[8];
    { const int pos = tl0 + l0; v4u q0 = (v4u){0u, 0u, 0u, 0u}, q1 = q0, q2 = q0;
      if (pos - 3 >= 0) q0 = *(const v4u*)(src - 3 * PROJ_LD);
      if (pos - 2 >= 0) q1 = *(const v4u*)(src - 2 * PROJ_LD);
      if (pos - 1 >= 0) q2 = *(const v4u*)(src - 1 * PROJ_LD);
      unpack8(q0, r0); unpack8(q1, r1); unpack8(q2, r2); }
#pragma unroll
    for (int i = 0; i < 8; i += 2) {
        float r3[8], r4[8], o0[8], o1[8];
        unpack8(*(const v4u*)(src + (size_t)i * PROJ_LD), r3); unpack8(*(const v4u*)(src + (size_t)(i + 1) * PROJ_LD), r4);
#pragma unroll
        for (int j = 0; j < 8; ++j) { const float a0 = bb[j] + w[0][j] * r0[j] + w[1][j] * r1[j] + w[2][j] * r2[j] + w[3][j] * r3[j];
            const float a1 = bb[j] + w[0][j] * r1[j] + w[1][j] * r2[j] + w[2][j] * r3[j] + w[3][j] * r4[j];
            o0[j] = a0 * fsigmoid(a0); o1[j] = a1 * fsigmoid(a1); }
        if constexpr (TR) {
            float s0 = 1.f, s1 = 1.f; if constexpr (SCALE) { s0 = sc[l0 + i]; s1 = sc[l0 + i + 1]; }
#pragma unroll
            for (int j = 0; j < 8; ++j) *(LAS unsigned*)(dst + (d0 + j) * SPT + l0 + i) = pk2(o0[j] * s0, o1[j] * s1);
        } else {
            *(LAS v4u*)(dst + (l0 + i) * SPT + d0) = (v4u){pk2(o0[0], o0[1]), pk2(o0[2], o0[3]), pk2(o0[4], o0[5]), pk2(o0[6], o0[7])};
            *(LAS v4u*)(dst + (l0 + i + 1) * SPT + d0) = (v4u){pk2(o1[0], o1[1]), pk2(o1[2], o1[3]), pk2(o1[4], o1[5]), pk2(o1[6], o1[7])};
        }
#pragma unroll
        for (int j = 0; j < 8; ++j) { r0[j] = r2[j]; r1[j] = r3[j]; r2[j] = r4[j]; }
    }
}

__device__ __forceinline__ void phase_ssd_states(const Params& p, LAS unsigned char* lds, int G, int lane, int wave) {
    const bf16* proj = (const bf16*)(p.ws + WS_PROJ); float* states = (float*)(p.ws + WS_STATES); float* cdec = (float*)(p.ws + WS_CDEC);
    LAS bf16* BT = (LAS bf16*)lds;
    LAS bf16* XdT = BT + 128 * SPT;
    LAS float* dtl = (LAS float*)(lds + 384 * SPT * 2);
    LAS float* csl = dtl + 512; LAS float* scl = csl + 512; LAS float* wtot = scl + 512;
    const int tid = threadIdx.x, r = lane & 31, hf = lane >> 5;
    for (int item = blockIdx.x; item < NB * 64 * 4; item += G) {
        const int b = item >> 8, c = (item >> 2) & 63, g = (item >> 1) & 1, hh2 = item & 1;
        const int h0 = g * 8 + hh2 * 4; const size_t trow0 = (size_t)b * SEQ + c * 128; const int tl0 = c * 128;
        __syncthreads();
        ssd_tables(p, dtl, csl, wtot, trow0, h0, 4, lane, wave);
        scl[tid] = dtl[tid] * __expf(csl[(tid & ~127) + 127] - csl[tid]);
        if ((tid & 127) == 127) cdec[((size_t)b * 64 + c) * 16 + h0 + (tid >> 7)] = __expf(csl[tid]);
        __syncthreads();
        for (int task = tid; task < 48 * 16; task += NTHREADS) { const int cg = task >> 4, run = task & 15;
            if (cg < 16) conv_task<true, false>(p, proj, trow0, tl0, run, 1024 + g * 128 + cg * 8, BT, cg * 8, nullptr);
            else { const int cx = cg - 16; conv_task<true, true>(p, proj, trow0, tl0, run, h0 * 64 + cx * 8, XdT, cx * 8, scl + (cx >> 3) * 128); } }
        __syncthreads();
        const int hh = wave >> 1, nh_ = wave & 1;
        f32x16 acc[2][2];
#pragma unroll
        for (int a = 0; a < 2; ++a)
#pragma unroll
            for (int bq = 0; bq < 2; ++bq)
#pragma unroll
                for (int e = 0; e < 16; ++e) acc[a][bq][e] = 0.f;
#pragma unroll
        for (int ks = 0; ks < 8; ++ks) {
            bf16x8 af[2], bfm[2];
#pragma unroll
            for (int pt = 0; pt < 2; ++pt) af[pt] = *(const LAS bf16x8*)(XdT + (hh * 64 + pt * 32 + r) * SPT + ks * 16 + 8 * hf);
#pragma unroll
            for (int nt = 0; nt < 2; ++nt) bfm[nt] = *(const LAS bf16x8*)(BT + (nh_ * 64 + nt * 32 + r) * SPT + ks * 16 + 8 * hf);
#pragma unroll
            for (int pt = 0; pt < 2; ++pt)
#pragma unroll
                for (int nt = 0; nt < 2; ++nt) acc[pt][nt] = MFMA32(af[pt], bfm[nt], acc[pt][nt]);
        }
        float* sp = states + (((size_t)b * 64 + c) * 16 + h0 + hh) * 64 * 128;
#pragma unroll
        for (int pt = 0; pt < 2; ++pt)
#pragma unroll
            for (int nt = 0; nt < 2; ++nt)
#pragma unroll
                for (int e = 0; e < 16; ++e) sp[(pt * 32 + (e & 3) + 8 * (e >> 2) + 4 * hf) * 128 + nh_ * 64 + nt * 32 + r] = acc[pt][nt][e];
    }
}
__device__ __forceinline__ void phase_ssd_scan(const Params& p, int G) {
    const float* states = (const float*)(p.ws + WS_STATES); const float* cdec = (const float*)(p.ws + WS_CDEC); bf16* sin = (bf16*)(p.ws + WS_SIN);
    for (int idx = blockIdx.x * NTHREADS + threadIdx.x; idx < NB * 16 * 64 * 32; idx += G * NTHREADS) {
        const int n4 = idx & 31, pp = (idx >> 5) & 63, h = (idx >> 11) & 15, b = idx >> 15;
        f32x4 run = (f32x4){0.f, 0.f, 0.f, 0.f};
#pragma unroll 8
        for (int c = 0; c < 64; ++c) {
            const size_t off = ((((size_t)b * 64 + c) * 16 + h) * 64 + pp) * 128 + n4 * 4;
            const f32x4 st = *(const f32x4*)(states + off); const float dec = cdec[((size_t)b * 64 + c) * 16 + h];
            *(v2u*)(sin + off) = (v2u){pk2(run[0], run[1]), pk2(run[2], run[3])};
            run = run * dec + st;
        }
    }
}
__device__ __forceinline__ void ssd_out_pass(const Params& p, const bf16* proj, const bf16* sinp  , const LAS bf16* Cs, const LAS bf16* CB, const LAS bf16* XT,
                                             const LAS float* dth, const LAS float* csh  , LAS float* ssqh  , float Dh, size_t trow0, int h, int hh, int lsel, int r, int hf,
                                             unsigned (&yp)[2][2][8]) {
    f32x16 acc[2][2];
#pragma unroll
    for (int a = 0; a < 2; ++a)
#pragma unroll
        for (int bq = 0; bq < 2; ++bq)
#pragma unroll
            for (int e = 0; e < 16; ++e) acc[a][bq][e] = 0.f;
#pragma unroll
    for (int pt = 0; pt < 2; ++pt) {
        bf16x8 af[8];
#pragma unroll
        for (int ks = 0; ks < 8; ++ks) af[ks] = *(const bf16x8*)(sinp + (pt * 32 + r) * 128 + ks * 16 + 8 * hf);
#pragma unroll
        for (int j = 0; j < 2; ++j) { const int lt = j == 0 ? (lsel ? 1 : 0) : (lsel ? 2 : 3);
#pragma unroll
            for (int ks = 0; ks < 8; ++ks) { const bf16x8 bq = *(const LAS bf16x8*)(Cs + (lt * 32 + r) * SPT + ks * 16 + 8 * hf); acc[pt][j] = MFMA32(af[ks], bq, acc[pt][j]); } }
    }
#pragma unroll
    for (int j = 0; j < 2; ++j) { const int lt = j == 0 ? (lsel ? 1 : 0) : (lsel ? 2 : 3); const float el = __expf(csh[lt * 32 + r]);
#pragma unroll
        for (int pt = 0; pt < 2; ++pt) acc[pt][j] = acc[pt][j] * el; }
#pragma unroll
    for (int j = 0; j < 2; ++j) { const int lt = j == 0 ? (lsel ? 1 : 0) : (lsel ? 2 : 3); const int lcol = lt * 32 + r; const float csL = csh[lcol]; const int nks = 2 * lt + 2;
        for (int ks = 0; ks < nks; ++ks) { const int s0 = ks * 16 + 8 * hf;
            const v4u cbv = *(const LAS v4u*)(CB + lcol * SPT + s0);
            const f32x4 c0 = *(const LAS f32x4*)(csh + s0), c1 = *(const LAS f32x4*)(csh + s0 + 4), d0 = *(const LAS f32x4*)(dth + s0), d1 = *(const LAS f32x4*)(dth + s0 + 4);
            float cbf[8]; unpack8(cbv, cbf); float m[8];
#pragma unroll
            for (int jj = 0; jj < 8; ++jj) { const float cs_s = jj < 4 ? c0[jj & 3] : c1[jj & 3], dt_s = jj < 4 ? d0[jj & 3] : d1[jj & 3];
                float v = cbf[jj] * __expf(fminf(csL - cs_s, 0.f)) * dt_s; v = (s0 + jj <= lcol) ? v : 0.f; m[jj] = (s0 + jj == lcol) ? v + Dh : v; }
            v4u mp; mp.x = pk2(m[0], m[1]); mp.y = pk2(m[2], m[3]); mp.z = pk2(m[4], m[5]); mp.w = pk2(m[6], m[7]);
            const bf16x8 mf = __builtin_bit_cast(bf16x8, mp);
#pragma unroll
            for (int pt = 0; pt < 2; ++pt) { const bf16x8 a = *(const LAS bf16x8*)(XT + (hh * 64 + pt * 32 + r) * SPT + s0); acc[pt][j] = MFMA32(a, mf, acc[pt][j]); }
        } }
#pragma unroll
    for (int j = 0; j < 2; ++j) { const int lt = j == 0 ? (lsel ? 1 : 0) : (lsel ? 2 : 3); const size_t t = trow0 + lt * 32 + r; float ss = 0.f;
#pragma unroll
        for (int pt = 0; pt < 2; ++pt)
#pragma unroll
            for (int q = 0; q < 4; ++q) { const v2u zz = *(const v2u*)(proj + t * PROJ_LD + COL_Z + h * 64 + pt * 32 + 8 * q + 4 * hf);
                const float z0 = bflo(zz.x), z1 = bfhi(zz.x), z2 = bflo(zz.y), z3 = bfhi(zz.y);
                const float g0 = acc[pt][j][4 * q] * (z0 * fsigmoid(z0)), g1 = acc[pt][j][4 * q + 1] * (z1 * fsigmoid(z1)), g2 = acc[pt][j][4 * q + 2] * (z2 * fsigmoid(z2)), g3 = acc[pt][j][4 * q + 3] * (z3 * fsigmoid(z3));
                yp[pt][j][2 * q] = pk2(g0, g1); yp[pt][j][2 * q + 1] = pk2(g2, g3);
                ss += (g0 * g0 + g1 * g1) + (g2 * g2 + g3 * g3); }
        ss += __shfl_xor(ss, 32);
        if (hf == 0) ssqh[lt * 32 + r] = ss; }
}
__device__ __forceinline__ void ssd_out_store(const Params& p, bf16* mix, const LAS float* ssqp, size_t trow0, int h, int lsel, int r, int hf, const unsigned (&yp)[2][2][8]) {
    f32x4 w4[2][4];
#pragma unroll
    for (int pt = 0; pt < 2; ++pt)
#pragma unroll
        for (int q = 0; q < 4; ++q) w4[pt][q] = *(const f32x4*)(p.ssm_norm_w + h * 64 + pt * 32 + 8 * q + 4 * hf);
#pragma unroll
    for (int pt = 0; pt < 2; ++pt) { asm volatile("" : "+v"(w4[pt][0]), "+v"(w4[pt][1]), "+v"(w4[pt][2]), "+v"(w4[pt][3])); }
#pragma unroll
    for (int j = 0; j < 2; ++j) { const int lt = j == 0 ? (lsel ? 1 : 0) : (lsel ? 2 : 3); const int l = lt * 32 + r; const size_t t = trow0 + l;
        float tot = 0.f;
#pragma unroll
        for (int hd = 0; hd < 8; ++hd) tot += ssqp[hd * 128 + l];
        const float rstd = rsqrtf(tot * (1.f / 512.f) + EPS);
#pragma unroll
        for (int pt = 0; pt < 2; ++pt)
#pragma unroll
            for (int q = 0; q < 4; ++q) { const int col = h * 64 + pt * 32 + 8 * q + 4 * hf;
                const unsigned u0 = yp[pt][j][2 * q], u1 = yp[pt][j][2 * q + 1];
                v2u o; o.x = pk2(bflo(u0) * rstd * w4[pt][q][0], bfhi(u0) * rstd * w4[pt][q][1]); o.y = pk2(bflo(u1) * rstd * w4[pt][q][2], bfhi(u1) * rstd * w4[pt][q][3]);
                *(v2u*)(mix + t * D + 1024 + col) = o; } }
}
__device__ __forceinline__ void phase_ssd_out(const Params& p, LAS unsigned char* lds, int G, int lane, int wave) {
    const bf16* proj = (const bf16*)(p.ws + WS_PROJ); const bf16* sin = (const bf16*)(p.ws + WS_SIN); bf16* mix = (bf16*)(p.ws + WS_MIX);
    LAS bf16* Cs = (LAS bf16*)lds;
    LAS bf16* Bs = Cs + 128 * SPT;
    LAS bf16* XT = Bs + 128 * SPT;
    LAS float* dtl = (LAS float*)(lds + 512 * SPT * 2);
    LAS float* csl = dtl + 1024; LAS float* ssqp = csl + 1024; LAS float* wtot = ssqp + 1024;
    const int tid = threadIdx.x, r = lane & 31, hf = lane >> 5;
    for (int item = blockIdx.x; item < NB * 64 * 2; item += G) {
        const int b = item >> 7, c = (item >> 1) & 63, g = item & 1;
        const int h0 = g * 8; const size_t trow0 = (size_t)b * SEQ + c * 128; const int tl0 = c * 128;
        __syncthreads();
        { int tz_ = threadIdx.x; asm volatile("" : "+v"(tz_)); ssd_tables(p, dtl, csl, wtot, trow0, h0, 8, tz_ & 63, __builtin_amdgcn_readfirstlane(tz_ >> 6)); }
        int tq = threadIdx.x; asm volatile("" : "+v"(tq));
        for (int task = tq; task < 64 * 16; task += NTHREADS) { const int cg = task >> 4, run = task & 15;
            if (cg < 16) conv_task<false, false>(p, proj, trow0, tl0, run, 1280 + g * 128 + cg * 8, Cs, cg * 8, nullptr);
            else if (cg < 32) conv_task<false, false>(p, proj, trow0, tl0, run, 1024 + g * 128 + (cg - 16) * 8, Bs, (cg - 16) * 8, nullptr);
            else conv_task<true, false>(p, proj, trow0, tl0, run, h0 * 64 + (cg - 32) * 8, XT, (cg - 32) * 8, nullptr); }
        __syncthreads();
        {
            int tz_ = threadIdx.x; asm volatile("" : "+v"(tz_)); const int wave = __builtin_amdgcn_readfirstlane(tz_ >> 6), r = tz_ & 31, hf = (tz_ >> 5) & 1;
            f32x16 cb[2];
#pragma unroll
            for (int q = 0; q < 2; ++q) { const int tile = 2 * wave + q, lt = tile >> 2, st = tile & 3;
#pragma unroll
                for (int e = 0; e < 16; ++e) cb[q][e] = 0.f;
                if (st <= lt) {
#pragma unroll
                    for (int ks = 0; ks < 8; ++ks) { const bf16x8 a = *(const LAS bf16x8*)(Cs + (lt * 32 + r) * SPT + ks * 16 + 8 * hf), bq = *(const LAS bf16x8*)(Bs + (st * 32 + r) * SPT + ks * 16 + 8 * hf);
                        cb[q] = MFMA32(a, bq, cb[q]); } } }
            __syncthreads();
#pragma unroll
            for (int q = 0; q < 2; ++q) { const int tile = 2 * wave + q, lt = tile >> 2, st = tile & 3;
                if (st <= lt) {
#pragma unroll
                    for (int e = 0; e < 16; ++e) Bs[(lt * 32 + (e & 3) + 8 * (e >> 2) + 4 * hf) * SPT + st * 32 + r] = (bf16)f2bf(cb[q][e]); } }
        }
        __syncthreads();
        unsigned y0[2][2][8], y1[2][2][8];
#define FRESH_IDS() int tz_ = threadIdx.x; asm volatile("" : "+v"(tz_)); const int wv_ = __builtin_amdgcn_readfirstlane(tz_ >> 6), hh = wv_ >> 1, lsel = wv_ & 1, r_ = tz_ & 31, hf_ = (tz_ >> 5) & 1
        { FRESH_IDS(); const int h = h0 + hh;
          ssd_out_pass(p, proj, sin + (((size_t)b * 64 + c) * 16 + h) * 64 * 128, Cs, Bs, XT, dtl + hh * 128, csl + hh * 128, ssqp + hh * 128, p.d_skip[h], trow0, h, hh, lsel, r_, hf_, y0); }
        __syncthreads();
        { int tz_ = threadIdx.x; asm volatile("" : "+v"(tz_)); const int cg = tz_ >> 4, run = tz_ & 15; conv_task<true, false>(p, proj, trow0, tl0, run, (h0 + 4) * 64 + cg * 8, XT, cg * 8, nullptr); }
        __syncthreads();
        { FRESH_IDS(); const int h = h0 + 4 + hh;
          ssd_out_pass(p, proj, sin + (((size_t)b * 64 + c) * 16 + h) * 64 * 128, Cs, Bs, XT, dtl + (4 + hh) * 128, csl + (4 + hh) * 128, ssqp + (4 + hh) * 128, p.d_skip[h], trow0, h, hh, lsel, r_, hf_, y1); }
        __syncthreads();
        { FRESH_IDS(); ssd_out_store(p, mix, ssqp, trow0, h0 + hh, lsel, r_, hf_, y0); }
        { FRESH_IDS(); ssd_out_store(p, mix, ssqp, trow0, h0 + 4 + hh, lsel, r_, hf_, y1); }
#undef FRESH_IDS
    }
}


__device__ __forceinline__ void phase_attn(const Params& p, LAS unsigned char* lds, int G) {
    const bf16* proj = (const bf16*)(p.ws + WS_PROJ); bf16* mix = (bf16*)(p.ws + WS_MIX);
    constexpr int KP = 72, VP = 260; constexpr float NEG = -1.0e30f;
    LAS bf16* Ks = (LAS bf16*)lds;
    LAS bf16* VT = Ks + 2 * 256 * KP;
    LAS float* ssqp = (LAS float*)(lds + 2 * 256 * KP * 2 + 2 * 64 * VP * 2);
    for (int item = blockIdx.x; item < NB * 64; item += G) {
        const int b = item >> 6, n = item & 63;
        __syncthreads();
        {
            int tz = threadIdx.x; asm volatile("" : "+v"(tz));
            const int j = tz >> 1, hk = tz & 1, pos = n * 128 - 128 + j;
            LAS bf16* kd = Ks + (hk * 256 + j) * KP; LAS bf16* vd = VT + hk * 64 * VP + j;
            if (pos >= 0) {
                const bf16* kp = proj + (size_t)(b * SEQ + pos) * PROJ_LD + COL_K + hk * 64;
                v4u kq[8]; float ss = 0.f;
#pragma unroll
                for (int c = 0; c < 8; ++c) { kq[c] = *(const v4u*)(kp + 8 * c); float f[8]; unpack8(kq[c], f);
#pragma unroll
                    for (int e = 0; e < 8; ++e) ss += f[e] * f[e]; }
                const float rstd = rsqrtf(ss * (1.f / 64.f) + EPS);
#pragma unroll
                for (int c = 0; c < 8; ++c) { float f[8]; unpack8(kq[c], f); const f32x4 w0 = *(const f32x4*)(p.k_norm_w + 8 * c), w1 = *(const f32x4*)(p.k_norm_w + 8 * c + 4);
                    *(LAS v4u*)(kd + 8 * c) = (v4u){pk2(f[0] * rstd * w0[0], f[1] * rstd * w0[1]), pk2(f[2] * rstd * w0[2], f[3] * rstd * w0[3]), pk2(f[4] * rstd * w1[0], f[5] * rstd * w1[1]), pk2(f[6] * rstd * w1[2], f[7] * rstd * w1[3])}; }
                const bf16* vp = kp + (COL_V - COL_K);
#pragma unroll
                for (int c = 0; c < 8; ++c) { const v4u q = *(const v4u*)(vp + 8 * c);
                    vd[(8 * c + 0) * VP] = (bf16)(q.x & 0xffffu); vd[(8 * c + 1) * VP] = (bf16)(q.x >> 16); vd[(8 * c + 2) * VP] = (bf16)(q.y & 0xffffu); vd[(8 * c + 3) * VP] = (bf16)(q.y >> 16);
                    vd[(8 * c + 4) * VP] = (bf16)(q.z & 0xffffu); vd[(8 * c + 5) * VP] = (bf16)(q.z >> 16); vd[(8 * c + 6) * VP] = (bf16)(q.w & 0xffffu); vd[(8 * c + 7) * VP] = (bf16)(q.w >> 16); }
            } else {
#pragma unroll
                for (int c = 0; c < 8; ++c) *(LAS v4u*)(kd + 8 * c) = (v4u){0u, 0u, 0u, 0u};
#pragma unroll
                for (int d = 0; d < 64; ++d) vd[d * VP] = (bf16)0;
            }
        }
        __syncthreads();
        {
            int tz = threadIdx.x; asm volatile("" : "+v"(tz));
            const int wave = __builtin_amdgcn_readfirstlane(tz >> 6), r = tz & 31, hf = (tz >> 5) & 1, hk = wave >> 2, wl = wave & 3;
            const LAS bf16* Kh = Ks + hk * 256 * KP; const LAS bf16* Vh = VT + hk * 64 * VP;
            f32x4 qw[4][2];
#pragma unroll
            for (int ks = 0; ks < 4; ++ks) { qw[ks][0] = *(const f32x4*)(p.q_norm_w + 16 * ks + 8 * hf); qw[ks][1] = *(const f32x4*)(p.q_norm_w + 16 * ks + 8 * hf + 4); }
            v4u qn[4];
            { const bf16* qp0 = proj + ((size_t)b * SEQ + n * 128 + r) * PROJ_LD + COL_Q + (hk * 8 + wl * 2) * 64 + 8 * hf;
#pragma unroll
              for (int ks = 0; ks < 4; ++ks) qn[ks] = *(const v4u*)(qp0 + 16 * ks); }
            for (int it = 0; it < 8; ++it) {
                const int hsel = it >> 2, qt = it & 3;
                const int hq = hk * 8 + wl * 2 + hsel; const float sink = p.sinks[hq] * 1.44269504f;
                {
                    const size_t tok = (size_t)b * SEQ + n * 128 + qt * 32 + r;
                    bf16x8 qf[4];
                    {
                        v4u qv[4]; float ss = 0.f;
#pragma unroll
                        for (int ks = 0; ks < 4; ++ks) { qv[ks] = qn[ks]; float f[8]; unpack8(qv[ks], f);
#pragma unroll
                            for (int e = 0; e < 8; ++e) ss += f[e] * f[e]; }
                        if (it < 7) { const int it2 = it + 1, hq2 = hk * 8 + wl * 2 + (it2 >> 2);
                            const bf16* qp2 = proj + ((size_t)b * SEQ + n * 128 + (it2 & 3) * 32 + r) * PROJ_LD + COL_Q + hq2 * 64 + 8 * hf;
#pragma unroll
                            for (int ks = 0; ks < 4; ++ks) qn[ks] = *(const v4u*)(qp2 + 16 * ks); }
                        ss += __shfl_xor(ss, 32);
                        const float rstd = rsqrtf(ss * (1.f / 64.f) + EPS) * (0.125f * 1.44269504f);
#pragma unroll
                        for (int ks = 0; ks < 4; ++ks) { float f[8]; unpack8(qv[ks], f); const f32x4 w0 = qw[ks][0], w1 = qw[ks][1];
                            const v4u o = (v4u){pk2(f[0] * rstd * w0[0], f[1] * rstd * w0[1]), pk2(f[2] * rstd * w0[2], f[3] * rstd * w0[3]), pk2(f[4] * rstd * w1[0], f[5] * rstd * w1[1]), pk2(f[6] * rstd * w1[2], f[7] * rstd * w1[3])};
                            qf[ks] = __builtin_bit_cast(bf16x8, o); }
                    }
                    f32x16 sc[5];
#pragma unroll
                    for (int jt = 0; jt < 5; ++jt) {
#pragma unroll
                        for (int e = 0; e < 16; ++e) sc[jt][e] = 0.f;
#pragma unroll
                        for (int ks = 0; ks < 4; ++ks) { const bf16x8 a = *(const LAS bf16x8*)(Kh + ((qt + jt) * 32 + r) * KP + ks * 16 + 8 * hf); sc[jt] = MFMA32(a, qf[ks], sc[jt]); } }
#pragma unroll
                    for (int e = 0; e < 16; ++e) { const int kk = (e & 3) + 8 * (e >> 2) + 4 * hf;
                        sc[0][e] = (kk > r) ? sc[0][e] : NEG; sc[4][e] = (kk <= r) ? sc[4][e] : NEG; }
                    if (n == 0) {
#pragma unroll
                        for (int jt = 0; jt < 4; ++jt) if (qt + jt < 4) {
#pragma unroll
                            for (int e = 0; e < 16; ++e) sc[jt][e] = NEG; } }
                    float m = sink;
#pragma unroll
                    for (int jt = 0; jt < 5; ++jt)
#pragma unroll
                        for (int e = 0; e < 16; ++e) m = fmaxf(m, sc[jt][e]);
                    m = fmaxf(m, __shfl_xor(m, 32));
                    float l = 0.f;
#pragma unroll
                    for (int jt = 0; jt < 5; ++jt)
#pragma unroll
                        for (int e = 0; e < 16; ++e) { const float pv = __builtin_amdgcn_exp2f(sc[jt][e] - m); sc[jt][e] = pv; l += pv; }
                    l += __shfl_xor(l, 32); l += __builtin_amdgcn_exp2f(sink - m);
                    f32x16 o[2];
#pragma unroll
                    for (int dt = 0; dt < 2; ++dt)
#pragma unroll
                        for (int e = 0; e < 16; ++e) o[dt][e] = 0.f;
#pragma unroll
                    for (int jt = 0; jt < 5; ++jt)
#pragma unroll
                        for (int s2 = 0; s2 < 2; ++s2) {
                            const v4u pp = (v4u){pk2(sc[jt][8 * s2], sc[jt][8 * s2 + 1]), pk2(sc[jt][8 * s2 + 2], sc[jt][8 * s2 + 3]), pk2(sc[jt][8 * s2 + 4], sc[jt][8 * s2 + 5]), pk2(sc[jt][8 * s2 + 6], sc[jt][8 * s2 + 7])};
                            const bf16x8 pf = __builtin_bit_cast(bf16x8, pp);
                            const int kb = (qt + jt) * 32 + 16 * s2 + 4 * hf;
#pragma unroll
                            for (int dt = 0; dt < 2; ++dt) { const LAS bf16* vr = Vh + (dt * 32 + r) * VP + kb;
                                const v2u a0 = *(const LAS v2u*)vr, a1 = *(const LAS v2u*)(vr + 8);
                                const v4u av = (v4u){a0.x, a0.y, a1.x, a1.y};
                                o[dt] = MFMA32(__builtin_bit_cast(bf16x8, av), pf, o[dt]); }
                        }
                    const float inv = 1.0f / l; float ss = 0.f;
#pragma unroll
                    for (int dt = 0; dt < 2; ++dt)
#pragma unroll
                        for (int q = 0; q < 4; ++q) { const float g0 = o[dt][4 * q] * inv, g1 = o[dt][4 * q + 1] * inv, g2 = o[dt][4 * q + 2] * inv, g3 = o[dt][4 * q + 3] * inv;
                            ss += (g0 * g0 + g1 * g1) + (g2 * g2 + g3 * g3);
                            *(v2u*)(mix + tok * D + hq * 64 + dt * 32 + 8 * q + 4 * hf) = (v2u){pk2(g0, g1), pk2(g2, g3)}; }
                    ss += __shfl_xor(ss, 32);
                    if (hf == 0) ssqp[hq * 128 + qt * 32 + r] = ss;
                }
            }
        }
        __syncthreads();
        {
            int tz = threadIdx.x; asm volatile("" : "+v"(tz));
            const int wave = __builtin_amdgcn_readfirstlane(tz >> 6), r = tz & 31, hf = (tz >> 5) & 1, hk = wave >> 2, wl = wave & 3;
            for (int qt = 0; qt < 4; ++qt) {
                const size_t tok = (size_t)b * SEQ + n * 128 + qt * 32 + r;
                float tot = 0.f;
#pragma unroll
                for (int hd = 0; hd < 16; ++hd) tot += ssqp[hd * 128 + qt * 32 + r];
                const float rstd = rsqrtf(tot * (1.f / 1024.f) + EPS);
                v2u uu[2][2][4];
#pragma unroll
                for (int hsel = 0; hsel < 2; ++hsel)
#pragma unroll
                    for (int dt = 0; dt < 2; ++dt)
#pragma unroll
                        for (int q = 0; q < 4; ++q) uu[hsel][dt][q] = *(const v2u*)(mix + tok * D + (hk * 8 + wl * 2 + hsel) * 64 + dt * 32 + 8 * q + 4 * hf);
#pragma unroll
                for (int hsel = 0; hsel < 2; ++hsel)
#pragma unroll
                    for (int dt = 0; dt < 2; ++dt) { asm volatile("" : "+v"(uu[hsel][dt][0]), "+v"(uu[hsel][dt][1]), "+v"(uu[hsel][dt][2]), "+v"(uu[hsel][dt][3])); }
#pragma unroll
                for (int hsel = 0; hsel < 2; ++hsel)
#pragma unroll
                    for (int dt = 0; dt < 2; ++dt)
#pragma unroll
                        for (int q = 0; q < 4; ++q) { const int col = (hk * 8 + wl * 2 + hsel) * 64 + dt * 32 + 8 * q + 4 * hf;
                            const v2u u = uu[hsel][dt][q]; const f32x4 w4 = *(const f32x4*)(p.attn_out_norm_w + col);
                            *(v2u*)(mix + tok * D + col) = (v2u){pk2(bflo(u.x) * rstd * w4[0], bfhi(u.x) * rstd * w4[1]), pk2(bflo(u.y) * rstd * w4[2], bfhi(u.y) * rstd * w4[3])}; }
            }
        }
    }
}

__device__ __forceinline__ void phase_router(const Params& p, LAS unsigned char* lds, unsigned* ctl, int G, int wave, int lane) {
    const bf16* x1 = (const bf16*)(p.ws + WS_X1); const float* ssq = (const float*)(p.ws + WS_SSQ); unsigned char* hf = p.ws + WS_HF;
    int* stok = (int*)(p.ws + WS_STOK); float* sgate = (float*)(p.ws + WS_SGATE); int* toke = (int*)(p.ws + WS_TOKE); int* tokp = (int*)(p.ws + WS_TOKP);
    LAS float* lg = (LAS float*)lds + wave * (16 * 33);
    LAS int* hist = (LAS int*)(lds + 32768); LAS int* gbase = hist + 32;
    const int tid = threadIdx.x, i16 = lane & 15, kq = lane >> 4;
    for (int tb = blockIdx.x * 8; tb < T / 16; tb += G * 8) {
        if (tid < 32) hist[tid] = 0;
        __syncthreads();
        const int tok = (tb + wave) * 16 + i16;
        float s = 0.f;
        { const f32x4* sp = (const f32x4*)(ssq + (size_t)tok * 32 + kq * 8); const f32x4 a = sp[0], b = sp[1]; s = ((a[0] + a[1]) + (a[2] + a[3])) + ((b[0] + b[1]) + (b[2] + b[3])); }
        s += __shfl_xor(s, 16); s += __shfl_xor(s, 32);
        const float rstd = rsqrtf(s * (1.f / D) + EPS);
        f32x4 acc0 = (f32x4){0.f, 0.f, 0.f, 0.f}, acc1 = (f32x4){0.f, 0.f, 0.f, 0.f};
        const bf16* xr = x1 + (size_t)tok * D + 8 * kq;
        unsigned char* hr = hf + (size_t)tok * D + 8 * kq;
        const v4u* wb = (const v4u*)(p.ws + WS_WRB) + lane;
        v4u xq[4];
#pragma unroll
        for (int u = 0; u < 4; ++u) xq[u] = *(const v4u*)(xr + 32 * u);
        for (int j4 = 0; j4 < 64; j4 += 4) {
            f32x4 xc[4][2], gq[4][2]; v4u wf[4][2][2];
#pragma unroll
            for (int u = 0; u < 4; ++u) { float f[8]; unpack8(xq[u], f); xc[u][0] = (f32x4){f[0], f[1], f[2], f[3]}; xc[u][1] = (f32x4){f[4], f[5], f[6], f[7]}; }
            if (j4 + 4 < 64) {
#pragma unroll
                for (int u = 0; u < 4; ++u) xq[u] = *(const v4u*)(xr + 32 * (j4 + 4 + u)); }
#pragma unroll
            for (int u = 0; u < 4; ++u) { gq[u][0] = *(const f32x4*)(p.ffn_norm_w + 32 * (j4 + u) + 8 * kq); gq[u][1] = *(const f32x4*)(p.ffn_norm_w + 32 * (j4 + u) + 8 * kq + 4);
#pragma unroll
                for (int hfl = 0; hfl < 2; ++hfl)
#pragma unroll
                    for (int hl = 0; hl < 2; ++hl) wf[u][hfl][hl] = wb[(((j4 + u) * 2 + hfl) * 2 + hl) * 64]; }
#pragma unroll
            for (int u = 0; u < 4; ++u) {
                float hv[8];
#pragma unroll
                for (int k = 0; k < 4; ++k) { hv[k] = xc[u][0][k] * rstd * gq[u][0][k]; hv[4 + k] = xc[u][1][k] * rstd * gq[u][1][k]; }
                *(v2u*)(hr + 32 * (j4 + u)) = (v2u){pk4_fp8(sat8(hv[0] * FP8_SA), sat8(hv[1] * FP8_SA), sat8(hv[2] * FP8_SA), sat8(hv[3] * FP8_SA)), pk4_fp8(sat8(hv[4] * FP8_SA), sat8(hv[5] * FP8_SA), sat8(hv[6] * FP8_SA), sat8(hv[7] * FP8_SA))};
                v4u ah, al;
                ah.x = pk2(hv[0], hv[1]); ah.y = pk2(hv[2], hv[3]); ah.z = pk2(hv[4], hv[5]); ah.w = pk2(hv[6], hv[7]);
                al.x = pk2(hv[0] - bflo(ah.x), hv[1] - bfhi(ah.x)); al.y = pk2(hv[2] - bflo(ah.y), hv[3] - bfhi(ah.y)); al.z = pk2(hv[4] - bflo(ah.z), hv[5] - bfhi(ah.z)); al.w = pk2(hv[6] - bflo(ah.w), hv[7] - bfhi(ah.w));
                const bf16x8 fah = __builtin_bit_cast(bf16x8, ah), fal = __builtin_bit_cast(bf16x8, al);
                acc0 = __builtin_amdgcn_mfma_f32_16x16x32_bf16(fah, __builtin_bit_cast(bf16x8, wf[u][0][0]), acc0, 0, 0, 0);
                acc0 = __builtin_amdgcn_mfma_f32_16x16x32_bf16(fah, __builtin_bit_cast(bf16x8, wf[u][0][1]), acc0, 0, 0, 0);
                acc0 = __builtin_amdgcn_mfma_f32_16x16x32_bf16(fal, __builtin_bit_cast(bf16x8, wf[u][0][0]), acc0, 0, 0, 0);
                acc1 = __builtin_amdgcn_mfma_f32_16x16x32_bf16(fah, __builtin_bit_cast(bf16x8, wf[u][1][0]), acc1, 0, 0, 0);
                acc1 = __builtin_amdgcn_mfma_f32_16x16x32_bf16(fah, __builtin_bit_cast(bf16x8, wf[u][1][1]), acc1, 0, 0, 0);
                acc1 = __builtin_amdgcn_mfma_f32_16x16x32_bf16(fal, __builtin_bit_cast(bf16x8, wf[u][1][0]), acc1, 0, 0, 0);
            }
        }
        { const float bb0 = p.b_router[i16], bb1 = p.b_router[16 + i16];
#pragma unroll
          for (int r = 0; r < 4; ++r) { lg[(4 * kq + r) * 33 + i16] = acc0[r] + bb0; lg[(4 * kq + r) * 33 + 16 + i16] = acc1[r] + bb1; } }
        LDS_WAIT(); asm volatile("" ::: "memory");
        int se[4]; float sv[4], gt[4]; int rk[4];
        if (lane < 16) {
            float v[32];
#pragma unroll
            for (int e = 0; e < 32; ++e) v[e] = lg[lane * 33 + e];
#pragma unroll
            for (int k = 0; k < 4; ++k) { float best = -3.0e38f; int bi = 0;
#pragma unroll
                for (int e = 0; e < 32; ++e) { const bool tk = v[e] > best; best = tk ? v[e] : best; bi = tk ? e : bi; }
                se[k] = bi; sv[k] = best;
#pragma unroll
                for (int e = 0; e < 32; ++e) v[e] = (e == bi) ? -3.0e38f : v[e]; }
            const float e1 = __expf(sv[1] - sv[0]), e2 = __expf(sv[2] - sv[0]), e3 = __expf(sv[3] - sv[0]);
            const float inv = 1.0f / (1.0f + e1 + e2 + e3);
            gt[0] = inv; gt[1] = e1 * inv; gt[2] = e2 * inv; gt[3] = e3 * inv;
#pragma unroll
            for (int k = 0; k < 4; ++k) rk[k] = __hip_atomic_fetch_add(&hist[se[k]], 1, __ATOMIC_RELAXED, __HIP_MEMORY_SCOPE_WORKGROUP);
        }
        __syncthreads();
        if (tid < 32) gbase[tid] = (int)__hip_atomic_fetch_add(ctl + CW_CNT + 64 * tid, (unsigned)hist[tid], __ATOMIC_RELAXED, __HIP_MEMORY_SCOPE_AGENT);
        __syncthreads();
        if (lane < 16) {
            const int tk = (tb + wave) * 16 + lane;
#pragma unroll
            for (int k = 0; k < 4; ++k) { const int pos = gbase[se[k]] + rk[k];
                stok[(size_t)se[k] * T + pos] = tk; sgate[(size_t)se[k] * T + pos] = gt[k]; toke[tk * 4 + k] = se[k]; tokp[tk * 4 + k] = pos; }
        }
        __syncthreads();
    }
}

__device__ __forceinline__ void moe_table(unsigned* ctl, LAS int* tstart, LAS int* lcnt) {
    __syncthreads();
    if (threadIdx.x < 32) lcnt[threadIdx.x] = (int)__hip_atomic_load(ctl + CW_CNT + 64 * threadIdx.x, __ATOMIC_RELAXED, __HIP_MEMORY_SCOPE_AGENT);
    __syncthreads();
    if (threadIdx.x == 0) { int a = 0; for (int e = 0; e < NE; ++e) { tstart[e] = a; a += (lcnt[e] + 255) >> 8; } tstart[NE] = a; }
    __syncthreads();
}

__device__ __forceinline__ void phase_combine(const Params& p, const LAS int* tstart, int gw, int NGW, int lane) {
    const unsigned char* y2 = p.ws + WS_Y2; const int* toke = (const int*)(p.ws + WS_TOKE); const int* tokp = (const int*)(p.ws + WS_TOKP);
    constexpr float DY = 1.0f / FP8_SY;
    typedef int i32x4v __attribute__((ext_vector_type(4)));
    i32x4v ne = (i32x4v){0, 0, 0, 0}, np = ne;
    if (gw < T) { ne = *(const i32x4v*)(toke + gw * 4); np = *(const i32x4v*)(tokp + gw * 4); }
    for (int m = gw; m < T; m += NGW) {
        const i32x4v ce = ne, cp = np;
        if (m + NGW < T) { ne = *(const i32x4v*)(toke + (m + NGW) * 4); np = *(const i32x4v*)(tokp + (m + NGW) * 4); }
        const unsigned char* yr[4];
#pragma unroll
        for (int k = 0; k < 4; ++k) yr[k] = y2 + ((size_t)tstart[ce[k]] * 256 + cp[k]) * D;
        float* op = p.out + (size_t)m * D; const bf16* xp = (const bf16*)(p.ws + WS_X1) + (size_t)m * D;
#pragma unroll
        for (int j = 0; j < 2; ++j) { const int c = (j * 64 + lane) * 16;
            v4u w[4];
#pragma unroll
            for (int k = 0; k < 4; ++k) w[k] = *(const v4u*)(yr[k] + c);
            f32x4 a[4];
            { const v4u xa = *(const v4u*)(xp + c), xb = *(const v4u*)(xp + c + 8); float fa[8], fb[8]; unpack8(xa, fa); unpack8(xb, fb);
              a[0] = (f32x4){fa[0], fa[1], fa[2], fa[3]}; a[1] = (f32x4){fa[4], fa[5], fa[6], fa[7]}; a[2] = (f32x4){fb[0], fb[1], fb[2], fb[3]}; a[3] = (f32x4){fb[4], fb[5], fb[6], fb[7]}; }
#pragma unroll
            for (int q = 0; q < 4; ++q) { float s0 = 0.f, s1 = 0.f, s2 = 0.f, s3 = 0.f;
#pragma unroll
                for (int k = 0; k < 4; ++k) { const int wd = (int)(q == 0 ? w[k].x : q == 1 ? w[k].y : q == 2 ? w[k].z : w[k].w);
                    const f32x2 lo = __builtin_amdgcn_cvt_pk_f32_fp8(wd, false), hi = __builtin_amdgcn_cvt_pk_f32_fp8(wd, true);
                    s0 += lo.x; s1 += lo.y; s2 += hi.x; s3 += hi.y; }
                a[q][0] += s0 * DY; a[q][1] += s1 * DY; a[q][2] += s2 * DY; a[q][3] += s3 * DY;
                *(f32x4*)(op + c + 4 * q) = a[q]; }
        }
    }
}

constexpr int N_PHASES = 10;
__global__ void __launch_bounds__(NTHREADS, 2) hymba_fwd(Params p) {
    extern __shared__ __attribute__((aligned(16))) unsigned char lds_raw[];
    LAS unsigned char* lds = (LAS unsigned char*)lds_raw;
    volatile LAS unsigned* MISC = (volatile LAS unsigned*)(lds + MISC_OFF);
    LAS int* tstart = (LAS int*)(lds + MISC_OFF + 256);
    LAS int* lcnt = (LAS int*)(lds + MISC_OFF + 512);
    const int tid = threadIdx.x, lane = tid & 63, wave = __builtin_amdgcn_readfirstlane(tid >> 6);
    const int G = gridDim.x;
    const int vcu = (G % 8 == 0) ? (blockIdx.x % 8) * (G / 8) + blockIdx.x / 8 : blockIdx.x;
    const int gw = vcu * NWAVES + wave, NGW = G * NWAVES;
    unsigned* ctl = (unsigned*)(p.ws + WS_CTL);
    if (tid < 64) MISC[tid] = 0u;
    __syncthreads();
    const int lo = p.ph_lo, hi = p.ph_hi;
    XcdBarrier bar; bar.bar = ctl + CW_BAR; bar.x = 0; bar.st = nullptr;
    if (hi - lo > 1) bar = xcd_barrier_post(ctl + CW_BAR, MISC + 8);
#ifndef PHMASK
#define PHMASK 0x3ff
#endif
#define IN(k) (((PHMASK >> (k)) & 1) && lo <= (k) && (k) < hi)
#define SEAM(k) do { if (IN(k) && IN((k) + 1)) xcd_barrier(bar); } while (0)

    if (IN(0)) { phase_prologue(p, lds, gw, NGW, wave, lane); }
    SEAM(0);
    int cid = (int)blockIdx.x;
    if (hi - lo > 1 && lo == 0) {
        if (tid == 0) {
            bool ok = (G % 8 == 0);
            for (unsigned j = 0; j < 16; ++j) { const unsigned cj = xb_ld(&bar.bar[XB_XCNT(j)]); ok = ok && (j < 8 ? cj == (unsigned)(G / 8) : cj == 0u); }
            MISC[12] = ok ? (MISC[10] * 8u + bar.x) : (unsigned)blockIdx.x;
        }
        __syncthreads();
        cid = (int)MISC[12];
    }
    if (IN(1)) {
        const int ncw = (G < 8 * NCV) ? G : 8 * NCV;
        if (cid < ncw) convert_experts(p, cid * NWAVES + wave, ncw * NWAVES, lane);
        LAS int* tk = (LAS int*)(lds + MISC_OFF + 768);
        unsigned* tick = ctl + CW_TICK + 64 * (cid & 7);
        __syncthreads();
        if (tid == 0) { tk[0] = (int)__hip_atomic_fetch_add(tick, 1u, __ATOMIC_RELAXED, __HIP_MEMORY_SCOPE_AGENT); tk[1] = (int)__hip_atomic_fetch_add(tick, 1u, __ATOMIC_RELAXED, __HIP_MEMORY_SCOPE_AGENT); }
        __syncthreads();
        pg8::SchedQueue S{(const char*)(p.ws + WS_HN), (const char*)(p.ws + WS_WIN), T / 256, NIN_PAD / 256, (T / 256) * (NIN_PAD / 256) / 8, cid & 7, tick, tk};
        EpiInProj E{(bf16*)(p.ws + WS_PROJ), (float*)(p.ws + WS_DT)};
        pg8::gemm_phase<EpiInProj, pg8::SchedQueue>(lds, S, E);
    }
    SEAM(1);
    if (IN(2)) { if (!(p.variant & 2)) phase_attn(p, lds, G); if (!(p.variant & 1)) phase_ssd_states(p, lds, G, lane, wave); }
    SEAM(2);
    if (IN(3)) { phase_ssd_scan(p, G); }
    SEAM(3);
    if (IN(4)) { phase_ssd_out(p, lds, G, lane, wave); }
    SEAM(4);
    if (IN(5)) {
        EpiOutProj E{p.x, (bf16*)(p.ws + WS_X1), (float*)(p.ws + WS_SSQ)};
#if PROBE_CRIP5
        if (p.variant) { pg8::SchedDenseT<PROBE_CRIP5> S{(const char*)(p.ws + WS_MIX), (const char*)(p.ws + WS_WOUT), T / 256, D / 256, G, cid};
            pg8::gemm_phase<EpiOutProj, pg8::SchedDenseT<PROBE_CRIP5>>(lds, S, E); } else
#endif
        { pg8::SchedDense S{(const char*)(p.ws + WS_MIX), (const char*)(p.ws + WS_WOUT), T / 256, D / 256, G, cid};
          pg8::gemm_phase<EpiOutProj, pg8::SchedDense>(lds, S, E); }
    }
    SEAM(5);
    if (IN(6)) { phase_router(p, lds, ctl, G, wave, lane); }
    SEAM(6);
    if (IN(7)) {
        moe_table(ctl, tstart, lcnt);
        EpiGateUp E{p.ws + WS_HB, p.b_gate, p.b_up};
#if PROBE_CRIP7
        if (p.variant) { pg8::SchedMoE<true, PROBE_CRIP7> S{(const char*)(p.ws + WS_HF), (const char*)(p.ws + WS_WGU), (const int*)(p.ws + WS_STOK), tstart, lcnt, (2 * FF) / 256, 2 * FF, G, cid};
            pg8::gemm_phase<EpiGateUp, pg8::SchedMoE<true, PROBE_CRIP7>>(lds, S, E); } else
#endif
        { pg8::SchedMoE<true> S{(const char*)(p.ws + WS_HF), (const char*)(p.ws + WS_WGU), (const int*)(p.ws + WS_STOK), tstart, lcnt, (2 * FF) / 256, 2 * FF, G, cid};
          pg8::gemm_phase<EpiGateUp, pg8::SchedMoE<true>>(lds, S, E); }
    }
    SEAM(7);
    if (IN(8)) {
        moe_table(ctl, tstart, lcnt);
        EpiDown E{p.ws + WS_Y2, p.b_down, (const float*)(p.ws + WS_SGATE), tstart};
#if PROBE_CRIP
        if (p.variant) { pg8::SchedMoE<false, PROBE_CRIP> S{(const char*)(p.ws + WS_HB), (const char*)(p.ws + WS_WD), (const int*)(p.ws + WS_STOK), tstart, lcnt, D / 256, D, G, cid};
            pg8::gemm_phase<EpiDown, pg8::SchedMoE<false, PROBE_CRIP>>(lds, S, E); } else
#endif
        { pg8::SchedMoE<false> S{(const char*)(p.ws + WS_HB), (const char*)(p.ws + WS_WD), (const int*)(p.ws + WS_STOK), tstart, lcnt, D / 256, D, G, cid};
          pg8::gemm_phase<EpiDown, pg8::SchedMoE<false>>(lds, S, E); }
    }
    SEAM(8);
    if (IN(9)) { moe_table(ctl, tstart, lcnt); phase_combine(p, tstart, gw, NGW, lane); }
#undef IN
#undef SEAM
}

extern "C" void kernel_launch(void* const* d_in, const int* in_sizes, int n_in, void* d_out, int out_size, void* d_ws, size_t ws_size, hipStream_t stream) {
    static int grid = 0;
    if (grid == 0) {
        if (n_in != 23 || out_size != T * D || ws_size < WS_END) { fprintf(stderr, "kernel_launch: unexpected sizes n_in %d out %d ws %zu\n", n_in, out_size, ws_size); grid = -1; return; }
        int dev = 0, cus = 0;
        if (hipGetDevice(&dev) != hipSuccess || hipDeviceGetAttribute(&cus, hipDeviceAttributeMultiprocessorCount, dev) != hipSuccess) { grid = -1; return; }
        if (hipFuncSetAttribute((const void*)hymba_fwd, hipFuncAttributeMaxDynamicSharedMemorySize, LDS_BYTES) != hipSuccess) { fprintf(stderr, "kernel_launch: hipFuncSetAttribute failed\n"); grid = -1; return; }
        int per_cu = 0;
        if (hipOccupancyMaxActiveBlocksPerMultiprocessor(&per_cu, (const void*)hymba_fwd, NTHREADS, LDS_BYTES) != hipSuccess || per_cu < 1) fprintf(stderr, "kernel_launch: occupancy query says %d\n", per_cu);
        (void)hipGetLastError();
        grid = cus;
    }
    if (grid < 0) return;
    (void)hipMemsetAsync((char*)d_ws + WS_CTL, 0, CTL_BYTES, stream);
    Params p{};
    const float** pp = (const float**)&p;
    for (int i = 0; i < 23; ++i) pp[i] = (const float*)d_in[i];
    p.out = (float*)d_out; p.ws = (unsigned char*)d_ws;
#if MK_MULTI || (PROBE_REPEAT >= 0) || PROBE_CRIP || PROBE_P2 || PROBE_P6 || PROBE_CRIP7 || PROBE_CRIP5
    for (int ph = 0; ph < N_PHASES; ++ph) { p.ph_lo = ph; p.ph_hi = ph + 1;
        if (PROBE_P2 && ph == 2) { p.variant = PROBE_P2; hipLaunchKernelGGL(hymba_fwd, dim3(grid), dim3(NTHREADS), LDS_BYTES, stream, p); p.variant = 0; }
        if (PROBE_P6 && ph == 6) { hipLaunchKernelGGL(hymba_fwd, dim3(grid), dim3(NTHREADS), LDS_BYTES, stream, p); (void)hipMemsetAsync((char*)d_ws + WS_CTL + CW_CNT * 4, 0, 64 * 4 * NE, stream); }
        if (PROBE_CRIP5 && ph == 5) { p.variant = 1; hipLaunchKernelGGL(hymba_fwd, dim3(grid), dim3(NTHREADS), LDS_BYTES, stream, p); p.variant = 0; }
        if (PROBE_CRIP7 && ph == 7) { p.variant = 1; hipLaunchKernelGGL(hymba_fwd, dim3(grid), dim3(NTHREADS), LDS_BYTES, stream, p); p.variant = 0; }
        if (PROBE_CRIP && ph == 8) { p.variant = 1; hipLaunchKernelGGL(hymba_fwd, dim3(grid), dim3(NTHREADS), LDS_BYTES, stream, p); p.variant = 0; }
        for (int r = 0; r < (ph == PROBE_REPEAT ? 2 : 1); ++r) hipLaunchKernelGGL(hymba_fwd, dim3(grid), dim3(NTHREADS), LDS_BYTES, stream, p); }
#else
    p.ph_lo = 0; p.ph_hi = N_PHASES; hipLaunchKernelGGL(hymba_fwd, dim3(grid), dim3(NTHREADS), LDS_BYTES, stream, p);
#endif
}
```

```cpp
#include <hip/hip_runtime.h>
#include <cstdio>
#include <cstdint>

#ifndef MK_MULTI
#define MK_MULTI 0
#endif

#ifndef PROBE_CRIP
#define PROBE_CRIP 0
#endif
#ifndef WGM
#define WGM 4
#endif
#ifndef WGMQ
#define WGMQ 8
#endif
#ifndef PROBE_CRIP5
#define PROBE_CRIP5 0
#endif
#ifndef PROBE_CRIP7
#define PROBE_CRIP7 0
#endif
#ifndef PROBE_P6
#define PROBE_P6 0
#endif
#ifndef PROBE_P2
#define PROBE_P2 0
#endif
#ifndef PROBE_REPEAT
#define PROBE_REPEAT -1
#endif
#define GAS __attribute__((address_space(1)))
#define LAS __attribute__((address_space(3)))
typedef unsigned short bf16;
typedef unsigned v4u __attribute__((ext_vector_type(4)));
typedef unsigned v2u __attribute__((ext_vector_type(2)));
typedef float f32x4 __attribute__((ext_vector_type(4)));
typedef float f32x2 __attribute__((ext_vector_type(2)));
typedef short bf16x8 __attribute__((ext_vector_type(8)));
typedef int i32x4 __attribute__((ext_vector_type(4)));
typedef int i32x8 __attribute__((ext_vector_type(8)));

constexpr int NB = 4, SEQ = 8192, T = NB * SEQ, D = 2048;
constexpr int PROJ_LD = 3840;
constexpr int COL_Q = 0, COL_K = 1024, COL_V = 1152, COL_Z = 1280, COL_XBC = 2304;
constexpr int NIN = 3856, NIN_PAD = 4096;
constexpr int NXBC = 1536;
constexpr int NE = 32, FF = 2048, TOPK = 4;
constexpr int SLOT_ROWS = T * TOPK + NE * 256;
constexpr float EPS = 1e-6f;

constexpr size_t MiB = 1u << 20;
constexpr size_t WS_CTL = 0, CTL_BYTES = 1 * MiB;
constexpr size_t WS_WGU = 16 * MiB;
constexpr size_t WS_WIN = 528 * MiB;
constexpr size_t WS_WOUT = 544 * MiB;
constexpr size_t WS_HF = 552 * MiB;
constexpr size_t WS_Y2 = 16 * MiB;
constexpr size_t WS_WD = 680 * MiB;
constexpr size_t WS_HN = 936 * MiB;
constexpr size_t WS_MIX = WS_HN;
constexpr size_t WS_PROJ = 1064 * MiB;
constexpr size_t WS_XBC = 1304 * MiB;
constexpr size_t WS_ATT = 1496 * MiB;
constexpr size_t WS_X1 = WS_ATT;
constexpr size_t WS_YS = 1624 * MiB;
constexpr size_t WS_HB = 936 * MiB;
constexpr size_t WS_STATES = WS_XBC;
constexpr size_t WS_SIN = WS_YS;
constexpr size_t WS_CDEC = WS_YS + 64 * MiB;
constexpr size_t WS_DT = 1752 * MiB;
constexpr size_t WS_DTS = 1754 * MiB;
constexpr size_t WS_SSQ = 1756 * MiB;
constexpr size_t WS_STOK = 1760 * MiB;
constexpr size_t WS_SGATE = 1764 * MiB;
constexpr size_t WS_TOKE = 1768 * MiB;
constexpr size_t WS_TOKP = 1769 * MiB;
constexpr size_t WS_WRB = 1770 * MiB;
constexpr size_t WS_END = 1771 * MiB;
static_assert(WS_Y2 + (size_t)SLOT_ROWS * 2048 <= WS_WD, "y2 overlay");
static_assert(WS_HB + (size_t)SLOT_ROWS * 2048 * 2 <= WS_ATT, "hb overlay");
constexpr int CW_CNT = 1024;
constexpr int CW_BAR = 4096;
constexpr int CW_TICK = 2048 + 1024;
constexpr int NCV = 16;

constexpr int RING_BYTES = 131072;
constexpr int MISC_OFF = 162816;
constexpr int LDS_BYTES = 163840;
constexpr int NWAVES = 8, NTHREADS = 512;

typedef __bf16 hwbf16x2 __attribute__((ext_vector_type(2)));
__device__ __forceinline__ unsigned f2bf(float f) { return (unsigned)__builtin_bit_cast(unsigned short, (__bf16)f); }
__device__ __forceinline__ unsigned pk2(float lo, float hi) { const f32x2 v = {lo, hi}; return __builtin_bit_cast(unsigned, __builtin_convertvector(v, hwbf16x2)); }
__device__ __forceinline__ float bflo(unsigned w) { return __builtin_bit_cast(float, w << 16); }
__device__ __forceinline__ float bfhi(unsigned w) { return __builtin_bit_cast(float, w & 0xffff0000u); }
__device__ __forceinline__ float wave_sum(float v) {
#pragma unroll
    for (int o = 1; o < 64; o <<= 1) v += __shfl_xor(v, o);
    return v;
}
__device__ __forceinline__ float sat8(float x) { return __builtin_amdgcn_fmed3f(x, -448.0f, 448.0f); }
__device__ __forceinline__ unsigned pk4_fp8(float a, float b, float c, float d) { int v = 0; v = __builtin_amdgcn_cvt_pk_fp8_f32(a, b, v, false); v = __builtin_amdgcn_cvt_pk_fp8_f32(c, d, v, true); return (unsigned)v; }
constexpr float FP8_SW = 256.f;
constexpr float FP8_SA = 16.f;
constexpr float FP8_SH = 4.f;
constexpr float FP8_SY = 32.f;
__device__ __forceinline__ float fsigmoid(float x) { return __builtin_amdgcn_rcpf(1.0f + __expf(-x)); }
__device__ __forceinline__ void unpack8(const v4u q, float (&d)[8]) { d[0] = bflo(q.x); d[1] = bfhi(q.x); d[2] = bflo(q.y); d[3] = bfhi(q.y); d[4] = bflo(q.z); d[5] = bfhi(q.z); d[6] = bflo(q.w); d[7] = bfhi(q.w); }
#define LDS_WAIT() asm volatile("s_waitcnt lgkmcnt(0)" ::: "memory")

#define XB_TMO      128
#define XB_XCNT(j)  (256  + 64 * (j))
#define XB_XSUB(j)  (1280 + 64 * (j))
#define XB_XGEN(j)  (2304 + 64 * (j))
#define XB_TOP      3328
#define XB_TOPGEN   3392
#define XCD_BAR_WORDS 3456
#define XB_SPIN_CAP (1u << 18)
__device__ __forceinline__ unsigned xb_ld(unsigned* p)              { return __hip_atomic_load(p, __ATOMIC_RELAXED, __HIP_MEMORY_SCOPE_AGENT); }
__device__ __forceinline__ unsigned xb_add(unsigned* p, unsigned v) { return __hip_atomic_fetch_add(p, v, __ATOMIC_RELAXED, __HIP_MEMORY_SCOPE_AGENT); }
__device__ __forceinline__ unsigned xb_xcc_id() { return (unsigned)__builtin_amdgcn_s_getreg((3 << 11) | 20) & 0xFu; }
#define XB_SPIN(cond, bar) do { unsigned _sp = 0; while (cond) { __builtin_amdgcn_s_sleep(1); \
    if ((++_sp & 255u) == 0u) { if (xb_ld(&(bar)[XB_TMO])) break; if (_sp > XB_SPIN_CAP) { atomicAdd(&(bar)[XB_TMO], 1u); break; } } } } while (0)
struct XcdBarrier { unsigned* bar; unsigned x; volatile LAS unsigned* st; };
__device__ __forceinline__ XcdBarrier xcd_barrier_post(unsigned* bar, volatile LAS unsigned* st) {
    XcdBarrier b; b.bar = bar; b.x = xb_xcc_id(); b.st = st;
    if (threadIdx.x == 0) st[2] = xb_add(&bar[XB_XCNT(b.x)], 1u);
    return b;
}
__device__ __forceinline__ void xcd_barrier_complete(unsigned* bar, unsigned x, unsigned& nloc, unsigned& nx) {
    const unsigned G = gridDim.x * gridDim.y * gridDim.z;
    unsigned sum, cnt, mine, sp = 0u;
    for (;;) {
        sum = 0u; cnt = 0u; mine = 0u;
#pragma unroll
        for (unsigned j = 0; j < 16; ++j) { const unsigned c = xb_ld(&bar[XB_XCNT(j)]); sum += c; cnt += (c > 0u) ? 1u : 0u; mine = (j == x) ? c : mine; }
        if (sum == G) break;
        __builtin_amdgcn_s_sleep(1);
        if ((++sp & 255u) == 0u) { if (xb_ld(&bar[XB_TMO])) break; if (sp > XB_SPIN_CAP) { atomicAdd(&bar[XB_TMO], 1u); break; } }
    }
    nloc = mine > 0u ? mine : 1u; nx = cnt > 0u ? cnt : 1u;
}
__device__ __forceinline__ void xcd_barrier(const XcdBarrier& b) {
    asm volatile("s_waitcnt vmcnt(0)" ::: "memory");
    __syncthreads();
    if (threadIdx.x == 0) {
        unsigned* bar = b.bar;
        __builtin_amdgcn_s_waitcnt(0);
        unsigned nloc = b.st[0], nx = b.st[1];
        if (nloc == 0u) { xcd_barrier_complete(bar, b.x, nloc, nx); b.st[0] = nloc; b.st[1] = nx; }
        const unsigned old = xb_add(&bar[XB_XSUB(b.x)], 1u);
        const unsigned gen = old / nloc;
        if (old + 1u == (gen + 1u) * nloc) {
            __builtin_amdgcn_fence(__ATOMIC_RELEASE, "agent");
            asm volatile("s_waitcnt vmcnt(0)" ::: "memory");
            const unsigned og = xb_add(&bar[XB_TOP], 1u);
            const unsigned tg = og / nx;
            if (og + 1u == (tg + 1u) * nx) xb_add(&bar[XB_TOPGEN], 1u);
            else XB_SPIN(xb_ld(&bar[XB_TOPGEN]) == tg, bar);
            __builtin_amdgcn_fence(__ATOMIC_ACQUIRE, "agent");
            xb_add(&bar[XB_XGEN(b.x)], 1u);
            asm volatile("s_waitcnt vmcnt(0)" ::: "memory");
        } else {
            XB_SPIN(xb_ld(&bar[XB_XGEN(b.x)]) == gen, bar);
            __builtin_amdgcn_fence(__ATOMIC_ACQUIRE, "agent");
            asm volatile("s_waitcnt vmcnt(0)" ::: "memory");
        }
    }
    __syncthreads();
}

struct Params {
    const float* x; const float* attn_norm_w; const float* w_in; const float* q_norm_w; const float* k_norm_w; const float* sinks;
    const float* conv_w; const float* conv_b; const float* dt_bias; const float* a_log; const float* d_skip; const float* ssm_norm_w;
    const float* attn_out_norm_w; const float* w_out; const float* ffn_norm_w; const float* w_router; const float* b_router;
    const float* w_gate; const float* b_gate; const float* w_up; const float* b_up; const float* w_down; const float* b_down;
    float* out; unsigned char* ws; int ph_lo, ph_hi, variant, pad;
};

namespace pg8 {
constexpr int BM = 256, BK = 64, HALF = 128, HTB = HALF * BK * 2, GK = 2048;
__device__ __forceinline__ int lds_byte(int r, int c) { const int st = (r >> 4) * 2 + (c >> 5), rr = r & 15, cc = c & 31, ob = rr * 64 + cc * 2; return st * 1024 + (ob ^ (((ob >> 9) & 1) << 5)); }
__device__ __forceinline__ void stage_rc(int b, int& R, int& C) { const int st = b / 1024, sb = b % 1024, swz = sb ^ (((sb >> 9) & 1) << 5); R = (st >> 1) * 16 + swz / 64; C = (st & 1) * 32 + (swz % 64) / 2; }
__device__ __forceinline__ int perm32(int rho) { const int n = rho >> 4, i = rho & 15; return 8 * (i >> 2) + 4 * n + (i & 3); }

struct Unit { const char* aBase; const char* bBase; const int* aidx; int avalid; int pm, pn, e; };

template <class Epi, class Sched>
__device__ __forceinline__ void gemm_phase(LAS unsigned char* lds, const Sched& S, const Epi& E) {
    constexpr int RP = Sched::ROWB, nt = RP / 128;
    constexpr bool F8 = Sched::FP8;
    const int tid = threadIdx.x, wid = __builtin_amdgcn_readfirstlane(tid >> 6), lane = tid & 63, wr = wid >> 2, wc = wid & 3, fr = lane & 15, fq = lane >> 4;
    int sR[2], sC[2];
    unsigned voffB[2], vA[2][2];
#pragma unroll
    for (int i = 0; i < 2; ++i) { stage_rc(tid * 16 + i * 8192, sR[i], sC[i]); const int Rb = Epi::PERM ? ((sR[i] & ~31) + perm32(sR[i] & 31)) : sR[i];
        voffB[i] = (unsigned)(Rb * RP + sC[i] * 2); }
    const size_t kstep = (size_t)(BK * 2);
    const size_t hstep = (size_t)HALF * RP;
    const unsigned ldsw = (unsigned)wid * 1024u;
    const int aoff = lds_byte(wr * 64 + fr, fq * 8), boff = lds_byte(wc * 32 + fr, fq * 8);
#define PG8_SA(b, h) (((b) * 2 + (h)) * HTB)
#define PG8_SB(b, h) ((4 + (b) * 2 + (h)) * HTB)
#define PG8_STAGE(bufoff, gbase, voff) do { if constexpr (!(Sched::CRIP & 2)) _Pragma("unroll") for (int _i = 0; _i < 2; ++_i) { unsigned _o = (voff)[_i]; asm volatile("" : "+v"(_o)); \
        __builtin_amdgcn_global_load_lds((const unsigned*)((const char*)(gbase) + _o), (LAS unsigned*)(lds + (bufoff) + ldsw + _i * 8192), 16, 0, 0); } } while (0)
#define PG8_CAT(x, y) __builtin_shufflevector(x, y, 0, 1, 2, 3, 4, 5, 6, 7)
#define PG8_LO(v) __builtin_bit_cast(bf16x8, __builtin_shufflevector(v, v, 0, 1, 2, 3))
#define PG8_HI(v) __builtin_bit_cast(bf16x8, __builtin_shufflevector(v, v, 4, 5, 6, 7))
#define PG8_LDA(dst, b, h) do { if constexpr (!(Sched::CRIP & 4)) _Pragma("unroll") for (int m = 0; m < 4; ++m) dst[m] = PG8_CAT(*(const LAS i32x4*)(lds + PG8_SA(b, h) + aoff + m * 2048), *(const LAS i32x4*)(lds + PG8_SA(b, h) + aoff + m * 2048 + 1024)); } while (0)
#define PG8_LDB(dst, b, h) do { if constexpr (!(Sched::CRIP & 4)) _Pragma("unroll") for (int n = 0; n < 2; ++n) dst[n] = PG8_CAT(*(const LAS i32x4*)(lds + PG8_SB(b, h) + boff + n * 2048), *(const LAS i32x4*)(lds + PG8_SB(b, h) + boff + n * 2048 + 1024)); } while (0)
#define PG8_MMA(ai, bj, At, Bt) do { __builtin_amdgcn_s_setprio(1); \
        if constexpr (Sched::CRIP & 1) {} else if constexpr (F8) { asm volatile("s_nop 1\n\t" \
            "v_mfma_scale_f32_16x16x128_f8f6f4 %0, %8, %10, %0, %14, %14 op_sel_hi:[0,0,0]\n\t" "v_mfma_scale_f32_16x16x128_f8f6f4 %1, %9, %10, %1, %14, %14 op_sel_hi:[0,0,0]\n\t" \
            "v_mfma_scale_f32_16x16x128_f8f6f4 %2, %8, %11, %2, %14, %14 op_sel_hi:[0,0,0]\n\t" "v_mfma_scale_f32_16x16x128_f8f6f4 %3, %9, %11, %3, %14, %14 op_sel_hi:[0,0,0]\n\t" \
            "v_mfma_scale_f32_16x16x128_f8f6f4 %4, %8, %12, %4, %14, %14 op_sel_hi:[0,0,0]\n\t" "v_mfma_scale_f32_16x16x128_f8f6f4 %5, %9, %12, %5, %14, %14 op_sel_hi:[0,0,0]\n\t" \
            "v_mfma_scale_f32_16x16x128_f8f6f4 %6, %8, %13, %6, %14, %14 op_sel_hi:[0,0,0]\n\t" "v_mfma_scale_f32_16x16x128_f8f6f4 %7, %9, %13, %7, %14, %14 op_sel_hi:[0,0,0]" \
            : "+v"(acc[ai][bj][0][0]), "+v"(acc[ai][bj][0][1]), "+v"(acc[ai][bj][1][0]), "+v"(acc[ai][bj][1][1]), "+v"(acc[ai][bj][2][0]), "+v"(acc[ai][bj][2][1]), "+v"(acc[ai][bj][3][0]), "+v"(acc[ai][bj][3][1]) \
            : "v"(Bt[0]), "v"(Bt[1]), "v"(At[0]), "v"(At[1]), "v"(At[2]), "v"(At[3]), "v"(f8scale)); } \
        else { _Pragma("unroll") for (int m = 0; m < 4; ++m) _Pragma("unroll") for (int n = 0; n < 2; ++n) { \
               acc[ai][bj][m][n] = __builtin_amdgcn_mfma_f32_16x16x32_bf16(PG8_LO(Bt[n]), PG8_LO(At[m]), acc[ai][bj][m][n], 0, 0, 0); \
               acc[ai][bj][m][n] = __builtin_amdgcn_mfma_f32_16x16x32_bf16(PG8_HI(Bt[n]), PG8_HI(At[m]), acc[ai][bj][m][n], 0, 0, 0); } } \
        __builtin_amdgcn_s_setprio(0); } while (0)
#define PG8_WAIT_V(n) asm volatile("s_waitcnt vmcnt(" #n ")" ::: "memory")
#define PG8_WAIT_L(n) asm volatile("s_waitcnt lgkmcnt(" #n ")" ::: "memory")
#define PG8_BAR __builtin_amdgcn_s_barrier()
#define PG8_BAR2 do { if constexpr (!(Sched::CRIP & 16)) __builtin_amdgcn_s_barrier(); } while (0)
#define PG8_SCHED __builtin_amdgcn_sched_barrier(0)
    Unit cur, nxt; int ui = 0;
    if (!S.next(0, cur)) return;
    typename Epi::Pre epre;
    E.prefetch(cur, epre);
    LAS int* lidx = (LAS int*)(lds + 8 * HTB);
    if constexpr (Sched::GATHER) {
        if (tid < 256) { const int v = cur.aidx[tid]; lidx[tid] = (tid < cur.avalid) ? v : 0; }
        __syncthreads();
    }
#pragma unroll
    for (int h = 0; h < 2; ++h)
#pragma unroll
        for (int i = 0; i < 2; ++i) {
            const int r = h * HALF + sR[i];
            if constexpr (Sched::GATHER) vA[h][i] = (unsigned)(lidx[r] * RP + sC[i] * 2);
            else vA[h][i] = (unsigned)(r * RP + sC[i] * 2);
        }
    f32x4 acc[2][2][4][2];
#pragma unroll
    for (int a = 0; a < 2; ++a)
#pragma unroll
        for (int b = 0; b < 2; ++b)
#pragma unroll
            for (int m = 0; m < 4; ++m)
#pragma unroll
                for (int n = 0; n < 2; ++n) acc[a][b][m][n] = (f32x4){0.f, 0.f, 0.f, 0.f};
    i32x8 At[4], B0[2], B1[2];
    if constexpr (Sched::CRIP & 4) { _Pragma("unroll") for (int m = 0; m < 4; ++m) At[m] = (i32x8){0, 0, 0, 0, 0, 0, 0, 0}; _Pragma("unroll") for (int n = 0; n < 2; ++n) { B0[n] = At[0]; B1[n] = At[0]; } }
    int f8scale = 0x7f7f7f7f; asm volatile("" : "+v"(f8scale));
    const char* cA = cur.aBase; const char* cB = cur.bBase;
#ifndef KROT
#define KROT(pm, pn) (((F8 ? 0 : (pm)) + (pn)) & (nt - 1))
#endif
#define PG8_KT(rot, tau) ((size_t)(((tau) + (rot)) & (nt - 1)) * kstep)
    int crot = KROT(cur.pm, cur.pn);
    PG8_STAGE(PG8_SB(0, 0), cB + PG8_KT(crot, 0), voffB); PG8_STAGE(PG8_SB(0, 1), cB + hstep + PG8_KT(crot, 0), voffB); PG8_STAGE(PG8_SA(0, 0), cA + PG8_KT(crot, 0), vA[0]); PG8_STAGE(PG8_SA(0, 1), cA + PG8_KT(crot, 0), vA[1]);
    if (wr == 1) PG8_BAR;
    PG8_WAIT_V(2); PG8_BAR;
    PG8_STAGE(PG8_SB(1, 0), cB + PG8_KT(crot, 1), voffB); PG8_STAGE(PG8_SA(1, 0), cA + PG8_KT(crot, 1), vA[0]); PG8_STAGE(PG8_SB(1, 1), cB + hstep + PG8_KT(crot, 1), voffB);
    PG8_WAIT_V(6); PG8_BAR;
    for (;;) {
        const bool has_next = S.next(ui + 1, nxt);
        const char* nA = has_next ? nxt.aBase : cA; const char* nB = has_next ? nxt.bBase : cB;
        const int nrot = has_next ? KROT(nxt.pm, nxt.pn) : crot;
        for (int t = 0; t < nt; t += 2) {
            const bool last = (t == nt - 2);
            const char* a1 = cA + PG8_KT(crot, t + 1);
            const char* a2 = last ? nA + PG8_KT(nrot, 0) : cA + PG8_KT(crot, t + 2); const char* b2 = last ? nB + PG8_KT(nrot, 0) : cB + PG8_KT(crot, t + 2);
            const char* a3 = last ? nA + PG8_KT(nrot, 1) : cA + PG8_KT(crot, t + 3); const char* b3 = last ? nB + PG8_KT(nrot, 1) : cB + PG8_KT(crot, t + 3);
            int gi = 0;
            if constexpr (Sched::GATHER) { if (t == 0 && has_next && tid < 256) gi = nxt.aidx[tid]; }
            PG8_LDB(B0, 0, 0); PG8_LDB(B1, 0, 1); PG8_SCHED; PG8_LDA(At, 0, 0); PG8_STAGE(PG8_SA(1, 1), a1, vA[1]);
            PG8_WAIT_V(8); PG8_WAIT_L(0); PG8_BAR; PG8_MMA(0, 0, At, B0); PG8_MMA(0, 1, At, B1); PG8_BAR2; PG8_SCHED;
            if constexpr (Sched::GATHER) { if (last && has_next) {
                int tz = threadIdx.x; asm volatile("" : "+v"(tz));
#pragma unroll
                for (int i = 0; i < 2; ++i) { int R, C; stage_rc(tz * 16 + i * 8192, R, C);
#pragma unroll
                    for (int h = 0; h < 2; ++h) vA[h][i] = (unsigned)(lidx[h * HALF + R] * RP + C * 2); } } }
            PG8_LDA(At, 0, 1); PG8_STAGE(PG8_SB(0, 0), b2, voffB); PG8_STAGE(PG8_SB(0, 1), b2 + hstep, voffB); PG8_STAGE(PG8_SA(0, 0), a2, vA[0]);
            PG8_WAIT_V(8); PG8_WAIT_L(0); PG8_BAR; PG8_MMA(1, 0, At, B0); PG8_MMA(1, 1, At, B1); PG8_BAR2; PG8_SCHED;
            PG8_LDB(B0, 1, 0); PG8_LDB(B1, 1, 1); PG8_SCHED; PG8_LDA(At, 1, 0); PG8_STAGE(PG8_SA(0, 1), a2, vA[1]);
            PG8_WAIT_V(8); PG8_WAIT_L(0); PG8_BAR; PG8_MMA(0, 0, At, B0); PG8_MMA(0, 1, At, B1); PG8_BAR2; PG8_SCHED;
            PG8_LDA(At, 1, 1); PG8_STAGE(PG8_SB(1, 0), b3, voffB); PG8_STAGE(PG8_SB(1, 1), b3 + hstep, voffB); PG8_STAGE(PG8_SA(1, 0), a3, vA[0]);
            PG8_WAIT_V(8); PG8_WAIT_L(0); PG8_BAR; PG8_MMA(1, 0, At, B0); PG8_MMA(1, 1, At, B1); PG8_BAR2; PG8_SCHED;
            if constexpr (Sched::GATHER) { if (t == 0 && has_next && tid < 256) lidx[tid] = (tid < nxt.avalid) ? gi : 0; }
        }
        if constexpr (F8) asm volatile("s_nop 15\n\ts_nop 15" ::: "memory");
        if (wr == 0) PG8_BAR;
        { int tz = threadIdx.x; asm volatile("" : "+v"(tz)); const int ewid = __builtin_amdgcn_readfirstlane(tz >> 6), el = tz & 63;
          E(acc, cur, epre, ewid >> 2, ewid & 3, el & 15, el >> 4); }
        if (!has_next) break;
#pragma unroll
        for (int a = 0; a < 2; ++a)
#pragma unroll
            for (int b = 0; b < 2; ++b)
#pragma unroll
                for (int m = 0; m < 4; ++m)
#pragma unroll
                    for (int n = 0; n < 2; ++n) acc[a][b][m][n] = (f32x4){0.f, 0.f, 0.f, 0.f};
        cur = nxt; cA = nA; cB = nB; crot = nrot; ++ui;
        E.prefetch(cur, epre);
        if (wr == 1) PG8_BAR;
    }
    PG8_WAIT_V(0);
    PG8_BAR;
#undef PG8_KT
#undef PG8_SA
#undef PG8_SB
#undef PG8_STAGE
#undef PG8_LDA
#undef PG8_LDB
#undef PG8_MMA
#undef PG8_CAT
#undef PG8_LO
#undef PG8_HI
#undef PG8_WAIT_V
#undef PG8_WAIT_L
#undef PG8_BAR
#undef PG8_BAR2
#undef PG8_SCHED
}

__device__ __forceinline__ bool tile_order(long L, int nM, int nN, int& pm, int& pn) {
    const int nwg = nM * nN; if (L >= nwg) return false;
    int wgid = (int)L; { const int q = nwg / 8, r = nwg % 8, xcd = wgid % 8, off = wgid / 8; wgid = (xcd < r ? xcd * (q + 1) : r * (q + 1) + (xcd - r) * q) + off; }
    const int nig = WGM * nN, gid = wgid / nig, fm = gid * WGM, gsz = (nM - fm) < WGM ? (nM - fm) : WGM;
    pm = fm + ((wgid % nig) % gsz); pn = (wgid % nig) / gsz; return true;
}
template <int CRIP_ = 0> struct SchedDenseT {
    static constexpr bool GATHER = false, FP8 = false; static constexpr int ROWB = 4096, CRIP = CRIP_;
    const char* A; const char* Bt; int nM, nN, G, c;
    __device__ __forceinline__ bool next(int i, Unit& u) const {
        int pm, pn; if (!tile_order((long)i * G + c, nM, nN, pm, pn)) return false;
        u.pm = pm; u.pn = pn; u.e = 0; u.aidx = nullptr; u.avalid = 256;
        u.aBase = A + (size_t)pm * 256 * GK * 2; u.bBase = Bt + (size_t)pn * 256 * GK * 2;
        if constexpr ((CRIP_ & 64) != 0) u.bBase = Bt;
        if constexpr ((CRIP_ & 128) != 0) u.aBase = A;
        return true;
    }
};
typedef SchedDenseT<0> SchedDense;
struct SchedQueue {
    static constexpr bool GATHER = false, FP8 = false; static constexpr int ROWB = 4096, CRIP = 0;
    const char* A; const char* Bt; int nM, nN, q, xcd; unsigned* tick; LAS int* tk;
    __device__ __forceinline__ bool next(int i, Unit& u) const {
        const int t = __builtin_amdgcn_readfirstlane(tk[i & 1]);
        if (i > 0 && threadIdx.x == 0) tk[(i + 1) & 1] = (int)__hip_atomic_fetch_add(tick, 1u, __ATOMIC_RELAXED, __HIP_MEMORY_SCOPE_AGENT);
        if (t >= q) return false;
        const int id = xcd * q + t, nig = WGMQ * nN, gid = id / nig, fm = gid * WGMQ, gsz = (nM - fm) < WGMQ ? (nM - fm) : WGMQ;
        const int pm = fm + ((id % nig) % gsz), pn = (id % nig) / gsz;
        u.pm = pm; u.pn = pn; u.e = 0; u.aidx = nullptr; u.avalid = 256;
        u.aBase = A + (size_t)pm * 256 * ROWB; u.bBase = Bt + (size_t)pn * 256 * ROWB; return true;
    }
};
template <bool GATHER_, int CRIP_ = 0> struct SchedMoE {
    static constexpr bool GATHER = GATHER_ && !(CRIP_ & 32), FP8 = true; static constexpr int ROWB = 2048, CRIP = CRIP_;
    const char* A; const char* Bt; const int* stok; const LAS int* tstart; const LAS int* cnt; int nN, nrowsB  , G, c;
    __device__ __forceinline__ bool next(int i, Unit& u) const {
        const int nM = __builtin_amdgcn_readfirstlane(tstart[NE]); int pm, pn; if (!tile_order((long)i * G + c, nM, nN, pm, pn)) return false;
        int e = 0;
        for (int j = 1; j < NE; ++j) e += (tstart[j] <= pm) ? 1 : 0;
        e = __builtin_amdgcn_readfirstlane(e);
        const int mt = __builtin_amdgcn_readfirstlane(pm - tstart[e]);
        u.pm = pm; u.pn = pn; u.e = e;
        u.avalid = __builtin_amdgcn_readfirstlane(cnt[e]) - mt * 256;
        u.aidx = stok + (size_t)e * T + mt * 256;
        u.aBase = GATHER ? A : A + (size_t)(GATHER_ ? (pm & 127) : pm) * 256 * ROWB;
        u.bBase = Bt + ((size_t)e * nrowsB + (size_t)pn * 256) * ROWB;
        if constexpr ((CRIP_ & 8) != 0) { u.aBase = A; u.bBase = Bt; }
        return true;
    }
};
}

struct EpiNoPre { };
struct EpiInProj {
    static constexpr bool PERM = true; typedef EpiNoPre Pre;
    bf16* proj; float* dtraw;
    __device__ __forceinline__ void prefetch(const pg8::Unit&, Pre&) const {}
    __device__ __forceinline__ void operator()(const f32x4 (&acc)[2][2][4][2], const pg8::Unit& u, const Pre&, int wr, int wc, int fr, int fq) const {
        const int row0 = u.pm * 256 + wr * 64 + fr;
        if (u.pn < 15) {
            const int col0 = u.pn * 256 + wc * 32 + 8 * fq;
#pragma unroll
            for (int ai = 0; ai < 2; ++ai)
#pragma unroll
                for (int m = 0; m < 4; ++m) { bf16* rowp = proj + (size_t)(row0 + ai * 128 + m * 16) * PROJ_LD + col0;
#pragma unroll
                    for (int bj = 0; bj < 2; ++bj) { const f32x4 v0 = acc[ai][bj][m][0], v1 = acc[ai][bj][m][1];
                        v4u w; w.x = pk2(v0[0], v0[1]); w.y = pk2(v0[2], v0[3]); w.z = pk2(v1[0], v1[1]); w.w = pk2(v1[2], v1[3]);
                        *(v4u*)(rowp + bj * 128) = w; } }
        } else if (wc == 0 && fq < 2) {
#pragma unroll
            for (int ai = 0; ai < 2; ++ai)
#pragma unroll
                for (int m = 0; m < 4; ++m) { float* rowp = dtraw + (size_t)(row0 + ai * 128 + m * 16) * 16 + 8 * fq;
                    *(f32x4*)(rowp) = acc[ai][0][m][0]; *(f32x4*)(rowp + 4) = acc[ai][0][m][1]; }
        }
    }
};
struct EpiOutProj {
    static constexpr bool PERM = true; typedef EpiNoPre Pre;
    const float* x; bf16* x1; float* ssq;
    __device__ __forceinline__ void prefetch(const pg8::Unit&, Pre&) const {}
    __device__ __forceinline__ void operator()(const f32x4 (&acc)[2][2][4][2], const pg8::Unit& u, const Pre&, int wr, int wc, int fr, int fq) const {
        const int row0 = u.pm * 256 + wr * 64 + fr, col0 = u.pn * 256 + wc * 32 + 8 * fq;
#pragma unroll
        for (int ai = 0; ai < 2; ++ai) {
            f32x4 xv[4][2][2];
#pragma unroll
            for (int m = 0; m < 4; ++m)
#pragma unroll
                for (int bj = 0; bj < 2; ++bj)
#pragma unroll
                    for (int n = 0; n < 2; ++n) xv[m][bj][n] = *(const f32x4*)(x + (size_t)(row0 + ai * 128 + m * 16) * D + col0 + bj * 128 + n * 4);
#pragma unroll
            for (int m = 0; m < 4; ++m) { asm volatile("" : "+v"(xv[m][0][0]), "+v"(xv[m][0][1]), "+v"(xv[m][1][0]), "+v"(xv[m][1][1])); }
#pragma unroll
            for (int m = 0; m < 4; ++m) { const int row = row0 + ai * 128 + m * 16; const size_t off = (size_t)row * D + col0; float s = 0.f;
#pragma unroll
                for (int bj = 0; bj < 2; ++bj) { const f32x4 o0 = xv[m][bj][0] + acc[ai][bj][m][0], o1 = xv[m][bj][1] + acc[ai][bj][m][1];
                    *(v4u*)(x1 + off + bj * 128) = (v4u){pk2(o0[0], o0[1]), pk2(o0[2], o0[3]), pk2(o1[0], o1[1]), pk2(o1[2], o1[3])};
                    s += ((o0[0] * o0[0] + o0[1] * o0[1]) + (o0[2] * o0[2] + o0[3] * o0[3])) + ((o1[0] * o1[0] + o1[1] * o1[1]) + (o1[2] * o1[2] + o1[3] * o1[3])); }
                s += __shfl_xor(s, 16); s += __shfl_xor(s, 32);
                if (fq == 0) ssq[(size_t)row * 32 + u.pn * 4 + wc] = s; }
        }
    }
};
struct EpiGateUp {
    static constexpr bool PERM = true;
    struct Pre { f32x4 bg[2], bu[2]; };
    unsigned char* hb; const float* b_gate; const float* b_up;
    __device__ __forceinline__ void prefetch(const pg8::Unit& u, Pre& q) const {
        int tz = threadIdx.x; asm volatile("" : "+v"(tz)); const int wc = (tz >> 6) & 3, fq = (tz >> 4) & 3;
        const int f0 = u.pn * 128 + wc * 32 + 8 * fq;
#pragma unroll
        for (int n = 0; n < 2; ++n) { q.bg[n] = *(const f32x4*)(b_gate + (size_t)u.e * FF + f0 + 4 * n); q.bu[n] = *(const f32x4*)(b_up + (size_t)u.e * FF + f0 + 4 * n); }
    }
    __device__ __forceinline__ void operator()(const f32x4 (&acc)[2][2][4][2], const pg8::Unit& u, const Pre& q, int wr, int wc, int fr, int fq) const {
        const int row0 = u.pm * 256 + wr * 64 + fr, f0 = u.pn * 128 + wc * 32 + 8 * fq;
        constexpr float DS = 1.0f / (FP8_SA * FP8_SW);
#pragma unroll
        for (int ai = 0; ai < 2; ++ai)
#pragma unroll
            for (int m = 0; m < 4; ++m) { unsigned char* rowp = hb + (size_t)(row0 + ai * 128 + m * 16) * FF + f0; float h[8];
#pragma unroll
                for (int n = 0; n < 2; ++n)
#pragma unroll
                    for (int j = 0; j < 4; ++j) { const float g = acc[ai][0][m][n][j] * DS + q.bg[n][j], up = acc[ai][1][m][n][j] * DS + q.bu[n][j];
                        const float gl = fminf(g, 7.0f), li = __builtin_amdgcn_fmed3f(up, -7.0f, 7.0f);
                        const float sg = __builtin_amdgcn_rcpf(1.0f + __builtin_amdgcn_exp2f(gl * (-1.702f * 1.44269504f)));
                        h[n * 4 + j] = (gl * sg) * (li * FP8_SH + FP8_SH); }
                *(v2u*)rowp = (v2u){pk4_fp8(h[0], h[1], h[2], h[3]), pk4_fp8(h[4], h[5], h[6], h[7])}; }
    }
};
struct EpiDown {
    static constexpr bool PERM = true;
    struct Pre { f32x4 bv[2][2]; float gt[2][4]; };
    unsigned char* y2; const float* b_down; const float* sgate; const LAS int* tstart;
    __device__ __forceinline__ void prefetch(const pg8::Unit& u, Pre& q) const {
        int tz = threadIdx.x; asm volatile("" : "+v"(tz)); const int wid = tz >> 6, wr = wid >> 2, wc = wid & 3, fr = tz & 15, fq = (tz >> 4) & 3;
        const int rl0 = wr * 64 + fr, col0 = u.pn * 256 + wc * 32 + 8 * fq;
        const int mt = __builtin_amdgcn_readfirstlane(u.pm - tstart[u.e]);
        const float* gp = sgate + (size_t)u.e * T + mt * 256;
#pragma unroll
        for (int bj = 0; bj < 2; ++bj)
#pragma unroll
            for (int n = 0; n < 2; ++n) q.bv[bj][n] = *(const f32x4*)(b_down + (size_t)u.e * D + col0 + bj * 128 + 4 * n);
#pragma unroll
        for (int ai = 0; ai < 2; ++ai)
#pragma unroll
            for (int m = 0; m < 4; ++m) q.gt[ai][m] = gp[rl0 + ai * 128 + m * 16];
    }
    __device__ __forceinline__ void operator()(const f32x4 (&acc)[2][2][4][2], const pg8::Unit& u, const Pre& q, int wr, int wc, int fr, int fq) const {
        const int rl0 = wr * 64 + fr, col0 = u.pn * 256 + wc * 32 + 8 * fq;
        constexpr float DS = 1.0f / (FP8_SH * FP8_SW);
#pragma unroll
        for (int ai = 0; ai < 2; ++ai)
#pragma unroll
            for (int m = 0; m < 4; ++m) { const int rl = rl0 + ai * 128 + m * 16; const float gt = q.gt[ai][m] * FP8_SY; unsigned char* rowp = y2 + (size_t)(u.pm * 256 + rl) * D + col0;
#pragma unroll
                for (int bj = 0; bj < 2; ++bj) { const f32x4 v0 = (acc[ai][bj][m][0] * DS + q.bv[bj][0]) * gt, v1 = (acc[ai][bj][m][1] * DS + q.bv[bj][1]) * gt;
                    *(v2u*)(rowp + bj * 128) = (v2u){pk4_fp8(sat8(v0[0]), sat8(v0[1]), sat8(v0[2]), sat8(v0[3])), pk4_fp8(sat8(v1[0]), sat8(v1[1]), sat8(v1[2]), sat8(v1[3]))}; } }
    }
};

__device__ __forceinline__ void p0_tr_item(const float* W, int ldw, int k0, int n0, int nvalid, bf16* WT, int dst_row0, LAS float* scr, int lane) {
    const int c4 = (lane & 15) * 4, kr = lane >> 4;
#pragma unroll 4
    for (int i = 0; i < 16; ++i) { const int kk = 4 * i + kr;
        f32x4 v = (f32x4){0.f, 0.f, 0.f, 0.f};
        if (c4 < nvalid) v = *(const f32x4*)(W + (size_t)(k0 + kk) * ldw + n0 + c4);
        LAS float* d = scr + kk * 65 + c4; d[0] = v[0]; d[1] = v[1]; d[2] = v[2]; d[3] = v[3]; }
    LDS_WAIT(); asm volatile("" ::: "memory");
    const int c = lane >> 3, np = lane & 7;
#pragma unroll
    for (int j = 0; j < 8; ++j) { const int n = 8 * j + np; const LAS float* s = scr + (8 * c) * 65 + n;
        v4u o; o.x = pk2(s[0 * 65], s[1 * 65]); o.y = pk2(s[2 * 65], s[3 * 65]); o.z = pk2(s[4 * 65], s[5 * 65]); o.w = pk2(s[6 * 65], s[7 * 65]);
        *(v4u*)(WT + (size_t)(dst_row0 + n) * 2048 + k0 + 8 * c) = o; }
    LDS_WAIT(); asm volatile("" ::: "memory");
}
__device__ __forceinline__ void f8_tile_load(const float* src, f32x4 (&v)[16], int lane) {
    const float* s0 = src + (size_t)(16 * (lane >> 3)) * 2048 + 4 * (lane & 7);
#pragma unroll
    for (int i = 0; i < 16; ++i) v[i] = __builtin_nontemporal_load((const f32x4*)(s0 + (size_t)i * 2048));
}
__device__ __forceinline__ void f8_tile_store(const f32x4 (&v)[16], unsigned char* dst, int lane) {
    unsigned d[16];
#pragma unroll
    for (int i = 0; i < 16; ++i) d[i] = pk4_fp8(sat8(v[i][0] * FP8_SW), sat8(v[i][1] * FP8_SW), sat8(v[i][2] * FP8_SW), sat8(v[i][3] * FP8_SW));
    unsigned o[4][4];
#pragma unroll
    for (int w = 0; w < 4; ++w) {
        const unsigned t0 = __builtin_amdgcn_perm(d[4 * w + 1], d[4 * w], 0x05010400u), t1 = __builtin_amdgcn_perm(d[4 * w + 1], d[4 * w], 0x07030602u);
        const unsigned t2 = __builtin_amdgcn_perm(d[4 * w + 3], d[4 * w + 2], 0x05010400u), t3 = __builtin_amdgcn_perm(d[4 * w + 3], d[4 * w + 2], 0x07030602u);
        o[0][w] = __builtin_amdgcn_perm(t2, t0, 0x05040100u); o[1][w] = __builtin_amdgcn_perm(t2, t0, 0x07060302u);
        o[2][w] = __builtin_amdgcn_perm(t3, t1, 0x05040100u); o[3][w] = __builtin_amdgcn_perm(t3, t1, 0x07060302u);
    }
    unsigned char* d0 = dst + (size_t)(4 * (lane & 7)) * 2048 + 16 * (lane >> 3);
#pragma unroll
    for (int b = 0; b < 4; ++b) __builtin_nontemporal_store((v4u){o[b][0], o[b][1], o[b][2], o[b][3]}, (v4u*)(d0 + (size_t)b * 2048));
}
__device__ __forceinline__ void f8_item(const Params& p, int it, const float*& src, unsigned char*& dst) {
    const int which = it >> 15, r = it & 32767, e = r >> 10, q = r & 1023, kb = q >> 6, nb = q & 63;
    if (which == 2) { src = p.w_down + (size_t)e * FF * D + (size_t)(kb * 128) * D + nb * 32; dst = p.ws + WS_WD + ((size_t)e * D + nb * 32) * 2048 + kb * 128; }
    else { const int f0 = nb * 32, drow = (f0 >> 7) * 256 + which * 128 + (f0 & 127);
        src = (which == 0 ? p.w_gate : p.w_up) + (size_t)e * D * FF + (size_t)(kb * 128) * FF + f0; dst = p.ws + WS_WGU + ((size_t)e * 4096 + drow) * 2048 + kb * 128; }
}
__device__ __forceinline__ void convert_experts(const Params& p, int first, int stride, int lane) {
    constexpr int NEXP = 3 * NE * 1024;
    f32x4 va[16], vb[16]; const float* sa; unsigned char* da; const float* sb; unsigned char* db;
    int ia = first, ib;
    if (ia < NEXP) { f8_item(p, ia, sa, da); f8_tile_load(sa, va, lane); }
    for (;;) {
        if (ia >= NEXP) break;
        ib = ia + stride; if (ib < NEXP) { f8_item(p, ib, sb, db); f8_tile_load(sb, vb, lane); }
        f8_tile_store(va, da, lane);
        if (ib >= NEXP) break;
        ia = ib + stride; if (ia < NEXP) { f8_item(p, ia, sa, da); f8_tile_load(sa, va, lane); }
        f8_tile_store(vb, db, lane);
    }
}
__device__ __forceinline__ void phase_prologue(const Params& p, LAS unsigned char* lds, int gw, int NGW, int wave, int lane) {
    LAS float* scr = (LAS float*)(lds + wave * 16896);
    bf16* WIN = (bf16*)(p.ws + WS_WIN); bf16* WOUT = (bf16*)(p.ws + WS_WOUT);
    constexpr int I_IN = 32 * 64, I_OUT = 32 * 32;
    for (int it = gw; it < I_IN + I_OUT; it += NGW) {
        int r = it;
        if (r < I_IN) { const int kb = r / 64, nb = r % 64; int nv = NIN - nb * 64; nv = nv < 0 ? 0 : (nv > 64 ? 64 : nv);
            p0_tr_item(p.w_in, NIN, kb * 64, nb * 64, nv, WIN, nb * 64, scr, lane); continue; }
        r -= I_IN;
        { const int kb = r / 32, nb = r % 32; p0_tr_item(p.w_out, D, kb * 64, nb * 64, 64, WOUT, nb * 64, scr, lane); }
    }
    {
        bf16* wrb = (bf16*)(p.ws + WS_WRB);
        for (int idx = gw * 64 + lane; idx < D * NE; idx += NGW * 64) { const int k = idx >> 5, n = idx & 31, j = k >> 5, kq = (k >> 3) & 3, m = k & 7, half = n >> 4, l64 = kq * 16 + (n & 15);
            const float w = p.w_router[idx]; const unsigned hi = f2bf(w); const float lo = w - bflo(hi);
            wrb[((((size_t)j * 2 + half) * 2 + 0) * 64 + l64) * 8 + m] = (bf16)hi; wrb[((((size_t)j * 2 + half) * 2 + 1) * 64 + l64) * 8 + m] = (bf16)f2bf(lo); }
    }
    bf16* HN = (bf16*)(p.ws + WS_HN);
    f32x4 gw4[8];
#pragma unroll
    for (int j = 0; j < 8; ++j) gw4[j] = *((const f32x4*)p.attn_norm_w + 64 * j + lane);
    f32x4 vn[8];
    if (gw < T) { const f32x4* xr = (const f32x4*)(p.x + (size_t)gw * D) + lane;
#pragma unroll
        for (int j = 0; j < 8; ++j) vn[j] = xr[64 * j]; }
    for (int m = gw; m < T; m += NGW) {
        f32x4 v[8]; float s = 0.f;
#pragma unroll
        for (int j = 0; j < 8; ++j) v[j] = vn[j];
        if (m + NGW < T) { const f32x4* xr = (const f32x4*)(p.x + (size_t)(m + NGW) * D) + lane;
#pragma unroll
            for (int j = 0; j < 8; ++j) vn[j] = xr[64 * j]; }
#pragma unroll
        for (int j = 0; j < 8; ++j) s += (v[j][0] * v[j][0] + v[j][1] * v[j][1]) + (v[j][2] * v[j][2] + v[j][3] * v[j][3]);
        const float rstd = rsqrtf(wave_sum(s) * (1.f / D) + EPS);
        v2u* o8 = (v2u*)(HN + (size_t)m * D) + lane;
#pragma unroll
        for (int j = 0; j < 8; ++j) { v2u w; w.x = pk2(v[j][0] * rstd * gw4[j][0], v[j][1] * rstd * gw4[j][1]); w.y = pk2(v[j][2] * rstd * gw4[j][2], v[j][3] * rstd * gw4[j][3]); o8[64 * j] = w; }
    }
}

__device__ __forceinline__ void phase_conv(const Params& p, int G) {
    const bf16* proj = (const bf16*)(p.ws + WS_PROJ); float* xbc = (float*)(p.ws + WS_XBC);
    const float* dtraw = (const float*)(p.ws + WS_DT); float* dts = (float*)(p.ws + WS_DTS);
    const int tid = threadIdx.x;
    for (int item = blockIdx.x; item < T / 64; item += G) {
        const int t0 = item * 64;
        if (tid < 384) {
            const int cg = tid % 192, half = tid / 192, c0 = cg * 8, ts = t0 + half * 32;
            float w[4][8], bb[8];
#pragma unroll
            for (int k = 0; k < 4; ++k)
#pragma unroll
                for (int j = 0; j < 8; ++j) w[k][j] = p.conv_w[k * NXBC + c0 + j];
#pragma unroll
            for (int j = 0; j < 8; ++j) bb[j] = p.conv_b[c0 + j];
            float r0[8], r1[8], r2[8];
            {
                const int tl = ts % SEQ;
                v4u q0 = (v4u){0u, 0u, 0u, 0u}, q1 = q0, q2 = q0;
                if (tl - 3 >= 0) q0 = *(const v4u*)(proj + (size_t)(ts - 3) * PROJ_LD + COL_XBC + c0);
                if (tl - 2 >= 0) q1 = *(const v4u*)(proj + (size_t)(ts - 2) * PROJ_LD + COL_XBC + c0);
                if (tl - 1 >= 0) q2 = *(const v4u*)(proj + (size_t)(ts - 1) * PROJ_LD + COL_XBC + c0);
                unpack8(q0, r0); unpack8(q1, r1); unpack8(q2, r2);
            }
            for (int i = 0; i < 32; ++i) {
                const int t = ts + i;
                const v4u q = *(const v4u*)(proj + (size_t)t * PROJ_LD + COL_XBC + c0);
                float r3[8]; unpack8(q, r3);
                float o[8];
#pragma unroll
                for (int j = 0; j < 8; ++j) { const float a = bb[j] + w[0][j] * r0[j] + w[1][j] * r1[j] + w[2][j] * r2[j] + w[3][j] * r3[j]; o[j] = a * fsigmoid(a); }
                float* dp = xbc + (size_t)t * NXBC + c0;
                *(f32x4*)dp = (f32x4){o[0], o[1], o[2], o[3]}; *(f32x4*)(dp + 4) = (f32x4){o[4], o[5], o[6], o[7]};
#pragma unroll
                for (int j = 0; j < 8; ++j) { r0[j] = r1[j]; r1[j] = r2[j]; r2[j] = r3[j]; }
            }
        } else {
            const int u = tid - 384;
#pragma unroll
            for (int i = 0; i < 8; ++i) { const int idx = u + 128 * i; const int t = t0 + (idx >> 4), h = idx & 15;
                const float v = dtraw[(size_t)t * 16 + h] + p.dt_bias[h];
                dts[(size_t)t * 16 + h] = fmaxf(v, 0.f) + log1pf(__expf(-fabsf(v))); }
        }
    }
}

__device__ __forceinline__ void phase_attn_simple(const Params& p, LAS unsigned char* lds, int G) {
    const bf16* proj = (const bf16*)(p.ws + WS_PROJ); float* att = (float*)(p.ws + WS_ATT);
    LAS float* Ks = (LAS float*)lds; LAS float* Vs = (LAS float*)(lds + 256 * 68 * 4);
    const int tid = threadIdx.x;
    for (int item = blockIdx.x; item < NB * 64 * 2; item += G) {
        const int b = item >> 7, n = (item >> 1) & 63, hk = item & 1;
        __syncthreads();
        {
            const int j = tid >> 1, hf = tid & 1, pos = n * 128 - 128 + j;
            float kv[32], vv[32];
            if (pos >= 0) {
                const bf16* kp = proj + (size_t)(b * SEQ + pos) * PROJ_LD + COL_K + hk * 64 + hf * 32;
                const bf16* vp = proj + (size_t)(b * SEQ + pos) * PROJ_LD + COL_V + hk * 64 + hf * 32;
#pragma unroll
                for (int c = 0; c < 4; ++c) { const v4u a = *(const v4u*)(kp + 8 * c), bq = *(const v4u*)(vp + 8 * c);
                    kv[8 * c + 0] = bflo(a.x); kv[8 * c + 1] = bfhi(a.x); kv[8 * c + 2] = bflo(a.y); kv[8 * c + 3] = bfhi(a.y); kv[8 * c + 4] = bflo(a.z); kv[8 * c + 5] = bfhi(a.z); kv[8 * c + 6] = bflo(a.w); kv[8 * c + 7] = bfhi(a.w);
                    vv[8 * c + 0] = bflo(bq.x); vv[8 * c + 1] = bfhi(bq.x); vv[8 * c + 2] = bflo(bq.y); vv[8 * c + 3] = bfhi(bq.y); vv[8 * c + 4] = bflo(bq.z); vv[8 * c + 5] = bfhi(bq.z); vv[8 * c + 6] = bflo(bq.w); vv[8 * c + 7] = bfhi(bq.w); }
            } else {
#pragma unroll
                for (int d = 0; d < 32; ++d) { kv[d] = 0.f; vv[d] = 0.f; }
            }
            float s = 0.f;
#pragma unroll
            for (int d = 0; d < 32; ++d) s += kv[d] * kv[d];
            s += __shfl_xor(s, 1);
            const float rstd = rsqrtf(s * (1.f / 64.f) + EPS);
#pragma unroll
            for (int d = 0; d < 32; ++d) { Ks[j * 68 + hf * 32 + d] = kv[d] * rstd * p.k_norm_w[hf * 32 + d]; Vs[j * 68 + hf * 32 + d] = vv[d]; }
        }
        __syncthreads();
        const int qi = tid & 127, grp = tid >> 7;
        const int tok = b * SEQ + n * 128 + qi;
        for (int hh = 0; hh < 2; ++hh) {
            const int hq = hk * 8 + grp * 2 + hh;
            float q[64];
            {
                const bf16* qp = proj + (size_t)tok * PROJ_LD + COL_Q + hq * 64;
                float s = 0.f;
#pragma unroll
                for (int c = 0; c < 8; ++c) { const v4u a = *(const v4u*)(qp + 8 * c);
                    q[8 * c + 0] = bflo(a.x); q[8 * c + 1] = bfhi(a.x); q[8 * c + 2] = bflo(a.y); q[8 * c + 3] = bfhi(a.y); q[8 * c + 4] = bflo(a.z); q[8 * c + 5] = bfhi(a.z); q[8 * c + 6] = bflo(a.w); q[8 * c + 7] = bfhi(a.w); }
#pragma unroll
                for (int d = 0; d < 64; ++d) s += q[d] * q[d];
                const float rstd = rsqrtf(s * (1.f / 64.f) + EPS) * 0.125f;
#pragma unroll
                for (int d = 0; d < 64; ++d) q[d] = q[d] * rstd * p.q_norm_w[d];
            }
            float mx = p.sinks[hq], l = 1.0f, o[64];
#pragma unroll
            for (int d = 0; d < 64; ++d) o[d] = 0.f;
            const int jlo = (n == 0) ? 128 : qi + 1;
            for (int j = jlo; j <= qi + 128; ++j) {
                const LAS f32x4* kr = (const LAS f32x4*)(Ks + j * 68);
                float s = 0.f;
#pragma unroll
                for (int c = 0; c < 16; ++c) { const f32x4 kk = kr[c]; s += q[4 * c] * kk[0] + q[4 * c + 1] * kk[1] + q[4 * c + 2] * kk[2] + q[4 * c + 3] * kk[3]; }
                const float mn = fmaxf(mx, s), corr = __expf(mx - mn), pj = __expf(s - mn);
                l = l * corr + pj; mx = mn;
                const LAS f32x4* vr = (const LAS f32x4*)(Vs + j * 68);
#pragma unroll
                for (int c = 0; c < 16; ++c) { const f32x4 vv = vr[c]; o[4 * c] = o[4 * c] * corr + pj * vv[0]; o[4 * c + 1] = o[4 * c + 1] * corr + pj * vv[1]; o[4 * c + 2] = o[4 * c + 2] * corr + pj * vv[2]; o[4 * c + 3] = o[4 * c + 3] * corr + pj * vv[3]; }
            }
            const float inv = 1.0f / l;
            float* op = att + (size_t)tok * 1024 + hq * 64;
#pragma unroll
            for (int c = 0; c < 16; ++c) *(f32x4*)(op + 4 * c) = (f32x4){o[4 * c] * inv, o[4 * c + 1] * inv, o[4 * c + 2] * inv, o[4 * c + 3] * inv};
        }
    }
}

__device__ __forceinline__ void phase_ssd_seq(const Params& p, LAS unsigned char* lds, int G) {
    const float* xbc = (const float*)(p.ws + WS_XBC); const float* dts = (const float*)(p.ws + WS_DTS); float* ys = (float*)(p.ws + WS_YS);
    constexpr int TT = 64;
    LAS float* Bs = (LAS float*)lds;
    LAS float* Cs = Bs + TT * 128;
    LAS float* xs = Cs + TT * 128;
    LAS float* dl = xs + TT * 16;
    LAS float* yo = dl + TT;
    const int tid = threadIdx.x, pl = tid >> 5, ns = tid & 31;
    for (int item = blockIdx.x; item < NB * 16 * 4; item += G) {
        const int b = item >> 6, h = (item >> 2) & 15, pq = item & 3, g = h >> 3;
        const float a = -__expf(p.a_log[h]), dsk = p.d_skip[h];
        f32x4 st = (f32x4){0.f, 0.f, 0.f, 0.f};
        for (int tc = 0; tc < SEQ; tc += TT) {
            __syncthreads();
            const size_t tb = (size_t)b * SEQ + tc;
            for (int i = tid; i < TT * 32; i += NTHREADS) { const int tt = i >> 5, c = (i & 31) * 4;
                *(LAS f32x4*)(Bs + tt * 128 + c) = *(const f32x4*)(xbc + (tb + tt) * NXBC + 1024 + g * 128 + c);
                *(LAS f32x4*)(Cs + tt * 128 + c) = *(const f32x4*)(xbc + (tb + tt) * NXBC + 1280 + g * 128 + c); }
            for (int i = tid; i < TT * 16; i += NTHREADS) { const int tt = i >> 4, c = i & 15; xs[i] = xbc[(tb + tt) * NXBC + h * 64 + pq * 16 + c]; }
            if (tid < TT) dl[tid] = dts[(tb + tid) * 16 + h];
            __syncthreads();
            for (int tt = 0; tt < TT; ++tt) {
                const float dt = dl[tt], xv = xs[tt * 16 + pl];
                const float dA = __expf(dt * a), xd = xv * dt;
                const f32x4 bv = *(const LAS f32x4*)(Bs + tt * 128 + ns * 4), cv = *(const LAS f32x4*)(Cs + tt * 128 + ns * 4);
                st = st * dA + bv * xd;
                float y = (cv[0] * st[0] + cv[1] * st[1]) + (cv[2] * st[2] + cv[3] * st[3]);
                y += __shfl_xor(y, 1); y += __shfl_xor(y, 2); y += __shfl_xor(y, 4); y += __shfl_xor(y, 8); y += __shfl_xor(y, 16);
                if (ns == 0) yo[tt * 16 + pl] = y + dsk * xv;
            }
            __syncthreads();
            for (int i = tid; i < TT * 16; i += NTHREADS) { const int tt = i >> 4, c = i & 15; ys[(tb + tt) * 1024 + h * 64 + pq * 16 + c] = yo[i]; }
        }
    }
}


typedef float f32x16 __attribute__((ext_vector_type(16)));
#define MFMA32(a, b, c) __builtin_amdgcn_mfma_f32_32x32x16_bf16(a, b, c, 0, 0, 0)
constexpr int SPT = 136;
__device__ __forceinline__ float softplus_f(float v) { return fmaxf(v, 0.f) + log1pf(__expf(-fabsf(v))); }

__device__ __forceinline__ void ssd_tables(const Params& p, LAS float* dtl, LAS float* csl, LAS float* wtot, size_t trow0, int h0, int nh, int lane, int wave) {
    const float* dtraw = (const float*)(p.ws + WS_DT);
    for (int rnd = 0; rnd < nh / 4; ++rnd) {
        const int hh = rnd * 4 + (wave >> 1), l = (wave & 1) * 64 + lane, h = h0 + hh;
        const float dt = softplus_f(dtraw[(trow0 + l) * 16 + h] + p.dt_bias[h]);
        float v = dt * (-expf(p.a_log[h]));
#pragma unroll
        for (int o = 1; o < 64; o <<= 1) { const float u = __shfl_up(v, o); v = (lane >= o) ? v + u : v; }
        if (lane == 63) wtot[rnd * 8 + wave] = v;
        __syncthreads();
        if (wave & 1) v += wtot[rnd * 8 + wave - 1];
        dtl[hh * 128 + l] = dt; csl[hh * 128 + l] = v;
    }
    __syncthreads();
}
template <bool TR, bool SCALE>
__device__ __forceinline__ void conv_task(const Params& p, const bf16* proj, size_t trow0, int tl0, int run, int xcol, LAS bf16* dst, int d0, const LAS float* sc) {
    float w[4][8], bb[8];
#pragma unroll
    for (int k = 0; k < 4; ++k) { const f32x4 a = *(const f32x4*)(p.conv_w + k * NXBC + xcol), b = *(const f32x4*)(p.conv_w + k * NXBC + xcol + 4);
        w[k][0] = a[0]; w[k][1] = a[1]; w[k][2] = a[2]; w[k][3] = a[3]; w[k][4] = b[0]; w[k][5] = b[1]; w[k][6] = b[2]; w[k][7] = b[3]; }
    { const f32x4 a = *(const f32x4*)(p.conv_b + xcol), b = *(const f32x4*)(p.conv_b + xcol + 4); bb[0] = a[0]; bb[1] = a[1]; bb[2] = a[2]; bb[3] = a[3]; bb[4] = b[0]; bb[5] = b[1]; bb[6] = b[2]; bb[7] = b[3]; }
    const int l0 = run * 8; const bf16* src = proj + (trow0 + l0) * PROJ_LD + COL_XBC + xcol;
    float r0[8], r1[8], r2[8];
    { const int pos = tl0 + l0; v4u q0 = (v4u){0u, 0u, 0u, 0u}, q1 = q0, q2 = q0;
      if (pos - 3 >= 0) q0 = *(const v4u*)(src - 3 * PROJ_LD);
      if (pos - 2 >= 0) q1 = *(const v4u*)(src - 2 * PROJ_LD);
      if (pos - 1 >= 0) q2 = *(const v4u*)(src - 1 * PROJ_LD);
      unpack8(q0, r0); unpack8(q1, r1); unpack8(q2, r2); }
#pragma unroll
    for (int i = 0; i < 8; i += 2) {
        float r3[8], r4[8], o0[8], o1[8];
        unpack8(*(const v4u*)(src + (size_t)i * PROJ_LD), r3); unpack8(*(const v4u*)(src + (size_t)(i + 1) * PROJ_LD), r4);
#pragma unroll
        for (int j = 0; j < 8; ++j) { const float a0 = bb[j] + w[0][j] * r0[j] + w[1][j] * r1[j] + w[2][j] * r2[j] + w[3][j] * r3[j];
            const float a1 = bb[j] + w[0][j] * r1[j] + w[1][j] * r2[j] + w[2][j] * r3[j] + w[3][j] * r4[j];
            o0[j] = a0 * fsigmoid(a0); o1[j] = a1 * fsigmoid(a1); }
        if constexpr (TR) {
            float s0 = 1.f, s1 = 1.f; if constexpr (SCALE) { s0 = sc[l0 + i]; s1 = sc[l0 + i + 1]; }
#pragma unroll
            for (int j = 0; j < 8; ++j) *(LAS unsigned*)(dst + (d0 + j) * SPT + l0 + i) = pk2(o0[j] * s0, o1[j] * s1);
        } else {
            *(LAS v4u*)(dst + (l0 + i) * SPT + d0) = (v4u){pk2(o0[0], o0[1]), pk2(o0[2], o0[3]), pk2(o0[4], o0[5]), pk2(o0[6], o0[7])};
            *(LAS v4u*)(dst + (l0 + i + 1) * SPT + d0) = (v4u){pk2(o1[0], o1[1]), pk2(o1[2], o1[3]), pk2(o1[4], o1[5]), pk2(o1[6], o1[7])};
        }
#pragma unroll
        for (int j = 0; j < 8; ++j) { r0[j] = r2[j]; r1[j] = r3[j]; r2[j] = r4[j]; }
    }
}

__device__ __forceinline__ void phase_ssd_states(const Params& p, LAS unsigned char* lds, int G, int lane, int wave) {
    const bf16* proj = (const bf16*)(p.ws + WS_PROJ); float* states = (float*)(p.ws + WS_STATES); float* cdec = (float*)(p.ws + WS_CDEC);
    LAS bf16* BT = (LAS bf16*)lds;
    LAS bf16* XdT = BT + 128 * SPT;
    LAS float* dtl = (LAS float*)(lds + 384 * SPT * 2);
    LAS float* csl = dtl + 512; LAS float* scl = csl + 512; LAS float* wtot = scl + 512;
    const int tid = threadIdx.x, r = lane & 31, hf = lane >> 5;
    for (int item = blockIdx.x; item < NB * 64 * 4; item += G) {
        const int b = item >> 8, c = (item >> 2) & 63, g = (item >> 1) & 1, hh2 = item & 1;
        const int h0 = g * 8 + hh2 * 4; const size_t trow0 = (size_t)b * SEQ + c * 128; const int tl0 = c * 128;
        __syncthreads();
        ssd_tables(p, dtl, csl, wtot, trow0, h0, 4, lane, wave);
        scl[tid] = dtl[tid] * __expf(csl[(tid & ~127) + 127] - csl[tid]);
        if ((tid & 127) == 127) cdec[((size_t)b * 64 + c) * 16 + h0 + (tid >> 7)] = __expf(csl[tid]);
        __syncthreads();
        for (int task = tid; task < 48 * 16; task += NTHREADS) { const int cg = task >> 4, run = task & 15;
            if (cg < 16) conv_task<true, false>(p, proj, trow0, tl0, run, 1024 + g * 128 + cg * 8, BT, cg * 8, nullptr);
            else { const int cx = cg - 16; conv_task<true, true>(p, proj, trow0, tl0, run, h0 * 64 + cx * 8, XdT, cx * 8, scl + (cx >> 3) * 128); } }
        __syncthreads();
        const int hh = wave >> 1, nh_ = wave & 1;
        f32x16 acc[2][2];
#pragma unroll
        for (int a = 0; a < 2; ++a)
#pragma unroll
            for (int bq = 0; bq < 2; ++bq)
#pragma unroll
                for (int e = 0; e < 16; ++e) acc[a][bq][e] = 0.f;
#pragma unroll
        for (int ks = 0; ks < 8; ++ks) {
            bf16x8 af[2], bfm[2];
#pragma unroll
            for (int pt = 0; pt < 2; ++pt) af[pt] = *(const LAS bf16x8*)(XdT + (hh * 64 + pt * 32 + r) * SPT + ks * 16 + 8 * hf);
#pragma unroll
            for (int nt = 0; nt < 2; ++nt) bfm[nt] = *(const LAS bf16x8*)(BT + (nh_ * 64 + nt * 32 + r) * SPT + ks * 16 + 8 * hf);
#pragma unroll
            for (int pt = 0; pt < 2; ++pt)
#pragma unroll
                for (int nt = 0; nt < 2; ++nt) acc[pt][nt] = MFMA32(af[pt], bfm[nt], acc[pt][nt]);
        }
        float* sp = states + (((size_t)b * 64 + c) * 16 + h0 + hh) * 64 * 128;
#pragma unroll
        for (int pt = 0; pt < 2; ++pt)
#pragma unroll
            for (int nt = 0; nt < 2; ++nt)
#pragma unroll
                for (int e = 0; e < 16; ++e) sp[(pt * 32 + (e & 3) + 8 * (e >> 2) + 4 * hf) * 128 + nh_ * 64 + nt * 32 + r] = acc[pt][nt][e];
    }
}
__device__ __forceinline__ void phase_ssd_scan(const Params& p, int G) {
    const float* states = (const float*)(p.ws + WS_STATES); const float* cdec = (const float*)(p.ws + WS_CDEC); bf16* sin = (bf16*)(p.ws + WS_SIN);
    for (int idx = blockIdx.x * NTHREADS + threadIdx.x; idx < NB * 16 * 64 * 32; idx += G * NTHREADS) {
        const int n4 = idx & 31, pp = (idx >> 5) & 63, h = (idx >> 11) & 15, b = idx >> 15;
        f32x4 run = (f32x4){0.f, 0.f, 0.f, 0.f};
#pragma unroll 8
        for (int c = 0; c < 64; ++c) {
            const size_t off = ((((size_t)b * 64 + c) * 16 + h) * 64 + pp) * 128 + n4 * 4;
            const f32x4 st = *(const f32x4*)(states + off); const float dec = cdec[((size_t)b * 64 + c) * 16 + h];
            *(v2u*)(sin + off) = (v2u){pk2(run[0], run[1]), pk2(run[2], run[3])};
            run = run * dec + st;
        }
    }
}
__device__ __forceinline__ void ssd_out_pass(const Params& p, const bf16* proj, const bf16* sinp  , const LAS bf16* Cs, const LAS bf16* CB, const LAS bf16* XT,
                                             const LAS float* dth, const LAS float* csh  , LAS float* ssqh  , float Dh, size_t trow0, int h, int hh, int lsel, int r, int hf,
                                             unsigned (&yp)[2][2][8]) {
    f32x16 acc[2][2];
#pragma unroll
    for (int a = 0; a < 2; ++a)
#pragma unroll
        for (int bq = 0; bq < 2; ++bq)
#pragma unroll
            for (int e = 0; e < 16; ++e) acc[a][bq][e] = 0.f;
#pragma unroll
    for (int pt = 0; pt < 2; ++pt) {
        bf16x8 af[8];
#pragma unroll
        for (int ks = 0; ks < 8; ++ks) af[ks] = *(const bf16x8*)(sinp + (pt * 32 + r) * 128 + ks * 16 + 8 * hf);
#pragma unroll
        for (int j = 0; j < 2; ++j) { const int lt = j == 0 ? (lsel ? 1 : 0) : (lsel ? 2 : 3);
#pragma unroll
            for (int ks = 0; ks < 8; ++ks) { const bf16x8 bq = *(const LAS bf16x8*)(Cs + (lt * 32 + r) * SPT + ks * 16 + 8 * hf); acc[pt][j] = MFMA32(af[ks], bq, acc[pt][j]); } }
    }
#pragma unroll
    for (int j = 0; j < 2; ++j) { const int lt = j == 0 ? (lsel ? 1 : 0) : (lsel ? 2 : 3); const float el = __expf(csh[lt * 32 + r]);
#pragma unroll
        for (int pt = 0; pt < 2; ++pt) acc[pt][j] = acc[pt][j] * el; }
#pragma unroll
    for (int j = 0; j < 2; ++j) { const int lt = j == 0 ? (lsel ? 1 : 0) : (lsel ? 2 : 3); const int lcol = lt * 32 + r; const float csL = csh[lcol]; const int nks = 2 * lt + 2;
        for (int ks = 0; ks < nks; ++ks) { const int s0 = ks * 16 + 8 * hf;
            const v4u cbv = *(const LAS v4u*)(CB + lcol * SPT + s0);
            const f32x4 c0 = *(const LAS f32x4*)(csh + s0), c1 = *(const LAS f32x4*)(csh + s0 + 4), d0 = *(const LAS f32x4*)(dth + s0), d1 = *(const LAS f32x4*)(dth + s0 + 4);
            float cbf[8]; unpack8(cbv, cbf); float m[8];
#pragma unroll
            for (int jj = 0; jj < 8; ++jj) { const float cs_s = jj < 4 ? c0[jj & 3] : c1[jj & 3], dt_s = jj < 4 ? d0[jj & 3] : d1[jj & 3];
                float v = cbf[jj] * __expf(fminf(csL - cs_s, 0.f)) * dt_s; v = (s0 + jj <= lcol) ? v : 0.f; m[jj] = (s0 + jj == lcol) ? v + Dh : v; }
            v4u mp; mp.x = pk2(m[0], m[1]); mp.y = pk2(m[2], m[3]); mp.z = pk2(m[4], m[5]); mp.w = pk2(m[6], m[7]);
            const bf16x8 mf = __builtin_bit_cast(bf16x8, mp);
#pragma unroll
            for (int pt = 0; pt < 2; ++pt) { const bf16x8 a = *(const LAS bf16x8*)(XT + (hh * 64 + pt * 32 + r) * SPT + s0); acc[pt][j] = MFMA32(a, mf, acc[pt][j]); }
        } }
#pragma unroll
    for (int j = 0; j < 2; ++j) { const int lt = j == 0 ? (lsel ? 1 : 0) : (lsel ? 2 : 3); const size_t t = trow0 + lt * 32 + r; float ss = 0.f;
#pragma unroll
        for (int pt = 0; pt < 2; ++pt)
#pragma unroll
            for (int q = 0; q < 4; ++q) { const v2u zz = *(const v2u*)(proj + t * PROJ_LD + COL_Z + h * 64 + pt * 32 + 8 * q + 4 * hf);
                const float z0 = bflo(zz.x), z1 = bfhi(zz.x), z2 = bflo(zz.y), z3 = bfhi(zz.y);
                const float g0 = acc[pt][j][4 * q] * (z0 * fsigmoid(z0)), g1 = acc[pt][j][4 * q + 1] * (z1 * fsigmoid(z1)), g2 = acc[pt][j][4 * q + 2] * (z2 * fsigmoid(z2)), g3 = acc[pt][j][4 * q + 3] * (z3 * fsigmoid(z3));
                yp[pt][j][2 * q] = pk2(g0, g1); yp[pt][j][2 * q + 1] = pk2(g2, g3);
                ss += (g0 * g0 + g1 * g1) + (g2 * g2 + g3 * g3); }
        ss += __shfl_xor(ss, 32);
        if (hf == 0) ssqh[lt * 32 + r] = ss; }
}
__device__ __forceinline__ void ssd_out_store(const Params& p, bf16* mix, const LAS float* ssqp, size_t trow0, int h, int lsel, int r, int hf, const unsigned (&yp)[2][2][8]) {
    f32x4 w4[2][4];
#pragma unroll
    for (int pt = 0; pt < 2; ++pt)
#pragma unroll
        for (int q = 0; q < 4; ++q) w4[pt][q] = *(const f32x4*)(p.ssm_norm_w + h * 64 + pt * 32 + 8 * q + 4 * hf);
#pragma unroll
    for (int pt = 0; pt < 2; ++pt) { asm volatile("" : "+v"(w4[pt][0]), "+v"(w4[pt][1]), "+v"(w4[pt][2]), "+v"(w4[pt][3])); }
#pragma unroll
    for (int j = 0; j < 2; ++j) { const int lt = j == 0 ? (lsel ? 1 : 0) : (lsel ? 2 : 3); const int l = lt * 32 + r; const size_t t = trow0 + l;
        float tot = 0.f;
#pragma unroll
        for (int hd = 0; hd < 8; ++hd) tot += ssqp[hd * 128 + l];
        const float rstd = rsqrtf(tot * (1.f / 512.f) + EPS);
#pragma unroll
        for (int pt = 0; pt < 2; ++pt)
#pragma unroll
            for (int q = 0; q < 4; ++q) { const int col = h * 64 + pt * 32 + 8 * q + 4 * hf;
                const unsigned u0 = yp[pt][j][2 * q], u1 = yp[pt][j][2 * q + 1];
                v2u o; o.x = pk2(bflo(u0) * rstd * w4[pt][q][0], bfhi(u0) * rstd * w4[pt][q][1]); o.y = pk2(bflo(u1) * rstd * w4[pt][q][2], bfhi(u1) * rstd * w4[pt][q][3]);
                *(v2u*)(mix + t * D + 1024 + col) = o; } }
}
__device__ __forceinline__ void phase_ssd_out(const Params& p, LAS unsigned char* lds, int G, int lane, int wave) {
    const bf16* proj = (const bf16*)(p.ws + WS_PROJ); const bf16* sin = (const bf16*)(p.ws + WS_SIN); bf16* mix = (bf16*)(p.ws + WS_MIX);
    LAS bf16* Cs = (LAS bf16*)lds;
    LAS bf16* Bs = Cs + 128 * SPT;
    LAS bf16* XT = Bs + 128 * SPT;
    LAS float* dtl = (LAS float*)(lds + 512 * SPT * 2);
    LAS float* csl = dtl + 1024; LAS float* ssqp = csl + 1024; LAS float* wtot = ssqp + 1024;
    const int tid = threadIdx.x, r = lane & 31, hf = lane >> 5;
    for (int item = blockIdx.x; item < NB * 64 * 2; item += G) {
        const int b = item >> 7, c = (item >> 1) & 63, g = item & 1;
        const int h0 = g * 8; const size_t trow0 = (size_t)b * SEQ + c * 128; const int tl0 = c * 128;
        __syncthreads();
        { int tz_ = threadIdx.x; asm volatile("" : "+v"(tz_)); ssd_tables(p, dtl, csl, wtot, trow0, h0, 8, tz_ & 63, __builtin_amdgcn_readfirstlane(tz_ >> 6)); }
        int tq = threadIdx.x; asm volatile("" : "+v"(tq));
        for (int task = tq; task < 64 * 16; task += NTHREADS) { const int cg = task >> 4, run = task & 15;
            if (cg < 16) conv_task<false, false>(p, proj, trow0, tl0, run, 1280 + g * 128 + cg * 8, Cs, cg * 8, nullptr);
            else if (cg < 32) conv_task<false, false>(p, proj, trow0, tl0, run, 1024 + g * 128 + (cg - 16) * 8, Bs, (cg - 16) * 8, nullptr);
            else conv_task<true, false>(p, proj, trow0, tl0, run, h0 * 64 + (cg - 32) * 8, XT, (cg - 32) * 8, nullptr); }
        __syncthreads();
        {
            int tz_ = threadIdx.x; asm volatile("" : "+v"(tz_)); const int wave = __builtin_amdgcn_readfirstlane(tz_ >> 6), r = tz_ & 31, hf = (tz_ >> 5) & 1;
            f32x16 cb[2];
#pragma unroll
            for (int q = 0; q < 2; ++q) { const int tile = 2 * wave + q, lt = tile >> 2, st = tile & 3;
#pragma unroll
                for (int e = 0; e < 16; ++e) cb[q][e] = 0.f;
                if (st <= lt) {
#pragma unroll
                    for (int ks = 0; ks < 8; ++ks) { const bf16x8 a = *(const LAS bf16x8*)(Cs + (lt * 32 + r) * SPT + ks * 16 + 8 * hf), bq = *(const LAS bf16x8*)(Bs + (st * 32 + r) * SPT + ks * 16 + 8 * hf);
                        cb[q] = MFMA32(a, bq, cb[q]); } } }
            __syncthreads();
#pragma unroll
            for (int q = 0; q < 2; ++q) { const int tile = 2 * wave + q, lt = tile >> 2, st = tile & 3;
                if (st <= lt) {
#pragma unroll
                    for (int e = 0; e < 16; ++e) Bs[(lt * 32 + (e & 3) + 8 * (e >> 2) + 4 * hf) * SPT + st * 32 + r] = (bf16)f2bf(cb[q][e]); } }
        }
        __syncthreads();
        unsigned y0[2][2][8], y1[2][2][8];
#define FRESH_IDS() int tz_ = threadIdx.x; asm volatile("" : "+v"(tz_)); const int wv_ = __builtin_amdgcn_readfirstlane(tz_ >> 6), hh = wv_ >> 1, lsel = wv_ & 1, r_ = tz_ & 31, hf_ = (tz_ >> 5) & 1
        { FRESH_IDS(); const int h = h0 + hh;
          ssd_out_pass(p, proj, sin + (((size_t)b * 64 + c) * 16 + h) * 64 * 128, Cs, Bs, XT, dtl + hh * 128, csl + hh * 128, ssqp + hh * 128, p.d_skip[h], trow0, h, hh, lsel, r_, hf_, y0); }
        __syncthreads();
        { int tz_ = threadIdx.x; asm volatile("" : "+v"(tz_)); const int cg = tz_ >> 4, run = tz_ & 15; conv_task<true, false>(p, proj, trow0, tl0, run, (h0 + 4) * 64 + cg * 8, XT, cg * 8, nullptr); }
        __syncthreads();
        { FRESH_IDS(); const int h = h0 + 4 + hh;
          ssd_out_pass(p, proj, sin + (((size_t)b * 64 + c) * 16 + h) * 64 * 128, Cs, Bs, XT, dtl + (4 + hh) * 128, csl + (4 + hh) * 128, ssqp + (4 + hh) * 128, p.d_skip[h], trow0, h, hh, lsel, r_, hf_, y1); }
        __syncthreads();
        { FRESH_IDS(); ssd_out_store(p, mix, ssqp, trow0, h0 + hh, lsel, r_, hf_, y0); }
        { FRESH_IDS(); ssd_out_store(p, mix, ssqp, trow0, h0 + 4 + hh, lsel, r_, hf_, y1); }
#undef FRESH_IDS
    }
}


__device__ __forceinline__ void phase_attn(const Params& p, LAS unsigned char* lds, int G) {
    const bf16* proj = (const bf16*)(p.ws + WS_PROJ); bf16* mix = (bf16*)(p.ws + WS_MIX);
    constexpr int KP = 72, VP = 260; constexpr float NEG = -1.0e30f;
    LAS bf16* Ks = (LAS bf16*)lds;
    LAS bf16* VT = Ks + 2 * 256 * KP;
    LAS float* ssqp = (LAS float*)(lds + 2 * 256 * KP * 2 + 2 * 64 * VP * 2);
    for (int item = blockIdx.x; item < NB * 64; item += G) {
        const int b = item >> 6, n = item & 63;
        __syncthreads();
        {
            int tz = threadIdx.x; asm volatile("" : "+v"(tz));
            const int j = tz >> 1, hk = tz & 1, pos = n * 128 - 128 + j;
            LAS bf16* kd = Ks + (hk * 256 + j) * KP; LAS bf16* vd = VT + hk * 64 * VP + j;
            if (pos >= 0) {
                const bf16* kp = proj + (size_t)(b * SEQ + pos) * PROJ_LD + COL_K + hk * 64;
                v4u kq[8]; float ss = 0.f;
#pragma unroll
                for (int c = 0; c < 8; ++c) { kq[c] = *(const v4u*)(kp + 8 * c); float f[8]; unpack8(kq[c], f);
#pragma unroll
                    for (int e = 0; e < 8; ++e) ss += f[e] * f[e]; }
                const float rstd = rsqrtf(ss * (1.f / 64.f) + EPS);
#pragma unroll
                for (int c = 0; c < 8; ++c) { float f[8]; unpack8(kq[c], f); const f32x4 w0 = *(const f32x4*)(p.k_norm_w + 8 * c), w1 = *(const f32x4*)(p.k_norm_w + 8 * c + 4);
                    *(LAS v4u*)(kd + 8 * c) = (v4u){pk2(f[0] * rstd * w0[0], f[1] * rstd * w0[1]), pk2(f[2] * rstd * w0[2], f[3] * rstd * w0[3]), pk2(f[4] * rstd * w1[0], f[5] * rstd * w1[1]), pk2(f[6] * rstd * w1[2], f[7] * rstd * w1[3])}; }
                const bf16* vp = kp + (COL_V - COL_K);
#pragma unroll
                for (int c = 0; c < 8; ++c) { const v4u q = *(const v4u*)(vp + 8 * c);
                    vd[(8 * c + 0) * VP] = (bf16)(q.x & 0xffffu); vd[(8 * c + 1) * VP] = (bf16)(q.x >> 16); vd[(8 * c + 2) * VP] = (bf16)(q.y & 0xffffu); vd[(8 * c + 3) * VP] = (bf16)(q.y >> 16);
                    vd[(8 * c + 4) * VP] = (bf16)(q.z & 0xffffu); vd[(8 * c + 5) * VP] = (bf16)(q.z >> 16); vd[(8 * c + 6) * VP] = (bf16)(q.w & 0xffffu); vd[(8 * c + 7) * VP] = (bf16)(q.w >> 16); }
            } else {
#pragma unroll
                for (int c = 0; c < 8; ++c) *(LAS v4u*)(kd + 8 * c) = (v4u){0u, 0u, 0u, 0u};
#pragma unroll
                for (int d = 0; d < 64; ++d) vd[d * VP] = (bf16)0;
            }
        }
        __syncthreads();
        {
            int tz = threadIdx.x; asm volatile("" : "+v"(tz));
            const int wave = __builtin_amdgcn_readfirstlane(tz >> 6), r = tz & 31, hf = (tz >> 5) & 1, hk = wave >> 2, wl = wave & 3;
            const LAS bf16* Kh = Ks + hk * 256 * KP; const LAS bf16* Vh = VT + hk * 64 * VP;
            f32x4 qw[4][2];
#pragma unroll
            for (int ks = 0; ks < 4; ++ks) { qw[ks][0] = *(const f32x4*)(p.q_norm_w + 16 * ks + 8 * hf); qw[ks][1] = *(const f32x4*)(p.q_norm_w + 16 * ks + 8 * hf + 4); }
            v4u qn[4];
            { const bf16* qp0 = proj + ((size_t)b * SEQ + n * 128 + r) * PROJ_LD + COL_Q + (hk * 8 + wl * 2) * 64 + 8 * hf;
#pragma unroll
              for (int ks = 0; ks < 4; ++ks) qn[ks] = *(const v4u*)(qp0 + 16 * ks); }
            for (int it = 0; it < 8; ++it) {
                const int hsel = it >> 2, qt = it & 3;
                const int hq = hk * 8 + wl * 2 + hsel; const float sink = p.sinks[hq] * 1.44269504f;
                {
                    const size_t tok = (size_t)b * SEQ + n * 128 + qt * 32 + r;
                    bf16x8 qf[4];
                    {
                        v4u qv[4]; float ss = 0.f;
#pragma unroll
                        for (int ks = 0; ks < 4; ++ks) { qv[ks] = qn[ks]; float f[8]; unpack8(qv[ks], f);
#pragma unroll
                            for (int e = 0; e < 8; ++e) ss += f[e] * f[e]; }
                        if (it < 7) { const int it2 = it + 1, hq2 = hk * 8 + wl * 2 + (it2 >> 2);
                            const bf16* qp2 = proj + ((size_t)b * SEQ + n * 128 + (it2 & 3) * 32 + r) * PROJ_LD + COL_Q + hq2 * 64 + 8 * hf;
#pragma unroll
                            for (int ks = 0; ks < 4; ++ks) qn[ks] = *(const v4u*)(qp2 + 16 * ks); }
                        ss += __shfl_xor(ss, 32);
                        const float rstd = rsqrtf(ss * (1.f / 64.f) + EPS) * (0.125f * 1.44269504f);
#pragma unroll
                        for (int ks = 0; ks < 4; ++ks) { float f[8]; unpack8(qv[ks], f); const f32x4 w0 = qw[ks][0], w1 = qw[ks][1];
                            const v4u o = (v4u){pk2(f[0] * rstd * w0[0], f[1] * rstd * w0[1]), pk2(f[2] * rstd * w0[2], f[3] * rstd * w0[3]), pk2(f[4] * rstd * w1[0], f[5] * rstd * w1[1]), pk2(f[6] * rstd * w1[2], f[7] * rstd * w1[3])};
                            qf[ks] = __builtin_bit_cast(bf16x8, o); }
                    }
                    f32x16 sc[5];
#pragma unroll
                    for (int jt = 0; jt < 5; ++jt) {
#pragma unroll
                        for (int e = 0; e < 16; ++e) sc[jt][e] = 0.f;
#pragma unroll
                        for (int ks = 0; ks < 4; ++ks) { const bf16x8 a = *(const LAS bf16x8*)(Kh + ((qt + jt) * 32 + r) * KP + ks * 16 + 8 * hf); sc[jt] = MFMA32(a, qf[ks], sc[jt]); } }
#pragma unroll
                    for (int e = 0; e < 16; ++e) { const int kk = (e & 3) + 8 * (e >> 2) + 4 * hf;
                        sc[0][e] = (kk > r) ? sc[0][e] : NEG; sc[4][e] = (kk <= r) ? sc[4][e] : NEG; }
                    if (n == 0) {
#pragma unroll
                        for (int jt = 0; jt < 4; ++jt) if (qt + jt < 4) {
#pragma unroll
                            for (int e = 0; e < 16; ++e) sc[jt][e] = NEG; } }
                    float m = sink;
#pragma unroll
                    for (int jt = 0; jt < 5; ++jt)
#pragma unroll
                        for (int e = 0; e < 16; ++e) m = fmaxf(m, sc[jt][e]);
                    m = fmaxf(m, __shfl_xor(m, 32));
                    float l = 0.f;
#pragma unroll
                    for (int jt = 0; jt < 5; ++jt)
#pragma unroll
                        for (int e = 0; e < 16; ++e) { const float pv = __builtin_amdgcn_exp2f(sc[jt][e] - m); sc[jt][e] = pv; l += pv; }
                    l += __shfl_xor(l, 32); l += __builtin_amdgcn_exp2f(sink - m);
                    f32x16 o[2];
#pragma unroll
                    for (int dt = 0; dt < 2; ++dt)
#pragma unroll
                        for (int e = 0; e < 16; ++e) o[dt][e] = 0.f;
#pragma unroll
                    for (int jt = 0; jt < 5; ++jt)
#pragma unroll
                        for (int s2 = 0; s2 < 2; ++s2) {
                            const v4u pp = (v4u){pk2(sc[jt][8 * s2], sc[jt][8 * s2 + 1]), pk2(sc[jt][8 * s2 + 2], sc[jt][8 * s2 + 3]), pk2(sc[jt][8 * s2 + 4], sc[jt][8 * s2 + 5]), pk2(sc[jt][8 * s2 + 6], sc[jt][8 * s2 + 7])};
                            const bf16x8 pf = __builtin_bit_cast(bf16x8, pp);
                            const int kb = (qt + jt) * 32 + 16 * s2 + 4 * hf;
#pragma unroll
                            for (int dt = 0; dt < 2; ++dt) { const LAS bf16* vr = Vh + (dt * 32 + r) * VP + kb;
                                const v2u a0 = *(const LAS v2u*)vr, a1 = *(const LAS v2u*)(vr + 8);
                                const v4u av = (v4u){a0.x, a0.y, a1.x, a1.y};
                                o[dt] = MFMA32(__builtin_bit_cast(bf16x8, av), pf, o[dt]); }
                        }
                    const float inv = 1.0f / l; float ss = 0.f;
#pragma unroll
                    for (int dt = 0; dt < 2; ++dt)
#pragma unroll
                        for (int q = 0; q < 4; ++q) { const float g0 = o[dt][4 * q] * inv, g1 = o[dt][4 * q + 1] * inv, g2 = o[dt][4 * q + 2] * inv, g3 = o[dt][4 * q + 3] * inv;
                            ss += (g0 * g0 + g1 * g1) + (g2 * g2 + g3 * g3);
                            *(v2u*)(mix + tok * D + hq * 64 + dt * 32 + 8 * q + 4 * hf) = (v2u){pk2(g0, g1), pk2(g2, g3)}; }
                    ss += __shfl_xor(ss, 32);
                    if (hf == 0) ssqp[hq * 128 + qt * 32 + r] = ss;
                }
            }
        }
        __syncthreads();
        {
            int tz = threadIdx.x; asm volatile("" : "+v"(tz));
            const int wave = __builtin_amdgcn_readfirstlane(tz >> 6), r = tz & 31, hf = (tz >> 5) & 1, hk = wave >> 2, wl = wave & 3;
            for (int qt = 0; qt < 4; ++qt) {
                const size_t tok = (size_t)b * SEQ + n * 128 + qt * 32 + r;
                float tot = 0.f;
#pragma unroll
                for (int hd = 0; hd < 16; ++hd) tot += ssqp[hd * 128 + qt * 32 + r];
                const float rstd = rsqrtf(tot * (1.f / 1024.f) + EPS);
                v2u uu[2][2][4];
#pragma unroll
                for (int hsel = 0; hsel < 2; ++hsel)
#pragma unroll
                    for (int dt = 0; dt < 2; ++dt)
#pragma unroll
                        for (int q = 0; q < 4; ++q) uu[hsel][dt][q] = *(const v2u*)(mix + tok * D + (hk * 8 + wl * 2 + hsel) * 64 + dt * 32 + 8 * q + 4 * hf);
#pragma unroll
                for (int hsel = 0; hsel < 2; ++hsel)
#pragma unroll
                    for (int dt = 0; dt < 2; ++dt) { asm volatile("" : "+v"(uu[hsel][dt][0]), "+v"(uu[hsel][dt][1]), "+v"(uu[hsel][dt][2]), "+v"(uu[hsel][dt][3])); }
#pragma unroll
                for (int hsel = 0; hsel < 2; ++hsel)
#pragma unroll
                    for (int dt = 0; dt < 2; ++dt)
#pragma unroll
                        for (int q = 0; q < 4; ++q) { const int col = (hk * 8 + wl * 2 + hsel) * 64 + dt * 32 + 8 * q + 4 * hf;
                            const v2u u = uu[hsel][dt][q]; const f32x4 w4 = *(const f32x4*)(p.attn_out_norm_w + col);
                            *(v2u*)(mix + tok * D + col) = (v2u){pk2(bflo(u.x) * rstd * w4[0], bfhi(u.x) * rstd * w4[1]), pk2(bflo(u.y) * rstd * w4[2], bfhi(u.y) * rstd * w4[3])}; }
            }
        }
    }
}

__device__ __forceinline__ void phase_router(const Params& p, LAS unsigned char* lds, unsigned* ctl, int G, int wave, int lane) {
    const bf16* x1 = (const bf16*)(p.ws + WS_X1); const float* ssq = (const float*)(p.ws + WS_SSQ); unsigned char* hf = p.ws + WS_HF;
    int* stok = (int*)(p.ws + WS_STOK); float* sgate = (float*)(p.ws + WS_SGATE); int* toke = (int*)(p.ws + WS_TOKE); int* tokp = (int*)(p.ws + WS_TOKP);
    LAS float* lg = (LAS float*)lds + wave * (16 * 33);
    LAS int* hist = (LAS int*)(lds + 32768); LAS int* gbase = hist + 32;
    const int tid = threadIdx.x, i16 = lane & 15, kq = lane >> 4;
    for (int tb = blockIdx.x * 8; tb < T / 16; tb += G * 8) {
        if (tid < 32) hist[tid] = 0;
        __syncthreads();
        const int tok = (tb + wave) * 16 + i16;
        float s = 0.f;
        { const f32x4* sp = (const f32x4*)(ssq + (size_t)tok * 32 + kq * 8); const f32x4 a = sp[0], b = sp[1]; s = ((a[0] + a[1]) + (a[2] + a[3])) + ((b[0] + b[1]) + (b[2] + b[3])); }
        s += __shfl_xor(s, 16); s += __shfl_xor(s, 32);
        const float rstd = rsqrtf(s * (1.f / D) + EPS);
        f32x4 acc0 = (f32x4){0.f, 0.f, 0.f, 0.f}, acc1 = (f32x4){0.f, 0.f, 0.f, 0.f};
        const bf16* xr = x1 + (size_t)tok * D + 8 * kq;
        unsigned char* hr = hf + (size_t)tok * D + 8 * kq;
        const v4u* wb = (const v4u*)(p.ws + WS_WRB) + lane;
        v4u xq[4];
#pragma unroll
        for (int u = 0; u < 4; ++u) xq[u] = *(const v4u*)(xr + 32 * u);
        for (int j4 = 0; j4 < 64; j4 += 4) {
            f32x4 xc[4][2], gq[4][2]; v4u wf[4][2][2];
#pragma unroll
            for (int u = 0; u < 4; ++u) { float f[8]; unpack8(xq[u], f); xc[u][0] = (f32x4){f[0], f[1], f[2], f[3]}; xc[u][1] = (f32x4){f[4], f[5], f[6], f[7]}; }
            if (j4 + 4 < 64) {
#pragma unroll
                for (int u = 0; u < 4; ++u) xq[u] = *(const v4u*)(xr + 32 * (j4 + 4 + u)); }
#pragma unroll
            for (int u = 0; u < 4; ++u) { gq[u][0] = *(const f32x4*)(p.ffn_norm_w + 32 * (j4 + u) + 8 * kq); gq[u][1] = *(const f32x4*)(p.ffn_norm_w + 32 * (j4 + u) + 8 * kq + 4);
#pragma unroll
                for (int hfl = 0; hfl < 2; ++hfl)
#pragma unroll
                    for (int hl = 0; hl < 2; ++hl) wf[u][hfl][hl] = wb[(((j4 + u) * 2 + hfl) * 2 + hl) * 64]; }
#pragma unroll
            for (int u = 0; u < 4; ++u) {
                float hv[8];
#pragma unroll
                for (int k = 0; k < 4; ++k) { hv[k] = xc[u][0][k] * rstd * gq[u][0][k]; hv[4 + k] = xc[u][1][k] * rstd * gq[u][1][k]; }
                *(v2u*)(hr + 32 * (j4 + u)) = (v2u){pk4_fp8(sat8(hv[0] * FP8_SA), sat8(hv[1] * FP8_SA), sat8(hv[2] * FP8_SA), sat8(hv[3] * FP8_SA)), pk4_fp8(sat8(hv[4] * FP8_SA), sat8(hv[5] * FP8_SA), sat8(hv[6] * FP8_SA), sat8(hv[7] * FP8_SA))};
                v4u ah, al;
                ah.x = pk2(hv[0], hv[1]); ah.y = pk2(hv[2], hv[3]); ah.z = pk2(hv[4], hv[5]); ah.w = pk2(hv[6], hv[7]);
                al.x = pk2(hv[0] - bflo(ah.x), hv[1] - bfhi(ah.x)); al.y = pk2(hv[2] - bflo(ah.y), hv[3] - bfhi(ah.y)); al.z = pk2(hv[4] - bflo(ah.z), hv[5] - bfhi(ah.z)); al.w = pk2(hv[6] - bflo(ah.w), hv[7] - bfhi(ah.w));
                const bf16x8 fah = __builtin_bit_cast(bf16x8, ah), fal = __builtin_bit_cast(bf16x8, al);
                acc0 = __builtin_amdgcn_mfma_f32_16x16x32_bf16(fah, __builtin_bit_cast(bf16x8, wf[u][0][0]), acc0, 0, 0, 0);
                acc0 = __builtin_amdgcn_mfma_f32_16x16x32_bf16(fah, __builtin_bit_cast(bf16x8, wf[u][0][1]), acc0, 0, 0, 0);
                acc0 = __builtin_amdgcn_mfma_f32_16x16x32_bf16(fal, __builtin_bit_cast(bf16x8, wf[u][0][0]), acc0, 0, 0, 0);
                acc1 = __builtin_amdgcn_mfma_f32_16x16x32_bf16(fah, __builtin_bit_cast(bf16x8, wf[u][1][0]), acc1, 0, 0, 0);
                acc1 = __builtin_amdgcn_mfma_f32_16x16x32_bf16(fah, __builtin_bit_cast(bf16x8, wf[u][1][1]), acc1, 0, 0, 0);
                acc1 = __builtin_amdgcn_mfma_f32_16x16x32_bf16(fal, __builtin_bit_cast(bf16x8, wf[u][1][0]), acc1, 0, 0, 0);
            }
        }
        { const float bb0 = p.b_router[i16], bb1 = p.b_router[16 + i16];
#pragma unroll
          for (int r = 0; r < 4; ++r) { lg[(4 * kq + r) * 33 + i16] = acc0[r] + bb0; lg[(4 * kq + r) * 33 + 16 + i16] = acc1[r] + bb1; } }
        LDS_WAIT(); asm volatile("" ::: "memory");
        int se[4]; float sv[4], gt[4]; int rk[4];
        if (lane < 16) {
            float v[32];
#pragma unroll
            for (int e = 0; e < 32; ++e) v[e] = lg[lane * 33 + e];
#pragma unroll
            for (int k = 0; k < 4; ++k) { float best = -3.0e38f; int bi = 0;
#pragma unroll
                for (int e = 0; e < 32; ++e) { const bool tk = v[e] > best; best = tk ? v[e] : best; bi = tk ? e : bi; }
                se[k] = bi; sv[k] = best;
#pragma unroll
                for (int e = 0; e < 32; ++e) v[e] = (e == bi) ? -3.0e38f : v[e]; }
            const float e1 = __expf(sv[1] - sv[0]), e2 = __expf(sv[2] - sv[0]), e3 = __expf(sv[3] - sv[0]);
            const float inv = 1.0f / (1.0f + e1 + e2 + e3);
            gt[0] = inv; gt[1] = e1 * inv; gt[2] = e2 * inv; gt[3] = e3 * inv;
#pragma unroll
            for (int k = 0; k < 4; ++k) rk[k] = __hip_atomic_fetch_add(&hist[se[k]], 1, __ATOMIC_RELAXED, __HIP_MEMORY_SCOPE_WORKGROUP);
        }
        __syncthreads();
        if (tid < 32) gbase[tid] = (int)__hip_atomic_fetch_add(ctl + CW_CNT + 64 * tid, (unsigned)hist[tid], __ATOMIC_RELAXED, __HIP_MEMORY_SCOPE_AGENT);
        __syncthreads();
        if (lane < 16) {
            const int tk = (tb + wave) * 16 + lane;
#pragma unroll
            for (int k = 0; k < 4; ++k) { const int pos = gbase[se[k]] + rk[k];
                stok[(size_t)se[k] * T + pos] = tk; sgate[(size_t)se[k] * T + pos] = gt[k]; toke[tk * 4 + k] = se[k]; tokp[tk * 4 + k] = pos; }
        }
        __syncthreads();
    }
}

__device__ __forceinline__ void moe_table(unsigned* ctl, LAS int* tstart, LAS int* lcnt) {
    __syncthreads();
    if (threadIdx.x < 32) lcnt[threadIdx.x] = (int)__hip_atomic_load(ctl + CW_CNT + 64 * threadIdx.x, __ATOMIC_RELAXED, __HIP_MEMORY_SCOPE_AGENT);
    __syncthreads();
    if (threadIdx.x == 0) { int a = 0; for (int e = 0; e < NE; ++e) { tstart[e] = a; a += (lcnt[e] + 255) >> 8; } tstart[NE] = a; }
    __syncthreads();
}

__device__ __forceinline__ void phase_combine(const Params& p, const LAS int* tstart, int gw, int NGW, int lane) {
    const unsigned char* y2 = p.ws + WS_Y2; const int* toke = (const int*)(p.ws + WS_TOKE); const int* tokp = (const int*)(p.ws + WS_TOKP);
    constexpr float DY = 1.0f / FP8_SY;
    typedef int i32x4v __attribute__((ext_vector_type(4)));
    i32x4v ne = (i32x4v){0, 0, 0, 0}, np = ne;
    if (gw < T) { ne = *(const i32x4v*)(toke + gw * 4); np = *(const i32x4v*)(tokp + gw * 4); }
    for (int m = gw; m < T; m += NGW) {
        const i32x4v ce = ne, cp = np;
        if (m + NGW < T) { ne = *(const i32x4v*)(toke + (m + NGW) * 4); np = *(const i32x4v*)(tokp + (m + NGW) * 4); }
        const unsigned char* yr[4];
#pragma unroll
        for (int k = 0; k < 4; ++k) yr[k] = y2 + ((size_t)tstart[ce[k]] * 256 + cp[k]) * D;
        float* op = p.out + (size_t)m * D; const bf16* xp = (const bf16*)(p.ws + WS_X1) + (size_t)m * D;
#pragma unroll
        for (int j = 0; j < 2; ++j) { const int c = (j * 64 + lane) * 16;
            v4u w[4];
#pragma unroll
            for (int k = 0; k < 4; ++k) w[k] = *(const v4u*)(yr[k] + c);
            f32x4 a[4];
            { const v4u xa = *(const v4u*)(xp + c), xb = *(const v4u*)(xp + c + 8); float fa[8], fb[8]; unpack8(xa, fa); unpack8(xb, fb);
              a[0] = (f32x4){fa[0], fa[1], fa[2], fa[3]}; a[1] = (f32x4){fa[4], fa[5], fa[6], fa[7]}; a[2] = (f32x4){fb[0], fb[1], fb[2], fb[3]}; a[3] = (f32x4){fb[4], fb[5], fb[6], fb[7]}; }
#pragma unroll
            for (int q = 0; q < 4; ++q) { float s0 = 0.f, s1 = 0.f, s2 = 0.f, s3 = 0.f;
#pragma unroll
                for (int k = 0; k < 4; ++k) { const int wd = (int)(q == 0 ? w[k].x : q == 1 ? w[k].y : q == 2 ? w[k].z : w[k].w);
                    const f32x2 lo = __builtin_amdgcn_cvt_pk_f32_fp8(wd, false), hi = __builtin_amdgcn_cvt_pk_f32_fp8(wd, true);
                    s0 += lo.x; s1 += lo.y; s2 += hi.x; s3 += hi.y; }
                a[q][0] += s0 * DY; a[q][1] += s1 * DY; a[q][2] += s2 * DY; a[q][3] += s3 * DY;
                *(f32x4*)(op + c + 4 * q) = a[q]; }
        }
    }
}

constexpr int N_PHASES = 10;
__global__ void __launch_bounds__(NTHREADS, 2) hymba_fwd(Params p) {
    extern __shared__ __attribute__((aligned(16))) unsigned char lds_raw[];
    LAS unsigned char* lds = (LAS unsigned char*)lds_raw;
    volatile LAS unsigned* MISC = (volatile LAS unsigned*)(lds + MISC_OFF);
    LAS int* tstart = (LAS int*)(lds + MISC_OFF + 256);
    LAS int* lcnt = (LAS int*)(lds + MISC_OFF + 512);
    const int tid = threadIdx.x, lane = tid & 63, wave = __builtin_amdgcn_readfirstlane(tid >> 6);
    const int G = gridDim.x;
    const int vcu = (G % 8 == 0) ? (blockIdx.x % 8) * (G / 8) + blockIdx.x / 8 : blockIdx.x;
    const int gw = vcu * NWAVES + wave, NGW = G * NWAVES;
    unsigned* ctl = (unsigned*)(p.ws + WS_CTL);
    if (tid < 64) MISC[tid] = 0u;
    __syncthreads();
    const int lo = p.ph_lo, hi = p.ph_hi;
    XcdBarrier bar; bar.bar = ctl + CW_BAR; bar.x = 0; bar.st = nullptr;
    if (hi - lo > 1) bar = xcd_barrier_post(ctl + CW_BAR, MISC + 8);
#ifndef PHMASK
#define PHMASK 0x3ff
#endif
#define IN(k) (((PHMASK >> (k)) & 1) && lo <= (k) && (k) < hi)
#define SEAM(k) do { if (IN(k) && IN((k) + 1)) xcd_barrier(bar); } while (0)

    if (IN(0)) { phase_prologue(p, lds, gw, NGW, wave, lane); }
    SEAM(0);
    int cid = (int)blockIdx.x;
    if (hi - lo > 1 && lo == 0) {
        if (tid == 0) {
            bool ok = (G % 8 == 0);
            for (unsigned j = 0; j < 16; ++j) { const unsigned cj = xb_ld(&bar.bar[XB_XCNT(j)]); ok = ok && (j < 8 ? cj == (unsigned)(G / 8) : cj == 0u); }
            MISC[12] = ok ? (MISC[10] * 8u + bar.x) : (unsigned)blockIdx.x;
        }
        __syncthreads();
        cid = (int)MISC[12];
    }
    if (IN(1)) {
        const int ncw = (G < 8 * NCV) ? G : 8 * NCV;
        if (cid < ncw) convert_experts(p, cid * NWAVES + wave, ncw * NWAVES, lane);
        LAS int* tk = (LAS int*)(lds + MISC_OFF + 768);
        unsigned* tick = ctl + CW_TICK + 64 * (cid & 7);
        __syncthreads();
        if (tid == 0) { tk[0] = (int)__hip_atomic_fetch_add(tick, 1u, __ATOMIC_RELAXED, __HIP_MEMORY_SCOPE_AGENT); tk[1] = (int)__hip_atomic_fetch_add(tick, 1u, __ATOMIC_RELAXED, __HIP_MEMORY_SCOPE_AGENT); }
        __syncthreads();
        pg8::SchedQueue S{(const char*)(p.ws + WS_HN), (const char*)(p.ws + WS_WIN), T / 256, NIN_PAD / 256, (T / 256) * (NIN_PAD / 256) / 8, cid & 7, tick, tk};
        EpiInProj E{(bf16*)(p.ws + WS_PROJ), (float*)(p.ws + WS_DT)};
        pg8::gemm_phase<EpiInProj, pg8::SchedQueue>(lds, S, E);
    }
    SEAM(1);
    if (IN(2)) { if (!(p.variant & 2)) phase_attn(p, lds, G); if (!(p.variant & 1)) phase_ssd_states(p, lds, G, lane, wave); }
    SEAM(2);
    if (IN(3)) { phase_ssd_scan(p, G); }
    SEAM(3);
    if (IN(4)) { phase_ssd_out(p, lds, G, lane, wave); }
    SEAM(4);
    if (IN(5)) {
        EpiOutProj E{p.x, (bf16*)(p.ws + WS_X1), (float*)(p.ws + WS_SSQ)};
#if PROBE_CRIP5
        if (p.variant) { pg8::SchedDenseT<PROBE_CRIP5> S{(const char*)(p.ws + WS_MIX), (const char*)(p.ws + WS_WOUT), T / 256, D / 256, G, cid};
            pg8::gemm_phase<EpiOutProj, pg8::SchedDenseT<PROBE_CRIP5>>(lds, S, E); } else
#endif
        { pg8::SchedDense S{(const char*)(p.ws + WS_MIX), (const char*)(p.ws + WS_WOUT), T / 256, D / 256, G, cid};
          pg8::gemm_phase<EpiOutProj, pg8::SchedDense>(lds, S, E); }
    }
    SEAM(5);
    if (IN(6)) { phase_router(p, lds, ctl, G, wave, lane); }
    SEAM(6);
    if (IN(7)) {
        moe_table(ctl, tstart, lcnt);
        EpiGateUp E{p.ws + WS_HB, p.b_gate, p.b_up};
#if PROBE_CRIP7
        if (p.variant) { pg8::SchedMoE<true, PROBE_CRIP7> S{(const char*)(p.ws + WS_HF), (const char*)(p.ws + WS_WGU), (const int*)(p.ws + WS_STOK), tstart, lcnt, (2 * FF) / 256, 2 * FF, G, cid};
            pg8::gemm_phase<EpiGateUp, pg8::SchedMoE<true, PROBE_CRIP7>>(lds, S, E); } else
#endif
        { pg8::SchedMoE<true> S{(const char*)(p.ws + WS_HF), (const char*)(p.ws + WS_WGU), (const int*)(p.ws + WS_STOK), tstart, lcnt, (2 * FF) / 256, 2 * FF, G, cid};
          pg8::gemm_phase<EpiGateUp, pg8::SchedMoE<true>>(lds, S, E); }
    }
    SEAM(7);
    if (IN(8)) {
        moe_table(ctl, tstart, lcnt);
        EpiDown E{p.ws + WS_Y2, p.b_down, (const float*)(p.ws + WS_SGATE), tstart};
#if PROBE_CRIP
        if (p.variant) { pg8::SchedMoE<false, PROBE_CRIP> S{(const char*)(p.ws + WS_HB), (const char*)(p.ws + WS_WD), (const int*)(p.ws + WS_STOK), tstart, lcnt, D / 256, D, G, cid};
            pg8::gemm_phase<EpiDown, pg8::SchedMoE<false, PROBE_CRIP>>(lds, S, E); } else
#endif
        { pg8::SchedMoE<false> S{(const char*)(p.ws + WS_HB), (const char*)(p.ws + WS_WD), (const int*)(p.ws + WS_STOK), tstart, lcnt, D / 256, D, G, cid};
          pg8::gemm_phase<EpiDown, pg8::SchedMoE<false>>(lds, S, E); }
    }
    SEAM(8);
    if (IN(9)) { moe_table(ctl, tstart, lcnt); phase_combine(p, tstart, gw, NGW, lane); }
#undef IN
#undef SEAM
}

extern "C" void kernel_launch(void* const* d_in, const int* in_sizes, int n_in, void* d_out, int out_size, void* d_ws, size_t ws_size, hipStream_t stream) {
    static int grid = 0;
    if (grid == 0) {
        if (n_in != 23 || out_size != T * D || ws_size < WS_END) { fprintf(stderr, "kernel_launch: unexpected sizes n_in %d out %d ws %zu\n", n_in, out_size, ws_size); grid = -1; return; }
        int dev = 0, cus = 0;
        if (hipGetDevice(&dev) != hipSuccess || hipDeviceGetAttribute(&cus, hipDeviceAttributeMultiprocessorCount, dev) != hipSuccess) { grid = -1; return; }
        if (hipFuncSetAttribute((const void*)hymba_fwd, hipFuncAttributeMaxDynamicSharedMemorySize, LDS_BYTES) != hipSuccess) { fprintf(stderr, "kernel_launch: hipFuncSetAttribute failed\n"); grid = -1; return; }
        int per_cu = 0;
        if (hipOccupancyMaxActiveBlocksPerMultiprocessor(&per_cu, (const void*)hymba_fwd, NTHREADS, LDS_BYTES) != hipSuccess || per_cu < 1) fprintf(stderr, "kernel_launch: occupancy query says %d\n", per_cu);
        (void)hipGetLastError();
        grid = cus;
    }
    if (grid < 0) return;
    (void)hipMemsetAsync((char*)d_ws + WS_CTL, 0, CTL_BYTES, stream);
    Params p{};
    const float** pp = (const float**)&p;
    for (int i = 0; i < 23; ++i) pp[i] = (const float*)d_in[i];
    p.out = (float*)d_out; p.ws = (unsigned char*)d_ws;
#if MK_MULTI || (PROBE_REPEAT >= 0) || PROBE_CRIP || PROBE_P2 || PROBE_P6 || PROBE_CRIP7 || PROBE_CRIP5
    for (int ph = 0; ph < N_PHASES; ++ph) { p.ph_lo = ph; p.ph_hi = ph + 1;
        if (PROBE_P2 && ph == 2) { p.variant = PROBE_P2; hipLaunchKernelGGL(hymba_fwd, dim3(grid), dim3(NTHREADS), LDS_BYTES, stream, p); p.variant = 0; }
        if (PROBE_P6 && ph == 6) { hipLaunchKernelGGL(hymba_fwd, dim3(grid), dim3(NTHREADS), LDS_BYTES, stream, p); (void)hipMemsetAsync((char*)d_ws + WS_CTL + CW_CNT * 4, 0, 64 * 4 * NE, stream); }
        if (PROBE_CRIP5 && ph == 5) { p.variant = 1; hipLaunchKernelGGL(hymba_fwd, dim3(grid), dim3(NTHREADS), LDS_BYTES, stream, p); p.variant = 0; }
        if (PROBE_CRIP7 && ph == 7) { p.variant = 1; hipLaunchKernelGGL(hymba_fwd, dim3(grid), dim3(NTHREADS), LDS_BYTES, stream, p); p.variant = 0; }
        if (PROBE_CRIP && ph == 8) { p.variant = 1; hipLaunchKernelGGL(hymba_fwd, dim3(grid), dim3(NTHREADS), LDS_BYTES, stream, p); p.variant = 0; }
        for (int r = 0; r < (ph == PROBE_REPEAT ? 2 : 1); ++r) hipLaunchKernelGGL(hymba_fwd, dim3(grid), dim3(NTHREADS), LDS_BYTES, stream, p); }
#else
    p.ph_lo = 0; p.ph_hi = N_PHASES; hipLaunchKernelGGL(hymba_fwd, dim3(grid), dim3(NTHREADS), LDS_BYTES, stream, p);
#endif
}
```

```cpp
#include <hip/hip_runtime.h>
#include <cstdio>
#include <cstdint>

#ifndef MK_MULTI
#define MK_MULTI 0
#endif

#ifndef PROBE_CRIP
#define PROBE_CRIP 0
#endif
#ifndef WGM
#define WGM 4
#endif
#ifndef WGMQ
#define WGMQ 8
#endif
#ifndef PROBE_CRIP5
#define PROBE_CRIP5 0
#endif
#ifndef PROBE_CRIP7
#define PROBE_CRIP7 0
#endif
#ifndef PROBE_P6
#define PROBE_P6 0
#endif
#ifndef PROBE_P2
#define PROBE_P2 0
#endif
#ifndef PROBE_REPEAT
#define PROBE_REPEAT -1
#endif
#define GAS __attribute__((address_space(1)))
#define LAS __attribute__((address_space(3)))
typedef unsigned short bf16;
typedef unsigned v4u __attribute__((ext_vector_type(4)));
typedef unsigned v2u __attribute__((ext_vector_type(2)));
typedef float f32x4 __attribute__((ext_vector_type(4)));
typedef float f32x2 __attribute__((ext_vector_type(2)));
typedef short bf16x8 __attribute__((ext_vector_type(8)));
typedef int i32x4 __attribute__((ext_vector_type(4)));
typedef int i32x8 __attribute__((ext_vector_type(8)));

constexpr int NB = 4, SEQ = 8192, T = NB * SEQ, D = 2048;
constexpr int PROJ_LD = 3840;
constexpr int COL_Q = 0, COL_K = 1024, COL_V = 1152, COL_Z = 1280, COL_XBC = 2304;
constexpr int NIN = 3856, NIN_PAD = 4096;
constexpr int NXBC = 1536;
constexpr int NE = 32, FF = 2048, TOPK = 4;
constexpr int SLOT_ROWS = T * TOPK + NE * 256;
constexpr float EPS = 1e-6f;

constexpr size_t MiB = 1u << 20;
constexpr size_t WS_CTL = 0, CTL_BYTES = 1 * MiB;
constexpr size_t WS_WGU = 16 * MiB;
constexpr size_t WS_WIN = 528 * MiB;
constexpr size_t WS_WOUT = 544 * MiB;
constexpr size_t WS_HF = 552 * MiB;
constexpr size_t WS_Y2 = 16 * MiB;
constexpr size_t WS_WD = 680 * MiB;
constexpr size_t WS_HN = 936 * MiB;
constexpr size_t WS_MIX = WS_HN;
constexpr size_t WS_PROJ = 1064 * MiB;
constexpr size_t WS_XBC = 1304 * MiB;
constexpr size_t WS_ATT = 1496 * MiB;
constexpr size_t WS_X1 = WS_ATT;
constexpr size_t WS_YS = 1624 * MiB;
constexpr size_t WS_HB = 936 * MiB;
constexpr size_t WS_STATES = WS_XBC;
constexpr size_t WS_SIN = WS_YS;
constexpr size_t WS_CDEC = WS_YS + 64 * MiB;
constexpr size_t WS_DT = 1752 * MiB;
constexpr size_t WS_DTS = 1754 * MiB;
constexpr size_t WS_SSQ = 1756 * MiB;
constexpr size_t WS_STOK = 1760 * MiB;
constexpr size_t WS_SGATE = 1764 * MiB;
constexpr size_t WS_TOKE = 1768 * MiB;
constexpr size_t WS_TOKP = 1769 * MiB;
constexpr size_t WS_WRB = 1770 * MiB;
constexpr size_t WS_END = 1771 * MiB;
static_assert(WS_Y2 + (size_t)SLOT_ROWS * 2048 <= WS_WD, "y2 overlay");
static_assert(WS_HB + (size_t)SLOT_ROWS * 2048 * 2 <= WS_ATT, "hb overlay");
constexpr int CW_CNT = 1024;
constexpr int CW_BAR = 4096;
constexpr int CW_TICK = 2048 + 1024;
constexpr int NCV = 16;

constexpr int RING_BYTES = 131072;
constexpr int MISC_OFF = 162816;
constexpr int LDS_BYTES = 163840;
constexpr int NWAVES = 8, NTHREADS = 512;

typedef __bf16 hwbf16x2 __attribute__((ext_vector_type(2)));
__device__ __forceinline__ unsigned f2bf(float f) { return (unsigned)__builtin_bit_cast(unsigned short, (__bf16)f); }
__device__ __forceinline__ unsigned pk2(float lo, float hi) { const f32x2 v = {lo, hi}; return __builtin_bit_cast(unsigned, __builtin_convertvector(v, hwbf16x2)); }
__device__ __forceinline__ float bflo(unsigned w) { return __builtin_bit_cast(float, w << 16); }
__device__ __forceinline__ float bfhi(unsigned w) { return __builtin_bit_cast(float, w & 0xffff0000u); }
__device__ __forceinline__ float wave_sum(float v) {
#pragma unroll
    for (int o = 1; o < 64; o <<= 1) v += __shfl_xor(v, o);
    return v;
}
__device__ __forceinline__ float sat8(float x) { return __builtin_amdgcn_fmed3f(x, -448.0f, 448.0f); }
__device__ __forceinline__ unsigned pk4_fp8(float a, float b, float c, float d) { int v = 0; v = __builtin_amdgcn_cvt_pk_fp8_f32(a, b, v, false); v = __builtin_amdgcn_cvt_pk_fp8_f32(c, d, v, true); return (unsigned)v; }
constexpr float FP8_SW = 256.f;
constexpr float FP8_SA = 16.f;
constexpr float FP8_SH = 4.f;
constexpr float FP8_SY = 32.f;
__device__ __forceinline__ float fsigmoid(float x) { return __builtin_amdgcn_rcpf(1.0f + __expf(-x)); }
__device__ __forceinline__ void unpack8(const v4u q, float (&d)[8]) { d[0] = bflo(q.x); d[1] = bfhi(q.x); d[2] = bflo(q.y); d[3] = bfhi(q.y); d[4] = bflo(q.z); d[5] = bfhi(q.z); d[6] = bflo(q.w); d[7] = bfhi(q.w); }
#define LDS_WAIT() asm volatile("s_waitcnt lgkmcnt(0)" ::: "memory")

#define XB_TMO      128
#define XB_XCNT(j)  (256  + 64 * (j))
#define XB_XSUB(j)  (1280 + 64 * (j))
#define XB_XGEN(j)  (2304 + 64 * (j))
#define XB_TOP      3328
#define XB_TOPGEN   3392
#define XCD_BAR_WORDS 3456
#define XB_SPIN_CAP (1u << 18)
__device__ __forceinline__ unsigned xb_ld(unsigned* p)              { return __hip_atomic_load(p, __ATOMIC_RELAXED, __HIP_MEMORY_SCOPE_AGENT); }
__device__ __forceinline__ unsigned xb_add(unsigned* p, unsigned v) { return __hip_atomic_fetch_add(p, v, __ATOMIC_RELAXED, __HIP_MEMORY_SCOPE_AGENT); }
__device__ __forceinline__ unsigned xb_xcc_id() { return (unsigned)__builtin_amdgcn_s_getreg((3 << 11) | 20) & 0xFu; }
#define XB_SPIN(cond, bar) do { unsigned _sp = 0; while (cond) { __builtin_amdgcn_s_sleep(1); \
    if ((++_sp & 255u) == 0u) { if (xb_ld(&(bar)[XB_TMO])) break; if (_sp > XB_SPIN_CAP) { atomicAdd(&(bar)[XB_TMO], 1u); break; } } } } while (0)
struct XcdBarrier { unsigned* bar; unsigned x; volatile LAS unsigned* st; };
__device__ __forceinline__ XcdBarrier xcd_barrier_post(unsigned* bar, volatile LAS unsigned* st) {
    XcdBarrier b; b.bar = bar; b.x = xb_xcc_id(); b.st = st;
    if (threadIdx.x == 0) st[2] = xb_add(&bar[XB_XCNT(b.x)], 1u);
    return b;
}
__device__ __forceinline__ void xcd_barrier_complete(unsigned* bar, unsigned x, unsigned& nloc, unsigned& nx) {
    const unsigned G = gridDim.x * gridDim.y * gridDim.z;
    unsigned sum, cnt, mine, sp = 0u;
    for (;;) {
        sum = 0u; cnt = 0u; mine = 0u;
#pragma unroll
        for (unsigned j = 0; j < 16; ++j) { const unsigned c = xb_ld(&bar[XB_XCNT(j)]); sum += c; cnt += (c > 0u) ? 1u : 0u; mine = (j == x) ? c : mine; }
        if (sum == G) break;
        __builtin_amdgcn_s_sleep(1);
        if ((++sp & 255u) == 0u) { if (xb_ld(&bar[XB_TMO])) break; if (sp > XB_SPIN_CAP) { atomicAdd(&bar[XB_TMO], 1u); break; } }
    }
    nloc = mine > 0u ? mine : 1u; nx = cnt > 0u ? cnt : 1u;
}
__device__ __forceinline__ void xcd_barrier(const XcdBarrier& b) {
    asm volatile("s_waitcnt vmcnt(0)" ::: "memory");
    __syncthreads();
    if (threadIdx.x == 0) {
        unsigned* bar = b.bar;
        __builtin_amdgcn_s_waitcnt(0);
        unsigned nloc = b.st[0], nx = b.st[1];
        if (nloc == 0u) { xcd_barrier_complete(bar, b.x, nloc, nx); b.st[0] = nloc; b.st[1] = nx; }
        const unsigned old = xb_add(&bar[XB_XSUB(b.x)], 1u);
        const unsigned gen = old / nloc;
        if (old + 1u == (gen + 1u) * nloc) {
            __builtin_amdgcn_fence(__ATOMIC_RELEASE, "agent");
            asm volatile("s_waitcnt vmcnt(0)" ::: "memory");
            const unsigned og = xb_add(&bar[XB_TOP], 1u);
            const unsigned tg = og / nx;
            if (og + 1u == (tg + 1u) * nx) xb_add(&bar[XB_TOPGEN], 1u);
            else XB_SPIN(xb_ld(&bar[XB_TOPGEN]) == tg, bar);
            __builtin_amdgcn_fence(__ATOMIC_ACQUIRE, "agent");
            xb_add(&bar[XB_XGEN(b.x)], 1u);
            asm volatile("s_waitcnt vmcnt(0)" ::: "memory");
        } else {
            XB_SPIN(xb_ld(&bar[XB_XGEN(b.x)]) == gen, bar);
            __builtin_amdgcn_fence(__ATOMIC_ACQUIRE, "agent");
            asm volatile("s_waitcnt vmcnt(0)" ::: "memory");
        }
    }
    __syncthreads();
}

struct Params {
    const float* x; const float* attn_norm_w; const float* w_in; const float* q_norm_w; const float* k_norm_w; const float* sinks;
    const float* conv_w; const float* conv_b; const float* dt_bias; const float* a_log; const float* d_skip; const float* ssm_norm_w;
    const float* attn_out_norm_w; const float* w_out; const float* ffn_norm_w; const float* w_router; const float* b_router;
    const float* w_gate; const float* b_gate; const float* w_up; const float* b_up; const float* w_down; const float* b_down;
    float* out; unsigned char* ws; int ph_lo, ph_hi, variant, pad;
};

namespace pg8 {
constexpr int BM = 256, BK = 64, HALF = 128, HTB = HALF * BK * 2, GK = 2048;
__device__ __forceinline__ int lds_byte(int r, int c) { const int st = (r >> 4) * 2 + (c >> 5), rr = r & 15, cc = c & 31, ob = rr * 64 + cc * 2; return st * 1024 + (ob ^ (((ob >> 9) & 1) << 5)); }
__device__ __forceinline__ void stage_rc(int b, int& R, int& C) { const int st = b / 1024, sb = b % 1024, swz = sb ^ (((sb >> 9) & 1) << 5); R = (st >> 1) * 16 + swz / 64; C = (st & 1) * 32 + (swz % 64) / 2; }
__device__ __forceinline__ int perm32(int rho) { const int n = rho >> 4, i = rho & 15; return 8 * (i >> 2) + 4 * n + (i & 3); }

struct Unit { const char* aBase; const char* bBase; const int* aidx; int avalid; int pm, pn, e; };

template <class Epi, class Sched>
__device__ __forceinline__ void gemm_phase(LAS unsigned char* lds, const Sched& S, const Epi& E) {
    constexpr int RP = Sched::ROWB, nt = RP / 128;
    constexpr bool F8 = Sched::FP8;
    const int tid = threadIdx.x, wid = __builtin_amdgcn_readfirstlane(tid >> 6), lane = tid & 63, wr = wid >> 2, wc = wid & 3, fr = lane & 15, fq = lane >> 4;
    int sR[2], sC[2];
    unsigned voffB[2], vA[2][2];
#pragma unroll
    for (int i = 0; i < 2; ++i) { stage_rc(tid * 16 + i * 8192, sR[i], sC[i]); const int Rb = Epi::PERM ? ((sR[i] & ~31) + perm32(sR[i] & 31)) : sR[i];
        voffB[i] = (unsigned)(Rb * RP + sC[i] * 2); }
    const size_t kstep = (size_t)(BK * 2);
    const size_t hstep = (size_t)HALF * RP;
    const unsigned ldsw = (unsigned)wid * 1024u;
    const int aoff = lds_byte(wr * 64 + fr, fq * 8), boff = lds_byte(wc * 32 + fr, fq * 8);
#define PG8_SA(b, h) (((b) * 2 + (h)) * HTB)
#define PG8_SB(b, h) ((4 + (b) * 2 + (h)) * HTB)
#define PG8_STAGE(bufoff, gbase, voff) do { if constexpr (!(Sched::CRIP & 2)) _Pragma("unroll") for (int _i = 0; _i < 2; ++_i) { unsigned _o = (voff)[_i]; asm volatile("" : "+v"(_o)); \
        __builtin_amdgcn_global_load_lds((const unsigned*)((const char*)(gbase) + _o), (LAS unsigned*)(lds + (bufoff) + ldsw + _i * 8192), 16, 0, 0); } } while (0)
#define PG8_CAT(x, y) __builtin_shufflevector(x, y, 0, 1, 2, 3, 4, 5, 6, 7)
#define PG8_LO(v) __builtin_bit_cast(bf16x8, __builtin_shufflevector(v, v, 0, 1, 2, 3))
#define PG8_HI(v) __builtin_bit_cast(bf16x8, __builtin_shufflevector(v, v, 4, 5, 6, 7))
#define PG8_LDA(dst, b, h) do { if constexpr (!(Sched::CRIP & 4)) _Pragma("unroll") for (int m = 0; m < 4; ++m) dst[m] = PG8_CAT(*(const LAS i32x4*)(lds + PG8_SA(b, h) + aoff + m * 2048), *(const LAS i32x4*)(lds + PG8_SA(b, h) + aoff + m * 2048 + 1024)); } while (0)
#define PG8_LDB(dst, b, h) do { if constexpr (!(Sched::CRIP & 4)) _Pragma("unroll") for (int n = 0; n < 2; ++n) dst[n] = PG8_CAT(*(const LAS i32x4*)(lds + PG8_SB(b, h) + boff + n * 2048), *(const LAS i32x4*)(lds + PG8_SB(b, h) + boff + n * 2048 + 1024)); } while (0)
#define PG8_MMA(ai, bj, At, Bt) do { __builtin_amdgcn_s_setprio(1); \
        if constexpr (Sched::CRIP & 1) {} else if constexpr (F8) { asm volatile("s_nop 1\n\t" \
            "v_mfma_scale_f32_16x16x128_f8f6f4 %0, %8, %10, %0, %14, %14 op_sel_hi:[0,0,0]\n\t" "v_mfma_scale_f32_16x16x128_f8f6f4 %1, %9, %10, %1, %14, %14 op_sel_hi:[0,0,0]\n\t" \
            "v_mfma_scale_f32_16x16x128_f8f6f4 %2, %8, %11, %2, %14, %14 op_sel_hi:[0,0,0]\n\t" "v_mfma_scale_f32_16x16x128_f8f6f4 %3, %9, %11, %3, %14, %14 op_sel_hi:[0,0,0]\n\t" \
            "v_mfma_scale_f32_16x16x128_f8f6f4 %4, %8, %12, %4, %14, %14 op_sel_hi:[0,0,0]\n\t" "v_mfma_scale_f32_16x16x128_f8f6f4 %5, %9, %12, %5, %14, %14 op_sel_hi:[0,0,0]\n\t" \
            "v_mfma_scale_f32_16x16x128_f8f6f4 %6, %8, %13, %6, %14, %14 op_sel_hi:[0,0,0]\n\t" "v_mfma_scale_f32_16x16x128_f8f6f4 %7, %9, %13, %7, %14, %14 op_sel_hi:[0,0,0]" \
            : "+v"(acc[ai][bj][0][0]), "+v"(acc[ai][bj][0][1]), "+v"(acc[ai][bj][1][0]), "+v"(acc[ai][bj][1][1]), "+v"(acc[ai][bj][2][0]), "+v"(acc[ai][bj][2][1]), "+v"(acc[ai][bj][3][0]), "+v"(acc[ai][bj][3][1]) \
            : "v"(Bt[0]), "v"(Bt[1]), "v"(At[0]), "v"(At[1]), "v"(At[2]), "v"(At[3]), "v"(f8scale)); } \
        else { _Pragma("unroll") for (int m = 0; m < 4; ++m) _Pragma("unroll") for (int n = 0; n < 2; ++n) { \
               acc[ai][bj][m][n] = __builtin_amdgcn_mfma_f32_16x16x32_bf16(PG8_LO(Bt[n]), PG8_LO(At[m]), acc[ai][bj][m][n], 0, 0, 0); \
               acc[ai][bj][m][n] = __builtin_amdgcn_mfma_f32_16x16x32_bf16(PG8_HI(Bt[n]), PG8_HI(At[m]), acc[ai][bj][m][n], 0, 0, 0); } } \
        __builtin_amdgcn_s_setprio(0); } while (0)
#define PG8_WAIT_V(n) asm volatile("s_waitcnt vmcnt(" #n ")" ::: "memory")
#define PG8_WAIT_L(n) asm volatile("s_waitcnt lgkmcnt(" #n ")" ::: "memory")
#define PG8_BAR __builtin_amdgcn_s_barrier()
#define PG8_BAR2 do { if constexpr (!(Sched::CRIP & 16)) __builtin_amdgcn_s_barrier(); } while (0)
#define PG8_SCHED __builtin_amdgcn_sched_barrier(0)
    Unit cur, nxt; int ui = 0;
    if (!S.next(0, cur)) return;
    typename Epi::Pre epre;
    E.prefetch(cur, epre);
    LAS int* lidx = (LAS int*)(lds + 8 * HTB);
    if constexpr (Sched::GATHER) {
        if (tid < 256) { const int v = cur.aidx[tid]; lidx[tid] = (tid < cur.avalid) ? v : 0; }
        __syncthreads();
    }
#pragma unroll
    for (int h = 0; h < 2; ++h)
#pragma unroll
        for (int i = 0; i < 2; ++i) {
            const int r = h * HALF + sR[i];
            if constexpr (Sched::GATHER) vA[h][i] = (unsigned)(lidx[r] * RP + sC[i] * 2);
            else vA[h][i] = (unsigned)(r * RP + sC[i] * 2);
        }
    f32x4 acc[2][2][4][2];
#pragma unroll
    for (int a = 0; a < 2; ++a)
#pragma unroll
        for (int b = 0; b < 2; ++b)
#pragma unroll
            for (int m = 0; m < 4; ++m)
#pragma unroll
                for (int n = 0; n < 2; ++n) acc[a][b][m][n] = (f32x4){0.f, 0.f, 0.f, 0.f};
    i32x8 At[4], B0[2], B1[2];
    if constexpr (Sched::CRIP & 4) { _Pragma("unroll") for (int m = 0; m < 4; ++m) At[m] = (i32x8){0, 0, 0, 0, 0, 0, 0, 0}; _Pragma("unroll") for (int n = 0; n < 2; ++n) { B0[n] = At[0]; B1[n] = At[0]; } }
    int f8scale = 0x7f7f7f7f; asm volatile("" : "+v"(f8scale));
    const char* cA = cur.aBase; const char* cB = cur.bBase;
#ifndef KROT
#define KROT(pm, pn) (((F8 ? 0 : (pm)) + (pn)) & (nt - 1))
#endif
#define PG8_KT(rot, tau) ((size_t)(((tau) + (rot)) & (nt - 1)) * kstep)
    int crot = KROT(cur.pm, cur.pn);
    PG8_STAGE(PG8_SB(0, 0), cB + PG8_KT(crot, 0), voffB); PG8_STAGE(PG8_SB(0, 1), cB + hstep + PG8_KT(crot, 0), voffB); PG8_STAGE(PG8_SA(0, 0), cA + PG8_KT(crot, 0), vA[0]); PG8_STAGE(PG8_SA(0, 1), cA + PG8_KT(crot, 0), vA[1]);
    if (wr == 1) PG8_BAR;
    PG8_WAIT_V(2); PG8_BAR;
    PG8_STAGE(PG8_SB(1, 0), cB + PG8_KT(crot, 1), voffB); PG8_STAGE(PG8_SA(1, 0), cA + PG8_KT(crot, 1), vA[0]); PG8_STAGE(PG8_SB(1, 1), cB + hstep + PG8_KT(crot, 1), voffB);
    PG8_WAIT_V(6); PG8_BAR;
    for (;;) {
        const bool has_next = S.next(ui + 1, nxt);
        const char* nA = has_next ? nxt.aBase : cA; const char* nB = has_next ? nxt.bBase : cB;
        const int nrot = has_next ? KROT(nxt.pm, nxt.pn) : crot;
        for (int t = 0; t < nt; t += 2) {
            const bool last = (t == nt - 2);
            const char* a1 = cA + PG8_KT(crot, t + 1);
            const char* a2 = last ? nA + PG8_KT(nrot, 0) : cA + PG8_KT(crot, t + 2); const char* b2 = last ? nB + PG8_KT(nrot, 0) : cB + PG8_KT(crot, t + 2);
            const char* a3 = last ? nA + PG8_KT(nrot, 1) : cA + PG8_KT(crot, t + 3); const char* b3 = last ? nB + PG8_KT(nrot, 1) : cB + PG8_KT(crot, t + 3);
            int gi = 0;
            if constexpr (Sched::GATHER) { if (t == 0 && has_next && tid < 256) gi = nxt.aidx[tid]; }
            PG8_LDB(B0, 0, 0); PG8_LDB(B1, 0, 1); PG8_SCHED; PG8_LDA(At, 0, 0); PG8_STAGE(PG8_SA(1, 1), a1, vA[1]);
            PG8_WAIT_V(8); PG8_WAIT_L(0); PG8_BAR; PG8_MMA(0, 0, At, B0); PG8_MMA(0, 1, At, B1); PG8_BAR2; PG8_SCHED;
            if constexpr (Sched::GATHER) { if (last && has_next) {
                int tz = threadIdx.x; asm volatile("" : "+v"(tz));
#pragma unroll
                for (int i = 0; i < 2; ++i) { int R, C; stage_rc(tz * 16 + i * 8192, R, C);
#pragma unroll
                    for (int h = 0; h < 2; ++h) vA[h][i] = (unsigned)(lidx[h * HALF + R] * RP + C * 2); } } }
            PG8_LDA(At, 0, 1); PG8_STAGE(PG8_SB(0, 0), b2, voffB); PG8_STAGE(PG8_SB(0, 1), b2 + hstep, voffB); PG8_STAGE(PG8_SA(0, 0), a2, vA[0]);
            PG8_WAIT_V(8); PG8_WAIT_L(0); PG8_BAR; PG8_MMA(1, 0, At, B0); PG8_MMA(1, 1, At, B1); PG8_BAR2; PG8_SCHED;
            PG8_LDB(B0, 1, 0); PG8_LDB(B1, 1, 1); PG8_SCHED; PG8_LDA(At, 1, 0); PG8_STAGE(PG8_SA(0, 1), a2, vA[1]);
            PG8_WAIT_V(8); PG8_WAIT_L(0); PG8_BAR; PG8_MMA(0, 0, At, B0); PG8_MMA(0, 1, At, B1); PG8_BAR2; PG8_SCHED;
            PG8_LDA(At, 1, 1); PG8_STAGE(PG8_SB(1, 0), b3, voffB); PG8_STAGE(PG8_SB(1, 1), b3 + hstep, voffB); PG8_STAGE(PG8_SA(1, 0), a3, vA[0]);
            PG8_WAIT_V(8); PG8_WAIT_L(0); PG8_BAR; PG8_MMA(1, 0, At, B0); PG8_MMA(1, 1, At, B1); PG8_BAR2; PG8_SCHED;
            if constexpr (Sched::GATHER) { if (t == 0 && has_next && tid < 256) lidx[tid] = (tid < nxt.avalid) ? gi : 0; }
        }
        if constexpr (F8) asm volatile("s_nop 15\n\ts_nop 15" ::: "memory");
        if (wr == 0) PG8_BAR;
        { int tz = threadIdx.x; asm volatile("" : "+v"(tz)); const int ewid = __builtin_amdgcn_readfirstlane(tz >> 6), el = tz & 63;
          E(acc, cur, epre, ewid >> 2, ewid & 3, el & 15, el >> 4); }
        if (!has_next) break;
#pragma unroll
        for (int a = 0; a < 2; ++a)
#pragma unroll
            for (int b = 0; b < 2; ++b)
#pragma unroll
                for (int m = 0; m < 4; ++m)
#pragma unroll
                    for (int n = 0; n < 2; ++n) acc[a][b][m][n] = (f32x4){0.f, 0.f, 0.f, 0.f};
        cur = nxt; cA = nA; cB = nB; crot = nrot; ++ui;
        E.prefetch(cur, epre);
        if (wr == 1) PG8_BAR;
    }
    PG8_WAIT_V(0);
    PG8_BAR;
#undef PG8_KT
#undef PG8_SA
#undef PG8_SB
#undef PG8_STAGE
#undef PG8_LDA
#undef PG8_LDB
#undef PG8_MMA
#undef PG8_CAT
#undef PG8_LO
#undef PG8_HI
#undef PG8_WAIT_V
#undef PG8_WAIT_L
#undef PG8_BAR
#undef PG8_BAR2
#undef PG8_SCHED
}

__device__ __forceinline__ bool tile_order(long L, int nM, int nN, int& pm, int& pn) {
    const int nwg = nM * nN; if (L >= nwg) return false;
    int wgid = (int)L; { const int q = nwg / 8, r = nwg % 8, xcd = wgid % 8, off = wgid / 8; wgid = (xcd < r ? xcd * (q + 1) : r * (q + 1) + (xcd - r) * q) + off; }
    const int nig = WGM * nN, gid = wgid / nig, fm = gid * WGM, gsz = (nM - fm) < WGM ? (nM - fm) : WGM;
    pm = fm + ((wgid % nig) % gsz); pn = (wgid % nig) / gsz; return true;
}
template <int CRIP_ = 0> struct SchedDenseT {
    static constexpr bool GATHER = false, FP8 = false; static constexpr int ROWB = 4096, CRIP = CRIP_;
    const char* A; const char* Bt; int nM, nN, G, c;
    __device__ __forceinline__ bool next(int i, Unit& u) const {
        int pm, pn; if (!tile_order((long)i * G + c, nM, nN, pm, pn)) return false;
        u.pm = pm; u.pn = pn; u.e = 0; u.aidx = nullptr; u.avalid = 256;
        u.aBase = A + (size_t)pm * 256 * GK * 2; u.bBase = Bt + (size_t)pn * 256 * GK * 2;
        if constexpr ((CRIP_ & 64) != 0) u.bBase = Bt;
        if constexpr ((CRIP_ & 128) != 0) u.aBase = A;
        return true;
    }
};
typedef SchedDenseT<0> SchedDense;
struct SchedQueue {
    static constexpr bool GATHER = false, FP8 = false; static constexpr int ROWB = 4096, CRIP = 0;
    const char* A; const char* Bt; int nM, nN, q, xcd; unsigned* tick; LAS int* tk;
    __device__ __forceinline__ bool next(int i, Unit& u) const {
        const int t = __builtin_amdgcn_readfirstlane(tk[i & 1]);
        if (i > 0 && threadIdx.x == 0) tk[(i + 1) & 1] = (int)__hip_atomic_fetch_add(tick, 1u, __ATOMIC_RELAXED, __HIP_MEMORY_SCOPE_AGENT);
        if (t >= q) return false;
        const int id = xcd * q + t, nig = WGMQ * nN, gid = id / nig, fm = gid * WGMQ, gsz = (nM - fm) < WGMQ ? (nM - fm) : WGMQ;
        const int pm = fm + ((id % nig) % gsz), pn = (id % nig) / gsz;
        u.pm = pm; u.pn = pn; u.e = 0; u.aidx = nullptr; u.avalid = 256;
        u.aBase = A + (size_t)pm * 256 * ROWB; u.bBase = Bt + (size_t)pn * 256 * ROWB; return true;
    }
};
template <bool GATHER_, int CRIP_ = 0> struct SchedMoE {
    static constexpr bool GATHER = GATHER_ && !(CRIP_ & 32), FP8 = true; static constexpr int ROWB = 2048, CRIP = CRIP_;
    const char* A; const char* Bt; const int* stok; const LAS int* tstart; const LAS int* cnt; int nN, nrowsB  , G, c;
    __device__ __forceinline__ bool next(int i, Unit& u) const {
        const int nM = __builtin_amdgcn_readfirstlane(tstart[NE]); int pm, pn; if (!tile_order((long)i * G + c, nM, nN, pm, pn)) return false;
        int e = 0;
        for (int j = 1; j < NE; ++j) e += (tstart[j] <= pm) ? 1 : 0;
        e = __builtin_amdgcn_readfirstlane(e);
        const int mt = __builtin_amdgcn_readfirstlane(pm - tstart[e]);
        u.pm = pm; u.pn = pn; u.e = e;
        u.avalid = __builtin_amdgcn_readfirstlane(cnt[e]) - mt * 256;
        u.aidx = stok + (size_t)e * T + mt * 256;
        u.aBase = GATHER ? A : A + (size_t)(GATHER_ ? (pm & 127) : pm) * 256 * ROWB;
        u.bBase = Bt + ((size_t)e * nrowsB + (size_t)pn * 256) * ROWB;
        if constexpr ((CRIP_ & 8) != 0) { u.aBase = A; u.bBase = Bt; }
        return true;
    }
};
}

struct EpiNoPre { };
struct EpiInProj {
    static constexpr bool PERM = true; typedef EpiNoPre Pre;
    bf16* proj; float* dtraw;
    __device__ __forceinline__ void prefetch(const pg8::Unit&, Pre&) const {}
    __device__ __forceinline__ void operator()(const f32x4 (&acc)[2][2][4][2], const pg8::Unit& u, const Pre&, int wr, int wc, int fr, int fq) const {
        const int row0 = u.pm * 256 + wr * 64 + fr;
        if (u.pn < 15) {
            const int col0 = u.pn * 256 + wc * 32 + 8 * fq;
#pragma unroll
            for (int ai = 0; ai < 2; ++ai)
#pragma unroll
                for (int m = 0; m < 4; ++m) { bf16* rowp = proj + (size_t)(row0 + ai * 128 + m * 16) * PROJ_LD + col0;
#pragma unroll
                    for (int bj = 0; bj < 2; ++bj) { const f32x4 v0 = acc[ai][bj][m][0], v1 = acc[ai][bj][m][1];
                        v4u w; w.x = pk2(v0[0], v0[1]); w.y = pk2(v0[2], v0[3]); w.z = pk2(v1[0], v1[1]); w.w = pk2(v1[2], v1[3]);
                        *(v4u*)(rowp + bj * 128) = w; } }
        } else if (wc == 0 && fq < 2) {
#pragma unroll
            for (int ai = 0; ai < 2; ++ai)
#pragma unroll
                for (int m = 0; m < 4; ++m) { float* rowp = dtraw + (size_t)(row0 + ai * 128 + m * 16) * 16 + 8 * fq;
                    *(f32x4*)(rowp) = acc[ai][0][m][0]; *(f32x4*)(rowp + 4) = acc[ai][0][m][1]; }
        }
    }
};
struct EpiOutProj {
    static constexpr bool PERM = true; typedef EpiNoPre Pre;
    const float* x; bf16* x1; float* ssq;
    __device__ __forceinline__ void prefetch(const pg8::Unit&, Pre&) const {}
    __device__ __forceinline__ void operator()(const f32x4 (&acc)[2][2][4][2], const pg8::Unit& u, const Pre&, int wr, int wc, int fr, int fq) const {
        const int row0 = u.pm * 256 + wr * 64 + fr, col0 = u.pn * 256 + wc * 32 + 8 * fq;
#pragma unroll
        for (int ai = 0; ai < 2; ++ai) {
            f32x4 xv[4][2][2];
#pragma unroll
            for (int m = 0; m < 4; ++m)
#pragma unroll
                for (int bj = 0; bj < 2; ++bj)
#pragma unroll
                    for (int n = 0; n < 2; ++n) xv[m][bj][n] = *(const f32x4*)(x + (size_t)(row0 + ai * 128 + m * 16) * D + col0 + bj * 128 + n * 4);
#pragma unroll
            for (int m = 0; m < 4; ++m) { asm volatile("" : "+v"(xv[m][0][0]), "+v"(xv[m][0][1]), "+v"(xv[m][1][0]), "+v"(xv[m][1][1])); }
#pragma unroll
            for (int m = 0; m < 4; ++m) { const int row = row0 + ai * 128 + m * 16; const size_t off = (size_t)row * D + col0; float s = 0.f;
#pragma unroll
                for (int bj = 0; bj < 2; ++bj) { const f32x4 o0 = xv[m][bj][0] + acc[ai][bj][m][0], o1 = xv[m][bj][1] + acc[ai][bj][m][1];
                    *(v4u*)(x1 + off + bj * 128) = (v4u){pk2(o0[0], o0[1]), pk2(o0[2], o0[3]), pk2(o1[0], o1[1]), pk2(o1[2], o1[3])};
                    s += ((o0[0] * o0[0] + o0[1] * o0[1]) + (o0[2] * o0[2] + o0[3] * o0[3])) + ((o1[0] * o1[0] + o1[1] * o1[1]) + (o1[2] * o1[2] + o1[3] * o1[3])); }
                s += __shfl_xor(s, 16); s += __shfl_xor(s, 32);
                if (fq == 0) ssq[(size_t)row * 32 + u.pn * 4 + wc] = s; }
        }
    }
};
struct EpiGateUp {
    static constexpr bool PERM = true;
    struct Pre { f32x4 bg[2], bu[2]; };
    unsigned char* hb; const float* b_gate; const float* b_up;
    __device__ __forceinline__ void prefetch(const pg8::Unit& u, Pre& q) const {
        int tz = threadIdx.x; asm volatile("" : "+v"(tz)); const int wc = (tz >> 6) & 3, fq = (tz >> 4) & 3;
        const int f0 = u.pn * 128 + wc * 32 + 8 * fq;
#pragma unroll
        for (int n = 0; n < 2; ++n) { q.bg[n] = *(const f32x4*)(b_gate + (size_t)u.e * FF + f0 + 4 * n); q.bu[n] = *(const f32x4*)(b_up + (size_t)u.e * FF + f0 + 4 * n); }
    }
    __device__ __forceinline__ void operator()(const f32x4 (&acc)[2][2][4][2], const pg8::Unit& u, const Pre& q, int wr, int wc, int fr, int fq) const {
        const int row0 = u.pm * 256 + wr * 64 + fr, f0w = u.pn * 128 + wc * 32;
        constexpr float DS = 1.0f / (FP8_SA * FP8_SW);
#pragma unroll
        for (int ai = 0; ai < 2; ++ai)
#pragma unroll
            for (int mp = 0; mp < 2; ++mp) { unsigned lo[2], hi[2];
#pragma unroll
                for (int mm = 0; mm < 2; ++mm) { const int m = 2 * mp + mm; float h[8];
#pragma unroll
                    for (int n = 0; n < 2; ++n)
#pragma unroll
                        for (int j = 0; j < 4; ++j) { const float g = acc[ai][0][m][n][j] * DS + q.bg[n][j], up = acc[ai][1][m][n][j] * DS + q.bu[n][j];
                            const float gl = fminf(g, 7.0f), li = __builtin_amdgcn_fmed3f(up, -7.0f, 7.0f);
                            const float sg = __builtin_amdgcn_rcpf(1.0f + __builtin_amdgcn_exp2f(gl * (-1.702f * 1.44269504f)));
                            h[n * 4 + j] = (gl * sg) * (li * FP8_SH + FP8_SH); }
                    lo[mm] = pk4_fp8(h[0], h[1], h[2], h[3]); hi[mm] = pk4_fp8(h[4], h[5], h[6], h[7]); }
                const v2u r0 = __builtin_amdgcn_permlane16_swap(lo[0], lo[1], false, false), r1 = __builtin_amdgcn_permlane16_swap(hi[0], hi[1], false, false);
                unsigned char* rowp = hb + (size_t)(row0 + ai * 128 + (2 * mp + (fq & 1)) * 16) * FF + f0w + 16 * (fq >> 1);
                *(v4u*)rowp = (v4u){r0.x, r1.x, r0.y, r1.y}; }
    }
};
struct EpiDown {
    static constexpr bool PERM = true;
    struct Pre { f32x4 bv[2][2]; float gt[2][4]; };
    unsigned char* y2; const float* b_down; const float* sgate; const LAS int* tstart;
    __device__ __forceinline__ void prefetch(const pg8::Unit& u, Pre& q) const {
        int tz = threadIdx.x; asm volatile("" : "+v"(tz)); const int wid = tz >> 6, wr = wid >> 2, wc = wid & 3, fr = tz & 15, fq = (tz >> 4) & 3;
        const int rl0 = wr * 64 + fr, col0 = u.pn * 256 + wc * 32 + 8 * fq;
        const int mt = __builtin_amdgcn_readfirstlane(u.pm - tstart[u.e]);
        const float* gp = sgate + (size_t)u.e * T + mt * 256;
#pragma unroll
        for (int bj = 0; bj < 2; ++bj)
#pragma unroll
            for (int n = 0; n < 2; ++n) q.bv[bj][n] = *(const f32x4*)(b_down + (size_t)u.e * D + col0 + bj * 128 + 4 * n);
#pragma unroll
        for (int ai = 0; ai < 2; ++ai)
#pragma unroll
            for (int m = 0; m < 4; ++m) q.gt[ai][m] = gp[rl0 + ai * 128 + m * 16];
    }
    __device__ __forceinline__ void operator()(const f32x4 (&acc)[2][2][4][2], const pg8::Unit& u, const Pre& q, int wr, int wc, int fr, int fq) const {
        const int rl0 = wr * 64 + fr, colw = u.pn * 256 + wc * 32;
        constexpr float DS = 1.0f / (FP8_SH * FP8_SW);
#pragma unroll
        for (int ai = 0; ai < 2; ++ai)
#pragma unroll
            for (int mp = 0; mp < 2; ++mp)
#pragma unroll
                for (int bj = 0; bj < 2; ++bj) { unsigned lo[2], hi[2];
#pragma unroll
                    for (int mm = 0; mm < 2; ++mm) { const int m = 2 * mp + mm; const float gt = q.gt[ai][m] * FP8_SY;
                        const f32x4 v0 = (acc[ai][bj][m][0] * DS + q.bv[bj][0]) * gt, v1 = (acc[ai][bj][m][1] * DS + q.bv[bj][1]) * gt;
                        lo[mm] = pk4_fp8(sat8(v0[0]), sat8(v0[1]), sat8(v0[2]), sat8(v0[3])); hi[mm] = pk4_fp8(sat8(v1[0]), sat8(v1[1]), sat8(v1[2]), sat8(v1[3])); }
                    const v2u r0 = __builtin_amdgcn_permlane16_swap(lo[0], lo[1], false, false), r1 = __builtin_amdgcn_permlane16_swap(hi[0], hi[1], false, false);
                    unsigned char* rowp = y2 + (size_t)(u.pm * 256 + rl0 + ai * 128 + (2 * mp + (fq & 1)) * 16) * D + colw + bj * 128 + 16 * (fq >> 1);
                    *(v4u*)rowp = (v4u){r0.x, r1.x, r0.y, r1.y}; }
    }
};

__device__ __forceinline__ void p0_tr_item(const float* W, int ldw, int k0, int n0, int nvalid, bf16* WT, int dst_row0, LAS float* scr, int lane) {
    const int c4 = (lane & 15) * 4, kr = lane >> 4;
#pragma unroll 4
    for (int i = 0; i < 16; ++i) { const int kk = 4 * i + kr;
        f32x4 v = (f32x4){0.f, 0.f, 0.f, 0.f};
        if (c4 < nvalid) v = *(const f32x4*)(W + (size_t)(k0 + kk) * ldw + n0 + c4);
        LAS float* d = scr + kk * 65 + c4; d[0] = v[0]; d[1] = v[1]; d[2] = v[2]; d[3] = v[3]; }
    LDS_WAIT(); asm volatile("" ::: "memory");
    const int c = lane >> 3, np = lane & 7;
#pragma unroll
    for (int j = 0; j < 8; ++j) { const int n = 8 * j + np; const LAS float* s = scr + (8 * c) * 65 + n;
        v4u o; o.x = pk2(s[0 * 65], s[1 * 65]); o.y = pk2(s[2 * 65], s[3 * 65]); o.z = pk2(s[4 * 65], s[5 * 65]); o.w = pk2(s[6 * 65], s[7 * 65]);
        *(v4u*)(WT + (size_t)(dst_row0 + n) * 2048 + k0 + 8 * c) = o; }
    LDS_WAIT(); asm volatile("" ::: "memory");
}
__device__ __forceinline__ void f8_tile_load(const float* src, f32x4 (&v)[16], int lane) {
    const float* s0 = src + (size_t)(16 * (lane >> 3)) * 2048 + 4 * (lane & 7);
#pragma unroll
    for (int i = 0; i < 16; ++i) v[i] = __builtin_nontemporal_load((const f32x4*)(s0 + (size_t)i * 2048));
}
__device__ __forceinline__ void f8_tile_store(const f32x4 (&v)[16], unsigned char* dst, int lane) {
    unsigned d[16];
#pragma unroll
    for (int i = 0; i < 16; ++i) d[i] = pk4_fp8(sat8(v[i][0] * FP8_SW), sat8(v[i][1] * FP8_SW), sat8(v[i][2] * FP8_SW), sat8(v[i][3] * FP8_SW));
    unsigned o[4][4];
#pragma unroll
    for (int w = 0; w < 4; ++w) {
        const unsigned t0 = __builtin_amdgcn_perm(d[4 * w + 1], d[4 * w], 0x05010400u), t1 = __builtin_amdgcn_perm(d[4 * w + 1], d[4 * w], 0x07030602u);
        const unsigned t2 = __builtin_amdgcn_perm(d[4 * w + 3], d[4 * w + 2], 0x05010400u), t3 = __builtin_amdgcn_perm(d[4 * w + 3], d[4 * w + 2], 0x07030602u);
        o[0][w] = __builtin_amdgcn_perm(t2, t0, 0x05040100u); o[1][w] = __builtin_amdgcn_perm(t2, t0, 0x07060302u);
        o[2][w] = __builtin_amdgcn_perm(t3, t1, 0x05040100u); o[3][w] = __builtin_amdgcn_perm(t3, t1, 0x07060302u);
    }
    unsigned char* d0 = dst + (size_t)(4 * (lane & 7)) * 2048 + 16 * (lane >> 3);
#pragma unroll
    for (int b = 0; b < 4; ++b) __builtin_nontemporal_store((v4u){o[b][0], o[b][1], o[b][2], o[b][3]}, (v4u*)(d0 + (size_t)b * 2048));
}
__device__ __forceinline__ void f8_item(const Params& p, int it, const float*& src, unsigned char*& dst) {
    const int which = it >> 15, r = it & 32767, e = r >> 10, q = r & 1023, kb = q >> 6, nb = q & 63;
    if (which == 2) { src = p.w_down + (size_t)e * FF * D + (size_t)(kb * 128) * D + nb * 32; dst = p.ws + WS_WD + ((size_t)e * D + nb * 32) * 2048 + kb * 128; }
    else { const int f0 = nb * 32, drow = (f0 >> 7) * 256 + which * 128 + (f0 & 127);
        src = (which == 0 ? p.w_gate : p.w_up) + (size_t)e * D * FF + (size_t)(kb * 128) * FF + f0; dst = p.ws + WS_WGU + ((size_t)e * 4096 + drow) * 2048 + kb * 128; }
}
__device__ __forceinline__ void convert_experts(const Params& p, int first, int stride, int lane) {
    constexpr int NEXP = 3 * NE * 1024;
    f32x4 va[16], vb[16]; const float* sa; unsigned char* da; const float* sb; unsigned char* db;
    int ia = first, ib;
    if (ia < NEXP) { f8_item(p, ia, sa, da); f8_tile_load(sa, va, lane); }
    for (;;) {
        if (ia >= NEXP) break;
        ib = ia + stride; if (ib < NEXP) { f8_item(p, ib, sb, db); f8_tile_load(sb, vb, lane); }
        f8_tile_store(va, da, lane);
        if (ib >= NEXP) break;
        ia = ib + stride; if (ia < NEXP) { f8_item(p, ia, sa, da); f8_tile_load(sa, va, lane); }
        f8_tile_store(vb, db, lane);
    }
}
__device__ __forceinline__ void phase_prologue(const Params& p, LAS unsigned char* lds, int gw, int NGW, int wave, int lane) {
    LAS float* scr = (LAS float*)(lds + wave * 16896);
    bf16* WIN = (bf16*)(p.ws + WS_WIN); bf16* WOUT = (bf16*)(p.ws + WS_WOUT);
    constexpr int I_IN = 32 * 64, I_OUT = 32 * 32;
    for (int it = gw; it < I_IN + I_OUT; it += NGW) {
        int r = it;
        if (r < I_IN) { const int kb = r / 64, nb = r % 64; int nv = NIN - nb * 64; nv = nv < 0 ? 0 : (nv > 64 ? 64 : nv);
            p0_tr_item(p.w_in, NIN, kb * 64, nb * 64, nv, WIN, nb * 64, scr, lane); continue; }
        r -= I_IN;
        { const int kb = r / 32, nb = r % 32; p0_tr_item(p.w_out, D, kb * 64, nb * 64, 64, WOUT, nb * 64, scr, lane); }
    }
    {
        bf16* wrb = (bf16*)(p.ws + WS_WRB);
        for (int idx = gw * 64 + lane; idx < D * NE; idx += NGW * 64) { const int k = idx >> 5, n = idx & 31, j = k >> 5, kq = (k >> 3) & 3, m = k & 7, half = n >> 4, l64 = kq * 16 + (n & 15);
            const float w = p.w_router[idx]; const unsigned hi = f2bf(w); const float lo = w - bflo(hi);
            wrb[((((size_t)j * 2 + half) * 2 + 0) * 64 + l64) * 8 + m] = (bf16)hi; wrb[((((size_t)j * 2 + half) * 2 + 1) * 64 + l64) * 8 + m] = (bf16)f2bf(lo); }
    }
    bf16* HN = (bf16*)(p.ws + WS_HN);
    f32x4 gw4[8];
#pragma unroll
    for (int j = 0; j < 8; ++j) gw4[j] = *((const f32x4*)p.attn_norm_w + 64 * j + lane);
    f32x4 vn[8];
    if (gw < T) { const f32x4* xr = (const f32x4*)(p.x + (size_t)gw * D) + lane;
#pragma unroll
        for (int j = 0; j < 8; ++j) vn[j] = xr[64 * j]; }
    for (int m = gw; m < T; m += NGW) {
        f32x4 v[8]; float s = 0.f;
#pragma unroll
        for (int j = 0; j < 8; ++j) v[j] = vn[j];
        if (m + NGW < T) { const f32x4* xr = (const f32x4*)(p.x + (size_t)(m + NGW) * D) + lane;
#pragma unroll
            for (int j = 0; j < 8; ++j) vn[j] = xr[64 * j]; }
#pragma unroll
        for (int j = 0; j < 8; ++j) s += (v[j][0] * v[j][0] + v[j][1] * v[j][1]) + (v[j][2] * v[j][2] + v[j][3] * v[j][3]);
        const float rstd = rsqrtf(wave_sum(s) * (1.f / D) + EPS);
        v2u* o8 = (v2u*)(HN + (size_t)m * D) + lane;
#pragma unroll
        for (int j = 0; j < 8; ++j) { v2u w; w.x = pk2(v[j][0] * rstd * gw4[j][0], v[j][1] * rstd * gw4[j][1]); w.y = pk2(v[j][2] * rstd * gw4[j][2], v[j][3] * rstd * gw4[j][3]); o8[64 * j] = w; }
    }
}

__device__ __forceinline__ void phase_conv(const Params& p, int G) {
    const bf16* proj = (const bf16*)(p.ws + WS_PROJ); float* xbc = (float*)(p.ws + WS_XBC);
    const float* dtraw = (const float*)(p.ws + WS_DT); float* dts = (float*)(p.ws + WS_DTS);
    const int tid = threadIdx.x;
    for (int item = blockIdx.x; item < T / 64; item += G) {
        const int t0 = item * 64;
        if (tid < 384) {
            const int cg = tid % 192, half = tid / 192, c0 = cg * 8, ts = t0 + half * 32;
            float w[4][8], bb[8];
#pragma unroll
            for (int k = 0; k < 4; ++k)
#pragma unroll
                for (int j = 0; j < 8; ++j) w[k][j] = p.conv_w[k * NXBC + c0 + j];
#pragma unroll
            for (int j = 0; j < 8; ++j) bb[j] = p.conv_b[c0 + j];
            float r0[8], r1[8], r2[8];
            {
                const int tl = ts % SEQ;
                v4u q0 = (v4u){0u, 0u, 0u, 0u}, q1 = q0, q2 = q0;
                if (tl - 3 >= 0) q0 = *(const v4u*)(proj + (size_t)(ts - 3) * PROJ_LD + COL_XBC + c0);
                if (tl - 2 >= 0) q1 = *(const v4u*)(proj + (size_t)(ts - 2) * PROJ_LD + COL_XBC + c0);
                if (tl - 1 >= 0) q2 = *(const v4u*)(proj + (size_t)(ts - 1) * PROJ_LD + COL_XBC + c0);
                unpack8(q0, r0); unpack8(q1, r1); unpack8(q2, r2);
            }
            for (int i = 0; i < 32; ++i) {
                const int t = ts + i;
                const v4u q = *(const v4u*)(proj + (size_t)t * PROJ_LD + COL_XBC + c0);
                float r3[8]; unpack8(q, r3);
                float o[8];
#pragma unroll
                for (int j = 0; j < 8; ++j) { const float a = bb[j] + w[0][j] * r0[j] + w[1][j] * r1[j] + w[2][j] * r2[j] + w[3][j] * r3[j]; o[j] = a * fsigmoid(a); }
                float* dp = xbc + (size_t)t * NXBC + c0;
                *(f32x4*)dp = (f32x4){o[0], o[1], o[2], o[3]}; *(f32x4*)(dp + 4) = (f32x4){o[4], o[5], o[6], o[7]};
#pragma unroll
                for (int j = 0; j < 8; ++j) { r0[j] = r1[j]; r1[j] = r2[j]; r2[j] = r3[j]; }
            }
        } else {
            const int u = tid - 384;
#pragma unroll
            for (int i = 0; i < 8; ++i) { const int idx = u + 128 * i; const int t = t0 + (idx >> 4), h = idx & 15;
                const float v = dtraw[(size_t)t * 16 + h] + p.dt_bias[h];
                dts[(size_t)t * 16 + h] = fmaxf(v, 0.f) + log1pf(__expf(-fabsf(v))); }
        }
    }
}

__device__ __forceinline__ void phase_attn_simple(const Params& p, LAS unsigned char* lds, int G) {
    const bf16* proj = (const bf16*)(p.ws + WS_PROJ); float* att = (float*)(p.ws + WS_ATT);
    LAS float* Ks = (LAS float*)lds; LAS float* Vs = (LAS float*)(lds + 256 * 68 * 4);
    const int tid = threadIdx.x;
    for (int item = blockIdx.x; item < NB * 64 * 2; item += G) {
        const int b = item >> 7, n = (item >> 1) & 63, hk = item & 1;
        __syncthreads();
        {
            const int j = tid >> 1, hf = tid & 1, pos = n * 128 - 128 + j;
            float kv[32], vv[32];
            if (pos >= 0) {
                const bf16* kp = proj + (size_t)(b * SEQ + pos) * PROJ_LD + COL_K + hk * 64 + hf * 32;
                const bf16* vp = proj + (size_t)(b * SEQ + pos) * PROJ_LD + COL_V + hk * 64 + hf * 32;
#pragma unroll
                for (int c = 0; c < 4; ++c) { const v4u a = *(const v4u*)(kp + 8 * c), bq = *(const v4u*)(vp + 8 * c);
                    kv[8 * c + 0] = bflo(a.x); kv[8 * c + 1] = bfhi(a.x); kv[8 * c + 2] = bflo(a.y); kv[8 * c + 3] = bfhi(a.y); kv[8 * c + 4] = bflo(a.z); kv[8 * c + 5] = bfhi(a.z); kv[8 * c + 6] = bflo(a.w); kv[8 * c + 7] = bfhi(a.w);
                    vv[8 * c + 0] = bflo(bq.x); vv[8 * c + 1] = bfhi(bq.x); vv[8 * c + 2] = bflo(bq.y); vv[8 * c + 3] = bfhi(bq.y); vv[8 * c + 4] = bflo(bq.z); vv[8 * c + 5] = bfhi(bq.z); vv[8 * c + 6] = bflo(bq.w); vv[8 * c + 7] = bfhi(bq.w); }
            } else {
#pragma unroll
                for (int d = 0; d < 32; ++d) { kv[d] = 0.f; vv[d] = 0.f; }
            }
            float s = 0.f;
#pragma unroll
            for (int d = 0; d < 32; ++d) s += kv[d] * kv[d];
            s += __shfl_xor(s, 1);
            const float rstd = rsqrtf(s * (1.f / 64.f) + EPS);
#pragma unroll
            for (int d = 0; d < 32; ++d) { Ks[j * 68 + hf * 32 + d] = kv[d] * rstd * p.k_norm_w[hf * 32 + d]; Vs[j * 68 + hf * 32 + d] = vv[d]; }
        }
        __syncthreads();
        const int qi = tid & 127, grp = tid >> 7;
        const int tok = b * SEQ + n * 128 + qi;
        for (int hh = 0; hh < 2; ++hh) {
            const int hq = hk * 8 + grp * 2 + hh;
            float q[64];
            {
                const bf16* qp = proj + (size_t)tok * PROJ_LD + COL_Q + hq * 64;
                float s = 0.f;
#pragma unroll
                for (int c = 0; c < 8; ++c) { const v4u a = *(const v4u*)(qp + 8 * c);
                    q[8 * c + 0] = bflo(a.x); q[8 * c + 1] = bfhi(a.x); q[8 * c + 2] = bflo(a.y); q[8 * c + 3] = bfhi(a.y); q[8 * c + 4] = bflo(a.z); q[8 * c + 5] = bfhi(a.z); q[8 * c + 6] = bflo(a.w); q[8 * c + 7] = bfhi(a.w); }
#pragma unroll
                for (int d = 0; d < 64; ++d) s += q[d] * q[d];
                const float rstd = rsqrtf(s * (1.f / 64.f) + EPS) * 0.125f;
#pragma unroll
                for (int d = 0; d < 64; ++d) q[d] = q[d] * rstd * p.q_norm_w[d];
            }
            float mx = p.sinks[hq], l = 1.0f, o[64];
#pragma unroll
            for (int d = 0; d < 64; ++d) o[d] = 0.f;
            const int jlo = (n == 0) ? 128 : qi + 1;
            for (int j = jlo; j <= qi + 128; ++j) {
                const LAS f32x4* kr = (const LAS f32x4*)(Ks + j * 68);
                float s = 0.f;
#pragma unroll
                for (int c = 0; c < 16; ++c) { const f32x4 kk = kr[c]; s += q[4 * c] * kk[0] + q[4 * c + 1] * kk[1] + q[4 * c + 2] * kk[2] + q[4 * c + 3] * kk[3]; }
                const float mn = fmaxf(mx, s), corr = __expf(mx - mn), pj = __expf(s - mn);
                l = l * corr + pj; mx = mn;
                const LAS f32x4* vr = (const LAS f32x4*)(Vs + j * 68);
#pragma unroll
                for (int c = 0; c < 16; ++c) { const f32x4 vv = vr[c]; o[4 * c] = o[4 * c] * corr + pj * vv[0]; o[4 * c + 1] = o[4 * c + 1] * corr + pj * vv[1]; o[4 * c + 2] = o[4 * c + 2] * corr + pj * vv[2]; o[4 * c + 3] = o[4 * c + 3] * corr + pj * vv[3]; }
            }
            const float inv = 1.0f / l;
            float* op = att + (size_t)tok * 1024 + hq * 64;
#pragma unroll
            for (int c = 0; c < 16; ++c) *(f32x4*)(op + 4 * c) = (f32x4){o[4 * c] * inv, o[4 * c + 1] * inv, o[4 * c + 2] * inv, o[4 * c + 3] * inv};
        }
    }
}

__device__ __forceinline__ void phase_ssd_seq(const Params& p, LAS unsigned char* lds, int G) {
    const float* xbc = (const float*)(p.ws + WS_XBC); const float* dts = (const float*)(p.ws + WS_DTS); float* ys = (float*)(p.ws + WS_YS);
    constexpr int TT = 64;
    LAS float* Bs = (LAS float*)lds;
    LAS float* Cs = Bs + TT * 128;
    LAS float* xs = Cs + TT * 128;
    LAS float* dl = xs + TT * 16;
    LAS float* yo = dl + TT;
    const int tid = threadIdx.x, pl = tid >> 5, ns = tid & 31;
    for (int item = blockIdx.x; item < NB * 16 * 4; item += G) {
        const int b = item >> 6, h = (item >> 2) & 15, pq = item & 3, g = h >> 3;
        const float a = -__expf(p.a_log[h]), dsk = p.d_skip[h];
        f32x4 st = (f32x4){0.f, 0.f, 0.f, 0.f};
        for (int tc = 0; tc < SEQ; tc += TT) {
            __syncthreads();
            const size_t tb = (size_t)b * SEQ + tc;
            for (int i = tid; i < TT * 32; i += NTHREADS) { const int tt = i >> 5, c = (i & 31) * 4;
                *(LAS f32x4*)(Bs + tt * 128 + c) = *(const f32x4*)(xbc + (tb + tt) * NXBC + 1024 + g * 128 + c);
                *(LAS f32x4*)(Cs + tt * 128 + c) = *(const f32x4*)(xbc + (tb + tt) * NXBC + 1280 + g * 128 + c); }
            for (int i = tid; i < TT * 16; i += NTHREADS) { const int tt = i >> 4, c = i & 15; xs[i] = xbc[(tb + tt) * NXBC + h * 64 + pq * 16 + c]; }
            if (tid < TT) dl[tid] = dts[(tb + tid) * 16 + h];
            __syncthreads();
            for (int tt = 0; tt < TT; ++tt) {
                const float dt = dl[tt], xv = xs[tt * 16 + pl];
                const float dA = __expf(dt * a), xd = xv * dt;
                const f32x4 bv = *(const LAS f32x4*)(Bs + tt * 128 + ns * 4), cv = *(const LAS f32x4*)(Cs + tt * 128 + ns * 4);
                st = st * dA + bv * xd;
                float y = (cv[0] * st[0] + cv[1] * st[1]) + (cv[2] * st[2] + cv[3] * st[3]);
                y += __shfl_xor(y, 1); y += __shfl_xor(y, 2); y += __shfl_xor(y, 4); y += __shfl_xor(y, 8); y += __shfl_xor(y, 16);
                if (ns == 0) yo[tt * 16 + pl] = y + dsk * xv;
            }
            __syncthreads();
            for (int i = tid; i < TT * 16; i += NTHREADS) { const int tt = i >> 4, c = i & 15; ys[(tb + tt) * 1024 + h * 64 + pq * 16 + c] = yo[i]; }
        }
    }
}


typedef float f32x16 __attribute__((ext_vector_type(16)));
#define MFMA32(a, b, c) __builtin_amdgcn_mfma_f32_32x32x16_bf16(a, b, c, 0, 0, 0)
constexpr int SPT = 136;
__device__ __forceinline__ float softplus_f(float v) { return fmaxf(v, 0.f) + log1pf(__expf(-fabsf(v))); }

__device__ __forceinline__ void ssd_tables(const Params& p, LAS float* dtl, LAS float* csl, LAS float* wtot, size_t trow0, int h0, int nh, int lane, int wave) {
    const float* dtraw = (const float*)(p.ws + WS_DT);
    for (int rnd = 0; rnd < nh / 4; ++rnd) {
        const int hh = rnd * 4 + (wave >> 1), l = (wave & 1) * 64 + lane, h = h0 + hh;
        const float dt = softplus_f(dtraw[(trow0 + l) * 16 + h] + p.dt_bias[h]);
        float v = dt * (-expf(p.a_log[h]));
#pragma unroll
        for (int o = 1; o < 64; o <<= 1) { const float u = __shfl_up(v, o); v = (lane >= o) ? v + u : v; }
        if (lane == 63) wtot[rnd * 8 + wave] = v;
        __syncthreads();
        if (wave & 1) v += wtot[rnd * 8 + wave - 1];
        dtl[hh * 128 + l] = dt; csl[hh * 128 + l] = v;
    }
    __syncthreads();
}
template <bool TR, bool SCALE>
__device__ __forceinline__ void conv_task(const Params& p, const bf16* proj, size_t trow0, int tl0, int run, int xcol, LAS bf16* dst, int d0, const LAS float* sc) {
    float w[4][8], bb[8];
#pragma unroll
    for (int k = 0; k < 4; ++k) { const f32x4 a = *(const f32x4*)(p.conv_w + k * NXBC + xcol), b = *(const f32x4*)(p.conv_w + k * NXBC + xcol + 4);
        w[k][0] = a[0]; w[k][1] = a[1]; w[k][2] = a[2]; w[k][3] = a[3]; w[k][4] = b[0]; w[k][5] = b[1]; w[k][6] = b[2]; w[k][7] = b[3]; }
    { const f32x4 a = *(const f32x4*)(p.conv_b + xcol), b = *(const f32x4*)(p.conv_b + xcol + 4); bb[0] = a[0]; bb[1] = a[1]; bb[2] = a[2]; bb[3] = a[3]; bb[4] = b[0]; bb[5] = b[1]; bb[6] = b[2]; bb[7] = b[3]; }
    const int l0 = run * 8; const bf16* src = proj + (trow0 + l0) * PROJ_LD + COL_XBC + xcol;
    float r0[8], r1[8], r2[8];
    { const int pos = tl0 + l0; v4u q0 = (v4u){0u, 0u, 0u, 0u}, q1 = q0, q2 = q0;
      if (pos - 3 >= 0) q0 = *(const v4u*)(src - 3 * PROJ_LD);
      if (pos - 2 >= 0) q1 = *(const v4u*)(src - 2 * PROJ_LD);
      if (pos - 1 >= 0) q2 = *(const v4u*)(src - 1 * PROJ_LD);
      unpack8(q0, r0); unpack8(q1, r1); unpack8(q2, r2); }
#pragma unroll
    for (int i = 0; i < 8; i += 2) {
        float r3[8], r4[8], o0[8], o1[8];
        unpack8(*(const v4u*)(src + (size_t)i * PROJ_LD), r3); unpack8(*(const v4u*)(src + (size_t)(i + 1) * PROJ_LD), r4);
#pragma unroll
        for (int j = 0; j < 8; ++j) { const float a0 = bb[j] + w[0][j] * r0[j] + w[1][j] * r1[j] + w[2][j] * r2[j] + w[3][j] * r3[j];
            const float a1 = bb[j] + w[0][j] * r1[j] + w[1][j] * r2[j] + w[2][j] * r3[j] + w[3][j] * r4[j];
            o0[j] = a0 * fsigmoid(a0); o1[j] = a1 * fsigmoid(a1); }
        if constexpr (TR) {
            float s0 = 1.f, s1 = 1.f; if constexpr (SCALE) { s0 = sc[l0 + i]; s1 = sc[l0 + i + 1]; }
#pragma unroll
            for (int j = 0; j < 8; ++j) *(LAS unsigned*)(dst + (d0 + j) * SPT + l0 + i) = pk2(o0[j] * s0, o1[j] * s1);
        } else {
            *(LAS v4u*)(dst + (l0 + i) * SPT + d0) = (v4u){pk2(o0[0], o0[1]), pk2(o0[2], o0[3]), pk2(o0[4], o0[5]), pk2(o0[6], o0[7])};
            *(LAS v4u*)(dst + (l0 + i + 1) * SPT + d0) = (v4u){pk2(o1[0], o1[1]), pk2(o1[2], o1[3]), pk2(o1[4], o1[5]), pk2(o1[6], o1[7])};
        }
#pragma unroll
        for (int j = 0; j < 8; ++j) { r0[j] = r2[j]; r1[j] = r3[j]; r2[j] = r4[j]; }
    }
}

__device__ __forceinline__ void phase_ssd_states(const Params& p, LAS unsigned char* lds, int G, int lane, int wave) {
    const bf16* proj = (const bf16*)(p.ws + WS_PROJ); float* states = (float*)(p.ws + WS_STATES); float* cdec = (float*)(p.ws + WS_CDEC);
    LAS bf16* BT = (LAS bf16*)lds;
    LAS bf16* XdT = BT + 128 * SPT;
    LAS float* dtl = (LAS float*)(lds + 384 * SPT * 2);
    LAS float* csl = dtl + 512; LAS float* scl = csl + 512; LAS float* wtot = scl + 512;
    const int tid = threadIdx.x, r = lane & 31, hf = lane >> 5;
    for (int item = blockIdx.x; item < NB * 64 * 4; item += G) {
        const int b = item >> 8, c = (item >> 2) & 63, g = (item >> 1) & 1, hh2 = item & 1;
        const int h0 = g * 8 + hh2 * 4; const size_t trow0 = (size_t)b * SEQ + c * 128; const int tl0 = c * 128;
        __syncthreads();
        ssd_tables(p, dtl, csl, wtot, trow0, h0, 4, lane, wave);
        scl[tid] = dtl[tid] * __expf(csl[(tid & ~127) + 127] - csl[tid]);
        if ((tid & 127) == 127) cdec[((size_t)b * 64 + c) * 16 + h0 + (tid >> 7)] = __expf(csl[tid]);
        __syncthreads();
        for (int task = tid; task < 48 * 16; task += NTHREADS) { const int cg = task >> 4, run = task & 15;
            if (cg < 16) conv_task<true, false>(p, proj, trow0, tl0, run, 1024 + g * 128 + cg * 8, BT, cg * 8, nullptr);
            else { const int cx = cg - 16; conv_task<true, true>(p, proj, trow0, tl0, run, h0 * 64 + cx * 8, XdT, cx * 8, scl + (cx >> 3) * 128); } }
        __syncthreads();
        const int hh = wave >> 1, nh_ = wave & 1;
        f32x16 acc[2][2];
#pragma unroll
        for (int a = 0; a < 2; ++a)
#pragma unroll
            for (int bq = 0; bq < 2; ++bq)
#pragma unroll
                for (int e = 0; e < 16; ++e) acc[a][bq][e] = 0.f;
#pragma unroll
        for (int ks = 0; ks < 8; ++ks) {
            bf16x8 af[2], bfm[2];
#pragma unroll
            for (int pt = 0; pt < 2; ++pt) af[pt] = *(const LAS bf16x8*)(XdT + (hh * 64 + pt * 32 + r) * SPT + ks * 16 + 8 * hf);
#pragma unroll
            for (int nt = 0; nt < 2; ++nt) bfm[nt] = *(const LAS bf16x8*)(BT + (nh_ * 64 + nt * 32 + r) * SPT + ks * 16 + 8 * hf);
#pragma unroll
            for (int pt = 0; pt < 2; ++pt)
#pragma unroll
                for (int nt = 0; nt < 2; ++nt) acc[pt][nt] = MFMA32(af[pt], bfm[nt], acc[pt][nt]);
        }
        float* sp = states + (((size_t)b * 64 + c) * 16 + h0 + hh) * 64 * 128;
#pragma unroll
        for (int pt = 0; pt < 2; ++pt)
#pragma unroll
            for (int nt = 0; nt < 2; ++nt)
#pragma unroll
                for (int e = 0; e < 16; ++e) sp[(pt * 32 + (e & 3) + 8 * (e >> 2) + 4 * hf) * 128 + nh_ * 64 + nt * 32 + r] = acc[pt][nt][e];
    }
}
__device__ __forceinline__ void phase_ssd_scan(const Params& p, int G) {
    const float* states = (const float*)(p.ws + WS_STATES); const float* cdec = (const float*)(p.ws + WS_CDEC); bf16* sin = (bf16*)(p.ws + WS_SIN);
    for (int idx = blockIdx.x * NTHREADS + threadIdx.x; idx < NB * 16 * 64 * 32; idx += G * NTHREADS) {
        const int n4 = idx & 31, pp = (idx >> 5) & 63, h = (idx >> 11) & 15, b = idx >> 15;
        f32x4 run = (f32x4){0.f, 0.f, 0.f, 0.f};
#pragma unroll 8
        for (int c = 0; c < 64; ++c) {
            const size_t off = ((((size_t)b * 64 + c) * 16 + h) * 64 + pp) * 128 + n4 * 4;
            const f32x4 st = *(const f32x4*)(states + off); const float dec = cdec[((size_t)b * 64 + c) * 16 + h];
            *(v2u*)(sin + off) = (v2u){pk2(run[0], run[1]), pk2(run[2], run[3])};
            run = run * dec + st;
        }
    }
}
__device__ __forceinline__ void ssd_out_pass(const Params& p, const bf16* proj, const bf16* sinp  , const LAS bf16* Cs, const LAS bf16* CB, const LAS bf16* XT,
                                             const LAS float* dth, const LAS float* csh  , LAS float* ssqh  , float Dh, size_t trow0, int h, int hh, int lsel, int r, int hf,
                                             unsigned (&yp)[2][2][8]) {
    f32x16 acc[2][2];
#pragma unroll
    for (int a = 0; a < 2; ++a)
#pragma unroll
        for (int bq = 0; bq < 2; ++bq)
#pragma unroll
            for (int e = 0; e < 16; ++e) acc[a][bq][e] = 0.f;
#pragma unroll
    for (int pt = 0; pt < 2; ++pt) {
        bf16x8 af[8];
#pragma unroll
        for (int ks = 0; ks < 8; ++ks) af[ks] = *(const bf16x8*)(sinp + (pt * 32 + r) * 128 + ks * 16 + 8 * hf);
#pragma unroll
        for (int j = 0; j < 2; ++j) { const int lt = j == 0 ? (lsel ? 1 : 0) : (lsel ? 2 : 3);
#pragma unroll
            for (int ks = 0; ks < 8; ++ks) { const bf16x8 bq = *(const LAS bf16x8*)(Cs + (lt * 32 + r) * SPT + ks * 16 + 8 * hf); acc[pt][j] = MFMA32(af[ks], bq, acc[pt][j]); } }
    }
#pragma unroll
    for (int j = 0; j < 2; ++j) { const int lt = j == 0 ? (lsel ? 1 : 0) : (lsel ? 2 : 3); const float el = __expf(csh[lt * 32 + r]);
#pragma unroll
        for (int pt = 0; pt < 2; ++pt) acc[pt][j] = acc[pt][j] * el; }
#pragma unroll
    for (int j = 0; j < 2; ++j) { const int lt = j == 0 ? (lsel ? 1 : 0) : (lsel ? 2 : 3); const int lcol = lt * 32 + r; const float csL = csh[lcol]; const int nks = 2 * lt + 2;
        for (int ks = 0; ks < nks; ++ks) { const int s0 = ks * 16 + 8 * hf;
            const v4u cbv = *(const LAS v4u*)(CB + lcol * SPT + s0);
            const f32x4 c0 = *(const LAS f32x4*)(csh + s0), c1 = *(const LAS f32x4*)(csh + s0 + 4), d0 = *(const LAS f32x4*)(dth + s0), d1 = *(const LAS f32x4*)(dth + s0 + 4);
            float cbf[8]; unpack8(cbv, cbf); float m[8];
#pragma unroll
            for (int jj = 0; jj < 8; ++jj) { const float cs_s = jj < 4 ? c0[jj & 3] : c1[jj & 3], dt_s = jj < 4 ? d0[jj & 3] : d1[jj & 3];
                float v = cbf[jj] * __expf(fminf(csL - cs_s, 0.f)) * dt_s; v = (s0 + jj <= lcol) ? v : 0.f; m[jj] = (s0 + jj == lcol) ? v + Dh : v; }
            v4u mp; mp.x = pk2(m[0], m[1]); mp.y = pk2(m[2], m[3]); mp.z = pk2(m[4], m[5]); mp.w = pk2(m[6], m[7]);
            const bf16x8 mf = __builtin_bit_cast(bf16x8, mp);
#pragma unroll
            for (int pt = 0; pt < 2; ++pt) { const bf16x8 a = *(const LAS bf16x8*)(XT + (hh * 64 + pt * 32 + r) * SPT + s0); acc[pt][j] = MFMA32(a, mf, acc[pt][j]); }
        } }
#pragma unroll
    for (int j = 0; j < 2; ++j) { const int lt = j == 0 ? (lsel ? 1 : 0) : (lsel ? 2 : 3); const size_t t = trow0 + lt * 32 + r; float ss = 0.f;
#pragma unroll
        for (int pt = 0; pt < 2; ++pt)
#pragma unroll
            for (int pp = 0; pp < 2; ++pp) {
                const v4u z16 = *(const v4u*)(proj + t * PROJ_LD + COL_Z + h * 64 + pt * 32 + 16 * pp + 8 * hf);
                const v2u s0 = __builtin_amdgcn_permlane32_swap(z16.x, z16.z, false, false), s1 = __builtin_amdgcn_permlane32_swap(z16.y, z16.w, false, false);
#pragma unroll
                for (int qq = 0; qq < 2; ++qq) { const int q = 2 * pp + qq; const unsigned zx = qq == 0 ? s0.x : s0.y, zy = qq == 0 ? s1.x : s1.y;
                    const float z0 = bflo(zx), z1 = bfhi(zx), z2 = bflo(zy), z3 = bfhi(zy);
                    const float g0 = acc[pt][j][4 * q] * (z0 * fsigmoid(z0)), g1 = acc[pt][j][4 * q + 1] * (z1 * fsigmoid(z1)), g2 = acc[pt][j][4 * q + 2] * (z2 * fsigmoid(z2)), g3 = acc[pt][j][4 * q + 3] * (z3 * fsigmoid(z3));
                    yp[pt][j][2 * q] = pk2(g0, g1); yp[pt][j][2 * q + 1] = pk2(g2, g3);
                    ss += (g0 * g0 + g1 * g1) + (g2 * g2 + g3 * g3); } }
        ss += __shfl_xor(ss, 32);
        if (hf == 0) ssqh[lt * 32 + r] = ss; }
}
__device__ __forceinline__ void ssd_out_store(const Params& p, bf16* mix, const LAS float* ssqp, size_t trow0, int h, int lsel, int r, int hf, const unsigned (&yp)[2][2][8]) {
    f32x4 w4[2][4];
#pragma unroll
    for (int pt = 0; pt < 2; ++pt)
#pragma unroll
        for (int q = 0; q < 4; ++q) w4[pt][q] = *(const f32x4*)(p.ssm_norm_w + h * 64 + pt * 32 + 8 * q + 4 * hf);
#pragma unroll
    for (int pt = 0; pt < 2; ++pt) { asm volatile("" : "+v"(w4[pt][0]), "+v"(w4[pt][1]), "+v"(w4[pt][2]), "+v"(w4[pt][3])); }
#pragma unroll
    for (int j = 0; j < 2; ++j) { const int lt = j == 0 ? (lsel ? 1 : 0) : (lsel ? 2 : 3); const int l = lt * 32 + r; const size_t t = trow0 + l;
        float tot = 0.f;
#pragma unroll
        for (int hd = 0; hd < 8; ++hd) tot += ssqp[hd * 128 + l];
        const float rstd = rsqrtf(tot * (1.f / 512.f) + EPS);
#pragma unroll
        for (int pt = 0; pt < 2; ++pt)
#pragma unroll
            for (int pp = 0; pp < 2; ++pp) { unsigned oa[2], ob[2];
#pragma unroll
                for (int qq = 0; qq < 2; ++qq) { const int q = 2 * pp + qq; const unsigned u0 = yp[pt][j][2 * q], u1 = yp[pt][j][2 * q + 1];
                    const unsigned x0 = pk2(bflo(u0) * rstd * w4[pt][q][0], bfhi(u0) * rstd * w4[pt][q][1]), x1 = pk2(bflo(u1) * rstd * w4[pt][q][2], bfhi(u1) * rstd * w4[pt][q][3]);
                    if (qq == 0) { oa[0] = x0; oa[1] = x1; } else { ob[0] = x0; ob[1] = x1; } }
                const v2u r0 = __builtin_amdgcn_permlane32_swap(oa[0], ob[0], false, false), r1 = __builtin_amdgcn_permlane32_swap(oa[1], ob[1], false, false);
                *(v4u*)(mix + t * D + 1024 + h * 64 + pt * 32 + 16 * pp + 8 * hf) = (v4u){r0.x, r1.x, r0.y, r1.y}; } }
}
__device__ __forceinline__ void phase_ssd_out(const Params& p, LAS unsigned char* lds, int G, int lane, int wave) {
    const bf16* proj = (const bf16*)(p.ws + WS_PROJ); const bf16* sin = (const bf16*)(p.ws + WS_SIN); bf16* mix = (bf16*)(p.ws + WS_MIX);
    LAS bf16* Cs = (LAS bf16*)lds;
    LAS bf16* Bs = Cs + 128 * SPT;
    LAS bf16* XT = Bs + 128 * SPT;
    LAS float* dtl = (LAS float*)(lds + 512 * SPT * 2);
    LAS float* csl = dtl + 1024; LAS float* ssqp = csl + 1024; LAS float* wtot = ssqp + 1024;
    const int tid = threadIdx.x, r = lane & 31, hf = lane >> 5;
    for (int item = blockIdx.x; item < NB * 64 * 2; item += G) {
        const int b = item >> 7, c = (item >> 1) & 63, g = item & 1;
        const int h0 = g * 8; const size_t trow0 = (size_t)b * SEQ + c * 128; const int tl0 = c * 128;
        __syncthreads();
        { int tz_ = threadIdx.x; asm volatile("" : "+v"(tz_)); ssd_tables(p, dtl, csl, wtot, trow0, h0, 8, tz_ & 63, __builtin_amdgcn_readfirstlane(tz_ >> 6)); }
        int tq = threadIdx.x; asm volatile("" : "+v"(tq));
        for (int task = tq; task < 64 * 16; task += NTHREADS) { const int cg = task >> 4, run = task & 15;
            if (cg < 16) conv_task<false, false>(p, proj, trow0, tl0, run, 1280 + g * 128 + cg * 8, Cs, cg * 8, nullptr);
            else if (cg < 32) conv_task<false, false>(p, proj, trow0, tl0, run, 1024 + g * 128 + (cg - 16) * 8, Bs, (cg - 16) * 8, nullptr);
            else conv_task<true, false>(p, proj, trow0, tl0, run, h0 * 64 + (cg - 32) * 8, XT, (cg - 32) * 8, nullptr); }
        __syncthreads();
        {
            int tz_ = threadIdx.x; asm volatile("" : "+v"(tz_)); const int wave = __builtin_amdgcn_readfirstlane(tz_ >> 6), r = tz_ & 31, hf = (tz_ >> 5) & 1;
            f32x16 cb[2];
#pragma unroll
            for (int q = 0; q < 2; ++q) { const int tile = 2 * wave + q, lt = tile >> 2, st = tile & 3;
#pragma unroll
                for (int e = 0; e < 16; ++e) cb[q][e] = 0.f;
                if (st <= lt) {
#pragma unroll
                    for (int ks = 0; ks < 8; ++ks) { const bf16x8 a = *(const LAS bf16x8*)(Cs + (lt * 32 + r) * SPT + ks * 16 + 8 * hf), bq = *(const LAS bf16x8*)(Bs + (st * 32 + r) * SPT + ks * 16 + 8 * hf);
                        cb[q] = MFMA32(a, bq, cb[q]); } } }
            __syncthreads();
#pragma unroll
            for (int q = 0; q < 2; ++q) { const int tile = 2 * wave + q, lt = tile >> 2, st = tile & 3;
                if (st <= lt) {
#pragma unroll
                    for (int e = 0; e < 16; ++e) Bs[(lt * 32 + (e & 3) + 8 * (e >> 2) + 4 * hf) * SPT + st * 32 + r] = (bf16)f2bf(cb[q][e]); } }
        }
        __syncthreads();
        unsigned y0[2][2][8], y1[2][2][8];
#define FRESH_IDS() int tz_ = threadIdx.x; asm volatile("" : "+v"(tz_)); const int wv_ = __builtin_amdgcn_readfirstlane(tz_ >> 6), hh = wv_ >> 1, lsel = wv_ & 1, r_ = tz_ & 31, hf_ = (tz_ >> 5) & 1
        { FRESH_IDS(); const int h = h0 + hh;
          ssd_out_pass(p, proj, sin + (((size_t)b * 64 + c) * 16 + h) * 64 * 128, Cs, Bs, XT, dtl + hh * 128, csl + hh * 128, ssqp + hh * 128, p.d_skip[h], trow0, h, hh, lsel, r_, hf_, y0); }
        __syncthreads();
        { int tz_ = threadIdx.x; asm volatile("" : "+v"(tz_)); const int cg = tz_ >> 4, run = tz_ & 15; conv_task<true, false>(p, proj, trow0, tl0, run, (h0 + 4) * 64 + cg * 8, XT, cg * 8, nullptr); }
        __syncthreads();
        { FRESH_IDS(); const int h = h0 + 4 + hh;
          ssd_out_pass(p, proj, sin + (((size_t)b * 64 + c) * 16 + h) * 64 * 128, Cs, Bs, XT, dtl + (4 + hh) * 128, csl + (4 + hh) * 128, ssqp + (4 + hh) * 128, p.d_skip[h], trow0, h, hh, lsel, r_, hf_, y1); }
        __syncthreads();
        { FRESH_IDS(); ssd_out_store(p, mix, ssqp, trow0, h0 + hh, lsel, r_, hf_, y0); }
        { FRESH_IDS(); ssd_out_store(p, mix, ssqp, trow0, h0 + 4 + hh, lsel, r_, hf_, y1); }
#undef FRESH_IDS
    }
}


__device__ __forceinline__ void phase_attn(const Params& p, LAS unsigned char* lds, int G) {
    const bf16* proj = (const bf16*)(p.ws + WS_PROJ); bf16* mix = (bf16*)(p.ws + WS_MIX);
    constexpr int KP = 72, VP = 260; constexpr float NEG = -1.0e30f;
    LAS bf16* Ks = (LAS bf16*)lds;
    LAS bf16* VT = Ks + 2 * 256 * KP;
    LAS float* ssqp = (LAS float*)(lds + 2 * 256 * KP * 2 + 2 * 64 * VP * 2);
    for (int item = blockIdx.x; item < NB * 64; item += G) {
        const int b = item >> 6, n = item & 63;
        __syncthreads();
        {
            int tz = threadIdx.x; asm volatile("" : "+v"(tz));
            const int j = tz >> 1, hk = tz & 1, pos = n * 128 - 128 + j;
            LAS bf16* kd = Ks + (hk * 256 + j) * KP; LAS bf16* vd = VT + hk * 64 * VP + j;
            if (pos >= 0) {
                const bf16* kp = proj + (size_t)(b * SEQ + pos) * PROJ_LD + COL_K + hk * 64;
                v4u kq[8]; float ss = 0.f;
#pragma unroll
                for (int c = 0; c < 8; ++c) { kq[c] = *(const v4u*)(kp + 8 * c); float f[8]; unpack8(kq[c], f);
#pragma unroll
                    for (int e = 0; e < 8; ++e) ss += f[e] * f[e]; }
                const float rstd = rsqrtf(ss * (1.f / 64.f) + EPS);
#pragma unroll
                for (int c = 0; c < 8; ++c) { float f[8]; unpack8(kq[c], f); const f32x4 w0 = *(const f32x4*)(p.k_norm_w + 8 * c), w1 = *(const f32x4*)(p.k_norm_w + 8 * c + 4);
                    *(LAS v4u*)(kd + 8 * c) = (v4u){pk2(f[0] * rstd * w0[0], f[1] * rstd * w0[1]), pk2(f[2] * rstd * w0[2], f[3] * rstd * w0[3]), pk2(f[4] * rstd * w1[0], f[5] * rstd * w1[1]), pk2(f[6] * rstd * w1[2], f[7] * rstd * w1[3])}; }
                const bf16* vp = kp + (COL_V - COL_K);
#pragma unroll
                for (int c = 0; c < 8; ++c) { const v4u q = *(const v4u*)(vp + 8 * c);
                    vd[(8 * c + 0) * VP] = (bf16)(q.x & 0xffffu); vd[(8 * c + 1) * VP] = (bf16)(q.x >> 16); vd[(8 * c + 2) * VP] = (bf16)(q.y & 0xffffu); vd[(8 * c + 3) * VP] = (bf16)(q.y >> 16);
                    vd[(8 * c + 4) * VP] = (bf16)(q.z & 0xffffu); vd[(8 * c + 5) * VP] = (bf16)(q.z >> 16); vd[(8 * c + 6) * VP] = (bf16)(q.w & 0xffffu); vd[(8 * c + 7) * VP] = (bf16)(q.w >> 16); }
            } else {
#pragma unroll
                for (int c = 0; c < 8; ++c) *(LAS v4u*)(kd + 8 * c) = (v4u){0u, 0u, 0u, 0u};
#pragma unroll
                for (int d = 0; d < 64; ++d) vd[d * VP] = (bf16)0;
            }
        }
        __syncthreads();
        {
            int tz = threadIdx.x; asm volatile("" : "+v"(tz));
            const int wave = __builtin_amdgcn_readfirstlane(tz >> 6), r = tz & 31, hf = (tz >> 5) & 1, hk = wave >> 2, wl = wave & 3;
            const LAS bf16* Kh = Ks + hk * 256 * KP; const LAS bf16* Vh = VT + hk * 64 * VP;
            f32x4 qw[4][2];
#pragma unroll
            for (int ks = 0; ks < 4; ++ks) { qw[ks][0] = *(const f32x4*)(p.q_norm_w + 16 * ks + 8 * hf); qw[ks][1] = *(const f32x4*)(p.q_norm_w + 16 * ks + 8 * hf + 4); }
            v4u qn[4];
            { const bf16* qp0 = proj + ((size_t)b * SEQ + n * 128 + r) * PROJ_LD + COL_Q + (hk * 8 + wl * 2) * 64 + 8 * hf;
#pragma unroll
              for (int ks = 0; ks < 4; ++ks) qn[ks] = *(const v4u*)(qp0 + 16 * ks); }
            for (int it = 0; it < 8; ++it) {
                const int hsel = it >> 2, qt = it & 3;
                const int hq = hk * 8 + wl * 2 + hsel; const float sink = p.sinks[hq] * 1.44269504f;
                {
                    const size_t tok = (size_t)b * SEQ + n * 128 + qt * 32 + r;
                    bf16x8 qf[4];
                    {
                        v4u qv[4]; float ss = 0.f;
#pragma unroll
                        for (int ks = 0; ks < 4; ++ks) { qv[ks] = qn[ks]; float f[8]; unpack8(qv[ks], f);
#pragma unroll
                            for (int e = 0; e < 8; ++e) ss += f[e] * f[e]; }
                        if (it < 7) { const int it2 = it + 1, hq2 = hk * 8 + wl * 2 + (it2 >> 2);
                            const bf16* qp2 = proj + ((size_t)b * SEQ + n * 128 + (it2 & 3) * 32 + r) * PROJ_LD + COL_Q + hq2 * 64 + 8 * hf;
#pragma unroll
                            for (int ks = 0; ks < 4; ++ks) qn[ks] = *(const v4u*)(qp2 + 16 * ks); }
                        ss += __shfl_xor(ss, 32);
                        const float rstd = rsqrtf(ss * (1.f / 64.f) + EPS) * (0.125f * 1.44269504f);
#pragma unroll
                        for (int ks = 0; ks < 4; ++ks) { float f[8]; unpack8(qv[ks], f); const f32x4 w0 = qw[ks][0], w1 = qw[ks][1];
                            const v4u o = (v4u){pk2(f[0] * rstd * w0[0], f[1] * rstd * w0[1]), pk2(f[2] * rstd * w0[2], f[3] * rstd * w0[3]), pk2(f[4] * rstd * w1[0], f[5] * rstd * w1[1]), pk2(f[6] * rstd * w1[2], f[7] * rstd * w1[3])};
                            qf[ks] = __builtin_bit_cast(bf16x8, o); }
                    }
                    f32x16 sc[5];
#pragma unroll
                    for (int jt = 0; jt < 5; ++jt) {
#pragma unroll
                        for (int e = 0; e < 16; ++e) sc[jt][e] = 0.f;
#pragma unroll
                        for (int ks = 0; ks < 4; ++ks) { const bf16x8 a = *(const LAS bf16x8*)(Kh + ((qt + jt) * 32 + r) * KP + ks * 16 + 8 * hf); sc[jt] = MFMA32(a, qf[ks], sc[jt]); } }
#pragma unroll
                    for (int e = 0; e < 16; ++e) { const int kk = (e & 3) + 8 * (e >> 2) + 4 * hf;
                        sc[0][e] = (kk > r) ? sc[0][e] : NEG; sc[4][e] = (kk <= r) ? sc[4][e] : NEG; }
                    if (n == 0) {
#pragma unroll
                        for (int jt = 0; jt < 4; ++jt) if (qt + jt < 4) {
#pragma unroll
                            for (int e = 0; e < 16; ++e) sc[jt][e] = NEG; } }
                    float m = sink;
#pragma unroll
                    for (int jt = 0; jt < 5; ++jt)
#pragma unroll
                        for (int e = 0; e < 16; ++e) m = fmaxf(m, sc[jt][e]);
                    m = fmaxf(m, __shfl_xor(m, 32));
                    float l = 0.f;
#pragma unroll
                    for (int jt = 0; jt < 5; ++jt)
#pragma unroll
                        for (int e = 0; e < 16; ++e) { const float pv = __builtin_amdgcn_exp2f(sc[jt][e] - m); sc[jt][e] = pv; l += pv; }
                    l += __shfl_xor(l, 32); l += __builtin_amdgcn_exp2f(sink - m);
                    f32x16 o[2];
#pragma unroll
                    for (int dt = 0; dt < 2; ++dt)
#pragma unroll
                        for (int e = 0; e < 16; ++e) o[dt][e] = 0.f;
#pragma unroll
                    for (int jt = 0; jt < 5; ++jt)
#pragma unroll
                        for (int s2 = 0; s2 < 2; ++s2) {
                            const v4u pp = (v4u){pk2(sc[jt][8 * s2], sc[jt][8 * s2 + 1]), pk2(sc[jt][8 * s2 + 2], sc[jt][8 * s2 + 3]), pk2(sc[jt][8 * s2 + 4], sc[jt][8 * s2 + 5]), pk2(sc[jt][8 * s2 + 6], sc[jt][8 * s2 + 7])};
                            const bf16x8 pf = __builtin_bit_cast(bf16x8, pp);
                            const int kb = (qt + jt) * 32 + 16 * s2 + 4 * hf;
#pragma unroll
                            for (int dt = 0; dt < 2; ++dt) { const LAS bf16* vr = Vh + (dt * 32 + r) * VP + kb;
                                const v2u a0 = *(const LAS v2u*)vr, a1 = *(const LAS v2u*)(vr + 8);
                                const v4u av = (v4u){a0.x, a0.y, a1.x, a1.y};
                                o[dt] = MFMA32(__builtin_bit_cast(bf16x8, av), pf, o[dt]); }
                        }
                    const float inv = 1.0f / l; float ss = 0.f;
#pragma unroll
                    for (int dt = 0; dt < 2; ++dt)
#pragma unroll
                        for (int pp = 0; pp < 2; ++pp) {
                            unsigned pa[2], pb[2];
#pragma unroll
                            for (int qq = 0; qq < 2; ++qq) { const int q = 2 * pp + qq; const float g0 = o[dt][4 * q] * inv, g1 = o[dt][4 * q + 1] * inv, g2 = o[dt][4 * q + 2] * inv, g3 = o[dt][4 * q + 3] * inv;
                                ss += (g0 * g0 + g1 * g1) + (g2 * g2 + g3 * g3);
                                if (qq == 0) { pa[0] = pk2(g0, g1); pa[1] = pk2(g2, g3); } else { pb[0] = pk2(g0, g1); pb[1] = pk2(g2, g3); } }
                            const v2u r0 = __builtin_amdgcn_permlane32_swap(pa[0], pb[0], false, false), r1 = __builtin_amdgcn_permlane32_swap(pa[1], pb[1], false, false);
                            *(v4u*)(mix + tok * D + hq * 64 + dt * 32 + 16 * pp + 8 * hf) = (v4u){r0.x, r1.x, r0.y, r1.y}; }
                    ss += __shfl_xor(ss, 32);
                    if (hf == 0) ssqp[hq * 128 + qt * 32 + r] = ss;
                }
            }
        }
        __syncthreads();
        {
            int tz = threadIdx.x; asm volatile("" : "+v"(tz));
            const int wave = __builtin_amdgcn_readfirstlane(tz >> 6), r = tz & 31, hf = (tz >> 5) & 1, hk = wave >> 2, wl = wave & 3;
            for (int qt = 0; qt < 4; ++qt) {
                const size_t tok = (size_t)b * SEQ + n * 128 + qt * 32 + r;
                float tot = 0.f;
#pragma unroll
                for (int hd = 0; hd < 16; ++hd) tot += ssqp[hd * 128 + qt * 32 + r];
                const float rstd = rsqrtf(tot * (1.f / 1024.f) + EPS);
                v4u uu[2][2][2];
#pragma unroll
                for (int hsel = 0; hsel < 2; ++hsel)
#pragma unroll
                    for (int dt = 0; dt < 2; ++dt)
#pragma unroll
                        for (int pp = 0; pp < 2; ++pp) uu[hsel][dt][pp] = *(const v4u*)(mix + tok * D + (hk * 8 + wl * 2 + hsel) * 64 + dt * 32 + 16 * pp + 8 * hf);
#pragma unroll
                for (int hsel = 0; hsel < 2; ++hsel)
#pragma unroll
                    for (int dt = 0; dt < 2; ++dt) { asm volatile("" : "+v"(uu[hsel][dt][0]), "+v"(uu[hsel][dt][1])); }
#pragma unroll
                for (int hsel = 0; hsel < 2; ++hsel)
#pragma unroll
                    for (int dt = 0; dt < 2; ++dt)
#pragma unroll
                        for (int pp = 0; pp < 2; ++pp) { const int col = (hk * 8 + wl * 2 + hsel) * 64 + dt * 32 + 16 * pp + 8 * hf;
                            const v4u u = uu[hsel][dt][pp]; const f32x4 w0 = *(const f32x4*)(p.attn_out_norm_w + col), w1 = *(const f32x4*)(p.attn_out_norm_w + col + 4);
                            *(v4u*)(mix + tok * D + col) = (v4u){pk2(bflo(u.x) * rstd * w0[0], bfhi(u.x) * rstd * w0[1]), pk2(bflo(u.y) * rstd * w0[2], bfhi(u.y) * rstd * w0[3]),
                                                                 pk2(bflo(u.z) * rstd * w1[0], bfhi(u.z) * rstd * w1[1]), pk2(bflo(u.w) * rstd * w1[2], bfhi(u.w) * rstd * w1[3])}; }
            }
        }
    }
}

__device__ __forceinline__ void phase_router(const Params& p, LAS unsigned char* lds, unsigned* ctl, int G, int wave, int lane) {
    const bf16* x1 = (const bf16*)(p.ws + WS_X1); const float* ssq = (const float*)(p.ws + WS_SSQ); unsigned char* hf = p.ws + WS_HF;
    int* stok = (int*)(p.ws + WS_STOK); float* sgate = (float*)(p.ws + WS_SGATE); int* toke = (int*)(p.ws + WS_TOKE); int* tokp = (int*)(p.ws + WS_TOKP);
    LAS float* lg = (LAS float*)lds + wave * (16 * 33);
    LAS int* hist = (LAS int*)(lds + 32768); LAS int* gbase = hist + 32;
    const int tid = threadIdx.x, i16 = lane & 15, kq = lane >> 4;
    for (int tb = blockIdx.x * 8; tb < T / 16; tb += G * 8) {
        if (tid < 32) hist[tid] = 0;
        __syncthreads();
        const int tok = (tb + wave) * 16 + i16;
        float s = 0.f;
        { const f32x4* sp = (const f32x4*)(ssq + (size_t)tok * 32 + kq * 8); const f32x4 a = sp[0], b = sp[1]; s = ((a[0] + a[1]) + (a[2] + a[3])) + ((b[0] + b[1]) + (b[2] + b[3])); }
        s += __shfl_xor(s, 16); s += __shfl_xor(s, 32);
        const float rstd = rsqrtf(s * (1.f / D) + EPS);
        f32x4 acc0 = (f32x4){0.f, 0.f, 0.f, 0.f}, acc1 = (f32x4){0.f, 0.f, 0.f, 0.f};
        const bf16* xr = x1 + (size_t)tok * D + 8 * kq;
        unsigned char* hr = hf + (size_t)tok * D + 8 * kq;
        const v4u* wb = (const v4u*)(p.ws + WS_WRB) + lane;
        v4u xq[4];
#pragma unroll
        for (int u = 0; u < 4; ++u) xq[u] = *(const v4u*)(xr + 32 * u);
        unsigned hlo = 0, hhi = 0;
        for (int j4 = 0; j4 < 64; j4 += 4) {
            f32x4 xc[4][2], gq[4][2]; v4u wf[4][2][2];
#pragma unroll
            for (int u = 0; u < 4; ++u) { float f[8]; unpack8(xq[u], f); xc[u][0] = (f32x4){f[0], f[1], f[2], f[3]}; xc[u][1] = (f32x4){f[4], f[5], f[6], f[7]}; }
            if (j4 + 4 < 64) {
#pragma unroll
                for (int u = 0; u < 4; ++u) xq[u] = *(const v4u*)(xr + 32 * (j4 + 4 + u)); }
#pragma unroll
            for (int u = 0; u < 4; ++u) { gq[u][0] = *(const f32x4*)(p.ffn_norm_w + 32 * (j4 + u) + 8 * kq); gq[u][1] = *(const f32x4*)(p.ffn_norm_w + 32 * (j4 + u) + 8 * kq + 4);
#pragma unroll
                for (int hfl = 0; hfl < 2; ++hfl)
#pragma unroll
                    for (int hl = 0; hl < 2; ++hl) wf[u][hfl][hl] = wb[(((j4 + u) * 2 + hfl) * 2 + hl) * 64]; }
#pragma unroll
            for (int u = 0; u < 4; ++u) {
                float hv[8];
#pragma unroll
                for (int k = 0; k < 4; ++k) { hv[k] = xc[u][0][k] * rstd * gq[u][0][k]; hv[4 + k] = xc[u][1][k] * rstd * gq[u][1][k]; }
                { const unsigned flo = pk4_fp8(sat8(hv[0] * FP8_SA), sat8(hv[1] * FP8_SA), sat8(hv[2] * FP8_SA), sat8(hv[3] * FP8_SA)), fhi = pk4_fp8(sat8(hv[4] * FP8_SA), sat8(hv[5] * FP8_SA), sat8(hv[6] * FP8_SA), sat8(hv[7] * FP8_SA));
                  if ((u & 1) == 0) { hlo = flo; hhi = fhi; }
                  else { const v2u r0 = __builtin_amdgcn_permlane16_swap(hlo, flo, false, false), r1 = __builtin_amdgcn_permlane16_swap(hhi, fhi, false, false);
                         *(v4u*)(hf + (size_t)tok * D + 32 * (j4 + u - 1 + (kq & 1)) + 16 * (kq >> 1)) = (v4u){r0.x, r1.x, r0.y, r1.y}; } }
                v4u ah, al;
                ah.x = pk2(hv[0], hv[1]); ah.y = pk2(hv[2], hv[3]); ah.z = pk2(hv[4], hv[5]); ah.w = pk2(hv[6], hv[7]);
                al.x = pk2(hv[0] - bflo(ah.x), hv[1] - bfhi(ah.x)); al.y = pk2(hv[2] - bflo(ah.y), hv[3] - bfhi(ah.y)); al.z = pk2(hv[4] - bflo(ah.z), hv[5] - bfhi(ah.z)); al.w = pk2(hv[6] - bflo(ah.w), hv[7] - bfhi(ah.w));
                const bf16x8 fah = __builtin_bit_cast(bf16x8, ah), fal = __builtin_bit_cast(bf16x8, al);
                acc0 = __builtin_amdgcn_mfma_f32_16x16x32_bf16(fah, __builtin_bit_cast(bf16x8, wf[u][0][0]), acc0, 0, 0, 0);
                acc0 = __builtin_amdgcn_mfma_f32_16x16x32_bf16(fah, __builtin_bit_cast(bf16x8, wf[u][0][1]), acc0, 0, 0, 0);
                acc0 = __builtin_amdgcn_mfma_f32_16x16x32_bf16(fal, __builtin_bit_cast(bf16x8, wf[u][0][0]), acc0, 0, 0, 0);
                acc1 = __builtin_amdgcn_mfma_f32_16x16x32_bf16(fah, __builtin_bit_cast(bf16x8, wf[u][1][0]), acc1, 0, 0, 0);
                acc1 = __builtin_amdgcn_mfma_f32_16x16x32_bf16(fah, __builtin_bit_cast(bf16x8, wf[u][1][1]), acc1, 0, 0, 0);
                acc1 = __builtin_amdgcn_mfma_f32_16x16x32_bf16(fal, __builtin_bit_cast(bf16x8, wf[u][1][0]), acc1, 0, 0, 0);
            }
        }
        { const float bb0 = p.b_router[i16], bb1 = p.b_router[16 + i16];
#pragma unroll
          for (int r = 0; r < 4; ++r) { lg[(4 * kq + r) * 33 + i16] = acc0[r] + bb0; lg[(4 * kq + r) * 33 + 16 + i16] = acc1[r] + bb1; } }
        LDS_WAIT(); asm volatile("" ::: "memory");
        int se[4]; float sv[4], gt[4]; int rk[4];
        if (lane < 16) {
            float v[32];
#pragma unroll
            for (int e = 0; e < 32; ++e) v[e] = lg[lane * 33 + e];
#pragma unroll
            for (int k = 0; k < 4; ++k) { float best = -3.0e38f; int bi = 0;
#pragma unroll
                for (int e = 0; e < 32; ++e) { const bool tk = v[e] > best; best = tk ? v[e] : best; bi = tk ? e : bi; }
                se[k] = bi; sv[k] = best;
#pragma unroll
                for (int e = 0; e < 32; ++e) v[e] = (e == bi) ? -3.0e38f : v[e]; }
            const float e1 = __expf(sv[1] - sv[0]), e2 = __expf(sv[2] - sv[0]), e3 = __expf(sv[3] - sv[0]);
            const float inv = 1.0f / (1.0f + e1 + e2 + e3);
            gt[0] = inv; gt[1] = e1 * inv; gt[2] = e2 * inv; gt[3] = e3 * inv;
#pragma unroll
            for (int k = 0; k < 4; ++k) rk[k] = __hip_atomic_fetch_add(&hist[se[k]], 1, __ATOMIC_RELAXED, __HIP_MEMORY_SCOPE_WORKGROUP);
        }
        __syncthreads();
        if (tid < 32) gbase[tid] = (int)__hip_atomic_fetch_add(ctl + CW_CNT + 64 * tid, (unsigned)hist[tid], __ATOMIC_RELAXED, __HIP_MEMORY_SCOPE_AGENT);
        __syncthreads();
        if (lane < 16) {
            const int tk = (tb + wave) * 16 + lane;
#pragma unroll
            for (int k = 0; k < 4; ++k) { const int pos = gbase[se[k]] + rk[k];
                stok[(size_t)se[k] * T + pos] = tk; sgate[(size_t)se[k] * T + pos] = gt[k]; toke[tk * 4 + k] = se[k]; tokp[tk * 4 + k] = pos; }
        }
        __syncthreads();
    }
}

__device__ __forceinline__ void moe_table(unsigned* ctl, LAS int* tstart, LAS int* lcnt) {
    __syncthreads();
    if (threadIdx.x < 32) lcnt[threadIdx.x] = (int)__hip_atomic_load(ctl + CW_CNT + 64 * threadIdx.x, __ATOMIC_RELAXED, __HIP_MEMORY_SCOPE_AGENT);
    __syncthreads();
    if (threadIdx.x == 0) { int a = 0; for (int e = 0; e < NE; ++e) { tstart[e] = a; a += (lcnt[e] + 255) >> 8; } tstart[NE] = a; }
    __syncthreads();
}

__device__ __forceinline__ void phase_combine(const Params& p, const LAS int* tstart, int gw, int NGW, int lane) {
    const unsigned char* y2 = p.ws + WS_Y2; const int* toke = (const int*)(p.ws + WS_TOKE); const int* tokp = (const int*)(p.ws + WS_TOKP);
    constexpr float DY = 1.0f / FP8_SY;
    typedef int i32x4v __attribute__((ext_vector_type(4)));
    i32x4v ne = (i32x4v){0, 0, 0, 0}, np = ne;
    if (gw < T) { ne = *(const i32x4v*)(toke + gw * 4); np = *(const i32x4v*)(tokp + gw * 4); }
    for (int m = gw; m < T; m += NGW) {
        const i32x4v ce = ne, cp = np;
        if (m + NGW < T) { ne = *(const i32x4v*)(toke + (m + NGW) * 4); np = *(const i32x4v*)(tokp + (m + NGW) * 4); }
        const unsigned char* yr[4];
#pragma unroll
        for (int k = 0; k < 4; ++k) yr[k] = y2 + ((size_t)tstart[ce[k]] * 256 + cp[k]) * D;
        float* op = p.out + (size_t)m * D; const bf16* xp = (const bf16*)(p.ws + WS_X1) + (size_t)m * D;
#pragma unroll
        for (int j = 0; j < 2; ++j) { const int c = (j * 64 + lane) * 16;
            v4u w[4];
#pragma unroll
            for (int k = 0; k < 4; ++k) w[k] = *(const v4u*)(yr[k] + c);
            f32x4 a[4];
            { const v4u xa = *(const v4u*)(xp + c), xb = *(const v4u*)(xp + c + 8); float fa[8], fb[8]; unpack8(xa, fa); unpack8(xb, fb);
              a[0] = (f32x4){fa[0], fa[1], fa[2], fa[3]}; a[1] = (f32x4){fa[4], fa[5], fa[6], fa[7]}; a[2] = (f32x4){fb[0], fb[1], fb[2], fb[3]}; a[3] = (f32x4){fb[4], fb[5], fb[6], fb[7]}; }
#pragma unroll
            for (int q = 0; q < 4; ++q) { float s0 = 0.f, s1 = 0.f, s2 = 0.f, s3 = 0.f;
#pragma unroll
                for (int k = 0; k < 4; ++k) { const int wd = (int)(q == 0 ? w[k].x : q == 1 ? w[k].y : q == 2 ? w[k].z : w[k].w);
                    const f32x2 lo = __builtin_amdgcn_cvt_pk_f32_fp8(wd, false), hi = __builtin_amdgcn_cvt_pk_f32_fp8(wd, true);
                    s0 += lo.x; s1 += lo.y; s2 += hi.x; s3 += hi.y; }
                a[q][0] += s0 * DY; a[q][1] += s1 * DY; a[q][2] += s2 * DY; a[q][3] += s3 * DY;
                *(f32x4*)(op + c + 4 * q) = a[q]; }
        }
    }
}

constexpr int N_PHASES = 10;
__global__ void __launch_bounds__(NTHREADS, 2) hymba_fwd(Params p) {
    extern __shared__ __attribute__((aligned(16))) unsigned char lds_raw[];
    LAS unsigned char* lds = (LAS unsigned char*)lds_raw;
    volatile LAS unsigned* MISC = (volatile LAS unsigned*)(lds + MISC_OFF);
    LAS int* tstart = (LAS int*)(lds + MISC_OFF + 256);
    LAS int* lcnt = (LAS int*)(lds + MISC_OFF + 512);
    const int tid = threadIdx.x, lane = tid & 63, wave = __builtin_amdgcn_readfirstlane(tid >> 6);
    const int G = gridDim.x;
    const int vcu = (G % 8 == 0) ? (blockIdx.x % 8) * (G / 8) + blockIdx.x / 8 : blockIdx.x;
    const int gw = vcu * NWAVES + wave, NGW = G * NWAVES;
    unsigned* ctl = (unsigned*)(p.ws + WS_CTL);
    if (tid < 64) MISC[tid] = 0u;
    __syncthreads();
    const int lo = p.ph_lo, hi = p.ph_hi;
    XcdBarrier bar; bar.bar = ctl + CW_BAR; bar.x = 0; bar.st = nullptr;
    if (hi - lo > 1) bar = xcd_barrier_post(ctl + CW_BAR, MISC + 8);
#ifndef PHMASK
#define PHMASK 0x3ff
#endif
#define IN(k) (((PHMASK >> (k)) & 1) && lo <= (k) && (k) < hi)
#define SEAM(k) do { if (IN(k) && IN((k) + 1)) xcd_barrier(bar); } while (0)

    if (IN(0)) { phase_prologue(p, lds, gw, NGW, wave, lane); }
    SEAM(0);
    int cid = (int)blockIdx.x;
    if (hi - lo > 1 && lo == 0) {
        if (tid == 0) {
            bool ok = (G % 8 == 0);
            for (unsigned j = 0; j < 16; ++j) { const unsigned cj = xb_ld(&bar.bar[XB_XCNT(j)]); ok = ok && (j < 8 ? cj == (unsigned)(G / 8) : cj == 0u); }
            MISC[12] = ok ? (MISC[10] * 8u + bar.x) : (unsigned)blockIdx.x;
        }
        __syncthreads();
        cid = (int)MISC[12];
    }
    if (IN(1)) {
        const int ncw = (G < 8 * NCV) ? G : 8 * NCV;
        if (cid < ncw) convert_experts(p, cid * NWAVES + wave, ncw * NWAVES, lane);
        LAS int* tk = (LAS int*)(lds + MISC_OFF + 768);
        unsigned* tick = ctl + CW_TICK + 64 * (cid & 7);
        __syncthreads();
        if (tid == 0) { tk[0] = (int)__hip_atomic_fetch_add(tick, 1u, __ATOMIC_RELAXED, __HIP_MEMORY_SCOPE_AGENT); tk[1] = (int)__hip_atomic_fetch_add(tick, 1u, __ATOMIC_RELAXED, __HIP_MEMORY_SCOPE_AGENT); }
        __syncthreads();
        pg8::SchedQueue S{(const char*)(p.ws + WS_HN), (const char*)(p.ws + WS_WIN), T / 256, NIN_PAD / 256, (T / 256) * (NIN_PAD / 256) / 8, cid & 7, tick, tk};
        EpiInProj E{(bf16*)(p.ws + WS_PROJ), (float*)(p.ws + WS_DT)};
        pg8::gemm_phase<EpiInProj, pg8::SchedQueue>(lds, S, E);
    }
    SEAM(1);
    if (IN(2)) { if (!(p.variant & 2)) phase_attn(p, lds, G); if (!(p.variant & 1)) phase_ssd_states(p, lds, G, lane, wave); }
    SEAM(2);
    if (IN(3)) { phase_ssd_scan(p, G); }
    SEAM(3);
    if (IN(4)) { phase_ssd_out(p, lds, G, lane, wave); }
    SEAM(4);
    if (IN(5)) {
        EpiOutProj E{p.x, (bf16*)(p.ws + WS_X1), (float*)(p.ws + WS_SSQ)};
#if PROBE_CRIP5
        if (p.variant) { pg8::SchedDenseT<PROBE_CRIP5> S{(const char*)(p.ws + WS_MIX), (const char*)(p.ws + WS_WOUT), T / 256, D / 256, G, cid};
            pg8::gemm_phase<EpiOutProj, pg8::SchedDenseT<PROBE_CRIP5>>(lds, S, E); } else
#endif
        { pg8::SchedDense S{(const char*)(p.ws + WS_MIX), (const char*)(p.ws + WS_WOUT), T / 256, D / 256, G, cid};
          pg8::gemm_phase<EpiOutProj, pg8::SchedDense>(lds, S, E); }
    }
    SEAM(5);
    if (IN(6)) { phase_router(p, lds, ctl, G, wave, lane); }
    SEAM(6);
    if (IN(7)) {
        moe_table(ctl, tstart, lcnt);
        EpiGateUp E{p.ws + WS_HB, p.b_gate, p.b_up};
#if PROBE_CRIP7
        if (p.variant) { pg8::SchedMoE<true, PROBE_CRIP7> S{(const char*)(p.ws + WS_HF), (const char*)(p.ws + WS_WGU), (const int*)(p.ws + WS_STOK), tstart, lcnt, (2 * FF) / 256, 2 * FF, G, cid};
            pg8::gemm_phase<EpiGateUp, pg8::SchedMoE<true, PROBE_CRIP7>>(lds, S, E); } else
#endif
        { pg8::SchedMoE<true> S{(const char*)(p.ws + WS_HF), (const char*)(p.ws + WS_WGU), (const int*)(p.ws + WS_STOK), tstart, lcnt, (2 * FF) / 256, 2 * FF, G, cid};
          pg8::gemm_phase<EpiGateUp, pg8::SchedMoE<true>>(lds, S, E); }
    }
    SEAM(7);
    if (IN(8)) {
        moe_table(ctl, tstart, lcnt);
        EpiDown E{p.ws + WS_Y2, p.b_down, (const float*)(p.ws + WS_SGATE), tstart};
#if PROBE_CRIP
        if (p.variant) { pg8::SchedMoE<false, PROBE_CRIP> S{(const char*)(p.ws + WS_HB), (const char*)(p.ws + WS_WD), (const int*)(p.ws + WS_STOK), tstart, lcnt, D / 256, D, G, cid};
            pg8::gemm_phase<EpiDown, pg8::SchedMoE<false, PROBE_CRIP>>(lds, S, E); } else
#endif
        { pg8::SchedMoE<false> S{(const char*)(p.ws + WS_HB), (const char*)(p.ws + WS_WD), (const int*)(p.ws + WS_STOK), tstart, lcnt, D / 256, D, G, cid};
          pg8::gemm_phase<EpiDown, pg8::SchedMoE<false>>(lds, S, E); }
    }
    SEAM(8);
    if (IN(9)) { moe_table(ctl, tstart, lcnt); phase_combine(p, tstart, gw, NGW, lane); }
#undef IN
#undef SEAM
}

extern "C" void kernel_launch(void* const* d_in, const int* in_sizes, int n_in, void* d_out, int out_size, void* d_ws, size_t ws_size, hipStream_t stream) {
    static int grid = 0;
    if (grid == 0) {
        if (n_in != 23 || out_size != T * D || ws_size < WS_END) { fprintf(stderr, "kernel_launch: unexpected sizes n_in %d out %d ws %zu\n", n_in, out_size, ws_size); grid = -1; return; }
        int dev = 0, cus = 0;
        if (hipGetDevice(&dev) != hipSuccess || hipDeviceGetAttribute(&cus, hipDeviceAttributeMultiprocessorCount, dev) != hipSuccess) { grid = -1; return; }
        if (hipFuncSetAttribute((const void*)hymba_fwd, hipFuncAttributeMaxDynamicSharedMemorySize, LDS_BYTES) != hipSuccess) { fprintf(stderr, "kernel_launch: hipFuncSetAttribute failed\n"); grid = -1; return; }
        int per_cu = 0;
        if (hipOccupancyMaxActiveBlocksPerMultiprocessor(&per_cu, (const void*)hymba_fwd, NTHREADS, LDS_BYTES) != hipSuccess || per_cu < 1) fprintf(stderr, "kernel_launch: occupancy query says %d\n", per_cu);
        (void)hipGetLastError();
        grid = cus;
    }
    if (grid < 0) return;
    (void)hipMemsetAsync((char*)d_ws + WS_CTL, 0, CTL_BYTES, stream);
    Params p{};
    const float** pp = (const float**)&p;
    for (int i = 0; i < 23; ++i) pp[i] = (const float*)d_in[i];
    p.out = (float*)d_out; p.ws = (unsigned char*)d_ws;
#if MK_MULTI || (PROBE_REPEAT >= 0) || PROBE_CRIP || PROBE_P2 || PROBE_P6 || PROBE_CRIP7 || PROBE_CRIP5
    for (int ph = 0; ph < N_PHASES; ++ph) { p.ph_lo = ph; p.ph_hi = ph + 1;
        if (PROBE_P2 && ph == 2) { p.variant = PROBE_P2; hipLaunchKernelGGL(hymba_fwd, dim3(grid), dim3(NTHREADS), LDS_BYTES, stream, p); p.variant = 0; }
        if (PROBE_P6 && ph == 6) { hipLaunchKernelGGL(hymba_fwd, dim3(grid), dim3(NTHREADS), LDS_BYTES, stream, p); (void)hipMemsetAsync((char*)d_ws + WS_CTL + CW_CNT * 4, 0, 64 * 4 * NE, stream); }
        if (PROBE_CRIP5 && ph == 5) { p.variant = 1; hipLaunchKernelGGL(hymba_fwd, dim3(grid), dim3(NTHREADS), LDS_BYTES, stream, p); p.variant = 0; }
        if (PROBE_CRIP7 && ph == 7) { p.variant = 1; hipLaunchKernelGGL(hymba_fwd, dim3(grid), dim3(NTHREADS), LDS_BYTES, stream, p); p.variant = 0; }
        if (PROBE_CRIP && ph == 8) { p.variant = 1; hipLaunchKernelGGL(hymba_fwd, dim3(grid), dim3(NTHREADS), LDS_BYTES, stream, p); p.variant = 0; }
        for (int r = 0; r < (ph == PROBE_REPEAT ? 2 : 1); ++r) hipLaunchKernelGGL(hymba_fwd, dim3(grid), dim3(NTHREADS), LDS_BYTES, stream, p); }
#else
    p.ph_lo = 0; p.ph_hi = N_PHASES; hipLaunchKernelGGL(hymba_fwd, dim3(grid), dim3(NTHREADS), LDS_BYTES, stream, p);
#endif
}
```

```cpp
#include <hip/hip_runtime.h>
#include <cstdio>
#include <cstdint>

#ifndef MK_MULTI
#define MK_MULTI 0
#endif

#ifndef PROBE_CRIP
#define PROBE_CRIP 0
#endif
#ifndef WGM
#define WGM 4
#endif
#ifndef WGMQ
#define WGMQ 8
#endif
#ifndef PROBE_CRIP5
#define PROBE_CRIP5 0
#endif
#ifndef PROBE_CRIP7
#define PROBE_CRIP7 0
#endif
#ifndef PROBE_P6
#define PROBE_P6 0
#endif
#ifndef PROBE_P2
#define PROBE_P2 0
#endif
#ifndef PROBE_REPEAT
#define PROBE_REPEAT -1
#endif
#ifndef INPROJ_F8
#define INPROJ_F8 0
#endif
#ifndef OUTPROJ_F8
#define OUTPROJ_F8 1
#endif
#define GAS __attribute__((address_space(1)))
#define LAS __attribute__((address_space(3)))
typedef unsigned short bf16;
typedef unsigned v4u __attribute__((ext_vector_type(4)));
typedef unsigned v2u __attribute__((ext_vector_type(2)));
typedef float f32x4 __attribute__((ext_vector_type(4)));
typedef float f32x2 __attribute__((ext_vector_type(2)));
typedef short bf16x8 __attribute__((ext_vector_type(8)));
typedef int i32x4 __attribute__((ext_vector_type(4)));
typedef int i32x8 __attribute__((ext_vector_type(8)));

constexpr int NB = 4, SEQ = 8192, T = NB * SEQ, D = 2048;
constexpr int PROJ_LD = 3840;
constexpr int COL_Q = 0, COL_K = 1024, COL_V = 1152, COL_Z = 1280, COL_XBC = 2304;
constexpr int NIN = 3856, NIN_PAD = 4096;
constexpr int NXBC = 1536;
constexpr int NE = 32, FF = 2048, TOPK = 4;
constexpr int SLOT_ROWS = T * TOPK + NE * 256;
constexpr float EPS = 1e-6f;

constexpr size_t MiB = 1u << 20;
constexpr size_t WS_CTL = 0, CTL_BYTES = 1 * MiB;
constexpr size_t WS_WGU = 16 * MiB;
constexpr size_t WS_WIN = 528 * MiB;
constexpr size_t WS_WOUT = 544 * MiB;
constexpr size_t WS_HF = 552 * MiB;
constexpr size_t WS_Y2 = 16 * MiB;
constexpr size_t WS_WD = 680 * MiB;
constexpr size_t WS_HN = 936 * MiB;
constexpr size_t WS_MIX = WS_HN;
constexpr size_t WS_PROJ = 1064 * MiB;
constexpr size_t WS_XBC = 1304 * MiB;
constexpr size_t WS_ATT = 1496 * MiB;
constexpr size_t WS_X1 = WS_ATT;
constexpr size_t WS_YS = 1624 * MiB;
constexpr size_t WS_HB = 936 * MiB;
constexpr size_t WS_STATES = WS_XBC;
constexpr size_t WS_SIN = WS_YS;
constexpr size_t WS_CDEC = WS_YS + 64 * MiB;
constexpr size_t WS_DT = 1752 * MiB;
constexpr size_t WS_DTS = 1754 * MiB;
constexpr size_t WS_SSQ = 1756 * MiB;
constexpr size_t WS_STOK = 1760 * MiB;
constexpr size_t WS_SGATE = 1764 * MiB;
constexpr size_t WS_TOKE = 1768 * MiB;
constexpr size_t WS_TOKP = 1769 * MiB;
constexpr size_t WS_WRB = 1770 * MiB;
constexpr size_t WS_END = 1771 * MiB;
static_assert(WS_Y2 + (size_t)SLOT_ROWS * 2048 <= WS_WD, "y2 overlay");
static_assert(WS_HB + (size_t)SLOT_ROWS * 2048 * 2 <= WS_ATT, "hb overlay");
constexpr int CW_CNT = 1024;
constexpr int CW_BAR = 4096;
constexpr int CW_TICK = 2048 + 1024;
constexpr int NCV = 16;

constexpr int RING_BYTES = 131072;
constexpr int MISC_OFF = 162816;
constexpr int LDS_BYTES = 163840;
constexpr int NWAVES = 8, NTHREADS = 512;

typedef __bf16 hwbf16x2 __attribute__((ext_vector_type(2)));
__device__ __forceinline__ unsigned f2bf(float f) { return (unsigned)__builtin_bit_cast(unsigned short, (__bf16)f); }
__device__ __forceinline__ unsigned pk2(float lo, float hi) { const f32x2 v = {lo, hi}; return __builtin_bit_cast(unsigned, __builtin_convertvector(v, hwbf16x2)); }
__device__ __forceinline__ float bflo(unsigned w) { return __builtin_bit_cast(float, w << 16); }
__device__ __forceinline__ float bfhi(unsigned w) { return __builtin_bit_cast(float, w & 0xffff0000u); }
__device__ __forceinline__ float wave_sum(float v) {
#pragma unroll
    for (int o = 1; o < 64; o <<= 1) v += __shfl_xor(v, o);
    return v;
}
__device__ __forceinline__ float sat8(float x) { return __builtin_amdgcn_fmed3f(x, -448.0f, 448.0f); }
__device__ __forceinline__ unsigned pk4_fp8(float a, float b, float c, float d) { int v = 0; v = __builtin_amdgcn_cvt_pk_fp8_f32(a, b, v, false); v = __builtin_amdgcn_cvt_pk_fp8_f32(c, d, v, true); return (unsigned)v; }
constexpr float FP8_SW = 256.f;
constexpr float FP8_SA = 16.f;
constexpr float FP8_SH = 4.f;
constexpr float FP8_SY = 32.f;
__device__ __forceinline__ float fsigmoid(float x) { return __builtin_amdgcn_rcpf(1.0f + __expf(-x)); }
__device__ __forceinline__ void unpack8(const v4u q, float (&d)[8]) { d[0] = bflo(q.x); d[1] = bfhi(q.x); d[2] = bflo(q.y); d[3] = bfhi(q.y); d[4] = bflo(q.z); d[5] = bfhi(q.z); d[6] = bflo(q.w); d[7] = bfhi(q.w); }
#define LDS_WAIT() asm volatile("s_waitcnt lgkmcnt(0)" ::: "memory")

#define XB_TMO      128
#define XB_XCNT(j)  (256  + 64 * (j))
#define XB_XSUB(j)  (1280 + 64 * (j))
#define XB_XGEN(j)  (2304 + 64 * (j))
#define XB_TOP      3328
#define XB_TOPGEN   3392
#define XCD_BAR_WORDS 3456
#define XB_SPIN_CAP (1u << 18)
__device__ __forceinline__ unsigned xb_ld(unsigned* p)              { return __hip_atomic_load(p, __ATOMIC_RELAXED, __HIP_MEMORY_SCOPE_AGENT); }
__device__ __forceinline__ unsigned xb_add(unsigned* p, unsigned v) { return __hip_atomic_fetch_add(p, v, __ATOMIC_RELAXED, __HIP_MEMORY_SCOPE_AGENT); }
__device__ __forceinline__ unsigned xb_xcc_id() { return (unsigned)__builtin_amdgcn_s_getreg((3 << 11) | 20) & 0xFu; }
#define XB_SPIN(cond, bar) do { unsigned _sp = 0; while (cond) { __builtin_amdgcn_s_sleep(1); \
    if ((++_sp & 255u) == 0u) { if (xb_ld(&(bar)[XB_TMO])) break; if (_sp > XB_SPIN_CAP) { atomicAdd(&(bar)[XB_TMO], 1u); break; } } } } while (0)
struct XcdBarrier { unsigned* bar; unsigned x; volatile LAS unsigned* st; };
__device__ __forceinline__ XcdBarrier xcd_barrier_post(unsigned* bar, volatile LAS unsigned* st) {
    XcdBarrier b; b.bar = bar; b.x = xb_xcc_id(); b.st = st;
    if (threadIdx.x == 0) st[2] = xb_add(&bar[XB_XCNT(b.x)], 1u);
    return b;
}
__device__ __forceinline__ void xcd_barrier_complete(unsigned* bar, unsigned x, unsigned& nloc, unsigned& nx) {
    const unsigned G = gridDim.x * gridDim.y * gridDim.z;
    unsigned sum, cnt, mine, sp = 0u;
    for (;;) {
        sum = 0u; cnt = 0u; mine = 0u;
#pragma unroll
        for (unsigned j = 0; j < 16; ++j) { const unsigned c = xb_ld(&bar[XB_XCNT(j)]); sum += c; cnt += (c > 0u) ? 1u : 0u; mine = (j == x) ? c : mine; }
        if (sum == G) break;
        __builtin_amdgcn_s_sleep(1);
        if ((++sp & 255u) == 0u) { if (xb_ld(&bar[XB_TMO])) break; if (sp > XB_SPIN_CAP) { atomicAdd(&bar[XB_TMO], 1u); break; } }
    }
    nloc = mine > 0u ? mine : 1u; nx = cnt > 0u ? cnt : 1u;
}
__device__ __forceinline__ void xcd_barrier(const XcdBarrier& b) {
    asm volatile("s_waitcnt vmcnt(0)" ::: "memory");
    __syncthreads();
    if (threadIdx.x == 0) {
        unsigned* bar = b.bar;
        __builtin_amdgcn_s_waitcnt(0);
        unsigned nloc = b.st[0], nx = b.st[1];
        if (nloc == 0u) { xcd_barrier_complete(bar, b.x, nloc, nx); b.st[0] = nloc; b.st[1] = nx; }
        const unsigned old = xb_add(&bar[XB_XSUB(b.x)], 1u);
        const unsigned gen = old / nloc;
        if (old + 1u == (gen + 1u) * nloc) {
            __builtin_amdgcn_fence(__ATOMIC_RELEASE, "agent");
            asm volatile("s_waitcnt vmcnt(0)" ::: "memory");
            const unsigned og = xb_add(&bar[XB_TOP], 1u);
            const unsigned tg = og / nx;
            if (og + 1u == (tg + 1u) * nx) xb_add(&bar[XB_TOPGEN], 1u);
            else XB_SPIN(xb_ld(&bar[XB_TOPGEN]) == tg, bar);
            __builtin_amdgcn_fence(__ATOMIC_ACQUIRE, "agent");
            xb_add(&bar[XB_XGEN(b.x)], 1u);
            asm volatile("s_waitcnt vmcnt(0)" ::: "memory");
        } else {
            XB_SPIN(xb_ld(&bar[XB_XGEN(b.x)]) == gen, bar);
            __builtin_amdgcn_fence(__ATOMIC_ACQUIRE, "agent");
            asm volatile("s_waitcnt vmcnt(0)" ::: "memory");
        }
    }
    __syncthreads();
}

struct Params {
    const float* x; const float* attn_norm_w; const float* w_in; const float* q_norm_w; const float* k_norm_w; const float* sinks;
    const float* conv_w; const float* conv_b; const float* dt_bias; const float* a_log; const float* d_skip; const float* ssm_norm_w;
    const float* attn_out_norm_w; const float* w_out; const float* ffn_norm_w; const float* w_router; const float* b_router;
    const float* w_gate; const float* b_gate; const float* w_up; const float* b_up; const float* w_down; const float* b_down;
    float* out; unsigned char* ws; int ph_lo, ph_hi, variant, pad;
};

namespace pg8 {
constexpr int BM = 256, BK = 64, HALF = 128, HTB = HALF * BK * 2, GK = 2048;
__device__ __forceinline__ int lds_byte(int r, int c) { const int st = (r >> 4) * 2 + (c >> 5), rr = r & 15, cc = c & 31, ob = rr * 64 + cc * 2; return st * 1024 + (ob ^ (((ob >> 9) & 1) << 5)); }
__device__ __forceinline__ void stage_rc(int b, int& R, int& C) { const int st = b / 1024, sb = b % 1024, swz = sb ^ (((sb >> 9) & 1) << 5); R = (st >> 1) * 16 + swz / 64; C = (st & 1) * 32 + (swz % 64) / 2; }
__device__ __forceinline__ int perm32(int rho) { const int n = rho >> 4, i = rho & 15; return 8 * (i >> 2) + 4 * n + (i & 3); }

struct Unit { const char* aBase; const char* bBase; const int* aidx; int avalid; int pm, pn, e; };

template <class Epi, class Sched>
__device__ __forceinline__ void gemm_phase(LAS unsigned char* lds, const Sched& S, const Epi& E) {
    constexpr int RP = Sched::ROWB, nt = RP / 128;
    constexpr bool F8 = Sched::FP8;
    const int tid = threadIdx.x, wid = __builtin_amdgcn_readfirstlane(tid >> 6), lane = tid & 63, wr = wid >> 2, wc = wid & 3, fr = lane & 15, fq = lane >> 4;
    int sR[2], sC[2];
    unsigned voffB[2], vA[2][2];
#pragma unroll
    for (int i = 0; i < 2; ++i) { stage_rc(tid * 16 + i * 8192, sR[i], sC[i]); const int Rb = Epi::PERM ? ((sR[i] & ~31) + perm32(sR[i] & 31)) : sR[i];
        voffB[i] = (unsigned)(Rb * RP + sC[i] * 2); }
    const size_t kstep = (size_t)(BK * 2);
    const size_t hstep = (size_t)HALF * RP;
    const unsigned ldsw = (unsigned)wid * 1024u;
    const int aoff = lds_byte(wr * 64 + fr, fq * 8), boff = lds_byte(wc * 32 + fr, fq * 8);
#define PG8_SA(b, h) (((b) * 2 + (h)) * HTB)
#define PG8_SB(b, h) ((4 + (b) * 2 + (h)) * HTB)
#define PG8_STAGE(bufoff, gbase, voff) do { if constexpr (!(Sched::CRIP & 2)) _Pragma("unroll") for (int _i = 0; _i < 2; ++_i) { unsigned _o = (voff)[_i]; asm volatile("" : "+v"(_o)); \
        __builtin_amdgcn_global_load_lds((const unsigned*)((const char*)(gbase) + _o), (LAS unsigned*)(lds + (bufoff) + ldsw + _i * 8192), 16, 0, 0); } } while (0)
#define PG8_CAT(x, y) __builtin_shufflevector(x, y, 0, 1, 2, 3, 4, 5, 6, 7)
#define PG8_LO(v) __builtin_bit_cast(bf16x8, __builtin_shufflevector(v, v, 0, 1, 2, 3))
#define PG8_HI(v) __builtin_bit_cast(bf16x8, __builtin_shufflevector(v, v, 4, 5, 6, 7))
#define PG8_LDA(dst, b, h) do { if constexpr (!(Sched::CRIP & 4)) _Pragma("unroll") for (int m = 0; m < 4; ++m) dst[m] = PG8_CAT(*(const LAS i32x4*)(lds + PG8_SA(b, h) + aoff + m * 2048), *(const LAS i32x4*)(lds + PG8_SA(b, h) + aoff + m * 2048 + 1024)); } while (0)
#define PG8_LDB(dst, b, h) do { if constexpr (!(Sched::CRIP & 4)) _Pragma("unroll") for (int n = 0; n < 2; ++n) dst[n] = PG8_CAT(*(const LAS i32x4*)(lds + PG8_SB(b, h) + boff + n * 2048), *(const LAS i32x4*)(lds + PG8_SB(b, h) + boff + n * 2048 + 1024)); } while (0)
#define PG8_MMA(ai, bj, At, Bt) do { __builtin_amdgcn_s_setprio(1); \
        if constexpr (Sched::CRIP & 1) {} else if constexpr (F8) { asm volatile("s_nop 1\n\t" \
            "v_mfma_scale_f32_16x16x128_f8f6f4 %0, %8, %10, %0, %14, %14 op_sel_hi:[0,0,0]\n\t" "v_mfma_scale_f32_16x16x128_f8f6f4 %1, %9, %10, %1, %14, %14 op_sel_hi:[0,0,0]\n\t" \
            "v_mfma_scale_f32_16x16x128_f8f6f4 %2, %8, %11, %2, %14, %14 op_sel_hi:[0,0,0]\n\t" "v_mfma_scale_f32_16x16x128_f8f6f4 %3, %9, %11, %3, %14, %14 op_sel_hi:[0,0,0]\n\t" \
            "v_mfma_scale_f32_16x16x128_f8f6f4 %4, %8, %12, %4, %14, %14 op_sel_hi:[0,0,0]\n\t" "v_mfma_scale_f32_16x16x128_f8f6f4 %5, %9, %12, %5, %14, %14 op_sel_hi:[0,0,0]\n\t" \
            "v_mfma_scale_f32_16x16x128_f8f6f4 %6, %8, %13, %6, %14, %14 op_sel_hi:[0,0,0]\n\t" "v_mfma_scale_f32_16x16x128_f8f6f4 %7, %9, %13, %7, %14, %14 op_sel_hi:[0,0,0]" \
            : "+v"(acc[ai][bj][0][0]), "+v"(acc[ai][bj][0][1]), "+v"(acc[ai][bj][1][0]), "+v"(acc[ai][bj][1][1]), "+v"(acc[ai][bj][2][0]), "+v"(acc[ai][bj][2][1]), "+v"(acc[ai][bj][3][0]), "+v"(acc[ai][bj][3][1]) \
            : "v"(Bt[0]), "v"(Bt[1]), "v"(At[0]), "v"(At[1]), "v"(At[2]), "v"(At[3]), "v"(f8scale)); } \
        else { _Pragma("unroll") for (int m = 0; m < 4; ++m) _Pragma("unroll") for (int n = 0; n < 2; ++n) { \
               acc[ai][bj][m][n] = __builtin_amdgcn_mfma_f32_16x16x32_bf16(PG8_LO(Bt[n]), PG8_LO(At[m]), acc[ai][bj][m][n], 0, 0, 0); \
               acc[ai][bj][m][n] = __builtin_amdgcn_mfma_f32_16x16x32_bf16(PG8_HI(Bt[n]), PG8_HI(At[m]), acc[ai][bj][m][n], 0, 0, 0); } } \
        __builtin_amdgcn_s_setprio(0); } while (0)
#define PG8_WAIT_V(n) asm volatile("s_waitcnt vmcnt(" #n ")" ::: "memory")
#define PG8_WAIT_L(n) asm volatile("s_waitcnt lgkmcnt(" #n ")" ::: "memory")
#define PG8_BAR __builtin_amdgcn_s_barrier()
#define PG8_BAR2 do { if constexpr (!(Sched::CRIP & 16)) __builtin_amdgcn_s_barrier(); } while (0)
#define PG8_SCHED __builtin_amdgcn_sched_barrier(0)
    Unit cur, nxt; int ui = 0;
    if (!S.next(0, cur)) return;
    typename Epi::Pre epre;
    E.prefetch(cur, epre);
    LAS int* lidx = (LAS int*)(lds + 8 * HTB);
    if constexpr (Sched::GATHER) {
        if (tid < 256) { const int v = cur.aidx[tid]; lidx[tid] = (tid < cur.avalid) ? v : 0; }
        __syncthreads();
    }
#pragma unroll
    for (int h = 0; h < 2; ++h)
#pragma unroll
        for (int i = 0; i < 2; ++i) {
            const int r = h * HALF + sR[i];
            if constexpr (Sched::GATHER) vA[h][i] = (unsigned)(lidx[r] * RP + sC[i] * 2);
            else vA[h][i] = (unsigned)(r * RP + sC[i] * 2);
        }
    f32x4 acc[2][2][4][2];
#pragma unroll
    for (int a = 0; a < 2; ++a)
#pragma unroll
        for (int b = 0; b < 2; ++b)
#pragma unroll
            for (int m = 0; m < 4; ++m)
#pragma unroll
                for (int n = 0; n < 2; ++n) acc[a][b][m][n] = (f32x4){0.f, 0.f, 0.f, 0.f};
    i32x8 At[4], B0[2], B1[2];
    if constexpr (Sched::CRIP & 4) { _Pragma("unroll") for (int m = 0; m < 4; ++m) At[m] = (i32x8){0, 0, 0, 0, 0, 0, 0, 0}; _Pragma("unroll") for (int n = 0; n < 2; ++n) { B0[n] = At[0]; B1[n] = At[0]; } }
    int f8scale = 0x7f7f7f7f; asm volatile("" : "+v"(f8scale));
    const char* cA = cur.aBase; const char* cB = cur.bBase;
#ifndef KROT
#define KROT(pm, pn) (((Sched::ROTM ? (pm) : 0) + (pn)) & (nt - 1))
#endif
#define PG8_KT(rot, tau) ((size_t)(((tau) + (rot)) & (nt - 1)) * kstep)
    int crot = KROT(cur.pm, cur.pn);
    PG8_STAGE(PG8_SB(0, 0), cB + PG8_KT(crot, 0), voffB); PG8_STAGE(PG8_SB(0, 1), cB + hstep + PG8_KT(crot, 0), voffB); PG8_STAGE(PG8_SA(0, 0), cA + PG8_KT(crot, 0), vA[0]); PG8_STAGE(PG8_SA(0, 1), cA + PG8_KT(crot, 0), vA[1]);
    if (wr == 1) PG8_BAR;
    PG8_WAIT_V(2); PG8_BAR;
    PG8_STAGE(PG8_SB(1, 0), cB + PG8_KT(crot, 1), voffB); PG8_STAGE(PG8_SA(1, 0), cA + PG8_KT(crot, 1), vA[0]); PG8_STAGE(PG8_SB(1, 1), cB + hstep + PG8_KT(crot, 1), voffB);
    PG8_WAIT_V(6); PG8_BAR;
    for (;;) {
        const bool has_next = S.next(ui + 1, nxt);
        const char* nA = has_next ? nxt.aBase : cA; const char* nB = has_next ? nxt.bBase : cB;
        const int nrot = has_next ? KROT(nxt.pm, nxt.pn) : crot;
        for (int t = 0; t < nt; t += 2) {
            const bool last = (t == nt - 2);
            const char* a1 = cA + PG8_KT(crot, t + 1);
            const char* a2 = last ? nA + PG8_KT(nrot, 0) : cA + PG8_KT(crot, t + 2); const char* b2 = last ? nB + PG8_KT(nrot, 0) : cB + PG8_KT(crot, t + 2);
            const char* a3 = last ? nA + PG8_KT(nrot, 1) : cA + PG8_KT(crot, t + 3); const char* b3 = last ? nB + PG8_KT(nrot, 1) : cB + PG8_KT(crot, t + 3);
            int gi = 0;
            if constexpr (Sched::GATHER) { if (t == 0 && has_next && tid < 256) gi = nxt.aidx[tid]; }
            PG8_LDB(B0, 0, 0); PG8_LDB(B1, 0, 1); PG8_SCHED; PG8_LDA(At, 0, 0); PG8_STAGE(PG8_SA(1, 1), a1, vA[1]);
            PG8_WAIT_V(8); PG8_WAIT_L(0); PG8_BAR; PG8_MMA(0, 0, At, B0); PG8_MMA(0, 1, At, B1); PG8_BAR2; PG8_SCHED;
            if constexpr (Sched::GATHER) { if (last && has_next) {
                int tz = threadIdx.x; asm volatile("" : "+v"(tz));
#pragma unroll
                for (int i = 0; i < 2; ++i) { int R, C; stage_rc(tz * 16 + i * 8192, R, C);
#pragma unroll
                    for (int h = 0; h < 2; ++h) vA[h][i] = (unsigned)(lidx[h * HALF + R] * RP + C * 2); } } }
            PG8_LDA(At, 0, 1); PG8_STAGE(PG8_SB(0, 0), b2, voffB); PG8_STAGE(PG8_SB(0, 1), b2 + hstep, voffB); PG8_STAGE(PG8_SA(0, 0), a2, vA[0]);
            PG8_WAIT_V(8); PG8_WAIT_L(0); PG8_BAR; PG8_MMA(1, 0, At, B0); PG8_MMA(1, 1, At, B1); PG8_BAR2; PG8_SCHED;
            PG8_LDB(B0, 1, 0); PG8_LDB(B1, 1, 1); PG8_SCHED; PG8_LDA(At, 1, 0); PG8_STAGE(PG8_SA(0, 1), a2, vA[1]);
            PG8_WAIT_V(8); PG8_WAIT_L(0); PG8_BAR; PG8_MMA(0, 0, At, B0); PG8_MMA(0, 1, At, B1); PG8_BAR2; PG8_SCHED;
            PG8_LDA(At, 1, 1); PG8_STAGE(PG8_SB(1, 0), b3, voffB); PG8_STAGE(PG8_SB(1, 1), b3 + hstep, voffB); PG8_STAGE(PG8_SA(1, 0), a3, vA[0]);
            PG8_WAIT_V(8); PG8_WAIT_L(0); PG8_BAR; PG8_MMA(1, 0, At, B0); PG8_MMA(1, 1, At, B1); PG8_BAR2; PG8_SCHED;
            if constexpr (Sched::GATHER) { if (t == 0 && has_next && tid < 256) lidx[tid] = (tid < nxt.avalid) ? gi : 0; }
        }
        if constexpr (F8) asm volatile("s_nop 15\n\ts_nop 15" ::: "memory");
        if (wr == 0) PG8_BAR;
        { int tz = threadIdx.x; asm volatile("" : "+v"(tz)); const int ewid = __builtin_amdgcn_readfirstlane(tz >> 6), el = tz & 63;
          E(acc, cur, epre, ewid >> 2, ewid & 3, el & 15, el >> 4); }
        if (!has_next) break;
#pragma unroll
        for (int a = 0; a < 2; ++a)
#pragma unroll
            for (int b = 0; b < 2; ++b)
#pragma unroll
                for (int m = 0; m < 4; ++m)
#pragma unroll
                    for (int n = 0; n < 2; ++n) acc[a][b][m][n] = (f32x4){0.f, 0.f, 0.f, 0.f};
        cur = nxt; cA = nA; cB = nB; crot = nrot; ++ui;
        E.prefetch(cur, epre);
        if (wr == 1) PG8_BAR;
    }
    PG8_WAIT_V(0);
    PG8_BAR;
#undef PG8_KT
#undef PG8_SA
#undef PG8_SB
#undef PG8_STAGE
#undef PG8_LDA
#undef PG8_LDB
#undef PG8_MMA
#undef PG8_CAT
#undef PG8_LO
#undef PG8_HI
#undef PG8_WAIT_V
#undef PG8_WAIT_L
#undef PG8_BAR
#undef PG8_BAR2
#undef PG8_SCHED
}

__device__ __forceinline__ bool tile_order(long L, int nM, int nN, int& pm, int& pn) {
    const int nwg = nM * nN; if (L >= nwg) return false;
    int wgid = (int)L; { const int q = nwg / 8, r = nwg % 8, xcd = wgid % 8, off = wgid / 8; wgid = (xcd < r ? xcd * (q + 1) : r * (q + 1) + (xcd - r) * q) + off; }
    const int nig = WGM * nN, gid = wgid / nig, fm = gid * WGM, gsz = (nM - fm) < WGM ? (nM - fm) : WGM;
    pm = fm + ((wgid % nig) % gsz); pn = (wgid % nig) / gsz; return true;
}
template <int CRIP_ = 0, bool F8_ = false> struct SchedDenseT {
    static constexpr bool GATHER = false, FP8 = F8_, ROTM = true; static constexpr int ROWB = F8_ ? 2048 : 4096, CRIP = CRIP_;
    const char* A; const char* Bt; int nM, nN, G, c;
    __device__ __forceinline__ bool next(int i, Unit& u) const {
        int pm, pn; if (!tile_order((long)i * G + c, nM, nN, pm, pn)) return false;
        u.pm = pm; u.pn = pn; u.e = 0; u.aidx = nullptr; u.avalid = 256;
        u.aBase = A + (size_t)pm * 256 * ROWB; u.bBase = Bt + (size_t)pn * 256 * ROWB;
        if constexpr ((CRIP_ & 64) != 0) u.bBase = Bt;
        if constexpr ((CRIP_ & 128) != 0) u.aBase = A;
        return true;
    }
};
typedef SchedDenseT<0> SchedDense;
struct SchedQueue {
    static constexpr bool GATHER = false, FP8 = (INPROJ_F8 != 0), ROTM = true; static constexpr int ROWB = INPROJ_F8 ? 2048 : 4096, CRIP = 0;
    const char* A; const char* Bt; int nM, nN, q, xcd; unsigned* tick; LAS int* tk;
    __device__ __forceinline__ bool next(int i, Unit& u) const {
        const int t = __builtin_amdgcn_readfirstlane(tk[i & 1]);
        if (i > 0 && threadIdx.x == 0) tk[(i + 1) & 1] = (int)__hip_atomic_fetch_add(tick, 1u, __ATOMIC_RELAXED, __HIP_MEMORY_SCOPE_AGENT);
        if (t >= q) return false;
        const int id = xcd * q + t, nig = WGMQ * nN, gid = id / nig, fm = gid * WGMQ, gsz = (nM - fm) < WGMQ ? (nM - fm) : WGMQ;
        const int pm = fm + ((id % nig) % gsz), pn = (id % nig) / gsz;
        u.pm = pm; u.pn = pn; u.e = 0; u.aidx = nullptr; u.avalid = 256;
        u.aBase = A + (size_t)pm * 256 * ROWB; u.bBase = Bt + (size_t)pn * 256 * ROWB; return true;
    }
};
template <bool GATHER_, int CRIP_ = 0> struct SchedMoE {
    static constexpr bool GATHER = GATHER_ && !(CRIP_ & 32), FP8 = true, ROTM = false; static constexpr int ROWB = 2048, CRIP = CRIP_;
    const char* A; const char* Bt; const int* stok; const LAS int* tstart; const LAS int* cnt; int nN, nrowsB  , G, c;
    __device__ __forceinline__ bool next(int i, Unit& u) const {
        const int nM = __builtin_amdgcn_readfirstlane(tstart[NE]); int pm, pn; if (!tile_order((long)i * G + c, nM, nN, pm, pn)) return false;
        int e = 0;
        for (int j = 1; j < NE; ++j) e += (tstart[j] <= pm) ? 1 : 0;
        e = __builtin_amdgcn_readfirstlane(e);
        const int mt = __builtin_amdgcn_readfirstlane(pm - tstart[e]);
        u.pm = pm; u.pn = pn; u.e = e;
        u.avalid = __builtin_amdgcn_readfirstlane(cnt[e]) - mt * 256;
        u.aidx = stok + (size_t)e * T + mt * 256;
        u.aBase = GATHER ? A : A + (size_t)(GATHER_ ? (pm & 127) : pm) * 256 * ROWB;
        u.bBase = Bt + ((size_t)e * nrowsB + (size_t)pn * 256) * ROWB;
        if constexpr ((CRIP_ & 8) != 0) { u.aBase = A; u.bBase = Bt; }
        return true;
    }
};
}

struct EpiNoPre { };
struct EpiInProj {
    static constexpr bool PERM = true; typedef EpiNoPre Pre;
    bf16* proj; float* dtraw;
    __device__ __forceinline__ void prefetch(const pg8::Unit&, Pre&) const {}
    __device__ __forceinline__ void operator()(const f32x4 (&acc)[2][2][4][2], const pg8::Unit& u, const Pre&, int wr, int wc, int fr, int fq) const {
        const int row0 = u.pm * 256 + wr * 64 + fr;
        constexpr float DS = INPROJ_F8 ? 1.0f / (FP8_SA * FP8_SW) : 1.0f;
        if (u.pn < 15) {
            const int col0 = u.pn * 256 + wc * 32 + 8 * fq;
#pragma unroll
            for (int ai = 0; ai < 2; ++ai)
#pragma unroll
                for (int m = 0; m < 4; ++m) { bf16* rowp = proj + (size_t)(row0 + ai * 128 + m * 16) * PROJ_LD + col0;
#pragma unroll
                    for (int bj = 0; bj < 2; ++bj) { const f32x4 v0 = acc[ai][bj][m][0] * DS, v1 = acc[ai][bj][m][1] * DS;
                        v4u w; w.x = pk2(v0[0], v0[1]); w.y = pk2(v0[2], v0[3]); w.z = pk2(v1[0], v1[1]); w.w = pk2(v1[2], v1[3]);
                        *(v4u*)(rowp + bj * 128) = w; } }
        } else if (wc == 0 && fq < 2) {
#pragma unroll
            for (int ai = 0; ai < 2; ++ai)
#pragma unroll
                for (int m = 0; m < 4; ++m) { float* rowp = dtraw + (size_t)(row0 + ai * 128 + m * 16) * 16 + 8 * fq;
                    *(f32x4*)(rowp) = acc[ai][0][m][0] * DS; *(f32x4*)(rowp + 4) = acc[ai][0][m][1] * DS; }
        }
    }
};
struct EpiOutProj {
    static constexpr bool PERM = true; typedef EpiNoPre Pre;
    const float* x; bf16* x1; float* ssq;
    __device__ __forceinline__ void prefetch(const pg8::Unit&, Pre&) const {}
    __device__ __forceinline__ void operator()(const f32x4 (&acc)[2][2][4][2], const pg8::Unit& u, const Pre&, int wr, int wc, int fr, int fq) const {
        const int row0 = u.pm * 256 + wr * 64 + fr, col0 = u.pn * 256 + wc * 32 + 8 * fq;
        constexpr float DSO = OUTPROJ_F8 ? 1.0f / (FP8_SA * FP8_SW) : 1.0f;
#pragma unroll
        for (int ai = 0; ai < 2; ++ai) {
            f32x4 xv[4][2][2];
#pragma unroll
            for (int m = 0; m < 4; ++m)
#pragma unroll
                for (int bj = 0; bj < 2; ++bj)
#pragma unroll
                    for (int n = 0; n < 2; ++n) xv[m][bj][n] = *(const f32x4*)(x + (size_t)(row0 + ai * 128 + m * 16) * D + col0 + bj * 128 + n * 4);
#pragma unroll
            for (int m = 0; m < 4; ++m) { asm volatile("" : "+v"(xv[m][0][0]), "+v"(xv[m][0][1]), "+v"(xv[m][1][0]), "+v"(xv[m][1][1])); }
#pragma unroll
            for (int m = 0; m < 4; ++m) { const int row = row0 + ai * 128 + m * 16; const size_t off = (size_t)row * D + col0; float s = 0.f;
#pragma unroll
                for (int bj = 0; bj < 2; ++bj) { const f32x4 o0 = xv[m][bj][0] + acc[ai][bj][m][0] * DSO, o1 = xv[m][bj][1] + acc[ai][bj][m][1] * DSO;
                    *(v4u*)(x1 + off + bj * 128) = (v4u){pk2(o0[0], o0[1]), pk2(o0[2], o0[3]), pk2(o1[0], o1[1]), pk2(o1[2], o1[3])};
                    s += ((o0[0] * o0[0] + o0[1] * o0[1]) + (o0[2] * o0[2] + o0[3] * o0[3])) + ((o1[0] * o1[0] + o1[1] * o1[1]) + (o1[2] * o1[2] + o1[3] * o1[3])); }
                s += __shfl_xor(s, 16); s += __shfl_xor(s, 32);
                if (fq == 0) ssq[(size_t)row * 32 + u.pn * 4 + wc] = s; }
        }
    }
};
struct EpiGateUp {
    static constexpr bool PERM = true;
    struct Pre { f32x4 bg[2], bu[2]; };
    unsigned char* hb; const float* b_gate; const float* b_up;
    __device__ __forceinline__ void prefetch(const pg8::Unit& u, Pre& q) const {
        int tz = threadIdx.x; asm volatile("" : "+v"(tz)); const int wc = (tz >> 6) & 3, fq = (tz >> 4) & 3;
        const int f0 = u.pn * 128 + wc * 32 + 8 * fq;
#pragma unroll
        for (int n = 0; n < 2; ++n) { q.bg[n] = *(const f32x4*)(b_gate + (size_t)u.e * FF + f0 + 4 * n); q.bu[n] = *(const f32x4*)(b_up + (size_t)u.e * FF + f0 + 4 * n); }
    }
    __device__ __forceinline__ void operator()(const f32x4 (&acc)[2][2][4][2], const pg8::Unit& u, const Pre& q, int wr, int wc, int fr, int fq) const {
        const int row0 = u.pm * 256 + wr * 64 + fr, f0w = u.pn * 128 + wc * 32;
        constexpr float DS = 1.0f / (FP8_SA * FP8_SW);
#pragma unroll
        for (int ai = 0; ai < 2; ++ai)
#pragma unroll
            for (int mp = 0; mp < 2; ++mp) { unsigned lo[2], hi[2];
#pragma unroll
                for (int mm = 0; mm < 2; ++mm) { const int m = 2 * mp + mm; float h[8];
#pragma unroll
                    for (int n = 0; n < 2; ++n)
#pragma unroll
                        for (int j = 0; j < 4; ++j) { const float g = acc[ai][0][m][n][j] * DS + q.bg[n][j], up = acc[ai][1][m][n][j] * DS + q.bu[n][j];
                            const float gl = fminf(g, 7.0f), li = __builtin_amdgcn_fmed3f(up, -7.0f, 7.0f);
                            const float sg = __builtin_amdgcn_rcpf(1.0f + __builtin_amdgcn_exp2f(gl * (-1.702f * 1.44269504f)));
                            h[n * 4 + j] = (gl * sg) * (li * FP8_SH + FP8_SH); }
                    lo[mm] = pk4_fp8(h[0], h[1], h[2], h[3]); hi[mm] = pk4_fp8(h[4], h[5], h[6], h[7]); }
                const v2u r0 = __builtin_amdgcn_permlane16_swap(lo[0], lo[1], false, false), r1 = __builtin_amdgcn_permlane16_swap(hi[0], hi[1], false, false);
                unsigned char* rowp = hb + (size_t)(row0 + ai * 128 + (2 * mp + (fq & 1)) * 16) * FF + f0w + 16 * (fq >> 1);
                *(v4u*)rowp = (v4u){r0.x, r1.x, r0.y, r1.y}; }
    }
};
struct EpiDown {
    static constexpr bool PERM = true;
    struct Pre { f32x4 bv[2][2]; float gt[2][4]; };
    unsigned char* y2; const float* b_down; const float* sgate; const LAS int* tstart;
    __device__ __forceinline__ void prefetch(const pg8::Unit& u, Pre& q) const {
        int tz = threadIdx.x; asm volatile("" : "+v"(tz)); const int wid = tz >> 6, wr = wid >> 2, wc = wid & 3, fr = tz & 15, fq = (tz >> 4) & 3;
        const int rl0 = wr * 64 + fr, col0 = u.pn * 256 + wc * 32 + 8 * fq;
        const int mt = __builtin_amdgcn_readfirstlane(u.pm - tstart[u.e]);
        const float* gp = sgate + (size_t)u.e * T + mt * 256;
#pragma unroll
        for (int bj = 0; bj < 2; ++bj)
#pragma unroll
            for (int n = 0; n < 2; ++n) q.bv[bj][n] = *(const f32x4*)(b_down + (size_t)u.e * D + col0 + bj * 128 + 4 * n);
#pragma unroll
        for (int ai = 0; ai < 2; ++ai)
#pragma unroll
            for (int m = 0; m < 4; ++m) q.gt[ai][m] = gp[rl0 + ai * 128 + m * 16];
    }
    __device__ __forceinline__ void operator()(const f32x4 (&acc)[2][2][4][2], const pg8::Unit& u, const Pre& q, int wr, int wc, int fr, int fq) const {
        const int rl0 = wr * 64 + fr, colw = u.pn * 256 + wc * 32;
        constexpr float DS = 1.0f / (FP8_SH * FP8_SW);
#pragma unroll
        for (int ai = 0; ai < 2; ++ai)
#pragma unroll
            for (int mp = 0; mp < 2; ++mp)
#pragma unroll
                for (int bj = 0; bj < 2; ++bj) { unsigned lo[2], hi[2];
#pragma unroll
                    for (int mm = 0; mm < 2; ++mm) { const int m = 2 * mp + mm; const float gt = q.gt[ai][m] * FP8_SY;
                        const f32x4 v0 = (acc[ai][bj][m][0] * DS + q.bv[bj][0]) * gt, v1 = (acc[ai][bj][m][1] * DS + q.bv[bj][1]) * gt;
                        lo[mm] = pk4_fp8(sat8(v0[0]), sat8(v0[1]), sat8(v0[2]), sat8(v0[3])); hi[mm] = pk4_fp8(sat8(v1[0]), sat8(v1[1]), sat8(v1[2]), sat8(v1[3])); }
                    const v2u r0 = __builtin_amdgcn_permlane16_swap(lo[0], lo[1], false, false), r1 = __builtin_amdgcn_permlane16_swap(hi[0], hi[1], false, false);
                    unsigned char* rowp = y2 + (size_t)(u.pm * 256 + rl0 + ai * 128 + (2 * mp + (fq & 1)) * 16) * D + colw + bj * 128 + 16 * (fq >> 1);
                    *(v4u*)rowp = (v4u){r0.x, r1.x, r0.y, r1.y}; }
    }
};

__device__ __forceinline__ void p0_tr_item(const float* W, int ldw, int k0, int n0, int nvalid, bf16* WT, int dst_row0, LAS float* scr, int lane) {
    const int c4 = (lane & 15) * 4, kr = lane >> 4;
#pragma unroll 4
    for (int i = 0; i < 16; ++i) { const int kk = 4 * i + kr;
        f32x4 v = (f32x4){0.f, 0.f, 0.f, 0.f};
        if (c4 < nvalid) v = *(const f32x4*)(W + (size_t)(k0 + kk) * ldw + n0 + c4);
        LAS float* d = scr + kk * 65 + c4; d[0] = v[0]; d[1] = v[1]; d[2] = v[2]; d[3] = v[3]; }
    LDS_WAIT(); asm volatile("" ::: "memory");
    const int c = lane >> 3, np = lane & 7;
#pragma unroll
    for (int j = 0; j < 8; ++j) { const int n = 8 * j + np; const LAS float* s = scr + (8 * c) * 65 + n;
        v4u o; o.x = pk2(s[0 * 65], s[1 * 65]); o.y = pk2(s[2 * 65], s[3 * 65]); o.z = pk2(s[4 * 65], s[5 * 65]); o.w = pk2(s[6 * 65], s[7 * 65]);
        *(v4u*)(WT + (size_t)(dst_row0 + n) * 2048 + k0 + 8 * c) = o; }
    LDS_WAIT(); asm volatile("" ::: "memory");
}
__device__ __forceinline__ void f8_tile_load(const float* src, f32x4 (&v)[16], int lane) {
    const float* s0 = src + (size_t)(16 * (lane >> 3)) * 2048 + 4 * (lane & 7);
#pragma unroll
    for (int i = 0; i < 16; ++i) v[i] = __builtin_nontemporal_load((const f32x4*)(s0 + (size_t)i * 2048));
}
__device__ __forceinline__ void f8_tile_store(const f32x4 (&v)[16], unsigned char* dst, int lane) {
    unsigned d[16];
#pragma unroll
    for (int i = 0; i < 16; ++i) d[i] = pk4_fp8(sat8(v[i][0] * FP8_SW), sat8(v[i][1] * FP8_SW), sat8(v[i][2] * FP8_SW), sat8(v[i][3] * FP8_SW));
    unsigned o[4][4];
#pragma unroll
    for (int w = 0; w < 4; ++w) {
        const unsigned t0 = __builtin_amdgcn_perm(d[4 * w + 1], d[4 * w], 0x05010400u), t1 = __builtin_amdgcn_perm(d[4 * w + 1], d[4 * w], 0x07030602u);
        const unsigned t2 = __builtin_amdgcn_perm(d[4 * w + 3], d[4 * w + 2], 0x05010400u), t3 = __builtin_amdgcn_perm(d[4 * w + 3], d[4 * w + 2], 0x07030602u);
        o[0][w] = __builtin_amdgcn_perm(t2, t0, 0x05040100u); o[1][w] = __builtin_amdgcn_perm(t2, t0, 0x07060302u);
        o[2][w] = __builtin_amdgcn_perm(t3, t1, 0x05040100u); o[3][w] = __builtin_amdgcn_perm(t3, t1, 0x07060302u);
    }
    unsigned char* d0 = dst + (size_t)(4 * (lane & 7)) * 2048 + 16 * (lane >> 3);
#pragma unroll
    for (int b = 0; b < 4; ++b) __builtin_nontemporal_store((v4u){o[b][0], o[b][1], o[b][2], o[b][3]}, (v4u*)(d0 + (size_t)b * 2048));
}
__device__ __forceinline__ void f8_item(const Params& p, int it, const float*& src, unsigned char*& dst) {
    const int which = it >> 15, r = it & 32767, e = r >> 10, q = r & 1023, kb = q >> 6, nb = q & 63;
    if (which == 2) { src = p.w_down + (size_t)e * FF * D + (size_t)(kb * 128) * D + nb * 32; dst = p.ws + WS_WD + ((size_t)e * D + nb * 32) * 2048 + kb * 128; }
    else { const int f0 = nb * 32, drow = (f0 >> 7) * 256 + which * 128 + (f0 & 127);
        src = (which == 0 ? p.w_gate : p.w_up) + (size_t)e * D * FF + (size_t)(kb * 128) * FF + f0; dst = p.ws + WS_WGU + ((size_t)e * 4096 + drow) * 2048 + kb * 128; }
}
__device__ __forceinline__ void convert_experts(const Params& p, int first, int stride, int lane) {
    constexpr int NEXP = 3 * NE * 1024;
    f32x4 va[16], vb[16]; const float* sa; unsigned char* da; const float* sb; unsigned char* db;
    int ia = first, ib;
    if (ia < NEXP) { f8_item(p, ia, sa, da); f8_tile_load(sa, va, lane); }
    for (;;) {
        if (ia >= NEXP) break;
        ib = ia + stride; if (ib < NEXP) { f8_item(p, ib, sb, db); f8_tile_load(sb, vb, lane); }
        f8_tile_store(va, da, lane);
        if (ib >= NEXP) break;
        ia = ib + stride; if (ia < NEXP) { f8_item(p, ia, sa, da); f8_tile_load(sa, va, lane); }
        f8_tile_store(vb, db, lane);
    }
}
__device__ __forceinline__ void phase_prologue(const Params& p, LAS unsigned char* lds, int gw, int NGW, int wave, int lane) {
    LAS float* scr = (LAS float*)(lds + wave * 16896);
    bf16* WIN = (bf16*)(p.ws + WS_WIN); bf16* WOUT = (bf16*)(p.ws + WS_WOUT);
#if OUTPROJ_F8
    constexpr int I_OUT = 0;
    for (int it = gw; it < 16 * 64; it += NGW) { const int kb = it >> 6, n0 = (it & 63) * 32;
        f32x4 v[16]; f8_tile_load(p.w_out + (size_t)(kb * 128) * D + n0, v, lane);
        f8_tile_store(v, p.ws + WS_WOUT + (size_t)n0 * 2048 + kb * 128, lane); }
#else
    constexpr int I_OUT = 32 * 32;
#endif
#if INPROJ_F8
    constexpr int I_IN = 0;
    for (int it = gw; it < 16 * 128; it += NGW) { const int kb = it >> 7, n0 = (it & 127) * 32;
        f32x4 v[16];
        if (n0 + 4 * (lane & 7) < NIN) { const float* s0 = p.w_in + (size_t)(kb * 128 + 16 * (lane >> 3)) * NIN + n0 + 4 * (lane & 7);
#pragma unroll
            for (int i = 0; i < 16; ++i) v[i] = __builtin_nontemporal_load((const f32x4*)(s0 + (size_t)i * NIN)); }
        else {
#pragma unroll
            for (int i = 0; i < 16; ++i) v[i] = (f32x4){0.f, 0.f, 0.f, 0.f}; }
        f8_tile_store(v, p.ws + WS_WIN + (size_t)n0 * 2048 + kb * 128, lane);
    }
#else
    constexpr int I_IN = 32 * 64;
#endif
    for (int it = gw; it < I_IN + I_OUT; it += NGW) {
        int r = it;
        if (r < I_IN) { const int kb = r / 64, nb = r % 64; int nv = NIN - nb * 64; nv = nv < 0 ? 0 : (nv > 64 ? 64 : nv);
            p0_tr_item(p.w_in, NIN, kb * 64, nb * 64, nv, WIN, nb * 64, scr, lane); continue; }
        r -= I_IN;
        { const int kb = r / 32, nb = r % 32; p0_tr_item(p.w_out, D, kb * 64, nb * 64, 64, WOUT, nb * 64, scr, lane); }
    }
    {
        bf16* wrb = (bf16*)(p.ws + WS_WRB);
        for (int idx = gw * 64 + lane; idx < D * NE; idx += NGW * 64) { const int k = idx >> 5, n = idx & 31, j = k >> 5, kq = (k >> 3) & 3, m = k & 7, half = n >> 4, l64 = kq * 16 + (n & 15);
            const float w = p.w_router[idx]; const unsigned hi = f2bf(w); const float lo = w - bflo(hi);
            wrb[((((size_t)j * 2 + half) * 2 + 0) * 64 + l64) * 8 + m] = (bf16)hi; wrb[((((size_t)j * 2 + half) * 2 + 1) * 64 + l64) * 8 + m] = (bf16)f2bf(lo); }
    }
    bf16* HN = (bf16*)(p.ws + WS_HN);
    f32x4 gw4[8];
#pragma unroll
    for (int j = 0; j < 8; ++j) gw4[j] = *((const f32x4*)p.attn_norm_w + 64 * j + lane);
    f32x4 vn[8];
    if (gw < T) { const f32x4* xr = (const f32x4*)(p.x + (size_t)gw * D) + lane;
#pragma unroll
        for (int j = 0; j < 8; ++j) vn[j] = xr[64 * j]; }
    for (int m = gw; m < T; m += NGW) {
        f32x4 v[8]; float s = 0.f;
#pragma unroll
        for (int j = 0; j < 8; ++j) v[j] = vn[j];
        if (m + NGW < T) { const f32x4* xr = (const f32x4*)(p.x + (size_t)(m + NGW) * D) + lane;
#pragma unroll
            for (int j = 0; j < 8; ++j) vn[j] = xr[64 * j]; }
#pragma unroll
        for (int j = 0; j < 8; ++j) s += (v[j][0] * v[j][0] + v[j][1] * v[j][1]) + (v[j][2] * v[j][2] + v[j][3] * v[j][3]);
        const float rstd = rsqrtf(wave_sum(s) * (1.f / D) + EPS);
#if INPROJ_F8
        unsigned* o4 = (unsigned*)((unsigned char*)HN + (size_t)m * D) + lane; const float rs = rstd * FP8_SA;
#pragma unroll
        for (int j = 0; j < 8; ++j) o4[64 * j] = pk4_fp8(sat8(v[j][0] * rs * gw4[j][0]), sat8(v[j][1] * rs * gw4[j][1]), sat8(v[j][2] * rs * gw4[j][2]), sat8(v[j][3] * rs * gw4[j][3]));
#else
        v2u* o8 = (v2u*)(HN + (size_t)m * D) + lane;
#pragma unroll
        for (int j = 0; j < 8; ++j) { v2u w; w.x = pk2(v[j][0] * rstd * gw4[j][0], v[j][1] * rstd * gw4[j][1]); w.y = pk2(v[j][2] * rstd * gw4[j][2], v[j][3] * rstd * gw4[j][3]); o8[64 * j] = w; }
#endif
    }
}

__device__ __forceinline__ void phase_conv(const Params& p, int G) {
    const bf16* proj = (const bf16*)(p.ws + WS_PROJ); float* xbc = (float*)(p.ws + WS_XBC);
    const float* dtraw = (const float*)(p.ws + WS_DT); float* dts = (float*)(p.ws + WS_DTS);
    const int tid = threadIdx.x;
    for (int item = blockIdx.x; item < T / 64; item += G) {
        const int t0 = item * 64;
        if (tid < 384) {
            const int cg = tid % 192, half = tid / 192, c0 = cg * 8, ts = t0 + half * 32;
            float w[4][8], bb[8];
#pragma unroll
            for (int k = 0; k < 4; ++k)
#pragma unroll
                for (int j = 0; j < 8; ++j) w[k][j] = p.conv_w[k * NXBC + c0 + j];
#pragma unroll
            for (int j = 0; j < 8; ++j) bb[j] = p.conv_b[c0 + j];
            float r0[8], r1[8], r2[8];
            {
                const int tl = ts % SEQ;
                v4u q0 = (v4u){0u, 0u, 0u, 0u}, q1 = q0, q2 = q0;
                if (tl - 3 >= 0) q0 = *(const v4u*)(proj + (size_t)(ts - 3) * PROJ_LD + COL_XBC + c0);
                if (tl - 2 >= 0) q1 = *(const v4u*)(proj + (size_t)(ts - 2) * PROJ_LD + COL_XBC + c0);
                if (tl - 1 >= 0) q2 = *(const v4u*)(proj + (size_t)(ts - 1) * PROJ_LD + COL_XBC + c0);
                unpack8(q0, r0); unpack8(q1, r1); unpack8(q2, r2);
            }
            for (int i = 0; i < 32; ++i) {
                const int t = ts + i;
                const v4u q = *(const v4u*)(proj + (size_t)t * PROJ_LD + COL_XBC + c0);
                float r3[8]; unpack8(q, r3);
                float o[8];
#pragma unroll
                for (int j = 0; j < 8; ++j) { const float a = bb[j] + w[0][j] * r0[j] + w[1][j] * r1[j] + w[2][j] * r2[j] + w[3][j] * r3[j]; o[j] = a * fsigmoid(a); }
                float* dp = xbc + (size_t)t * NXBC + c0;
                *(f32x4*)dp = (f32x4){o[0], o[1], o[2], o[3]}; *(f32x4*)(dp + 4) = (f32x4){o[4], o[5], o[6], o[7]};
#pragma unroll
                for (int j = 0; j < 8; ++j) { r0[j] = r1[j]; r1[j] = r2[j]; r2[j] = r3[j]; }
            }
        } else {
            const int u = tid - 384;
#pragma unroll
            for (int i = 0; i < 8; ++i) { const int idx = u + 128 * i; const int t = t0 + (idx >> 4), h = idx & 15;
                const float v = dtraw[(size_t)t * 16 + h] + p.dt_bias[h];
                dts[(size_t)t * 16 + h] = fmaxf(v, 0.f) + log1pf(__expf(-fabsf(v))); }
        }
    }
}

__device__ __forceinline__ void phase_attn_simple(const Params& p, LAS unsigned char* lds, int G) {
    const bf16* proj = (const bf16*)(p.ws + WS_PROJ); float* att = (float*)(p.ws + WS_ATT);
    LAS float* Ks = (LAS float*)lds; LAS float* Vs = (LAS float*)(lds + 256 * 68 * 4);
    const int tid = threadIdx.x;
    for (int item = blockIdx.x; item < NB * 64 * 2; item += G) {
        const int b = item >> 7, n = (item >> 1) & 63, hk = item & 1;
        __syncthreads();
        {
            const int j = tid >> 1, hf = tid & 1, pos = n * 128 - 128 + j;
            float kv[32], vv[32];
            if (pos >= 0) {
                const bf16* kp = proj + (size_t)(b * SEQ + pos) * PROJ_LD + COL_K + hk * 64 + hf * 32;
                const bf16* vp = proj + (size_t)(b * SEQ + pos) * PROJ_LD + COL_V + hk * 64 + hf * 32;
#pragma unroll
                for (int c = 0; c < 4; ++c) { const v4u a = *(const v4u*)(kp + 8 * c), bq = *(const v4u*)(vp + 8 * c);
                    kv[8 * c + 0] = bflo(a.x); kv[8 * c + 1] = bfhi(a.x); kv[8 * c + 2] = bflo(a.y); kv[8 * c + 3] = bfhi(a.y); kv[8 * c + 4] = bflo(a.z); kv[8 * c + 5] = bfhi(a.z); kv[8 * c + 6] = bflo(a.w); kv[8 * c + 7] = bfhi(a.w);
                    vv[8 * c + 0] = bflo(bq.x); vv[8 * c + 1] = bfhi(bq.x); vv[8 * c + 2] = bflo(bq.y); vv[8 * c + 3] = bfhi(bq.y); vv[8 * c + 4] = bflo(bq.z); vv[8 * c + 5] = bfhi(bq.z); vv[8 * c + 6] = bflo(bq.w); vv[8 * c + 7] = bfhi(bq.w); }
            } else {
#pragma unroll
                for (int d = 0; d < 32; ++d) { kv[d] = 0.f; vv[d] = 0.f; }
            }
            float s = 0.f;
#pragma unroll
            for (int d = 0; d < 32; ++d) s += kv[d] * kv[d];
            s += __shfl_xor(s, 1);
            const float rstd = rsqrtf(s * (1.f / 64.f) + EPS);
#pragma unroll
            for (int d = 0; d < 32; ++d) { Ks[j * 68 + hf * 32 + d] = kv[d] * rstd * p.k_norm_w[hf * 32 + d]; Vs[j * 68 + hf * 32 + d] = vv[d]; }
        }
        __syncthreads();
        const int qi = tid & 127, grp = tid >> 7;
        const int tok = b * SEQ + n * 128 + qi;
        for (int hh = 0; hh < 2; ++hh) {
            const int hq = hk * 8 + grp * 2 + hh;
            float q[64];
            {
                const bf16* qp = proj + (size_t)tok * PROJ_LD + COL_Q + hq * 64;
                float s = 0.f;
#pragma unroll
                for (int c = 0; c < 8; ++c) { const v4u a = *(const v4u*)(qp + 8 * c);
                    q[8 * c + 0] = bflo(a.x); q[8 * c + 1] = bfhi(a.x); q[8 * c + 2] = bflo(a.y); q[8 * c + 3] = bfhi(a.y); q[8 * c + 4] = bflo(a.z); q[8 * c + 5] = bfhi(a.z); q[8 * c + 6] = bflo(a.w); q[8 * c + 7] = bfhi(a.w); }
#pragma unroll
                for (int d = 0; d < 64; ++d) s += q[d] * q[d];
                const float rstd = rsqrtf(s * (1.f / 64.f) + EPS) * 0.125f;
#pragma unroll
                for (int d = 0; d < 64; ++d) q[d] = q[d] * rstd * p.q_norm_w[d];
            }
            float mx = p.sinks[hq], l = 1.0f, o[64];
#pragma unroll
            for (int d = 0; d < 64; ++d) o[d] = 0.f;
            const int jlo = (n == 0) ? 128 : qi + 1;
            for (int j = jlo; j <= qi + 128; ++j) {
                const LAS f32x4* kr = (const LAS f32x4*)(Ks + j * 68);
                float s = 0.f;
#pragma unroll
                for (int c = 0; c < 16; ++c) { const f32x4 kk = kr[c]; s += q[4 * c] * kk[0] + q[4 * c + 1] * kk[1] + q[4 * c + 2] * kk[2] + q[4 * c + 3] * kk[3]; }
                const float mn = fmaxf(mx, s), corr = __expf(mx - mn), pj = __expf(s - mn);
                l = l * corr + pj; mx = mn;
                const LAS f32x4* vr = (const LAS f32x4*)(Vs + j * 68);
#pragma unroll
                for (int c = 0; c < 16; ++c) { const f32x4 vv = vr[c]; o[4 * c] = o[4 * c] * corr + pj * vv[0]; o[4 * c + 1] = o[4 * c + 1] * corr + pj * vv[1]; o[4 * c + 2] = o[4 * c + 2] * corr + pj * vv[2]; o[4 * c + 3] = o[4 * c + 3] * corr + pj * vv[3]; }
            }
            const float inv = 1.0f / l;
            float* op = att + (size_t)tok * 1024 + hq * 64;
#pragma unroll
            for (int c = 0; c < 16; ++c) *(f32x4*)(op + 4 * c) = (f32x4){o[4 * c] * inv, o[4 * c + 1] * inv, o[4 * c + 2] * inv, o[4 * c + 3] * inv};
        }
    }
}

__device__ __forceinline__ void phase_ssd_seq(const Params& p, LAS unsigned char* lds, int G) {
    const float* xbc = (const float*)(p.ws + WS_XBC); const float* dts = (const float*)(p.ws + WS_DTS); float* ys = (float*)(p.ws + WS_YS);
    constexpr int TT = 64;
    LAS float* Bs = (LAS float*)lds;
    LAS float* Cs = Bs + TT * 128;
    LAS float* xs = Cs + TT * 128;
    LAS float* dl = xs + TT * 16;
    LAS float* yo = dl + TT;
    const int tid = threadIdx.x, pl = tid >> 5, ns = tid & 31;
    for (int item = blockIdx.x; item < NB * 16 * 4; item += G) {
        const int b = item >> 6, h = (item >> 2) & 15, pq = item & 3, g = h >> 3;
        const float a = -__expf(p.a_log[h]), dsk = p.d_skip[h];
        f32x4 st = (f32x4){0.f, 0.f, 0.f, 0.f};
        for (int tc = 0; tc < SEQ; tc += TT) {
            __syncthreads();
            const size_t tb = (size_t)b * SEQ + tc;
            for (int i = tid; i < TT * 32; i += NTHREADS) { const int tt = i >> 5, c = (i & 31) * 4;
                *(LAS f32x4*)(Bs + tt * 128 + c) = *(const f32x4*)(xbc + (tb + tt) * NXBC + 1024 + g * 128 + c);
                *(LAS f32x4*)(Cs + tt * 128 + c) = *(const f32x4*)(xbc + (tb + tt) * NXBC + 1280 + g * 128 + c); }
            for (int i = tid; i < TT * 16; i += NTHREADS) { const int tt = i >> 4, c = i & 15; xs[i] = xbc[(tb + tt) * NXBC + h * 64 + pq * 16 + c]; }
            if (tid < TT) dl[tid] = dts[(tb + tid) * 16 + h];
            __syncthreads();
            for (int tt = 0; tt < TT; ++tt) {
                const float dt = dl[tt], xv = xs[tt * 16 + pl];
                const float dA = __expf(dt * a), xd = xv * dt;
                const f32x4 bv = *(const LAS f32x4*)(Bs + tt * 128 + ns * 4), cv = *(const LAS f32x4*)(Cs + tt * 128 + ns * 4);
                st = st * dA + bv * xd;
                float y = (cv[0] * st[0] + cv[1] * st[1]) + (cv[2] * st[2] + cv[3] * st[3]);
                y += __shfl_xor(y, 1); y += __shfl_xor(y, 2); y += __shfl_xor(y, 4); y += __shfl_xor(y, 8); y += __shfl_xor(y, 16);
                if (ns == 0) yo[tt * 16 + pl] = y + dsk * xv;
            }
            __syncthreads();
            for (int i = tid; i < TT * 16; i += NTHREADS) { const int tt = i >> 4, c = i & 15; ys[(tb + tt) * 1024 + h * 64 + pq * 16 + c] = yo[i]; }
        }
    }
}


typedef float f32x16 __attribute__((ext_vector_type(16)));
#define MFMA32(a, b, c) __builtin_amdgcn_mfma_f32_32x32x16_bf16(a, b, c, 0, 0, 0)
constexpr int SPT = 136;
__device__ __forceinline__ float softplus_f(float v) { return fmaxf(v, 0.f) + log1pf(__expf(-fabsf(v))); }

__device__ __forceinline__ void ssd_tables(const Params& p, LAS float* dtl, LAS float* csl, LAS float* wtot, size_t trow0, int h0, int nh, int lane, int wave) {
    const float* dtraw = (const float*)(p.ws + WS_DT);
    for (int rnd = 0; rnd < nh / 4; ++rnd) {
        const int hh = rnd * 4 + (wave >> 1), l = (wave & 1) * 64 + lane, h = h0 + hh;
        const float dt = softplus_f(dtraw[(trow0 + l) * 16 + h] + p.dt_bias[h]);
        float v = dt * (-expf(p.a_log[h]));
#pragma unroll
        for (int o = 1; o < 64; o <<= 1) { const float u = __shfl_up(v, o); v = (lane >= o) ? v + u : v; }
        if (lane == 63) wtot[rnd * 8 + wave] = v;
        __syncthreads();
        if (wave & 1) v += wtot[rnd * 8 + wave - 1];
        dtl[hh * 128 + l] = dt; csl[hh * 128 + l] = v;
    }
    __syncthreads();
}
template <bool TR, bool SCALE>
__device__ __forceinline__ void conv_task(const Params& p, const bf16* proj, size_t trow0, int tl0, int run, int xcol, LAS bf16* dst, int d0, const LAS float* sc) {
    float w[4][8], bb[8];
#pragma unroll
    for (int k = 0; k < 4; ++k) { const f32x4 a = *(const f32x4*)(p.conv_w + k * NXBC + xcol), b = *(const f32x4*)(p.conv_w + k * NXBC + xcol + 4);
        w[k][0] = a[0]; w[k][1] = a[1]; w[k][2] = a[2]; w[k][3] = a[3]; w[k][4] = b[0]; w[k][5] = b[1]; w[k][6] = b[2]; w[k][7] = b[3]; }
    { const f32x4 a = *(const f32x4*)(p.conv_b + xcol), b = *(const f32x4*)(p.conv_b + xcol + 4); bb[0] = a[0]; bb[1] = a[1]; bb[2] = a[2]; bb[3] = a[3]; bb[4] = b[0]; bb[5] = b[1]; bb[6] = b[2]; bb[7] = b[3]; }
    const int l0 = run * 8; const bf16* src = proj + (trow0 + l0) * PROJ_LD + COL_XBC + xcol;
    float r0[8], r1[8], r2[8];
    { const int pos = tl0 + l0; v4u q0 = (v4u){0u, 0u, 0u, 0u}, q1 = q0, q2 = q0;
      if (pos - 3 >= 0) q0 = *(const v4u*)(src - 3 * PROJ_LD);
      if (pos - 2 >= 0) q1 = *(const v4u*)(src - 2 * PROJ_LD);
      if (pos - 1 >= 0) q2 = *(const v4u*)(src - 1 * PROJ_LD);
      unpack8(q0, r0); unpack8(q1, r1); unpack8(q2, r2); }
#pragma unroll
    for (int i = 0; i < 8; i += 2) {
        float r3[8], r4[8], o0[8], o1[8];
        unpack8(*(const v4u*)(src + (size_t)i * PROJ_LD), r3); unpack8(*(const v4u*)(src + (size_t)(i + 1) * PROJ_LD), r4);
#pragma unroll
        for (int j = 0; j < 8; ++j) { const float a0 = bb[j] + w[0][j] * r0[j] + w[1][j] * r1[j] + w[2][j] * r2[j] + w[3][j] * r3[j];
            const float a1 = bb[j] + w[0][j] * r1[j] + w[1][j] * r2[j] + w[2][j] * r3[j] + w[3][j] * r4[j];
            o0[j] = a0 * fsigmoid(a0); o1[j] = a1 * fsigmoid(a1); }
        if constexpr (TR) {
            float s0 = 1.f, s1 = 1.f; if constexpr (SCALE) { s0 = sc[l0 + i]; s1 = sc[l0 + i + 1]; }
#pragma unroll
            for (int j = 0; j < 8; ++j) *(LAS unsigned*)(dst + (d0 + j) * SPT + l0 + i) = pk2(o0[j] * s0, o1[j] * s1);
        } else {
            *(LAS v4u*)(dst + (l0 + i) * SPT + d0) = (v4u){pk2(o0[0], o0[1]), pk2(o0[2], o0[3]), pk2(o0[4], o0[5]), pk2(o0[6], o0[7])};
            *(LAS v4u*)(dst + (l0 + i + 1) * SPT + d0) = (v4u){pk2(o1[0], o1[1]), pk2(o1[2], o1[3]), pk2(o1[4], o1[5]), pk2(o1[6], o1[7])};
        }
#pragma unroll
        for (int j = 0; j < 8; ++j) { r0[j] = r2[j]; r1[j] = r3[j]; r2[j] = r4[j]; }
    }
}

__device__ __forceinline__ void phase_ssd_states(const Params& p, LAS unsigned char* lds, int G, int lane, int wave) {
    const bf16* proj = (const bf16*)(p.ws + WS_PROJ); float* states = (float*)(p.ws + WS_STATES); float* cdec = (float*)(p.ws + WS_CDEC);
    LAS bf16* BT = (LAS bf16*)lds;
    LAS bf16* XdT = BT + 128 * SPT;
    LAS float* dtl = (LAS float*)(lds + 384 * SPT * 2);
    LAS float* csl = dtl + 512; LAS float* scl = csl + 512; LAS float* wtot = scl + 512;
    const int tid = threadIdx.x, r = lane & 31, hf = lane >> 5;
    for (int item = blockIdx.x; item < NB * 64 * 4; item += G) {
        const int b = item >> 8, c = (item >> 2) & 63, g = (item >> 1) & 1, hh2 = item & 1;
        const int h0 = g * 8 + hh2 * 4; const size_t trow0 = (size_t)b * SEQ + c * 128; const int tl0 = c * 128;
        __syncthreads();
        ssd_tables(p, dtl, csl, wtot, trow0, h0, 4, lane, wave);
        scl[tid] = dtl[tid] * __expf(csl[(tid & ~127) + 127] - csl[tid]);
        if ((tid & 127) == 127) cdec[((size_t)b * 64 + c) * 16 + h0 + (tid >> 7)] = __expf(csl[tid]);
        __syncthreads();
        for (int task = tid; task < 48 * 16; task += NTHREADS) { const int cg = task >> 4, run = task & 15;
            if (cg < 16) conv_task<true, false>(p, proj, trow0, tl0, run, 1024 + g * 128 + cg * 8, BT, cg * 8, nullptr);
            else { const int cx = cg - 16; conv_task<true, true>(p, proj, trow0, tl0, run, h0 * 64 + cx * 8, XdT, cx * 8, scl + (cx >> 3) * 128); } }
        __syncthreads();
        const int hh = wave >> 1, nh_ = wave & 1;
        f32x16 acc[2][2];
#pragma unroll
        for (int a = 0; a < 2; ++a)
#pragma unroll
            for (int bq = 0; bq < 2; ++bq)
#pragma unroll
                for (int e = 0; e < 16; ++e) acc[a][bq][e] = 0.f;
#pragma unroll
        for (int ks = 0; ks < 8; ++ks) {
            bf16x8 af[2], bfm[2];
#pragma unroll
            for (int pt = 0; pt < 2; ++pt) af[pt] = *(const LAS bf16x8*)(XdT + (hh * 64 + pt * 32 + r) * SPT + ks * 16 + 8 * hf);
#pragma unroll
            for (int nt = 0; nt < 2; ++nt) bfm[nt] = *(const LAS bf16x8*)(BT + (nh_ * 64 + nt * 32 + r) * SPT + ks * 16 + 8 * hf);
#pragma unroll
            for (int pt = 0; pt < 2; ++pt)
#pragma unroll
                for (int nt = 0; nt < 2; ++nt) acc[pt][nt] = MFMA32(bfm[nt], af[pt], acc[pt][nt]);
        }
        float* sp = states + (((size_t)b * 64 + c) * 16 + h0 + hh) * 64 * 128;
#pragma unroll
        for (int pt = 0; pt < 2; ++pt)
#pragma unroll
            for (int nt = 0; nt < 2; ++nt)
#pragma unroll
                for (int q = 0; q < 4; ++q) *(f32x4*)(sp + (pt * 32 + r) * 128 + nh_ * 64 + nt * 32 + 8 * q + 4 * hf) = (f32x4){acc[pt][nt][4 * q], acc[pt][nt][4 * q + 1], acc[pt][nt][4 * q + 2], acc[pt][nt][4 * q + 3]};
    }
}
__device__ __forceinline__ void phase_ssd_scan(const Params& p, int G) {
    const float* states = (const float*)(p.ws + WS_STATES); const float* cdec = (const float*)(p.ws + WS_CDEC); bf16* sin = (bf16*)(p.ws + WS_SIN);
    for (int idx = blockIdx.x * NTHREADS + threadIdx.x; idx < NB * 16 * 64 * 32; idx += G * NTHREADS) {
        const int n4 = idx & 31, pp = (idx >> 5) & 63, h = (idx >> 11) & 15, b = idx >> 15;
        f32x4 run = (f32x4){0.f, 0.f, 0.f, 0.f};
#pragma unroll 8
        for (int c = 0; c < 64; ++c) {
            const size_t off = ((((size_t)b * 64 + c) * 16 + h) * 64 + pp) * 128 + n4 * 4;
            const f32x4 st = *(const f32x4*)(states + off); const float dec = cdec[((size_t)b * 64 + c) * 16 + h];
            *(v2u*)(sin + off) = (v2u){pk2(run[0], run[1]), pk2(run[2], run[3])};
            run = run * dec + st;
        }
    }
}
__device__ __forceinline__ void ssd_out_pass(const Params& p, const bf16* proj, const bf16* sinp  , const LAS bf16* Cs, const LAS bf16* CB, const LAS bf16* XT,
                                             const LAS float* dth, const LAS float* csh  , LAS float* ssqh  , float Dh, size_t trow0, int h, int hh, int lsel, int r, int hf,
                                             unsigned (&yp)[2][2][8]) {
    f32x16 acc[2][2];
#pragma unroll
    for (int a = 0; a < 2; ++a)
#pragma unroll
        for (int bq = 0; bq < 2; ++bq)
#pragma unroll
            for (int e = 0; e < 16; ++e) acc[a][bq][e] = 0.f;
#pragma unroll
    for (int pt = 0; pt < 2; ++pt) {
        bf16x8 af[8];
#pragma unroll
        for (int ks = 0; ks < 8; ++ks) af[ks] = *(const bf16x8*)(sinp + (pt * 32 + r) * 128 + ks * 16 + 8 * hf);
#pragma unroll
        for (int j = 0; j < 2; ++j) { const int lt = j == 0 ? (lsel ? 1 : 0) : (lsel ? 2 : 3);
#pragma unroll
            for (int ks = 0; ks < 8; ++ks) { const bf16x8 bq = *(const LAS bf16x8*)(Cs + (lt * 32 + r) * SPT + ks * 16 + 8 * hf); acc[pt][j] = MFMA32(af[ks], bq, acc[pt][j]); } }
    }
#pragma unroll
    for (int j = 0; j < 2; ++j) { const int lt = j == 0 ? (lsel ? 1 : 0) : (lsel ? 2 : 3); const float el = __expf(csh[lt * 32 + r]);
#pragma unroll
        for (int pt = 0; pt < 2; ++pt) acc[pt][j] = acc[pt][j] * el; }
#pragma unroll
    for (int j = 0; j < 2; ++j) { const int lt = j == 0 ? (lsel ? 1 : 0) : (lsel ? 2 : 3); const int lcol = lt * 32 + r; const float csL = csh[lcol]; const int nks = 2 * lt + 2;
        for (int ks = 0; ks < nks; ++ks) { const int s0 = ks * 16 + 8 * hf;
            const v4u cbv = *(const LAS v4u*)(CB + lcol * SPT + s0);
            const f32x4 c0 = *(const LAS f32x4*)(csh + s0), c1 = *(const LAS f32x4*)(csh + s0 + 4), d0 = *(const LAS f32x4*)(dth + s0), d1 = *(const LAS f32x4*)(dth + s0 + 4);
            float cbf[8]; unpack8(cbv, cbf); float m[8];
#pragma unroll
            for (int jj = 0; jj < 8; ++jj) { const float cs_s = jj < 4 ? c0[jj & 3] : c1[jj & 3], dt_s = jj < 4 ? d0[jj & 3] : d1[jj & 3];
                float v = cbf[jj] * __expf(fminf(csL - cs_s, 0.f)) * dt_s; v = (s0 + jj <= lcol) ? v : 0.f; m[jj] = (s0 + jj == lcol) ? v + Dh : v; }
            v4u mp; mp.x = pk2(m[0], m[1]); mp.y = pk2(m[2], m[3]); mp.z = pk2(m[4], m[5]); mp.w = pk2(m[6], m[7]);
            const bf16x8 mf = __builtin_bit_cast(bf16x8, mp);
#pragma unroll
            for (int pt = 0; pt < 2; ++pt) { const bf16x8 a = *(const LAS bf16x8*)(XT + (hh * 64 + pt * 32 + r) * SPT + s0); acc[pt][j] = MFMA32(a, mf, acc[pt][j]); }
        } }
#pragma unroll
    for (int j = 0; j < 2; ++j) { const int lt = j == 0 ? (lsel ? 1 : 0) : (lsel ? 2 : 3); const size_t t = trow0 + lt * 32 + r; float ss = 0.f;
#pragma unroll
        for (int pt = 0; pt < 2; ++pt)
#pragma unroll
            for (int pp = 0; pp < 2; ++pp) {
                const v4u z16 = *(const v4u*)(proj + t * PROJ_LD + COL_Z + h * 64 + pt * 32 + 16 * pp + 8 * hf);
                const v2u s0 = __builtin_amdgcn_permlane32_swap(z16.x, z16.z, false, false), s1 = __builtin_amdgcn_permlane32_swap(z16.y, z16.w, false, false);
#pragma unroll
                for (int qq = 0; qq < 2; ++qq) { const int q = 2 * pp + qq; const unsigned zx = qq == 0 ? s0.x : s0.y, zy = qq == 0 ? s1.x : s1.y;
                    const float z0 = bflo(zx), z1 = bfhi(zx), z2 = bflo(zy), z3 = bfhi(zy);
                    const float g0 = acc[pt][j][4 * q] * (z0 * fsigmoid(z0)), g1 = acc[pt][j][4 * q + 1] * (z1 * fsigmoid(z1)), g2 = acc[pt][j][4 * q + 2] * (z2 * fsigmoid(z2)), g3 = acc[pt][j][4 * q + 3] * (z3 * fsigmoid(z3));
                    yp[pt][j][2 * q] = pk2(g0, g1); yp[pt][j][2 * q + 1] = pk2(g2, g3);
                    ss += (g0 * g0 + g1 * g1) + (g2 * g2 + g3 * g3); } }
        ss += __shfl_xor(ss, 32);
        if (hf == 0) ssqh[lt * 32 + r] = ss; }
}
__device__ __forceinline__ void ssd_out_store(const Params& p, bf16* mix, const LAS float* ssqp, size_t trow0, int h, int lsel, int r, int hf, const unsigned (&yp)[2][2][8]) {
    f32x4 w4[2][4];
#pragma unroll
    for (int pt = 0; pt < 2; ++pt)
#pragma unroll
        for (int q = 0; q < 4; ++q) w4[pt][q] = *(const f32x4*)(p.ssm_norm_w + h * 64 + pt * 32 + 8 * q + 4 * hf);
#pragma unroll
    for (int pt = 0; pt < 2; ++pt) { asm volatile("" : "+v"(w4[pt][0]), "+v"(w4[pt][1]), "+v"(w4[pt][2]), "+v"(w4[pt][3])); }
#pragma unroll
    for (int j = 0; j < 2; ++j) { const int lt = j == 0 ? (lsel ? 1 : 0) : (lsel ? 2 : 3); const int l = lt * 32 + r; const size_t t = trow0 + l;
        float tot = 0.f;
#pragma unroll
        for (int hd = 0; hd < 8; ++hd) tot += ssqp[hd * 128 + l];
        const float rstd = rsqrtf(tot * (1.f / 512.f) + EPS);
#pragma unroll
#if OUTPROJ_F8
        for (int pt = 0; pt < 2; ++pt) { unsigned dq[4]; const float rs = rstd * FP8_SA;
#pragma unroll
            for (int q = 0; q < 4; ++q) { const unsigned u0 = yp[pt][j][2 * q], u1 = yp[pt][j][2 * q + 1];
                dq[q] = pk4_fp8(sat8(bflo(u0) * rs * w4[pt][q][0]), sat8(bfhi(u0) * rs * w4[pt][q][1]), sat8(bflo(u1) * rs * w4[pt][q][2]), sat8(bfhi(u1) * rs * w4[pt][q][3])); }
            const v2u r0 = __builtin_amdgcn_permlane32_swap(dq[0], dq[2], false, false), r1 = __builtin_amdgcn_permlane32_swap(dq[1], dq[3], false, false);
            *(v4u*)((unsigned char*)mix + t * 2048 + 1024 + h * 64 + pt * 32 + 16 * hf) = (v4u){r0.x, r0.y, r1.x, r1.y}; }
#else
        for (int pt = 0; pt < 2; ++pt)
#pragma unroll
            for (int pp = 0; pp < 2; ++pp) { unsigned oa[2], ob[2];
#pragma unroll
                for (int qq = 0; qq < 2; ++qq) { const int q = 2 * pp + qq; const unsigned u0 = yp[pt][j][2 * q], u1 = yp[pt][j][2 * q + 1];
                    const unsigned x0 = pk2(bflo(u0) * rstd * w4[pt][q][0], bfhi(u0) * rstd * w4[pt][q][1]), x1 = pk2(bflo(u1) * rstd * w4[pt][q][2], bfhi(u1) * rstd * w4[pt][q][3]);
                    if (qq == 0) { oa[0] = x0; oa[1] = x1; } else { ob[0] = x0; ob[1] = x1; } }
                const v2u r0 = __builtin_amdgcn_permlane32_swap(oa[0], ob[0], false, false), r1 = __builtin_amdgcn_permlane32_swap(oa[1], ob[1], false, false);
                *(v4u*)(mix + t * D + 1024 + h * 64 + pt * 32 + 16 * pp + 8 * hf) = (v4u){r0.x, r1.x, r0.y, r1.y}; }
#endif
    }
}
__device__ __forceinline__ void phase_ssd_out(const Params& p, LAS unsigned char* lds, int G, int lane, int wave) {
    const bf16* proj = (const bf16*)(p.ws + WS_PROJ); const bf16* sin = (const bf16*)(p.ws + WS_SIN); bf16* mix = (bf16*)(p.ws + WS_MIX);
    LAS bf16* Cs = (LAS bf16*)lds;
    LAS bf16* Bs = Cs + 128 * SPT;
    LAS bf16* XT = Bs + 128 * SPT;
    LAS float* dtl = (LAS float*)(lds + 512 * SPT * 2);
    LAS float* csl = dtl + 1024; LAS float* ssqp = csl + 1024; LAS float* wtot = ssqp + 1024;
    const int tid = threadIdx.x, r = lane & 31, hf = lane >> 5;
    for (int item = blockIdx.x; item < NB * 64 * 2; item += G) {
        const int b = item >> 7, c = (item >> 1) & 63, g = item & 1;
        const int h0 = g * 8; const size_t trow0 = (size_t)b * SEQ + c * 128; const int tl0 = c * 128;
        __syncthreads();
        { int tz_ = threadIdx.x; asm volatile("" : "+v"(tz_)); ssd_tables(p, dtl, csl, wtot, trow0, h0, 8, tz_ & 63, __builtin_amdgcn_readfirstlane(tz_ >> 6)); }
        int tq = threadIdx.x; asm volatile("" : "+v"(tq));
        for (int task = tq; task < 64 * 16; task += NTHREADS) { const int cg = task >> 4, run = task & 15;
            if (cg < 16) conv_task<false, false>(p, proj, trow0, tl0, run, 1280 + g * 128 + cg * 8, Cs, cg * 8, nullptr);
            else if (cg < 32) conv_task<false, false>(p, proj, trow0, tl0, run, 1024 + g * 128 + (cg - 16) * 8, Bs, (cg - 16) * 8, nullptr);
            else conv_task<true, false>(p, proj, trow0, tl0, run, h0 * 64 + (cg - 32) * 8, XT, (cg - 32) * 8, nullptr); }
        __syncthreads();
        {
            int tz_ = threadIdx.x; asm volatile("" : "+v"(tz_)); const int wave = __builtin_amdgcn_readfirstlane(tz_ >> 6), r = tz_ & 31, hf = (tz_ >> 5) & 1;
            f32x16 cb[2];
#pragma unroll
            for (int q = 0; q < 2; ++q) { const int tile = 2 * wave + q, lt = tile >> 2, st = tile & 3;
#pragma unroll
                for (int e = 0; e < 16; ++e) cb[q][e] = 0.f;
                if (st <= lt) {
#pragma unroll
                    for (int ks = 0; ks < 8; ++ks) { const bf16x8 a = *(const LAS bf16x8*)(Cs + (lt * 32 + r) * SPT + ks * 16 + 8 * hf), bq = *(const LAS bf16x8*)(Bs + (st * 32 + r) * SPT + ks * 16 + 8 * hf);
                        cb[q] = MFMA32(a, bq, cb[q]); } } }
            __syncthreads();
#pragma unroll
            for (int q = 0; q < 2; ++q) { const int tile = 2 * wave + q, lt = tile >> 2, st = tile & 3;
                if (st <= lt) {
#pragma unroll
                    for (int e = 0; e < 16; ++e) Bs[(lt * 32 + (e & 3) + 8 * (e >> 2) + 4 * hf) * SPT + st * 32 + r] = (bf16)f2bf(cb[q][e]); } }
        }
        __syncthreads();
        unsigned y0[2][2][8], y1[2][2][8];
#define FRESH_IDS() int tz_ = threadIdx.x; asm volatile("" : "+v"(tz_)); const int wv_ = __builtin_amdgcn_readfirstlane(tz_ >> 6), hh = wv_ >> 1, lsel = wv_ & 1, r_ = tz_ & 31, hf_ = (tz_ >> 5) & 1
        { FRESH_IDS(); const int h = h0 + hh;
          ssd_out_pass(p, proj, sin + (((size_t)b * 64 + c) * 16 + h) * 64 * 128, Cs, Bs, XT, dtl + hh * 128, csl + hh * 128, ssqp + hh * 128, p.d_skip[h], trow0, h, hh, lsel, r_, hf_, y0); }
        __syncthreads();
        { int tz_ = threadIdx.x; asm volatile("" : "+v"(tz_)); const int cg = tz_ >> 4, run = tz_ & 15; conv_task<true, false>(p, proj, trow0, tl0, run, (h0 + 4) * 64 + cg * 8, XT, cg * 8, nullptr); }
        __syncthreads();
        { FRESH_IDS(); const int h = h0 + 4 + hh;
          ssd_out_pass(p, proj, sin + (((size_t)b * 64 + c) * 16 + h) * 64 * 128, Cs, Bs, XT, dtl + (4 + hh) * 128, csl + (4 + hh) * 128, ssqp + (4 + hh) * 128, p.d_skip[h], trow0, h, hh, lsel, r_, hf_, y1); }
        __syncthreads();
        { FRESH_IDS(); ssd_out_store(p, mix, ssqp, trow0, h0 + hh, lsel, r_, hf_, y0); }
        { FRESH_IDS(); ssd_out_store(p, mix, ssqp, trow0, h0 + 4 + hh, lsel, r_, hf_, y1); }
#undef FRESH_IDS
    }
}


__device__ __forceinline__ void phase_attn(const Params& p, LAS unsigned char* lds, int G) {
    const bf16* proj = (const bf16*)(p.ws + WS_PROJ); bf16* mix = (bf16*)(p.ws + WS_MIX);
    bf16* att = OUTPROJ_F8 ? (bf16*)(p.ws + WS_ATT) : mix; constexpr size_t ALD = OUTPROJ_F8 ? 1024 : D;
    constexpr int KP = 72, VP = 260; constexpr float NEG = -1.0e30f;
    LAS bf16* Ks = (LAS bf16*)lds;
    LAS bf16* VT = Ks + 2 * 256 * KP;
    LAS float* ssqp = (LAS float*)(lds + 2 * 256 * KP * 2 + 2 * 64 * VP * 2);
    for (int item = blockIdx.x; item < NB * 64; item += G) {
        const int b = item >> 6, n = item & 63;
        __syncthreads();
        {
            int tz = threadIdx.x; asm volatile("" : "+v"(tz));
            const int j = tz >> 1, hk = tz & 1, pos = n * 128 - 128 + j;
            LAS bf16* kd = Ks + (hk * 256 + j) * KP; LAS bf16* vd = VT + hk * 64 * VP + j;
            if (pos >= 0) {
                const bf16* kp = proj + (size_t)(b * SEQ + pos) * PROJ_LD + COL_K + hk * 64;
                v4u kq[8]; float ss = 0.f;
#pragma unroll
                for (int c = 0; c < 8; ++c) { kq[c] = *(const v4u*)(kp + 8 * c); float f[8]; unpack8(kq[c], f);
#pragma unroll
                    for (int e = 0; e < 8; ++e) ss += f[e] * f[e]; }
                const float rstd = rsqrtf(ss * (1.f / 64.f) + EPS);
#pragma unroll
                for (int c = 0; c < 8; ++c) { float f[8]; unpack8(kq[c], f); const f32x4 w0 = *(const f32x4*)(p.k_norm_w + 8 * c), w1 = *(const f32x4*)(p.k_norm_w + 8 * c + 4);
                    *(LAS v4u*)(kd + 8 * c) = (v4u){pk2(f[0] * rstd * w0[0], f[1] * rstd * w0[1]), pk2(f[2] * rstd * w0[2], f[3] * rstd * w0[3]), pk2(f[4] * rstd * w1[0], f[5] * rstd * w1[1]), pk2(f[6] * rstd * w1[2], f[7] * rstd * w1[3])}; }
                const bf16* vp = kp + (COL_V - COL_K);
#pragma unroll
                for (int c = 0; c < 8; ++c) { const v4u q = *(const v4u*)(vp + 8 * c);
                    vd[(8 * c + 0) * VP] = (bf16)(q.x & 0xffffu); vd[(8 * c + 1) * VP] = (bf16)(q.x >> 16); vd[(8 * c + 2) * VP] = (bf16)(q.y & 0xffffu); vd[(8 * c + 3) * VP] = (bf16)(q.y >> 16);
                    vd[(8 * c + 4) * VP] = (bf16)(q.z & 0xffffu); vd[(8 * c + 5) * VP] = (bf16)(q.z >> 16); vd[(8 * c + 6) * VP] = (bf16)(q.w & 0xffffu); vd[(8 * c + 7) * VP] = (bf16)(q.w >> 16); }
            } else {
#pragma unroll
                for (int c = 0; c < 8; ++c) *(LAS v4u*)(kd + 8 * c) = (v4u){0u, 0u, 0u, 0u};
#pragma unroll
                for (int d = 0; d < 64; ++d) vd[d * VP] = (bf16)0;
            }
        }
        __syncthreads();
        {
            int tz = threadIdx.x; asm volatile("" : "+v"(tz));
            const int wave = __builtin_amdgcn_readfirstlane(tz >> 6), r = tz & 31, hf = (tz >> 5) & 1, hk = wave >> 2, wl = wave & 3;
            const LAS bf16* Kh = Ks + hk * 256 * KP; const LAS bf16* Vh = VT + hk * 64 * VP;
            f32x4 qw[4][2];
#pragma unroll
            for (int ks = 0; ks < 4; ++ks) { qw[ks][0] = *(const f32x4*)(p.q_norm_w + 16 * ks + 8 * hf); qw[ks][1] = *(const f32x4*)(p.q_norm_w + 16 * ks + 8 * hf + 4); }
            v4u qn[4];
            { const bf16* qp0 = proj + ((size_t)b * SEQ + n * 128 + r) * PROJ_LD + COL_Q + (hk * 8 + wl * 2) * 64 + 8 * hf;
#pragma unroll
              for (int ks = 0; ks < 4; ++ks) qn[ks] = *(const v4u*)(qp0 + 16 * ks); }
            for (int it = 0; it < 8; ++it) {
                const int hsel = it >> 2, qt = it & 3;
                const int hq = hk * 8 + wl * 2 + hsel; const float sink = p.sinks[hq] * 1.44269504f;
                {
                    const size_t tok = (size_t)b * SEQ + n * 128 + qt * 32 + r;
                    bf16x8 qf[4];
                    {
                        v4u qv[4]; float ss = 0.f;
#pragma unroll
                        for (int ks = 0; ks < 4; ++ks) { qv[ks] = qn[ks]; float f[8]; unpack8(qv[ks], f);
#pragma unroll
                            for (int e = 0; e < 8; ++e) ss += f[e] * f[e]; }
                        if (it < 7) { const int it2 = it + 1, hq2 = hk * 8 + wl * 2 + (it2 >> 2);
                            const bf16* qp2 = proj + ((size_t)b * SEQ + n * 128 + (it2 & 3) * 32 + r) * PROJ_LD + COL_Q + hq2 * 64 + 8 * hf;
#pragma unroll
                            for (int ks = 0; ks < 4; ++ks) qn[ks] = *(const v4u*)(qp2 + 16 * ks); }
                        ss += __shfl_xor(ss, 32);
                        const float rstd = rsqrtf(ss * (1.f / 64.f) + EPS) * (0.125f * 1.44269504f);
#pragma unroll
                        for (int ks = 0; ks < 4; ++ks) { float f[8]; unpack8(qv[ks], f); const f32x4 w0 = qw[ks][0], w1 = qw[ks][1];
                            const v4u o = (v4u){pk2(f[0] * rstd * w0[0], f[1] * rstd * w0[1]), pk2(f[2] * rstd * w0[2], f[3] * rstd * w0[3]), pk2(f[4] * rstd * w1[0], f[5] * rstd * w1[1]), pk2(f[6] * rstd * w1[2], f[7] * rstd * w1[3])};
                            qf[ks] = __builtin_bit_cast(bf16x8, o); }
                    }
                    f32x16 sc[5];
#pragma unroll
                    for (int jt = 0; jt < 5; ++jt) {
#pragma unroll
                        for (int e = 0; e < 16; ++e) sc[jt][e] = 0.f;
#pragma unroll
                        for (int ks = 0; ks < 4; ++ks) { const bf16x8 a = *(const LAS bf16x8*)(Kh + ((qt + jt) * 32 + r) * KP + ks * 16 + 8 * hf); sc[jt] = MFMA32(a, qf[ks], sc[jt]); } }
#pragma unroll
                    for (int e = 0; e < 16; ++e) { const int kk = (e & 3) + 8 * (e >> 2) + 4 * hf;
                        sc[0][e] = (kk > r) ? sc[0][e] : NEG; sc[4][e] = (kk <= r) ? sc[4][e] : NEG; }
                    if (n == 0) {
#pragma unroll
                        for (int jt = 0; jt < 4; ++jt) if (qt + jt < 4) {
#pragma unroll
                            for (int e = 0; e < 16; ++e) sc[jt][e] = NEG; } }
                    float m = sink;
#pragma unroll
                    for (int jt = 0; jt < 5; ++jt)
#pragma unroll
                        for (int e = 0; e < 16; ++e) m = fmaxf(m, sc[jt][e]);
                    m = fmaxf(m, __shfl_xor(m, 32));
                    float l = 0.f;
#pragma unroll
                    for (int jt = 0; jt < 5; ++jt)
#pragma unroll
                        for (int e = 0; e < 16; ++e) { const float pv = __builtin_amdgcn_exp2f(sc[jt][e] - m); sc[jt][e] = pv; l += pv; }
                    l += __shfl_xor(l, 32); l += __builtin_amdgcn_exp2f(sink - m);
                    f32x16 o[2];
#pragma unroll
                    for (int dt = 0; dt < 2; ++dt)
#pragma unroll
                        for (int e = 0; e < 16; ++e) o[dt][e] = 0.f;
#pragma unroll
                    for (int jt = 0; jt < 5; ++jt)
#pragma unroll
                        for (int s2 = 0; s2 < 2; ++s2) {
                            const v4u pp = (v4u){pk2(sc[jt][8 * s2], sc[jt][8 * s2 + 1]), pk2(sc[jt][8 * s2 + 2], sc[jt][8 * s2 + 3]), pk2(sc[jt][8 * s2 + 4], sc[jt][8 * s2 + 5]), pk2(sc[jt][8 * s2 + 6], sc[jt][8 * s2 + 7])};
                            const bf16x8 pf = __builtin_bit_cast(bf16x8, pp);
                            const int kb = (qt + jt) * 32 + 16 * s2 + 4 * hf;
#pragma unroll
                            for (int dt = 0; dt < 2; ++dt) { const LAS bf16* vr = Vh + (dt * 32 + r) * VP + kb;
                                const v2u a0 = *(const LAS v2u*)vr, a1 = *(const LAS v2u*)(vr + 8);
                                const v4u av = (v4u){a0.x, a0.y, a1.x, a1.y};
                                o[dt] = MFMA32(__builtin_bit_cast(bf16x8, av), pf, o[dt]); }
                        }
                    const float inv = 1.0f / l; float ss = 0.f;
#pragma unroll
                    for (int dt = 0; dt < 2; ++dt)
#pragma unroll
                        for (int pp = 0; pp < 2; ++pp) {
                            unsigned pa[2], pb[2];
#pragma unroll
                            for (int qq = 0; qq < 2; ++qq) { const int q = 2 * pp + qq; const float g0 = o[dt][4 * q] * inv, g1 = o[dt][4 * q + 1] * inv, g2 = o[dt][4 * q + 2] * inv, g3 = o[dt][4 * q + 3] * inv;
                                ss += (g0 * g0 + g1 * g1) + (g2 * g2 + g3 * g3);
                                if (qq == 0) { pa[0] = pk2(g0, g1); pa[1] = pk2(g2, g3); } else { pb[0] = pk2(g0, g1); pb[1] = pk2(g2, g3); } }
                            const v2u r0 = __builtin_amdgcn_permlane32_swap(pa[0], pb[0], false, false), r1 = __builtin_amdgcn_permlane32_swap(pa[1], pb[1], false, false);
                            *(v4u*)(att + tok * ALD + hq * 64 + dt * 32 + 16 * pp + 8 * hf) = (v4u){r0.x, r1.x, r0.y, r1.y}; }
                    ss += __shfl_xor(ss, 32);
                    if (hf == 0) ssqp[hq * 128 + qt * 32 + r] = ss;
                }
            }
        }
        __syncthreads();
        {
            int tz = threadIdx.x; asm volatile("" : "+v"(tz));
            const int wave = __builtin_amdgcn_readfirstlane(tz >> 6), r = tz & 31, hf = (tz >> 5) & 1, hk = wave >> 2, wl = wave & 3;
            for (int qt = 0; qt < 4; ++qt) {
                const size_t tok = (size_t)b * SEQ + n * 128 + qt * 32 + r;
                float tot = 0.f;
#pragma unroll
                for (int hd = 0; hd < 16; ++hd) tot += ssqp[hd * 128 + qt * 32 + r];
                const float rstd = rsqrtf(tot * (1.f / 1024.f) + EPS);
                v4u uu[2][2][2];
#pragma unroll
                for (int hsel = 0; hsel < 2; ++hsel)
#pragma unroll
                    for (int dt = 0; dt < 2; ++dt)
#pragma unroll
                        for (int pp = 0; pp < 2; ++pp) uu[hsel][dt][pp] = *(const v4u*)(att + tok * ALD + (hk * 8 + wl * 2 + hsel) * 64 + dt * 32 + 16 * pp + 8 * hf);
#pragma unroll
                for (int hsel = 0; hsel < 2; ++hsel)
#pragma unroll
                    for (int dt = 0; dt < 2; ++dt) { asm volatile("" : "+v"(uu[hsel][dt][0]), "+v"(uu[hsel][dt][1])); }
#if OUTPROJ_F8
#pragma unroll
                for (int hsel = 0; hsel < 2; ++hsel)
#pragma unroll
                    for (int dt = 0; dt < 2; ++dt) { unsigned fa[2], fb[2]; const float rs = rstd * FP8_SA;
#pragma unroll
                        for (int pp = 0; pp < 2; ++pp) { const int col = (hk * 8 + wl * 2 + hsel) * 64 + dt * 32 + 16 * pp + 8 * hf;
                            const v4u u = uu[hsel][dt][pp]; const f32x4 w0 = *(const f32x4*)(p.attn_out_norm_w + col), w1 = *(const f32x4*)(p.attn_out_norm_w + col + 4);
                            const unsigned d0 = pk4_fp8(sat8(bflo(u.x) * rs * w0[0]), sat8(bfhi(u.x) * rs * w0[1]), sat8(bflo(u.y) * rs * w0[2]), sat8(bfhi(u.y) * rs * w0[3]));
                            const unsigned d1 = pk4_fp8(sat8(bflo(u.z) * rs * w1[0]), sat8(bfhi(u.z) * rs * w1[1]), sat8(bflo(u.w) * rs * w1[2]), sat8(bfhi(u.w) * rs * w1[3]));
                            if (pp == 0) { fa[0] = d0; fa[1] = d1; } else { fb[0] = d0; fb[1] = d1; } }
                        const v2u r0 = __builtin_amdgcn_permlane32_swap(fa[0], fb[0], false, false), r1 = __builtin_amdgcn_permlane32_swap(fa[1], fb[1], false, false);
                        *(v4u*)((unsigned char*)mix + tok * 2048 + (hk * 8 + wl * 2 + hsel) * 64 + dt * 32 + 16 * hf) = (v4u){r0.x, r1.x, r0.y, r1.y}; }
#else
#pragma unroll
                for (int hsel = 0; hsel < 2; ++hsel)
#pragma unroll
                    for (int dt = 0; dt < 2; ++dt)
#pragma unroll
                        for (int pp = 0; pp < 2; ++pp) { const int col = (hk * 8 + wl * 2 + hsel) * 64 + dt * 32 + 16 * pp + 8 * hf;
                            const v4u u = uu[hsel][dt][pp]; const f32x4 w0 = *(const f32x4*)(p.attn_out_norm_w + col), w1 = *(const f32x4*)(p.attn_out_norm_w + col + 4);
                            *(v4u*)(mix + tok * D + col) = (v4u){pk2(bflo(u.x) * rstd * w0[0], bfhi(u.x) * rstd * w0[1]), pk2(bflo(u.y) * rstd * w0[2], bfhi(u.y) * rstd * w0[3]),
                                                                 pk2(bflo(u.z) * rstd * w1[0], bfhi(u.z) * rstd * w1[1]), pk2(bflo(u.w) * rstd * w1[2], bfhi(u.w) * rstd * w1[3])}; }
#endif
            }
        }
    }
}

__device__ __forceinline__ void phase_router(const Params& p, LAS unsigned char* lds, unsigned* ctl, int G, int wave, int lane) {
    const bf16* x1 = (const bf16*)(p.ws + WS_X1); const float* ssq = (const float*)(p.ws + WS_SSQ); unsigned char* hf = p.ws + WS_HF;
    int* stok = (int*)(p.ws + WS_STOK); float* sgate = (float*)(p.ws + WS_SGATE); int* toke = (int*)(p.ws + WS_TOKE); int* tokp = (int*)(p.ws + WS_TOKP);
    LAS float* lg = (LAS float*)lds + wave * (16 * 33);
    LAS int* hist = (LAS int*)(lds + 32768); LAS int* gbase = hist + 32;
    const int tid = threadIdx.x, i16 = lane & 15, kq = lane >> 4;
    for (int tb = blockIdx.x * 8; tb < T / 16; tb += G * 8) {
        if (tid < 32) hist[tid] = 0;
        __syncthreads();
        const int tok = (tb + wave) * 16 + i16;
        float s = 0.f;
        { const f32x4* sp = (const f32x4*)(ssq + (size_t)tok * 32 + kq * 8); const f32x4 a = sp[0], b = sp[1]; s = ((a[0] + a[1]) + (a[2] + a[3])) + ((b[0] + b[1]) + (b[2] + b[3])); }
        s += __shfl_xor(s, 16); s += __shfl_xor(s, 32);
        const float rstd = rsqrtf(s * (1.f / D) + EPS);
        f32x4 acc0 = (f32x4){0.f, 0.f, 0.f, 0.f}, acc1 = (f32x4){0.f, 0.f, 0.f, 0.f};
        const bf16* xr = x1 + (size_t)tok * D + 8 * kq;
        unsigned char* hr = hf + (size_t)tok * D + 8 * kq;
        const v4u* wb = (const v4u*)(p.ws + WS_WRB) + lane;
        v4u xq[4];
#pragma unroll
        for (int u = 0; u < 4; ++u) xq[u] = *(const v4u*)(xr + 32 * u);
        unsigned hlo = 0, hhi = 0;
        for (int j4 = 0; j4 < 64; j4 += 4) {
            f32x4 xc[4][2], gq[4][2]; v4u wf[4][2][2];
#pragma unroll
            for (int u = 0; u < 4; ++u) { float f[8]; unpack8(xq[u], f); xc[u][0] = (f32x4){f[0], f[1], f[2], f[3]}; xc[u][1] = (f32x4){f[4], f[5], f[6], f[7]}; }
            if (j4 + 4 < 64) {
#pragma unroll
                for (int u = 0; u < 4; ++u) xq[u] = *(const v4u*)(xr + 32 * (j4 + 4 + u)); }
#pragma unroll
            for (int u = 0; u < 4; ++u) { gq[u][0] = *(const f32x4*)(p.ffn_norm_w + 32 * (j4 + u) + 8 * kq); gq[u][1] = *(const f32x4*)(p.ffn_norm_w + 32 * (j4 + u) + 8 * kq + 4);
#pragma unroll
                for (int hfl = 0; hfl < 2; ++hfl)
#pragma unroll
                    for (int hl = 0; hl < 2; ++hl) wf[u][hfl][hl] = wb[(((j4 + u) * 2 + hfl) * 2 + hl) * 64]; }
#pragma unroll
            for (int u = 0; u < 4; ++u) {
                float hv[8];
#pragma unroll
                for (int k = 0; k < 4; ++k) { hv[k] = xc[u][0][k] * rstd * gq[u][0][k]; hv[4 + k] = xc[u][1][k] * rstd * gq[u][1][k]; }
                { const unsigned flo = pk4_fp8(sat8(hv[0] * FP8_SA), sat8(hv[1] * FP8_SA), sat8(hv[2] * FP8_SA), sat8(hv[3] * FP8_SA)), fhi = pk4_fp8(sat8(hv[4] * FP8_SA), sat8(hv[5] * FP8_SA), sat8(hv[6] * FP8_SA), sat8(hv[7] * FP8_SA));
                  if ((u & 1) == 0) { hlo = flo; hhi = fhi; }
                  else { const v2u r0 = __builtin_amdgcn_permlane16_swap(hlo, flo, false, false), r1 = __builtin_amdgcn_permlane16_swap(hhi, fhi, false, false);
                         *(v4u*)(hf + (size_t)tok * D + 32 * (j4 + u - 1 + (kq & 1)) + 16 * (kq >> 1)) = (v4u){r0.x, r1.x, r0.y, r1.y}; } }
                v4u ah, al;
                ah.x = pk2(hv[0], hv[1]); ah.y = pk2(hv[2], hv[3]); ah.z = pk2(hv[4], hv[5]); ah.w = pk2(hv[6], hv[7]);
                al.x = pk2(hv[0] - bflo(ah.x), hv[1] - bfhi(ah.x)); al.y = pk2(hv[2] - bflo(ah.y), hv[3] - bfhi(ah.y)); al.z = pk2(hv[4] - bflo(ah.z), hv[5] - bfhi(ah.z)); al.w = pk2(hv[6] - bflo(ah.w), hv[7] - bfhi(ah.w));
                const bf16x8 fah = __builtin_bit_cast(bf16x8, ah), fal = __builtin_bit_cast(bf16x8, al);
                acc0 = __builtin_amdgcn_mfma_f32_16x16x32_bf16(fah, __builtin_bit_cast(bf16x8, wf[u][0][0]), acc0, 0, 0, 0);
                acc0 = __builtin_amdgcn_mfma_f32_16x16x32_bf16(fah, __builtin_bit_cast(bf16x8, wf[u][0][1]), acc0, 0, 0, 0);
                acc0 = __builtin_amdgcn_mfma_f32_16x16x32_bf16(fal, __builtin_bit_cast(bf16x8, wf[u][0][0]), acc0, 0, 0, 0);
                acc1 = __builtin_amdgcn_mfma_f32_16x16x32_bf16(fah, __builtin_bit_cast(bf16x8, wf[u][1][0]), acc1, 0, 0, 0);
                acc1 = __builtin_amdgcn_mfma_f32_16x16x32_bf16(fah, __builtin_bit_cast(bf16x8, wf[u][1][1]), acc1, 0, 0, 0);
                acc1 = __builtin_amdgcn_mfma_f32_16x16x32_bf16(fal, __builtin_bit_cast(bf16x8, wf[u][1][0]), acc1, 0, 0, 0);
            }
        }
        { const float bb0 = p.b_router[i16], bb1 = p.b_router[16 + i16];
#pragma unroll
          for (int r = 0; r < 4; ++r) { lg[(4 * kq + r) * 33 + i16] = acc0[r] + bb0; lg[(4 * kq + r) * 33 + 16 + i16] = acc1[r] + bb1; } }
        LDS_WAIT(); asm volatile("" ::: "memory");
        int se[4]; float sv[4], gt[4]; int rk[4];
        if (lane < 16) {
            float v[32];
#pragma unroll
            for (int e = 0; e < 32; ++e) v[e] = lg[lane * 33 + e];
#pragma unroll
            for (int k = 0; k < 4; ++k) { float best = -3.0e38f; int bi = 0;
#pragma unroll
                for (int e = 0; e < 32; ++e) { const bool tk = v[e] > best; best = tk ? v[e] : best; bi = tk ? e : bi; }
                se[k] = bi; sv[k] = best;
#pragma unroll
                for (int e = 0; e < 32; ++e) v[e] = (e == bi) ? -3.0e38f : v[e]; }
            const float e1 = __expf(sv[1] - sv[0]), e2 = __expf(sv[2] - sv[0]), e3 = __expf(sv[3] - sv[0]);
            const float inv = 1.0f / (1.0f + e1 + e2 + e3);
            gt[0] = inv; gt[1] = e1 * inv; gt[2] = e2 * inv; gt[3] = e3 * inv;
#pragma unroll
            for (int k = 0; k < 4; ++k) rk[k] = __hip_atomic_fetch_add(&hist[se[k]], 1, __ATOMIC_RELAXED, __HIP_MEMORY_SCOPE_WORKGROUP);
        }
        __syncthreads();
        if (tid < 32) gbase[tid] = (int)__hip_atomic_fetch_add(ctl + CW_CNT + 64 * tid, (unsigned)hist[tid], __ATOMIC_RELAXED, __HIP_MEMORY_SCOPE_AGENT);
        __syncthreads();
        if (lane < 16) {
            const int tk = (tb + wave) * 16 + lane;
#pragma unroll
            for (int k = 0; k < 4; ++k) { const int pos = gbase[se[k]] + rk[k];
                stok[(size_t)se[k] * T + pos] = tk; sgate[(size_t)se[k] * T + pos] = gt[k]; toke[tk * 4 + k] = se[k]; tokp[tk * 4 + k] = pos; }
        }
        __syncthreads();
    }
}

__device__ __forceinline__ void moe_table(unsigned* ctl, LAS int* tstart, LAS int* lcnt) {
    __syncthreads();
    if (threadIdx.x < 32) lcnt[threadIdx.x] = (int)__hip_atomic_load(ctl + CW_CNT + 64 * threadIdx.x, __ATOMIC_RELAXED, __HIP_MEMORY_SCOPE_AGENT);
    __syncthreads();
    if (threadIdx.x == 0) { int a = 0; for (int e = 0; e < NE; ++e) { tstart[e] = a; a += (lcnt[e] + 255) >> 8; } tstart[NE] = a; }
    __syncthreads();
}

__device__ __forceinline__ void phase_combine(const Params& p, const LAS int* tstart, int gw, int NGW, int lane) {
    const unsigned char* y2 = p.ws + WS_Y2; const int* toke = (const int*)(p.ws + WS_TOKE); const int* tokp = (const int*)(p.ws + WS_TOKP);
    constexpr float DY = 1.0f / FP8_SY;
    typedef int i32x4v __attribute__((ext_vector_type(4)));
    i32x4v ne = (i32x4v){0, 0, 0, 0}, np = ne;
    if (gw < T) { ne = *(const i32x4v*)(toke + gw * 4); np = *(const i32x4v*)(tokp + gw * 4); }
    for (int m = gw; m < T; m += NGW) {
        const i32x4v ce = ne, cp = np;
        if (m + NGW < T) { ne = *(const i32x4v*)(toke + (m + NGW) * 4); np = *(const i32x4v*)(tokp + (m + NGW) * 4); }
        const unsigned char* yr[4];
#pragma unroll
        for (int k = 0; k < 4; ++k) yr[k] = y2 + ((size_t)tstart[ce[k]] * 256 + cp[k]) * D;
        float* op = p.out + (size_t)m * D; const bf16* xp = (const bf16*)(p.ws + WS_X1) + (size_t)m * D;
#pragma unroll
        for (int j = 0; j < 2; ++j) { const int c = (j * 64 + lane) * 16;
            v4u w[4];
#pragma unroll
            for (int k = 0; k < 4; ++k) w[k] = *(const v4u*)(yr[k] + c);
            f32x4 a[4];
            { const v4u xa = *(const v4u*)(xp + c), xb = *(const v4u*)(xp + c + 8); float fa[8], fb[8]; unpack8(xa, fa); unpack8(xb, fb);
              a[0] = (f32x4){fa[0], fa[1], fa[2], fa[3]}; a[1] = (f32x4){fa[4], fa[5], fa[6], fa[7]}; a[2] = (f32x4){fb[0], fb[1], fb[2], fb[3]}; a[3] = (f32x4){fb[4], fb[5], fb[6], fb[7]}; }
#pragma unroll
            for (int q = 0; q < 4; ++q) { float s0 = 0.f, s1 = 0.f, s2 = 0.f, s3 = 0.f;
#pragma unroll
                for (int k = 0; k < 4; ++k) { const int wd = (int)(q == 0 ? w[k].x : q == 1 ? w[k].y : q == 2 ? w[k].z : w[k].w);
                    const f32x2 lo = __builtin_amdgcn_cvt_pk_f32_fp8(wd, false), hi = __builtin_amdgcn_cvt_pk_f32_fp8(wd, true);
                    s0 += lo.x; s1 += lo.y; s2 += hi.x; s3 += hi.y; }
                a[q][0] += s0 * DY; a[q][1] += s1 * DY; a[q][2] += s2 * DY; a[q][3] += s3 * DY;
                *(f32x4*)(op + c + 4 * q) = a[q]; }
        }
    }
}

constexpr int N_PHASES = 10;
__global__ void __launch_bounds__(NTHREADS, 2) hymba_fwd(Params p) {
    extern __shared__ __attribute__((aligned(16))) unsigned char lds_raw[];
    LAS unsigned char* lds = (LAS unsigned char*)lds_raw;
    volatile LAS unsigned* MISC = (volatile LAS unsigned*)(lds + MISC_OFF);
    LAS int* tstart = (LAS int*)(lds + MISC_OFF + 256);
    LAS int* lcnt = (LAS int*)(lds + MISC_OFF + 512);
    const int tid = threadIdx.x, lane = tid & 63, wave = __builtin_amdgcn_readfirstlane(tid >> 6);
    const int G = gridDim.x;
    const int vcu = (G % 8 == 0) ? (blockIdx.x % 8) * (G / 8) + blockIdx.x / 8 : blockIdx.x;
    const int gw = vcu * NWAVES + wave, NGW = G * NWAVES;
    unsigned* ctl = (unsigned*)(p.ws + WS_CTL);
    if (tid < 64) MISC[tid] = 0u;
    __syncthreads();
    const int lo = p.ph_lo, hi = p.ph_hi;
    XcdBarrier bar; bar.bar = ctl + CW_BAR; bar.x = 0; bar.st = nullptr;
    if (hi - lo > 1) bar = xcd_barrier_post(ctl + CW_BAR, MISC + 8);
#ifndef PHMASK
#define PHMASK 0x3ff
#endif
#define IN(k) (((PHMASK >> (k)) & 1) && lo <= (k) && (k) < hi)
#define SEAM(k) do { if (IN(k) && IN((k) + 1)) xcd_barrier(bar); } while (0)

    if (IN(0)) { phase_prologue(p, lds, gw, NGW, wave, lane); }
    SEAM(0);
    int cid = (int)blockIdx.x;
    if (hi - lo > 1 && lo == 0) {
        if (tid == 0) {
            bool ok = (G % 8 == 0);
            for (unsigned j = 0; j < 16; ++j) { const unsigned cj = xb_ld(&bar.bar[XB_XCNT(j)]); ok = ok && (j < 8 ? cj == (unsigned)(G / 8) : cj == 0u); }
            MISC[12] = ok ? (MISC[10] * 8u + bar.x) : (unsigned)blockIdx.x;
        }
        __syncthreads();
        cid = (int)MISC[12];
    }
    if (IN(1)) {
        const int ncw = (G < 8 * NCV) ? G : 8 * NCV;
        if (cid < ncw) convert_experts(p, cid * NWAVES + wave, ncw * NWAVES, lane);
        LAS int* tk = (LAS int*)(lds + MISC_OFF + 768);
        unsigned* tick = ctl + CW_TICK + 64 * (cid & 7);
        __syncthreads();
        if (tid == 0) { tk[0] = (int)__hip_atomic_fetch_add(tick, 1u, __ATOMIC_RELAXED, __HIP_MEMORY_SCOPE_AGENT); tk[1] = (int)__hip_atomic_fetch_add(tick, 1u, __ATOMIC_RELAXED, __HIP_MEMORY_SCOPE_AGENT); }
        __syncthreads();
        pg8::SchedQueue S{(const char*)(p.ws + WS_HN), (const char*)(p.ws + WS_WIN), T / 256, NIN_PAD / 256, (T / 256) * (NIN_PAD / 256) / 8, cid & 7, tick, tk};
        EpiInProj E{(bf16*)(p.ws + WS_PROJ), (float*)(p.ws + WS_DT)};
        pg8::gemm_phase<EpiInProj, pg8::SchedQueue>(lds, S, E);
    }
    SEAM(1);
    if (IN(2)) { if (!(p.variant & 2)) phase_attn(p, lds, G); if (!(p.variant & 1)) phase_ssd_states(p, lds, G, lane, wave); }
    SEAM(2);
    if (IN(3)) { phase_ssd_scan(p, G); }
    SEAM(3);
    if (IN(4)) { phase_ssd_out(p, lds, G, lane, wave); }
    SEAM(4);
    if (IN(5)) {
        EpiOutProj E{p.x, (bf16*)(p.ws + WS_X1), (float*)(p.ws + WS_SSQ)};
#if PROBE_CRIP5
        if (p.variant) { pg8::SchedDenseT<PROBE_CRIP5, OUTPROJ_F8 != 0> S{(const char*)(p.ws + WS_MIX), (const char*)(p.ws + WS_WOUT), T / 256, D / 256, G, cid};
            pg8::gemm_phase<EpiOutProj, pg8::SchedDenseT<PROBE_CRIP5, OUTPROJ_F8 != 0>>(lds, S, E); } else
#endif
        { pg8::SchedDenseT<0, OUTPROJ_F8 != 0> S{(const char*)(p.ws + WS_MIX), (const char*)(p.ws + WS_WOUT), T / 256, D / 256, G, cid};
          pg8::gemm_phase<EpiOutProj, pg8::SchedDenseT<0, OUTPROJ_F8 != 0>>(lds, S, E); }
    }
    SEAM(5);
    if (IN(6)) { phase_router(p, lds, ctl, G, wave, lane); }
    SEAM(6);
    if (IN(7)) {
        moe_table(ctl, tstart, lcnt);
        EpiGateUp E{p.ws + WS_HB, p.b_gate, p.b_up};
#if PROBE_CRIP7
        if (p.variant) { pg8::SchedMoE<true, PROBE_CRIP7> S{(const char*)(p.ws + WS_HF), (const char*)(p.ws + WS_WGU), (const int*)(p.ws + WS_STOK), tstart, lcnt, (2 * FF) / 256, 2 * FF, G, cid};
            pg8::gemm_phase<EpiGateUp, pg8::SchedMoE<true, PROBE_CRIP7>>(lds, S, E); } else
#endif
        { pg8::SchedMoE<true> S{(const char*)(p.ws + WS_HF), (const char*)(p.ws + WS_WGU), (const int*)(p.ws + WS_STOK), tstart, lcnt, (2 * FF) / 256, 2 * FF, G, cid};
          pg8::gemm_phase<EpiGateUp, pg8::SchedMoE<true>>(lds, S, E); }
    }
    SEAM(7);
    if (IN(8)) {
        moe_table(ctl, tstart, lcnt);
        EpiDown E{p.ws + WS_Y2, p.b_down, (const float*)(p.ws + WS_SGATE), tstart};
#if PROBE_CRIP
        if (p.variant) { pg8::SchedMoE<false, PROBE_CRIP> S{(const char*)(p.ws + WS_HB), (const char*)(p.ws + WS_WD), (const int*)(p.ws + WS_STOK), tstart, lcnt, D / 256, D, G, cid};
            pg8::gemm_phase<EpiDown, pg8::SchedMoE<false, PROBE_CRIP>>(lds, S, E); } else
#endif
        { pg8::SchedMoE<false> S{(const char*)(p.ws + WS_HB), (const char*)(p.ws + WS_WD), (const int*)(p.ws + WS_STOK), tstart, lcnt, D / 256, D, G, cid};
          pg8::gemm_phase<EpiDown, pg8::SchedMoE<false>>(lds, S, E); }
    }
    SEAM(8);
    if (IN(9)) { moe_table(ctl, tstart, lcnt); phase_combine(p, tstart, gw, NGW, lane); }
#undef IN
#undef SEAM
}

extern "C" void kernel_launch(void* const* d_in, const int* in_sizes, int n_in, void* d_out, int out_size, void* d_ws, size_t ws_size, hipStream_t stream) {
    static int grid = 0;
    if (grid == 0) {
        if (n_in != 23 || out_size != T * D || ws_size < WS_END) { fprintf(stderr, "kernel_launch: unexpected sizes n_in %d out %d ws %zu\n", n_in, out_size, ws_size); grid = -1; return; }
        int dev = 0, cus = 0;
        if (hipGetDevice(&dev) != hipSuccess || hipDeviceGetAttribute(&cus, hipDeviceAttributeMultiprocessorCount, dev) != hipSuccess) { grid = -1; return; }
        if (hipFuncSetAttribute((const void*)hymba_fwd, hipFuncAttributeMaxDynamicSharedMemorySize, LDS_BYTES) != hipSuccess) { fprintf(stderr, "kernel_launch: hipFuncSetAttribute failed\n"); grid = -1; return; }
        int per_cu = 0;
        if (hipOccupancyMaxActiveBlocksPerMultiprocessor(&per_cu, (const void*)hymba_fwd, NTHREADS, LDS_BYTES) != hipSuccess || per_cu < 1) fprintf(stderr, "kernel_launch: occupancy query says %d\n", per_cu);
        (void)hipGetLastError();
        grid = cus;
    }
    if (grid < 0) return;
    (void)hipMemsetAsync((char*)d_ws + WS_CTL, 0, CTL_BYTES, stream);
    Params p{};
    const float** pp = (const float**)&p;
    for (int i = 0; i < 23; ++i) pp[i] = (const float*)d_in[i];
    p.out = (float*)d_out; p.ws = (unsigned char*)d_ws;
#if MK_MULTI || (PROBE_REPEAT >= 0) || PROBE_CRIP || PROBE_P2 || PROBE_P6 || PROBE_CRIP7 || PROBE_CRIP5
    for (int ph = 0; ph < N_PHASES; ++ph) { p.ph_lo = ph; p.ph_hi = ph + 1;
        if (PROBE_P2 && ph == 2) { p.variant = PROBE_P2; hipLaunchKernelGGL(hymba_fwd, dim3(grid), dim3(NTHREADS), LDS_BYTES, stream, p); p.variant = 0; }
        if (PROBE_P6 && ph == 6) { hipLaunchKernelGGL(hymba_fwd, dim3(grid), dim3(NTHREADS), LDS_BYTES, stream, p); (void)hipMemsetAsync((char*)d_ws + WS_CTL + CW_CNT * 4, 0, 64 * 4 * NE, stream); }
        if (PROBE_CRIP5 && ph == 5) { p.variant = 1; hipLaunchKernelGGL(hymba_fwd, dim3(grid), dim3(NTHREADS), LDS_BYTES, stream, p); p.variant = 0; }
        if (PROBE_CRIP7 && ph == 7) { p.variant = 1; hipLaunchKernelGGL(hymba_fwd, dim3(grid), dim3(NTHREADS), LDS_BYTES, stream, p); p.variant = 0; }
        if (PROBE_CRIP && ph == 8) { p.variant = 1; hipLaunchKernelGGL(hymba_fwd, dim3(grid), dim3(NTHREADS), LDS_BYTES, stream, p); p.variant = 0; }
        for (int r = 0; r < (ph == PROBE_REPEAT ? 2 : 1); ++r) hipLaunchKernelGGL(hymba_fwd, dim3(grid), dim3(NTHREADS), LDS_BYTES, stream, p); }
#else
    p.ph_lo = 0; p.ph_hi = N_PHASES; hipLaunchKernelGGL(hymba_fwd, dim3(grid), dim3(NTHREADS), LDS_BYTES, stream, p);
#endif
}
```

```cpp
#include <hip/hip_runtime.h>
#include <cstdio>
#include <cstdint>

#ifndef MK_MULTI
#define MK_MULTI 0
#endif

#ifndef PROBE_CRIP
#define PROBE_CRIP 0
#endif
#ifndef WGM
#define WGM 4
#endif
#ifndef WGMQ
#define WGMQ 8
#endif
#ifndef PROBE_CRIP5
#define PROBE_CRIP5 0
#endif
#ifndef PROBE_CRIP7
#define PROBE_CRIP7 0
#endif
#ifndef PROBE_P6
#define PROBE_P6 0
#endif
#ifndef PROBE_P2
#define PROBE_P2 0
#endif
#ifndef PROBE_REPEAT
#define PROBE_REPEAT -1
#endif
#ifndef INPROJ_F8
#define INPROJ_F8 0
#endif
#ifndef OUTPROJ_F8
#define OUTPROJ_F8 1
#endif
#define GAS __attribute__((address_space(1)))
#define LAS __attribute__((address_space(3)))
typedef unsigned short bf16;
typedef unsigned v4u __attribute__((ext_vector_type(4)));
typedef unsigned v2u __attribute__((ext_vector_type(2)));
typedef float f32x4 __attribute__((ext_vector_type(4)));
typedef float f32x2 __attribute__((ext_vector_type(2)));
typedef short bf16x8 __attribute__((ext_vector_type(8)));
typedef int i32x4 __attribute__((ext_vector_type(4)));
typedef int i32x8 __attribute__((ext_vector_type(8)));

constexpr int NB = 4, SEQ = 8192, T = NB * SEQ, D = 2048;
constexpr int PROJ_LD = 3840;
constexpr int COL_Q = 0, COL_K = 1024, COL_V = 1152, COL_Z = 1280, COL_XBC = 2304;
constexpr int NIN = 3856, NIN_PAD = 4096;
constexpr int NXBC = 1536;
constexpr int NE = 32, FF = 2048, TOPK = 4;
constexpr int SLOT_ROWS = T * TOPK + NE * 256;
constexpr float EPS = 1e-6f;

constexpr size_t MiB = 1u << 20;
constexpr size_t WS_CTL = 0, CTL_BYTES = 1 * MiB;
constexpr size_t WS_WGU = 16 * MiB;
constexpr size_t WS_WIN = 528 * MiB;
constexpr size_t WS_WOUT = 544 * MiB;
constexpr size_t WS_HF = 552 * MiB;
constexpr size_t WS_Y2 = 16 * MiB;
constexpr size_t WS_WD = 680 * MiB;
constexpr size_t WS_HN = 936 * MiB;
constexpr size_t WS_MIX = WS_HN;
constexpr size_t WS_PROJ = 1064 * MiB;
constexpr size_t WS_XBC = 1304 * MiB;
constexpr size_t WS_ATT = 1496 * MiB;
constexpr size_t WS_X1 = WS_ATT;
constexpr size_t WS_YS = 1624 * MiB;
constexpr size_t WS_HB = 936 * MiB;
constexpr size_t WS_STATES = WS_XBC;
constexpr size_t WS_SIN = WS_YS;
constexpr size_t WS_CDEC = WS_YS + 64 * MiB;
constexpr size_t WS_DT = 1752 * MiB;
constexpr size_t WS_DTS = 1754 * MiB;
constexpr size_t WS_SSQ = 1756 * MiB;
constexpr size_t WS_STOK = 1760 * MiB;
constexpr size_t WS_SGATE = 1764 * MiB;
constexpr size_t WS_TOKE = 1768 * MiB;
constexpr size_t WS_TOKP = 1769 * MiB;
constexpr size_t WS_WRB = 1770 * MiB;
constexpr size_t WS_END = 1771 * MiB;
static_assert(WS_Y2 + (size_t)SLOT_ROWS * 2048 <= WS_WD, "y2 overlay");
static_assert(WS_HB + (size_t)SLOT_ROWS * 2048 * 2 <= WS_ATT, "hb overlay");
constexpr int CW_CNT = 1024;
constexpr int CW_BAR = 4096;
constexpr int CW_TICK = 2048 + 1024;
constexpr int NCV = 12;

constexpr int RING_BYTES = 131072;
constexpr int MISC_OFF = 162816;
constexpr int LDS_BYTES = 163840;
constexpr int NWAVES = 8, NTHREADS = 512;

typedef __bf16 hwbf16x2 __attribute__((ext_vector_type(2)));
__device__ __forceinline__ unsigned f2bf(float f) { return (unsigned)__builtin_bit_cast(unsigned short, (__bf16)f); }
__device__ __forceinline__ unsigned pk2(float lo, float hi) { const f32x2 v = {lo, hi}; return __builtin_bit_cast(unsigned, __builtin_convertvector(v, hwbf16x2)); }
__device__ __forceinline__ float bflo(unsigned w) { return __builtin_bit_cast(float, w << 16); }
__device__ __forceinline__ float bfhi(unsigned w) { return __builtin_bit_cast(float, w & 0xffff0000u); }
__device__ __forceinline__ float wave_sum(float v) {
#pragma unroll
    for (int o = 1; o < 64; o <<= 1) v += __shfl_xor(v, o);
    return v;
}
__device__ __forceinline__ float sat8(float x) { return __builtin_amdgcn_fmed3f(x, -448.0f, 448.0f); }
__device__ __forceinline__ unsigned pk4_fp8(float a, float b, float c, float d) { int v = 0; v = __builtin_amdgcn_cvt_pk_fp8_f32(a, b, v, false); v = __builtin_amdgcn_cvt_pk_fp8_f32(c, d, v, true); return (unsigned)v; }
constexpr float FP8_SW = 256.f;
constexpr float FP8_SA = 16.f;
constexpr float FP8_SH = 4.f;
constexpr float FP8_SY = 32.f;
__device__ __forceinline__ float fsigmoid(float x) { return __builtin_amdgcn_rcpf(1.0f + __expf(-x)); }
__device__ __forceinline__ void unpack8(const v4u q, float (&d)[8]) { d[0] = bflo(q.x); d[1] = bfhi(q.x); d[2] = bflo(q.y); d[3] = bfhi(q.y); d[4] = bflo(q.z); d[5] = bfhi(q.z); d[6] = bflo(q.w); d[7] = bfhi(q.w); }
#define LDS_WAIT() asm volatile("s_waitcnt lgkmcnt(0)" ::: "memory")
#define LDS_BARRIER() do { asm volatile("s_waitcnt lgkmcnt(0)" ::: "memory"); __builtin_amdgcn_s_barrier(); asm volatile("" ::: "memory"); } while (0)

#define XB_TMO      128
#define XB_XCNT(j)  (256  + 64 * (j))
#define XB_XSUB(j)  (1280 + 64 * (j))
#define XB_XGEN(j)  (2304 + 64 * (j))
#define XB_TOP      3328
#define XB_TOPGEN   3392
#define XCD_BAR_WORDS 3456
#define XB_SPIN_CAP (1u << 18)
__device__ __forceinline__ unsigned xb_ld(unsigned* p)              { return __hip_atomic_load(p, __ATOMIC_RELAXED, __HIP_MEMORY_SCOPE_AGENT); }
__device__ __forceinline__ unsigned xb_add(unsigned* p, unsigned v) { return __hip_atomic_fetch_add(p, v, __ATOMIC_RELAXED, __HIP_MEMORY_SCOPE_AGENT); }
__device__ __forceinline__ unsigned xb_xcc_id() { return (unsigned)__builtin_amdgcn_s_getreg((3 << 11) | 20) & 0xFu; }
#define XB_SPIN(cond, bar) do { unsigned _sp = 0; while (cond) { __builtin_amdgcn_s_sleep(1); \
    if ((++_sp & 255u) == 0u) { if (xb_ld(&(bar)[XB_TMO])) break; if (_sp > XB_SPIN_CAP) { atomicAdd(&(bar)[XB_TMO], 1u); break; } } } } while (0)
struct XcdBarrier { unsigned* bar; unsigned x; volatile LAS unsigned* st; };
__device__ __forceinline__ XcdBarrier xcd_barrier_post(unsigned* bar, volatile LAS unsigned* st) {
    XcdBarrier b; b.bar = bar; b.x = xb_xcc_id(); b.st = st;
    if (threadIdx.x == 0) st[2] = xb_add(&bar[XB_XCNT(b.x)], 1u);
    return b;
}
__device__ __forceinline__ void xcd_barrier_complete(unsigned* bar, unsigned x, unsigned& nloc, unsigned& nx) {
    const unsigned G = gridDim.x * gridDim.y * gridDim.z;
    unsigned sum, cnt, mine, sp = 0u;
    for (;;) {
        sum = 0u; cnt = 0u; mine = 0u;
#pragma unroll
        for (unsigned j = 0; j < 16; ++j) { const unsigned c = xb_ld(&bar[XB_XCNT(j)]); sum += c; cnt += (c > 0u) ? 1u : 0u; mine = (j == x) ? c : mine; }
        if (sum == G) break;
        __builtin_amdgcn_s_sleep(1);
        if ((++sp & 255u) == 0u) { if (xb_ld(&bar[XB_TMO])) break; if (sp > XB_SPIN_CAP) { atomicAdd(&bar[XB_TMO], 1u); break; } }
    }
    nloc = mine > 0u ? mine : 1u; nx = cnt > 0u ? cnt : 1u;
}
__device__ __forceinline__ void xcd_barrier(const XcdBarrier& b) {
    asm volatile("s_waitcnt vmcnt(0)" ::: "memory");
    __syncthreads();
    if (threadIdx.x == 0) {
        unsigned* bar = b.bar;
        __builtin_amdgcn_s_waitcnt(0);
        unsigned nloc = b.st[0], nx = b.st[1];
        if (nloc == 0u) { xcd_barrier_complete(bar, b.x, nloc, nx); b.st[0] = nloc; b.st[1] = nx; }
        const unsigned old = xb_add(&bar[XB_XSUB(b.x)], 1u);
        const unsigned gen = old / nloc;
        if (old + 1u == (gen + 1u) * nloc) {
            __builtin_amdgcn_fence(__ATOMIC_RELEASE, "agent");
            asm volatile("s_waitcnt vmcnt(0)" ::: "memory");
            const unsigned og = xb_add(&bar[XB_TOP], 1u);
            const unsigned tg = og / nx;
            if (og + 1u == (tg + 1u) * nx) xb_add(&bar[XB_TOPGEN], 1u);
            else XB_SPIN(xb_ld(&bar[XB_TOPGEN]) == tg, bar);
            __builtin_amdgcn_fence(__ATOMIC_ACQUIRE, "agent");
            xb_add(&bar[XB_XGEN(b.x)], 1u);
            asm volatile("s_waitcnt vmcnt(0)" ::: "memory");
        } else {
            XB_SPIN(xb_ld(&bar[XB_XGEN(b.x)]) == gen, bar);
            __builtin_amdgcn_fence(__ATOMIC_ACQUIRE, "agent");
            asm volatile("s_waitcnt vmcnt(0)" ::: "memory");
        }
    }
    __syncthreads();
}

struct Params {
    const float* x; const float* attn_norm_w; const float* w_in; const float* q_norm_w; const float* k_norm_w; const float* sinks;
    const float* conv_w; const float* conv_b; const float* dt_bias; const float* a_log; const float* d_skip; const float* ssm_norm_w;
    const float* attn_out_norm_w; const float* w_out; const float* ffn_norm_w; const float* w_router; const float* b_router;
    const float* w_gate; const float* b_gate; const float* w_up; const float* b_up; const float* w_down; const float* b_down;
    float* out; unsigned char* ws; int ph_lo, ph_hi, variant, pad;
};

namespace pg8 {
constexpr int BM = 256, BK = 64, HALF = 128, HTB = HALF * BK * 2, GK = 2048;
__device__ __forceinline__ int lds_byte(int r, int c) { const int st = (r >> 4) * 2 + (c >> 5), rr = r & 15, cc = c & 31, ob = rr * 64 + cc * 2; return st * 1024 + (ob ^ (((ob >> 9) & 1) << 5)); }
__device__ __forceinline__ void stage_rc(int b, int& R, int& C) { const int st = b / 1024, sb = b % 1024, swz = sb ^ (((sb >> 9) & 1) << 5); R = (st >> 1) * 16 + swz / 64; C = (st & 1) * 32 + (swz % 64) / 2; }
__device__ __forceinline__ int perm32(int rho) { const int n = rho >> 4, i = rho & 15; return 8 * (i >> 2) + 4 * n + (i & 3); }

struct Unit { const char* aBase; const char* bBase; const int* aidx; int avalid; int pm, pn, e; };

template <class Epi, class Sched>
__device__ __forceinline__ void gemm_phase(LAS unsigned char* lds, const Sched& S, const Epi& E) {
    constexpr int RP = Sched::ROWB, nt = RP / 128;
    constexpr bool F8 = Sched::FP8;
    const int tid = threadIdx.x, wid = __builtin_amdgcn_readfirstlane(tid >> 6), lane = tid & 63, wr = wid >> 2, wc = wid & 3, fr = lane & 15, fq = lane >> 4;
    int sR[2], sC[2];
    unsigned voffB[2], vA[2][2];
#pragma unroll
    for (int i = 0; i < 2; ++i) { stage_rc(tid * 16 + i * 8192, sR[i], sC[i]); const int Rb = Epi::PERM ? ((sR[i] & ~31) + perm32(sR[i] & 31)) : sR[i];
        voffB[i] = (unsigned)(Rb * RP + sC[i] * 2); }
    const size_t kstep = (size_t)(BK * 2);
    const size_t hstep = (size_t)HALF * RP;
    const unsigned ldsw = (unsigned)wid * 1024u;
    const int aoff = lds_byte(wr * 64 + fr, fq * 8), boff = lds_byte(wc * 32 + fr, fq * 8);
#define PG8_SA(b, h) (((b) * 2 + (h)) * HTB)
#define PG8_SB(b, h) ((4 + (b) * 2 + (h)) * HTB)
#define PG8_STAGE(bufoff, gbase, voff) do { if constexpr (!(Sched::CRIP & 2)) _Pragma("unroll") for (int _i = 0; _i < 2; ++_i) { unsigned _o = (voff)[_i]; asm volatile("" : "+v"(_o)); \
        __builtin_amdgcn_global_load_lds((const unsigned*)((const char*)(gbase) + _o), (LAS unsigned*)(lds + (bufoff) + ldsw + _i * 8192), 16, 0, 0); } } while (0)
#define PG8_CAT(x, y) __builtin_shufflevector(x, y, 0, 1, 2, 3, 4, 5, 6, 7)
#define PG8_LO(v) __builtin_bit_cast(bf16x8, __builtin_shufflevector(v, v, 0, 1, 2, 3))
#define PG8_HI(v) __builtin_bit_cast(bf16x8, __builtin_shufflevector(v, v, 4, 5, 6, 7))
#define PG8_LDA(dst, b, h) do { if constexpr (!(Sched::CRIP & 4)) _Pragma("unroll") for (int m = 0; m < 4; ++m) dst[m] = PG8_CAT(*(const LAS i32x4*)(lds + PG8_SA(b, h) + aoff + m * 2048), *(const LAS i32x4*)(lds + PG8_SA(b, h) + aoff + m * 2048 + 1024)); } while (0)
#define PG8_LDB(dst, b, h) do { if constexpr (!(Sched::CRIP & 4)) _Pragma("unroll") for (int n = 0; n < 2; ++n) dst[n] = PG8_CAT(*(const LAS i32x4*)(lds + PG8_SB(b, h) + boff + n * 2048), *(const LAS i32x4*)(lds + PG8_SB(b, h) + boff + n * 2048 + 1024)); } while (0)
#define PG8_MMA(ai, bj, At, Bt) do { __builtin_amdgcn_s_setprio(1); \
        if constexpr (Sched::CRIP & 1) {} else if constexpr (F8) { asm volatile("s_nop 1\n\t" \
            "v_mfma_scale_f32_16x16x128_f8f6f4 %0, %8, %10, %0, %14, %14 op_sel_hi:[0,0,0]\n\t" "v_mfma_scale_f32_16x16x128_f8f6f4 %1, %9, %10, %1, %14, %14 op_sel_hi:[0,0,0]\n\t" \
            "v_mfma_scale_f32_16x16x128_f8f6f4 %2, %8, %11, %2, %14, %14 op_sel_hi:[0,0,0]\n\t" "v_mfma_scale_f32_16x16x128_f8f6f4 %3, %9, %11, %3, %14, %14 op_sel_hi:[0,0,0]\n\t" \
            "v_mfma_scale_f32_16x16x128_f8f6f4 %4, %8, %12, %4, %14, %14 op_sel_hi:[0,0,0]\n\t" "v_mfma_scale_f32_16x16x128_f8f6f4 %5, %9, %12, %5, %14, %14 op_sel_hi:[0,0,0]\n\t" \
            "v_mfma_scale_f32_16x16x128_f8f6f4 %6, %8, %13, %6, %14, %14 op_sel_hi:[0,0,0]\n\t" "v_mfma_scale_f32_16x16x128_f8f6f4 %7, %9, %13, %7, %14, %14 op_sel_hi:[0,0,0]" \
            : "+v"(acc[ai][bj][0][0]), "+v"(acc[ai][bj][0][1]), "+v"(acc[ai][bj][1][0]), "+v"(acc[ai][bj][1][1]), "+v"(acc[ai][bj][2][0]), "+v"(acc[ai][bj][2][1]), "+v"(acc[ai][bj][3][0]), "+v"(acc[ai][bj][3][1]) \
            : "v"(Bt[0]), "v"(Bt[1]), "v"(At[0]), "v"(At[1]), "v"(At[2]), "v"(At[3]), "v"(f8scale)); } \
        else { _Pragma("unroll") for (int m = 0; m < 4; ++m) _Pragma("unroll") for (int n = 0; n < 2; ++n) { \
               acc[ai][bj][m][n] = __builtin_amdgcn_mfma_f32_16x16x32_bf16(PG8_LO(Bt[n]), PG8_LO(At[m]), acc[ai][bj][m][n], 0, 0, 0); \
               acc[ai][bj][m][n] = __builtin_amdgcn_mfma_f32_16x16x32_bf16(PG8_HI(Bt[n]), PG8_HI(At[m]), acc[ai][bj][m][n], 0, 0, 0); } } \
        __builtin_amdgcn_s_setprio(0); } while (0)
#define PG8_WAIT_V(n) asm volatile("s_waitcnt vmcnt(" #n ")" ::: "memory")
#define PG8_WAIT_L(n) asm volatile("s_waitcnt lgkmcnt(" #n ")" ::: "memory")
#define PG8_BAR __builtin_amdgcn_s_barrier()
#define PG8_BAR2 do { if constexpr (!(Sched::CRIP & 16)) __builtin_amdgcn_s_barrier(); } while (0)
#define PG8_SCHED __builtin_amdgcn_sched_barrier(0)
    Unit cur, nxt; int ui = 0;
    if (!S.next(0, cur)) return;
    typename Epi::Pre epre;
    E.prefetch(cur, epre);
    LAS int* lidx = (LAS int*)(lds + 8 * HTB);
    if constexpr (Sched::GATHER) {
        if (tid < 256) { const int v = cur.aidx[tid]; lidx[tid] = (tid < cur.avalid) ? v : 0; }
        __syncthreads();
    }
#pragma unroll
    for (int h = 0; h < 2; ++h)
#pragma unroll
        for (int i = 0; i < 2; ++i) {
            const int r = h * HALF + sR[i];
            if constexpr (Sched::GATHER) vA[h][i] = (unsigned)(lidx[r] * RP + sC[i] * 2);
            else vA[h][i] = (unsigned)(r * RP + sC[i] * 2);
        }
    f32x4 acc[2][2][4][2];
#pragma unroll
    for (int a = 0; a < 2; ++a)
#pragma unroll
        for (int b = 0; b < 2; ++b)
#pragma unroll
            for (int m = 0; m < 4; ++m)
#pragma unroll
                for (int n = 0; n < 2; ++n) acc[a][b][m][n] = (f32x4){0.f, 0.f, 0.f, 0.f};
    i32x8 At[4], B0[2], B1[2];
    if constexpr (Sched::CRIP & 4) { _Pragma("unroll") for (int m = 0; m < 4; ++m) At[m] = (i32x8){0, 0, 0, 0, 0, 0, 0, 0}; _Pragma("unroll") for (int n = 0; n < 2; ++n) { B0[n] = At[0]; B1[n] = At[0]; } }
    int f8scale = 0x7f7f7f7f; asm volatile("" : "+v"(f8scale));
    const char* cA = cur.aBase; const char* cB = cur.bBase;
#ifndef KROT
#define KROT(pm, pn) (((Sched::ROTM ? (pm) : 0) + (pn)) & (nt - 1))
#endif
#define PG8_KT(rot, tau) ((size_t)(((tau) + (rot)) & (nt - 1)) * kstep)
    int crot = KROT(cur.pm, cur.pn);
    PG8_STAGE(PG8_SB(0, 0), cB + PG8_KT(crot, 0), voffB); PG8_STAGE(PG8_SB(0, 1), cB + hstep + PG8_KT(crot, 0), voffB); PG8_STAGE(PG8_SA(0, 0), cA + PG8_KT(crot, 0), vA[0]); PG8_STAGE(PG8_SA(0, 1), cA + PG8_KT(crot, 0), vA[1]);
    if (wr == 1) PG8_BAR;
    PG8_WAIT_V(2); PG8_BAR;
    PG8_STAGE(PG8_SB(1, 0), cB + PG8_KT(crot, 1), voffB); PG8_STAGE(PG8_SA(1, 0), cA + PG8_KT(crot, 1), vA[0]); PG8_STAGE(PG8_SB(1, 1), cB + hstep + PG8_KT(crot, 1), voffB);
    PG8_WAIT_V(6); PG8_BAR;
    for (;;) {
        const bool has_next = S.next(ui + 1, nxt);
        const char* nA = has_next ? nxt.aBase : cA; const char* nB = has_next ? nxt.bBase : cB;
        const int nrot = has_next ? KROT(nxt.pm, nxt.pn) : crot;
        for (int t = 0; t < nt; t += 2) {
            const bool last = (t == nt - 2);
            const char* a1 = cA + PG8_KT(crot, t + 1);
            const char* a2 = last ? nA + PG8_KT(nrot, 0) : cA + PG8_KT(crot, t + 2); const char* b2 = last ? nB + PG8_KT(nrot, 0) : cB + PG8_KT(crot, t + 2);
            const char* a3 = last ? nA + PG8_KT(nrot, 1) : cA + PG8_KT(crot, t + 3); const char* b3 = last ? nB + PG8_KT(nrot, 1) : cB + PG8_KT(crot, t + 3);
            int gi = 0;
            if constexpr (Sched::GATHER) { if (t == 0 && has_next && tid < 256) gi = nxt.aidx[tid]; }
            PG8_LDB(B0, 0, 0); PG8_LDB(B1, 0, 1); PG8_SCHED; PG8_LDA(At, 0, 0); PG8_STAGE(PG8_SA(1, 1), a1, vA[1]);
            PG8_WAIT_V(8); PG8_WAIT_L(0); PG8_BAR; PG8_MMA(0, 0, At, B0); PG8_MMA(0, 1, At, B1); PG8_BAR2; PG8_SCHED;
            if constexpr (Sched::GATHER) { if (last && has_next) {
                int tz = threadIdx.x; asm volatile("" : "+v"(tz));
#pragma unroll
                for (int i = 0; i < 2; ++i) { int R, C; stage_rc(tz * 16 + i * 8192, R, C);
#pragma unroll
                    for (int h = 0; h < 2; ++h) vA[h][i] = (unsigned)(lidx[h * HALF + R] * RP + C * 2); } } }
            PG8_LDA(At, 0, 1); PG8_STAGE(PG8_SB(0, 0), b2, voffB); PG8_STAGE(PG8_SB(0, 1), b2 + hstep, voffB); PG8_STAGE(PG8_SA(0, 0), a2, vA[0]);
            PG8_WAIT_V(8); PG8_WAIT_L(0); PG8_BAR; PG8_MMA(1, 0, At, B0); PG8_MMA(1, 1, At, B1); PG8_BAR2; PG8_SCHED;
            PG8_LDB(B0, 1, 0); PG8_LDB(B1, 1, 1); PG8_SCHED; PG8_LDA(At, 1, 0); PG8_STAGE(PG8_SA(0, 1), a2, vA[1]);
            PG8_WAIT_V(8); PG8_WAIT_L(0); PG8_BAR; PG8_MMA(0, 0, At, B0); PG8_MMA(0, 1, At, B1); PG8_BAR2; PG8_SCHED;
            PG8_LDA(At, 1, 1); PG8_STAGE(PG8_SB(1, 0), b3, voffB); PG8_STAGE(PG8_SB(1, 1), b3 + hstep, voffB); PG8_STAGE(PG8_SA(1, 0), a3, vA[0]);
            PG8_WAIT_V(8); PG8_WAIT_L(0); PG8_BAR; PG8_MMA(1, 0, At, B0); PG8_MMA(1, 1, At, B1); PG8_BAR2; PG8_SCHED;
            if constexpr (Sched::GATHER) { if (t == 0 && has_next && tid < 256) lidx[tid] = (tid < nxt.avalid) ? gi : 0; }
        }
        if constexpr (F8) asm volatile("s_nop 15\n\ts_nop 15" ::: "memory");
        if (wr == 0) PG8_BAR;
        { int tz = threadIdx.x; asm volatile("" : "+v"(tz)); const int ewid = __builtin_amdgcn_readfirstlane(tz >> 6), el = tz & 63;
          E(acc, cur, epre, ewid >> 2, ewid & 3, el & 15, el >> 4); }
        if (!has_next) break;
#pragma unroll
        for (int a = 0; a < 2; ++a)
#pragma unroll
            for (int b = 0; b < 2; ++b)
#pragma unroll
                for (int m = 0; m < 4; ++m)
#pragma unroll
                    for (int n = 0; n < 2; ++n) acc[a][b][m][n] = (f32x4){0.f, 0.f, 0.f, 0.f};
        cur = nxt; cA = nA; cB = nB; crot = nrot; ++ui;
        E.prefetch(cur, epre);
        if (wr == 1) PG8_BAR;
    }
    PG8_WAIT_V(0);
    PG8_BAR;
#undef PG8_KT
#undef PG8_SA
#undef PG8_SB
#undef PG8_STAGE
#undef PG8_LDA
#undef PG8_LDB
#undef PG8_MMA
#undef PG8_CAT
#undef PG8_LO
#undef PG8_HI
#undef PG8_WAIT_V
#undef PG8_WAIT_L
#undef PG8_BAR
#undef PG8_BAR2
#undef PG8_SCHED
}

__device__ __forceinline__ bool tile_order(long L, int nM, int nN, int& pm, int& pn) {
    const int nwg = nM * nN; if (L >= nwg) return false;
    int wgid = (int)L; { const int q = nwg / 8, r = nwg % 8, xcd = wgid % 8, off = wgid / 8; wgid = (xcd < r ? xcd * (q + 1) : r * (q + 1) + (xcd - r) * q) + off; }
    const int nig = WGM * nN, gid = wgid / nig, fm = gid * WGM, gsz = (nM - fm) < WGM ? (nM - fm) : WGM;
    pm = fm + ((wgid % nig) % gsz); pn = (wgid % nig) / gsz; return true;
}
template <int CRIP_ = 0, bool F8_ = false> struct SchedDenseT {
    static constexpr bool GATHER = false, FP8 = F8_, ROTM = true; static constexpr int ROWB = F8_ ? 2048 : 4096, CRIP = CRIP_;
    const char* A; const char* Bt; int nM, nN, G, c;
    __device__ __forceinline__ bool next(int i, Unit& u) const {
        int pm, pn; if (!tile_order((long)i * G + c, nM, nN, pm, pn)) return false;
        u.pm = pm; u.pn = pn; u.e = 0; u.aidx = nullptr; u.avalid = 256;
        u.aBase = A + (size_t)pm * 256 * ROWB; u.bBase = Bt + (size_t)pn * 256 * ROWB;
        if constexpr ((CRIP_ & 64) != 0) u.bBase = Bt;
        if constexpr ((CRIP_ & 128) != 0) u.aBase = A;
        return true;
    }
};
typedef SchedDenseT<0> SchedDense;
struct SchedQueue {
    static constexpr bool GATHER = false, FP8 = (INPROJ_F8 != 0), ROTM = true; static constexpr int ROWB = INPROJ_F8 ? 2048 : 4096, CRIP = 0;
    const char* A; const char* Bt; int nM, nN, q, xcd; unsigned* tick; LAS int* tk;
    __device__ __forceinline__ bool next(int i, Unit& u) const {
        const int t = __builtin_amdgcn_readfirstlane(tk[i & 1]);
        if (i > 0 && threadIdx.x == 0) tk[(i + 1) & 1] = (int)__hip_atomic_fetch_add(tick, 1u, __ATOMIC_RELAXED, __HIP_MEMORY_SCOPE_AGENT);
        if (t >= q) return false;
        const int id = xcd * q + t, nig = WGMQ * nN, gid = id / nig, fm = gid * WGMQ, gsz = (nM - fm) < WGMQ ? (nM - fm) : WGMQ;
        const int pm = fm + ((id % nig) % gsz), pn = (id % nig) / gsz;
        u.pm = pm; u.pn = pn; u.e = 0; u.aidx = nullptr; u.avalid = 256;
        u.aBase = A + (size_t)pm * 256 * ROWB; u.bBase = Bt + (size_t)pn * 256 * ROWB; return true;
    }
};
template <bool GATHER_, int CRIP_ = 0> struct SchedMoE {
    static constexpr bool GATHER = GATHER_ && !(CRIP_ & 32), FP8 = true, ROTM = false; static constexpr int ROWB = 2048, CRIP = CRIP_;
    const char* A; const char* Bt; const int* stok; const LAS int* tstart; const LAS int* cnt; int nN, nrowsB  , G, c;
    __device__ __forceinline__ bool next(int i, Unit& u) const {
        const int nM = __builtin_amdgcn_readfirstlane(tstart[NE]); int pm, pn; if (!tile_order((long)i * G + c, nM, nN, pm, pn)) return false;
        int e = 0;
        for (int j = 1; j < NE; ++j) e += (tstart[j] <= pm) ? 1 : 0;
        e = __builtin_amdgcn_readfirstlane(e);
        const int mt = __builtin_amdgcn_readfirstlane(pm - tstart[e]);
        u.pm = pm; u.pn = pn; u.e = e;
        u.avalid = __builtin_amdgcn_readfirstlane(cnt[e]) - mt * 256;
        u.aidx = stok + (size_t)e * T + mt * 256;
        u.aBase = GATHER ? A : A + (size_t)(GATHER_ ? (pm & 127) : pm) * 256 * ROWB;
        u.bBase = Bt + ((size_t)e * nrowsB + (size_t)pn * 256) * ROWB;
        if constexpr ((CRIP_ & 8) != 0) { u.aBase = A; u.bBase = Bt; }
        return true;
    }
};
}

struct EpiNoPre { };
struct EpiInProj {
    static constexpr bool PERM = true; typedef EpiNoPre Pre;
    bf16* proj; float* dtraw;
    __device__ __forceinline__ void prefetch(const pg8::Unit&, Pre&) const {}
    __device__ __forceinline__ void operator()(const f32x4 (&acc)[2][2][4][2], const pg8::Unit& u, const Pre&, int wr, int wc, int fr, int fq) const {
        const int row0 = u.pm * 256 + wr * 64 + fr;
        constexpr float DS = INPROJ_F8 ? 1.0f / (FP8_SA * FP8_SW) : 1.0f;
        if (u.pn < 15) {
            const int col0 = u.pn * 256 + wc * 32 + 8 * fq;
#pragma unroll
            for (int ai = 0; ai < 2; ++ai)
#pragma unroll
                for (int m = 0; m < 4; ++m) { bf16* rowp = proj + (size_t)(row0 + ai * 128 + m * 16) * PROJ_LD + col0;
#pragma unroll
                    for (int bj = 0; bj < 2; ++bj) { const f32x4 v0 = acc[ai][bj][m][0] * DS, v1 = acc[ai][bj][m][1] * DS;
                        v4u w; w.x = pk2(v0[0], v0[1]); w.y = pk2(v0[2], v0[3]); w.z = pk2(v1[0], v1[1]); w.w = pk2(v1[2], v1[3]);
                        *(v4u*)(rowp + bj * 128) = w; } }
        } else if (wc == 0 && fq < 2) {
#pragma unroll
            for (int ai = 0; ai < 2; ++ai)
#pragma unroll
                for (int m = 0; m < 4; ++m) { float* rowp = dtraw + (size_t)(row0 + ai * 128 + m * 16) * 16 + 8 * fq;
                    *(f32x4*)(rowp) = acc[ai][0][m][0] * DS; *(f32x4*)(rowp + 4) = acc[ai][0][m][1] * DS; }
        }
    }
};
struct EpiOutProj {
    static constexpr bool PERM = true; typedef EpiNoPre Pre;
    const float* x; bf16* x1; float* ssq;
    __device__ __forceinline__ void prefetch(const pg8::Unit&, Pre&) const {}
    __device__ __forceinline__ void operator()(const f32x4 (&acc)[2][2][4][2], const pg8::Unit& u, const Pre&, int wr, int wc, int fr, int fq) const {
        const int row0 = u.pm * 256 + wr * 64 + fr, col0 = u.pn * 256 + wc * 32 + 8 * fq;
        constexpr float DSO = OUTPROJ_F8 ? 1.0f / (FP8_SA * FP8_SW) : 1.0f;
#pragma unroll
        for (int ai = 0; ai < 2; ++ai) {
            f32x4 xv[4][2][2];
#pragma unroll
            for (int m = 0; m < 4; ++m)
#pragma unroll
                for (int bj = 0; bj < 2; ++bj)
#pragma unroll
                    for (int n = 0; n < 2; ++n) xv[m][bj][n] = *(const f32x4*)(x + (size_t)(row0 + ai * 128 + m * 16) * D + col0 + bj * 128 + n * 4);
#pragma unroll
            for (int m = 0; m < 4; ++m) { asm volatile("" : "+v"(xv[m][0][0]), "+v"(xv[m][0][1]), "+v"(xv[m][1][0]), "+v"(xv[m][1][1])); }
#pragma unroll
            for (int m = 0; m < 4; ++m) { const int row = row0 + ai * 128 + m * 16; const size_t off = (size_t)row * D + col0; float s = 0.f;
#pragma unroll
                for (int bj = 0; bj < 2; ++bj) { const f32x4 o0 = xv[m][bj][0] + acc[ai][bj][m][0] * DSO, o1 = xv[m][bj][1] + acc[ai][bj][m][1] * DSO;
                    *(v4u*)(x1 + off + bj * 128) = (v4u){pk2(o0[0], o0[1]), pk2(o0[2], o0[3]), pk2(o1[0], o1[1]), pk2(o1[2], o1[3])};
                    s += ((o0[0] * o0[0] + o0[1] * o0[1]) + (o0[2] * o0[2] + o0[3] * o0[3])) + ((o1[0] * o1[0] + o1[1] * o1[1]) + (o1[2] * o1[2] + o1[3] * o1[3])); }
                s += __shfl_xor(s, 16); s += __shfl_xor(s, 32);
                if (fq == 0) ssq[(size_t)row * 32 + u.pn * 4 + wc] = s; }
        }
    }
};
struct EpiGateUp {
    static constexpr bool PERM = true;
    struct Pre { f32x4 bg[2], bu[2]; };
    static constexpr float KP = -1.702f * 1.44269504f;
    unsigned char* hb; const float* b_gate; const float* b_up;
    __device__ __forceinline__ void prefetch(const pg8::Unit& u, Pre& q) const {
        int tz = threadIdx.x; asm volatile("" : "+v"(tz)); const int wc = (tz >> 6) & 3, fq = (tz >> 4) & 3;
        const int f0 = u.pn * 128 + wc * 32 + 8 * fq;
#pragma unroll
        for (int n = 0; n < 2; ++n) { q.bg[n] = *(const f32x4*)(b_gate + (size_t)u.e * FF + f0 + 4 * n) * KP; q.bu[n] = *(const f32x4*)(b_up + (size_t)u.e * FF + f0 + 4 * n); }
    }
    __device__ __forceinline__ void operator()(const f32x4 (&acc)[2][2][4][2], const pg8::Unit& u, const Pre& q, int wr, int wc, int fr, int fq) const {
        const int row0 = u.pm * 256 + wr * 64 + fr, f0w = u.pn * 128 + wc * 32;
        constexpr float DS = 1.0f / (FP8_SA * FP8_SW);
        f32x4 dsk = (f32x4){DS * KP, DS * KP, DS * KP, DS * KP}, dsu = (f32x4){DS, DS, DS, DS}; asm volatile("" : "+v"(dsk), "+v"(dsu));
#pragma unroll
        for (int ai = 0; ai < 2; ++ai)
#pragma unroll
            for (int mp = 0; mp < 2; ++mp) { unsigned lo[2], hi[2];
#pragma unroll
                for (int mm = 0; mm < 2; ++mm) { const int m = 2 * mp + mm; float h[8];
#pragma unroll
                    for (int n = 0; n < 2; ++n) { const f32x4 gk = __builtin_elementwise_fma(acc[ai][0][m][n], dsk, q.bg[n]), up = __builtin_elementwise_fma(acc[ai][1][m][n], dsu, q.bu[n]);
#pragma unroll
                        for (int j = 0; j < 4; ++j) { const float gm = __builtin_fmaxf(gk[j], 7.0f * KP), li = __builtin_amdgcn_fmed3f(up[j], -7.0f, 7.0f);
                            const float sg = __builtin_amdgcn_rcpf(1.0f + __builtin_amdgcn_exp2f(gm));
                            h[n * 4 + j] = (gm * sg) * (li * (FP8_SH / KP) + (FP8_SH / KP)); } }
                    lo[mm] = pk4_fp8(h[0], h[1], h[2], h[3]); hi[mm] = pk4_fp8(h[4], h[5], h[6], h[7]); }
                const v2u r0 = __builtin_amdgcn_permlane16_swap(lo[0], lo[1], false, false), r1 = __builtin_amdgcn_permlane16_swap(hi[0], hi[1], false, false);
                unsigned char* rowp = hb + (size_t)(row0 + ai * 128 + (2 * mp + (fq & 1)) * 16) * FF + f0w + 16 * (fq >> 1);
                *(v4u*)rowp = (v4u){r0.x, r1.x, r0.y, r1.y}; }
    }
};
struct EpiDown {
    static constexpr bool PERM = true;
    struct Pre { f32x4 bv[2][2]; float gt[2][4]; };
    unsigned char* y2; const float* b_down; const float* sgate; const LAS int* tstart;
    __device__ __forceinline__ void prefetch(const pg8::Unit& u, Pre& q) const {
        int tz = threadIdx.x; asm volatile("" : "+v"(tz)); const int wid = tz >> 6, wr = wid >> 2, wc = wid & 3, fr = tz & 15, fq = (tz >> 4) & 3;
        const int rl0 = wr * 64 + fr, col0 = u.pn * 256 + wc * 32 + 8 * fq;
        const int mt = __builtin_amdgcn_readfirstlane(u.pm - tstart[u.e]);
        const float* gp = sgate + (size_t)u.e * T + mt * 256;
#pragma unroll
        for (int bj = 0; bj < 2; ++bj)
#pragma unroll
            for (int n = 0; n < 2; ++n) q.bv[bj][n] = *(const f32x4*)(b_down + (size_t)u.e * D + col0 + bj * 128 + 4 * n);
#pragma unroll
        for (int ai = 0; ai < 2; ++ai)
#pragma unroll
            for (int m = 0; m < 4; ++m) q.gt[ai][m] = gp[rl0 + ai * 128 + m * 16];
    }
    __device__ __forceinline__ void operator()(const f32x4 (&acc)[2][2][4][2], const pg8::Unit& u, const Pre& q, int wr, int wc, int fr, int fq) const {
        const int rl0 = wr * 64 + fr, colw = u.pn * 256 + wc * 32;
        constexpr float DS = 1.0f / (FP8_SH * FP8_SW);
#pragma unroll
        for (int ai = 0; ai < 2; ++ai)
#pragma unroll
            for (int mp = 0; mp < 2; ++mp)
#pragma unroll
                for (int bj = 0; bj < 2; ++bj) { unsigned lo[2], hi[2];
#pragma unroll
                    for (int mm = 0; mm < 2; ++mm) { const int m = 2 * mp + mm; const float gt = q.gt[ai][m] * FP8_SY;
                        const f32x4 v0 = (acc[ai][bj][m][0] * DS + q.bv[bj][0]) * gt, v1 = (acc[ai][bj][m][1] * DS + q.bv[bj][1]) * gt;
                        lo[mm] = pk4_fp8(sat8(v0[0]), sat8(v0[1]), sat8(v0[2]), sat8(v0[3])); hi[mm] = pk4_fp8(sat8(v1[0]), sat8(v1[1]), sat8(v1[2]), sat8(v1[3])); }
                    const v2u r0 = __builtin_amdgcn_permlane16_swap(lo[0], lo[1], false, false), r1 = __builtin_amdgcn_permlane16_swap(hi[0], hi[1], false, false);
                    unsigned char* rowp = y2 + (size_t)(u.pm * 256 + rl0 + ai * 128 + (2 * mp + (fq & 1)) * 16) * D + colw + bj * 128 + 16 * (fq >> 1);
                    *(v4u*)rowp = (v4u){r0.x, r1.x, r0.y, r1.y}; }
    }
};

__device__ __forceinline__ void p0_tr_item(const float* W, int ldw, int k0, int n0, int nvalid, bf16* WT, int dst_row0, LAS float* scr, int lane) {
    const int c4 = (lane & 15) * 4, kr = lane >> 4;
#pragma unroll 4
    for (int i = 0; i < 16; ++i) { const int kk = 4 * i + kr;
        f32x4 v = (f32x4){0.f, 0.f, 0.f, 0.f};
        if (c4 < nvalid) v = *(const f32x4*)(W + (size_t)(k0 + kk) * ldw + n0 + c4);
        LAS float* d = scr + kk * 65 + c4; d[0] = v[0]; d[1] = v[1]; d[2] = v[2]; d[3] = v[3]; }
    LDS_WAIT(); asm volatile("" ::: "memory");
    const int c = lane >> 3, np = lane & 7;
#pragma unroll
    for (int j = 0; j < 8; ++j) { const int n = 8 * j + np; const LAS float* s = scr + (8 * c) * 65 + n;
        v4u o; o.x = pk2(s[0 * 65], s[1 * 65]); o.y = pk2(s[2 * 65], s[3 * 65]); o.z = pk2(s[4 * 65], s[5 * 65]); o.w = pk2(s[6 * 65], s[7 * 65]);
        *(v4u*)(WT + (size_t)(dst_row0 + n) * 2048 + k0 + 8 * c) = o; }
    LDS_WAIT(); asm volatile("" ::: "memory");
}
__device__ __forceinline__ void f8_tile_load(const float* src, f32x4 (&v)[16], int lane) {
    const float* s0 = src + (size_t)(16 * (lane >> 3)) * 2048 + 4 * (lane & 7);
#pragma unroll
    for (int i = 0; i < 16; ++i) v[i] = __builtin_nontemporal_load((const f32x4*)(s0 + (size_t)i * 2048));
}
__device__ __forceinline__ void f8_tile_store(const f32x4 (&v)[16], unsigned char* dst, int lane) {
    unsigned d[16];
#pragma unroll
    for (int i = 0; i < 16; ++i) d[i] = pk4_fp8(sat8(v[i][0] * FP8_SW), sat8(v[i][1] * FP8_SW), sat8(v[i][2] * FP8_SW), sat8(v[i][3] * FP8_SW));
    unsigned o[4][4];
#pragma unroll
    for (int w = 0; w < 4; ++w) {
        const unsigned t0 = __builtin_amdgcn_perm(d[4 * w + 1], d[4 * w], 0x05010400u), t1 = __builtin_amdgcn_perm(d[4 * w + 1], d[4 * w], 0x07030602u);
        const unsigned t2 = __builtin_amdgcn_perm(d[4 * w + 3], d[4 * w + 2], 0x05010400u), t3 = __builtin_amdgcn_perm(d[4 * w + 3], d[4 * w + 2], 0x07030602u);
        o[0][w] = __builtin_amdgcn_perm(t2, t0, 0x05040100u); o[1][w] = __builtin_amdgcn_perm(t2, t0, 0x07060302u);
        o[2][w] = __builtin_amdgcn_perm(t3, t1, 0x05040100u); o[3][w] = __builtin_amdgcn_perm(t3, t1, 0x07060302u);
    }
    unsigned char* d0 = dst + (size_t)(4 * (lane & 7)) * 2048 + 16 * (lane >> 3);
#pragma unroll
    for (int b = 0; b < 4; ++b) __builtin_nontemporal_store((v4u){o[b][0], o[b][1], o[b][2], o[b][3]}, (v4u*)(d0 + (size_t)b * 2048));
}
__device__ __forceinline__ void f8_item(const Params& p, int it, const float*& src, unsigned char*& dst) {
    const int which = it >> 15, r = it & 32767, e = r >> 10, q = r & 1023, kb = q >> 6, nb = q & 63;
    if (which == 2) { src = p.w_down + (size_t)e * FF * D + (size_t)(kb * 128) * D + nb * 32; dst = p.ws + WS_WD + ((size_t)e * D + nb * 32) * 2048 + kb * 128; }
    else { const int f0 = nb * 32, drow = (f0 >> 7) * 256 + which * 128 + (f0 & 127);
        src = (which == 0 ? p.w_gate : p.w_up) + (size_t)e * D * FF + (size_t)(kb * 128) * FF + f0; dst = p.ws + WS_WGU + ((size_t)e * 4096 + drow) * 2048 + kb * 128; }
}
__device__ __forceinline__ void convert_experts(const Params& p, int first, int stride, int lane) {
    constexpr int NEXP = 3 * NE * 1024;
    f32x4 va[16], vb[16], vc[16]; const float* sa; unsigned char* da; const float* sb; unsigned char* db; const float* sc; unsigned char* dc;
    int it = first; bool oka, okb, okc;
#define F8_LD(v, s_, d_, ok) do { ok = it < NEXP; if (ok) { f8_item(p, it, s_, d_); f8_tile_load(s_, v, lane); } it += stride; } while (0)
    F8_LD(va, sa, da, oka); F8_LD(vb, sb, db, okb); F8_LD(vc, sc, dc, okc);
    for (;;) {
        if (!oka) break; f8_tile_store(va, da, lane); F8_LD(va, sa, da, oka);
        if (!okb) break; f8_tile_store(vb, db, lane); F8_LD(vb, sb, db, okb);
        if (!okc) break; f8_tile_store(vc, dc, lane); F8_LD(vc, sc, dc, okc);
    }
#undef F8_LD
}
__device__ __forceinline__ void phase_prologue(const Params& p, LAS unsigned char* lds, int gw, int NGW, int wave, int lane) {
    LAS float* scr = (LAS float*)(lds + wave * 16896);
    bf16* WIN = (bf16*)(p.ws + WS_WIN); bf16* WOUT = (bf16*)(p.ws + WS_WOUT);
#if OUTPROJ_F8
    constexpr int I_OUT = 0;
    for (int it = gw; it < 16 * 64; it += NGW) { const int kb = it >> 6, n0 = (it & 63) * 32;
        f32x4 v[16]; f8_tile_load(p.w_out + (size_t)(kb * 128) * D + n0, v, lane);
        f8_tile_store(v, p.ws + WS_WOUT + (size_t)n0 * 2048 + kb * 128, lane); }
#else
    constexpr int I_OUT = 32 * 32;
#endif
#if INPROJ_F8
    constexpr int I_IN = 0;
    for (int it = gw; it < 16 * 128; it += NGW) { const int kb = it >> 7, n0 = (it & 127) * 32;
        f32x4 v[16];
        if (n0 + 4 * (lane & 7) < NIN) { const float* s0 = p.w_in + (size_t)(kb * 128 + 16 * (lane >> 3)) * NIN + n0 + 4 * (lane & 7);
#pragma unroll
            for (int i = 0; i < 16; ++i) v[i] = __builtin_nontemporal_load((const f32x4*)(s0 + (size_t)i * NIN)); }
        else {
#pragma unroll
            for (int i = 0; i < 16; ++i) v[i] = (f32x4){0.f, 0.f, 0.f, 0.f}; }
        f8_tile_store(v, p.ws + WS_WIN + (size_t)n0 * 2048 + kb * 128, lane);
    }
#else
    constexpr int I_IN = 32 * 64;
#endif
    for (int it = gw; it < I_IN + I_OUT; it += NGW) {
        int r = it;
        if (r < I_IN) { const int kb = r / 64, nb = r % 64; int nv = NIN - nb * 64; nv = nv < 0 ? 0 : (nv > 64 ? 64 : nv);
            p0_tr_item(p.w_in, NIN, kb * 64, nb * 64, nv, WIN, nb * 64, scr, lane); continue; }
        r -= I_IN;
        { const int kb = r / 32, nb = r % 32; p0_tr_item(p.w_out, D, kb * 64, nb * 64, 64, WOUT, nb * 64, scr, lane); }
    }
    {
        bf16* wrb = (bf16*)(p.ws + WS_WRB);
        for (int idx = gw * 64 + lane; idx < D * NE; idx += NGW * 64) { const int k = idx >> 5, n = idx & 31, j = k >> 5, kq = (k >> 3) & 3, m = k & 7, half = n >> 4, l64 = kq * 16 + (n & 15);
            const float w = p.w_router[idx]; const unsigned hi = f2bf(w); const float lo = w - bflo(hi);
            wrb[((((size_t)j * 2 + half) * 2 + 0) * 64 + l64) * 8 + m] = (bf16)hi; wrb[((((size_t)j * 2 + half) * 2 + 1) * 64 + l64) * 8 + m] = (bf16)f2bf(lo); }
    }
    bf16* HN = (bf16*)(p.ws + WS_HN);
    f32x4 gw4[8];
#pragma unroll
    for (int j = 0; j < 8; ++j) gw4[j] = *((const f32x4*)p.attn_norm_w + 64 * j + lane);
    f32x4 vn[8];
    if (gw < T) { const f32x4* xr = (const f32x4*)(p.x + (size_t)gw * D) + lane;
#pragma unroll
        for (int j = 0; j < 8; ++j) vn[j] = xr[64 * j]; }
    for (int m = gw; m < T; m += NGW) {
        f32x4 v[8]; float s = 0.f;
#pragma unroll
        for (int j = 0; j < 8; ++j) v[j] = vn[j];
        if (m + NGW < T) { const f32x4* xr = (const f32x4*)(p.x + (size_t)(m + NGW) * D) + lane;
#pragma unroll
            for (int j = 0; j < 8; ++j) vn[j] = xr[64 * j]; }
#pragma unroll
        for (int j = 0; j < 8; ++j) s += (v[j][0] * v[j][0] + v[j][1] * v[j][1]) + (v[j][2] * v[j][2] + v[j][3] * v[j][3]);
        const float rstd = rsqrtf(wave_sum(s) * (1.f / D) + EPS);
#if INPROJ_F8
        unsigned* o4 = (unsigned*)((unsigned char*)HN + (size_t)m * D) + lane; const float rs = rstd * FP8_SA;
#pragma unroll
        for (int j = 0; j < 8; ++j) o4[64 * j] = pk4_fp8(sat8(v[j][0] * rs * gw4[j][0]), sat8(v[j][1] * rs * gw4[j][1]), sat8(v[j][2] * rs * gw4[j][2]), sat8(v[j][3] * rs * gw4[j][3]));
#else
        v2u* o8 = (v2u*)(HN + (size_t)m * D) + lane;
#pragma unroll
        for (int j = 0; j < 8; ++j) { v2u w; w.x = pk2(v[j][0] * rstd * gw4[j][0], v[j][1] * rstd * gw4[j][1]); w.y = pk2(v[j][2] * rstd * gw4[j][2], v[j][3] * rstd * gw4[j][3]); o8[64 * j] = w; }
#endif
    }
}

__device__ __forceinline__ void phase_conv(const Params& p, int G) {
    const bf16* proj = (const bf16*)(p.ws + WS_PROJ); float* xbc = (float*)(p.ws + WS_XBC);
    const float* dtraw = (const float*)(p.ws + WS_DT); float* dts = (float*)(p.ws + WS_DTS);
    const int tid = threadIdx.x;
    for (int item = blockIdx.x; item < T / 64; item += G) {
        const int t0 = item * 64;
        if (tid < 384) {
            const int cg = tid % 192, half = tid / 192, c0 = cg * 8, ts = t0 + half * 32;
            float w[4][8], bb[8];
#pragma unroll
            for (int k = 0; k < 4; ++k)
#pragma unroll
                for (int j = 0; j < 8; ++j) w[k][j] = p.conv_w[k * NXBC + c0 + j];
#pragma unroll
            for (int j = 0; j < 8; ++j) bb[j] = p.conv_b[c0 + j];
            float r0[8], r1[8], r2[8];
            {
                const int tl = ts % SEQ;
                v4u q0 = (v4u){0u, 0u, 0u, 0u}, q1 = q0, q2 = q0;
                if (tl - 3 >= 0) q0 = *(const v4u*)(proj + (size_t)(ts - 3) * PROJ_LD + COL_XBC + c0);
                if (tl - 2 >= 0) q1 = *(const v4u*)(proj + (size_t)(ts - 2) * PROJ_LD + COL_XBC + c0);
                if (tl - 1 >= 0) q2 = *(const v4u*)(proj + (size_t)(ts - 1) * PROJ_LD + COL_XBC + c0);
                unpack8(q0, r0); unpack8(q1, r1); unpack8(q2, r2);
            }
            for (int i = 0; i < 32; ++i) {
                const int t = ts + i;
                const v4u q = *(const v4u*)(proj + (size_t)t * PROJ_LD + COL_XBC + c0);
                float r3[8]; unpack8(q, r3);
                float o[8];
#pragma unroll
                for (int j = 0; j < 8; ++j) { const float a = bb[j] + w[0][j] * r0[j] + w[1][j] * r1[j] + w[2][j] * r2[j] + w[3][j] * r3[j]; o[j] = a * fsigmoid(a); }
                float* dp = xbc + (size_t)t * NXBC + c0;
                *(f32x4*)dp = (f32x4){o[0], o[1], o[2], o[3]}; *(f32x4*)(dp + 4) = (f32x4){o[4], o[5], o[6], o[7]};
#pragma unroll
                for (int j = 0; j < 8; ++j) { r0[j] = r1[j]; r1[j] = r2[j]; r2[j] = r3[j]; }
            }
        } else {
            const int u = tid - 384;
#pragma unroll
            for (int i = 0; i < 8; ++i) { const int idx = u + 128 * i; const int t = t0 + (idx >> 4), h = idx & 15;
                const float v = dtraw[(size_t)t * 16 + h] + p.dt_bias[h];
                dts[(size_t)t * 16 + h] = fmaxf(v, 0.f) + log1pf(__expf(-fabsf(v))); }
        }
    }
}

__device__ __forceinline__ void phase_attn_simple(const Params& p, LAS unsigned char* lds, int G) {
    const bf16* proj = (const bf16*)(p.ws + WS_PROJ); float* att = (float*)(p.ws + WS_ATT);
    LAS float* Ks = (LAS float*)lds; LAS float* Vs = (LAS float*)(lds + 256 * 68 * 4);
    const int tid = threadIdx.x;
    for (int item = blockIdx.x; item < NB * 64 * 2; item += G) {
        const int b = item >> 7, n = (item >> 1) & 63, hk = item & 1;
        __syncthreads();
        {
            const int j = tid >> 1, hf = tid & 1, pos = n * 128 - 128 + j;
            float kv[32], vv[32];
            if (pos >= 0) {
                const bf16* kp = proj + (size_t)(b * SEQ + pos) * PROJ_LD + COL_K + hk * 64 + hf * 32;
                const bf16* vp = proj + (size_t)(b * SEQ + pos) * PROJ_LD + COL_V + hk * 64 + hf * 32;
#pragma unroll
                for (int c = 0; c < 4; ++c) { const v4u a = *(const v4u*)(kp + 8 * c), bq = *(const v4u*)(vp + 8 * c);
                    kv[8 * c + 0] = bflo(a.x); kv[8 * c + 1] = bfhi(a.x); kv[8 * c + 2] = bflo(a.y); kv[8 * c + 3] = bfhi(a.y); kv[8 * c + 4] = bflo(a.z); kv[8 * c + 5] = bfhi(a.z); kv[8 * c + 6] = bflo(a.w); kv[8 * c + 7] = bfhi(a.w);
                    vv[8 * c + 0] = bflo(bq.x); vv[8 * c + 1] = bfhi(bq.x); vv[8 * c + 2] = bflo(bq.y); vv[8 * c + 3] = bfhi(bq.y); vv[8 * c + 4] = bflo(bq.z); vv[8 * c + 5] = bfhi(bq.z); vv[8 * c + 6] = bflo(bq.w); vv[8 * c + 7] = bfhi(bq.w); }
            } else {
#pragma unroll
                for (int d = 0; d < 32; ++d) { kv[d] = 0.f; vv[d] = 0.f; }
            }
            float s = 0.f;
#pragma unroll
            for (int d = 0; d < 32; ++d) s += kv[d] * kv[d];
            s += __shfl_xor(s, 1);
            const float rstd = rsqrtf(s * (1.f / 64.f) + EPS);
#pragma unroll
            for (int d = 0; d < 32; ++d) { Ks[j * 68 + hf * 32 + d] = kv[d] * rstd * p.k_norm_w[hf * 32 + d]; Vs[j * 68 + hf * 32 + d] = vv[d]; }
        }
        __syncthreads();
        const int qi = tid & 127, grp = tid >> 7;
        const int tok = b * SEQ + n * 128 + qi;
        for (int hh = 0; hh < 2; ++hh) {
            const int hq = hk * 8 + grp * 2 + hh;
            float q[64];
            {
                const bf16* qp = proj + (size_t)tok * PROJ_LD + COL_Q + hq * 64;
                float s = 0.f;
#pragma unroll
                for (int c = 0; c < 8; ++c) { const v4u a = *(const v4u*)(qp + 8 * c);
                    q[8 * c + 0] = bflo(a.x); q[8 * c + 1] = bfhi(a.x); q[8 * c + 2] = bflo(a.y); q[8 * c + 3] = bfhi(a.y); q[8 * c + 4] = bflo(a.z); q[8 * c + 5] = bfhi(a.z); q[8 * c + 6] = bflo(a.w); q[8 * c + 7] = bfhi(a.w); }
#pragma unroll
                for (int d = 0; d < 64; ++d) s += q[d] * q[d];
                const float rstd = rsqrtf(s * (1.f / 64.f) + EPS) * 0.125f;
#pragma unroll
                for (int d = 0; d < 64; ++d) q[d] = q[d] * rstd * p.q_norm_w[d];
            }
            float mx = p.sinks[hq], l = 1.0f, o[64];
#pragma unroll
            for (int d = 0; d < 64; ++d) o[d] = 0.f;
            const int jlo = (n == 0) ? 128 : qi + 1;
            for (int j = jlo; j <= qi + 128; ++j) {
                const LAS f32x4* kr = (const LAS f32x4*)(Ks + j * 68);
                float s = 0.f;
#pragma unroll
                for (int c = 0; c < 16; ++c) { const f32x4 kk = kr[c]; s += q[4 * c] * kk[0] + q[4 * c + 1] * kk[1] + q[4 * c + 2] * kk[2] + q[4 * c + 3] * kk[3]; }
                const float mn = fmaxf(mx, s), corr = __expf(mx - mn), pj = __expf(s - mn);
                l = l * corr + pj; mx = mn;
                const LAS f32x4* vr = (const LAS f32x4*)(Vs + j * 68);
#pragma unroll
                for (int c = 0; c < 16; ++c) { const f32x4 vv = vr[c]; o[4 * c] = o[4 * c] * corr + pj * vv[0]; o[4 * c + 1] = o[4 * c + 1] * corr + pj * vv[1]; o[4 * c + 2] = o[4 * c + 2] * corr + pj * vv[2]; o[4 * c + 3] = o[4 * c + 3] * corr + pj * vv[3]; }
            }
            const float inv = 1.0f / l;
            float* op = att + (size_t)tok * 1024 + hq * 64;
#pragma unroll
            for (int c = 0; c < 16; ++c) *(f32x4*)(op + 4 * c) = (f32x4){o[4 * c] * inv, o[4 * c + 1] * inv, o[4 * c + 2] * inv, o[4 * c + 3] * inv};
        }
    }
}

__device__ __forceinline__ void phase_ssd_seq(const Params& p, LAS unsigned char* lds, int G) {
    const float* xbc = (const float*)(p.ws + WS_XBC); const float* dts = (const float*)(p.ws + WS_DTS); float* ys = (float*)(p.ws + WS_YS);
    constexpr int TT = 64;
    LAS float* Bs = (LAS float*)lds;
    LAS float* Cs = Bs + TT * 128;
    LAS float* xs = Cs + TT * 128;
    LAS float* dl = xs + TT * 16;
    LAS float* yo = dl + TT;
    const int tid = threadIdx.x, pl = tid >> 5, ns = tid & 31;
    for (int item = blockIdx.x; item < NB * 16 * 4; item += G) {
        const int b = item >> 6, h = (item >> 2) & 15, pq = item & 3, g = h >> 3;
        const float a = -__expf(p.a_log[h]), dsk = p.d_skip[h];
        f32x4 st = (f32x4){0.f, 0.f, 0.f, 0.f};
        for (int tc = 0; tc < SEQ; tc += TT) {
            __syncthreads();
            const size_t tb = (size_t)b * SEQ + tc;
            for (int i = tid; i < TT * 32; i += NTHREADS) { const int tt = i >> 5, c = (i & 31) * 4;
                *(LAS f32x4*)(Bs + tt * 128 + c) = *(const f32x4*)(xbc + (tb + tt) * NXBC + 1024 + g * 128 + c);
                *(LAS f32x4*)(Cs + tt * 128 + c) = *(const f32x4*)(xbc + (tb + tt) * NXBC + 1280 + g * 128 + c); }
            for (int i = tid; i < TT * 16; i += NTHREADS) { const int tt = i >> 4, c = i & 15; xs[i] = xbc[(tb + tt) * NXBC + h * 64 + pq * 16 + c]; }
            if (tid < TT) dl[tid] = dts[(tb + tid) * 16 + h];
            __syncthreads();
            for (int tt = 0; tt < TT; ++tt) {
                const float dt = dl[tt], xv = xs[tt * 16 + pl];
                const float dA = __expf(dt * a), xd = xv * dt;
                const f32x4 bv = *(const LAS f32x4*)(Bs + tt * 128 + ns * 4), cv = *(const LAS f32x4*)(Cs + tt * 128 + ns * 4);
                st = st * dA + bv * xd;
                float y = (cv[0] * st[0] + cv[1] * st[1]) + (cv[2] * st[2] + cv[3] * st[3]);
                y += __shfl_xor(y, 1); y += __shfl_xor(y, 2); y += __shfl_xor(y, 4); y += __shfl_xor(y, 8); y += __shfl_xor(y, 16);
                if (ns == 0) yo[tt * 16 + pl] = y + dsk * xv;
            }
            __syncthreads();
            for (int i = tid; i < TT * 16; i += NTHREADS) { const int tt = i >> 4, c = i & 15; ys[(tb + tt) * 1024 + h * 64 + pq * 16 + c] = yo[i]; }
        }
    }
}


typedef float f32x16 __attribute__((ext_vector_type(16)));
#define MFMA32(a, b, c) __builtin_amdgcn_mfma_f32_32x32x16_bf16(a, b, c, 0, 0, 0)
constexpr int SPT = 136;
__device__ __forceinline__ float softplus_f(float v) { return fmaxf(v, 0.f) + log1pf(__expf(-fabsf(v))); }

__device__ __forceinline__ void ssd_tables(const Params& p, LAS float* dtl, LAS float* csl, LAS float* wtot, size_t trow0, int h0, int nh, int lane, int wave) {
    const float* dtraw = (const float*)(p.ws + WS_DT);
    for (int rnd = 0; rnd < nh / 4; ++rnd) {
        const int hh = rnd * 4 + (wave >> 1), l = (wave & 1) * 64 + lane, h = h0 + hh;
        const float dt = softplus_f(dtraw[(trow0 + l) * 16 + h] + p.dt_bias[h]);
        float v = dt * (-expf(p.a_log[h]));
#pragma unroll
        for (int o = 1; o < 64; o <<= 1) { const float u = __shfl_up(v, o); v = (lane >= o) ? v + u : v; }
        if (lane == 63) wtot[rnd * 8 + wave] = v;
        __syncthreads();
        if (wave & 1) v += wtot[rnd * 8 + wave - 1];
        dtl[hh * 128 + l] = dt; csl[hh * 128 + l] = v;
    }
    __syncthreads();
}
template <bool TR, bool SCALE>
__device__ __forceinline__ void conv_task(const Params& p, const bf16* proj, size_t trow0, int tl0, int run, int xcol, LAS bf16* dst, int d0, const LAS float* sc) {
    float w[4][8], bb[8];
#pragma unroll
    for (int k = 0; k < 4; ++k) { const f32x4 a = *(const f32x4*)(p.conv_w + k * NXBC + xcol), b = *(const f32x4*)(p.conv_w + k * NXBC + xcol + 4);
        w[k][0] = a[0]; w[k][1] = a[1]; w[k][2] = a[2]; w[k][3] = a[3]; w[k][4] = b[0]; w[k][5] = b[1]; w[k][6] = b[2]; w[k][7] = b[3]; }
    { const f32x4 a = *(const f32x4*)(p.conv_b + xcol), b = *(const f32x4*)(p.conv_b + xcol + 4); bb[0] = a[0]; bb[1] = a[1]; bb[2] = a[2]; bb[3] = a[3]; bb[4] = b[0]; bb[5] = b[1]; bb[6] = b[2]; bb[7] = b[3]; }
    const int l0 = run * 8; const bf16* src = proj + (trow0 + l0) * PROJ_LD + COL_XBC + xcol;
    float r0[8], r1[8], r2[8];
    { const int pos = tl0 + l0; v4u q0 = (v4u){0u, 0u, 0u, 0u}, q1 = q0, q2 = q0;
      if (pos - 3 >= 0) q0 = *(const v4u*)(src - 3 * PROJ_LD);
      if (pos - 2 >= 0) q1 = *(const v4u*)(src - 2 * PROJ_LD);
      if (pos - 1 >= 0) q2 = *(const v4u*)(src - 1 * PROJ_LD);
      unpack8(q0, r0); unpack8(q1, r1); unpack8(q2, r2); }
#pragma unroll
    for (int i = 0; i < 8; i += 2) {
        float r3[8], r4[8], o0[8], o1[8];
        unpack8(*(const v4u*)(src + (size_t)i * PROJ_LD), r3); unpack8(*(const v4u*)(src + (size_t)(i + 1) * PROJ_LD), r4);
#pragma unroll
        for (int j = 0; j < 8; ++j) { const float a0 = bb[j] + w[0][j] * r0[j] + w[1][j] * r1[j] + w[2][j] * r2[j] + w[3][j] * r3[j];
            const float a1 = bb[j] + w[0][j] * r1[j] + w[1][j] * r2[j] + w[2][j] * r3[j] + w[3][j] * r4[j];
            o0[j] = a0 * fsigmoid(a0); o1[j] = a1 * fsigmoid(a1); }
        if constexpr (TR) {
            float s0 = 1.f, s1 = 1.f; if constexpr (SCALE) { s0 = sc[l0 + i]; s1 = sc[l0 + i + 1]; }
#pragma unroll
            for (int j = 0; j < 8; ++j) *(LAS unsigned*)(dst + (d0 + j) * SPT + l0 + i) = pk2(o0[j] * s0, o1[j] * s1);
        } else {
            *(LAS v4u*)(dst + (l0 + i) * SPT + d0) = (v4u){pk2(o0[0], o0[1]), pk2(o0[2], o0[3]), pk2(o0[4], o0[5]), pk2(o0[6], o0[7])};
            *(LAS v4u*)(dst + (l0 + i + 1) * SPT + d0) = (v4u){pk2(o1[0], o1[1]), pk2(o1[2], o1[3]), pk2(o1[4], o1[5]), pk2(o1[6], o1[7])};
        }
#pragma unroll
        for (int j = 0; j < 8; ++j) { r0[j] = r2[j]; r1[j] = r3[j]; r2[j] = r4[j]; }
    }
}

__device__ __forceinline__ void phase_ssd_states(const Params& p, LAS unsigned char* lds, int G, int lane, int wave) {
    const bf16* proj = (const bf16*)(p.ws + WS_PROJ); bf16* states = (bf16*)(p.ws + WS_STATES); float* cdec = (float*)(p.ws + WS_CDEC);
    LAS bf16* BT = (LAS bf16*)lds;
    LAS bf16* XdT = BT + 128 * SPT;
    LAS float* dtl = (LAS float*)(lds + 384 * SPT * 2);
    LAS float* csl = dtl + 512; LAS float* scl = csl + 512; LAS float* wtot = scl + 512;
    const int tid = threadIdx.x, r = lane & 31, hf = lane >> 5;
    for (int it2 = blockIdx.x * 2; it2 < NB * 64 * 4; it2 += ((it2 & 1) ? 2 * G - 1 : 1)) {
        const int item = it2;
        const int b = item >> 8, c = (item >> 2) & 63, g = (item >> 1) & 1, hh2 = item & 1;
        const int h0 = g * 8 + hh2 * 4; const size_t trow0 = (size_t)b * SEQ + c * 128; const int tl0 = c * 128;
        LDS_BARRIER();
        ssd_tables(p, dtl, csl, wtot, trow0, h0, 4, lane, wave);
        scl[tid] = dtl[tid] * __expf(csl[(tid & ~127) + 127] - csl[tid]);
        if ((tid & 127) == 127) cdec[((size_t)b * 64 + c) * 16 + h0 + (tid >> 7)] = __expf(csl[tid]);
        __syncthreads();
        for (int task = tid + (hh2 ? 256 : 0); task < 48 * 16; task += NTHREADS) { const int cg = task >> 4, run = task & 15;
            if (cg < 16) conv_task<true, false>(p, proj, trow0, tl0, run, 1024 + g * 128 + cg * 8, BT, cg * 8, nullptr);
            else { const int cx = cg - 16; conv_task<true, true>(p, proj, trow0, tl0, run, h0 * 64 + cx * 8, XdT, cx * 8, scl + (cx >> 3) * 128); } }
        __syncthreads();
        const int hh = wave >> 1, nh_ = wave & 1;
        f32x16 acc[2][2];
#pragma unroll
        for (int a = 0; a < 2; ++a)
#pragma unroll
            for (int bq = 0; bq < 2; ++bq)
#pragma unroll
                for (int e = 0; e < 16; ++e) acc[a][bq][e] = 0.f;
#pragma unroll
        for (int ks = 0; ks < 8; ++ks) {
            bf16x8 af[2], bfm[2];
#pragma unroll
            for (int pt = 0; pt < 2; ++pt) af[pt] = *(const LAS bf16x8*)(XdT + (hh * 64 + pt * 32 + r) * SPT + ks * 16 + 8 * hf);
#pragma unroll
            for (int nt = 0; nt < 2; ++nt) bfm[nt] = *(const LAS bf16x8*)(BT + (nh_ * 64 + nt * 32 + r) * SPT + ks * 16 + 8 * hf);
#pragma unroll
            for (int pt = 0; pt < 2; ++pt)
#pragma unroll
                for (int nt = 0; nt < 2; ++nt) acc[pt][nt] = MFMA32(bfm[nt], af[pt], acc[pt][nt]);
        }
        bf16* sp = states + (((size_t)b * 64 + c) * 16 + h0 + hh) * 64 * 128;
#pragma unroll
        for (int pt = 0; pt < 2; ++pt)
#pragma unroll
            for (int nt = 0; nt < 2; ++nt)
#pragma unroll
                for (int pp = 0; pp < 2; ++pp) {
                    const unsigned a0 = pk2(acc[pt][nt][8 * pp], acc[pt][nt][8 * pp + 1]), a1 = pk2(acc[pt][nt][8 * pp + 2], acc[pt][nt][8 * pp + 3]);
                    const unsigned b0 = pk2(acc[pt][nt][8 * pp + 4], acc[pt][nt][8 * pp + 5]), b1 = pk2(acc[pt][nt][8 * pp + 6], acc[pt][nt][8 * pp + 7]);
                    const v2u r0 = __builtin_amdgcn_permlane32_swap(a0, b0, false, false), r1 = __builtin_amdgcn_permlane32_swap(a1, b1, false, false);
                    *(v4u*)(sp + (pt * 32 + r) * 128 + nh_ * 64 + nt * 32 + 16 * pp + 8 * hf) = (v4u){r0.x, r1.x, r0.y, r1.y}; }
    }
}
__device__ __forceinline__ void phase_ssd_scan(const Params& p, int G) {
    const bf16* states = (const bf16*)(p.ws + WS_STATES); const float* cdec = (const float*)(p.ws + WS_CDEC); bf16* sin = (bf16*)(p.ws + WS_SIN);
    for (int idx = blockIdx.x * NTHREADS + threadIdx.x; idx < NB * 16 * 64 * 32; idx += G * NTHREADS) {
        const int n4 = idx & 31, pp = (idx >> 5) & 63, h = (idx >> 11) & 15, b = idx >> 15;
        f32x4 run = (f32x4){0.f, 0.f, 0.f, 0.f};
#pragma unroll 16
        for (int c = 0; c < 64; ++c) {
            const size_t off = ((((size_t)b * 64 + c) * 16 + h) * 64 + pp) * 128 + n4 * 4;
            const v2u sb = *(const v2u*)(states + off); const float dec = cdec[((size_t)b * 64 + c) * 16 + h];
            *(v2u*)(sin + off) = (v2u){pk2(run[0], run[1]), pk2(run[2], run[3])};
            run = run * dec + (f32x4){bflo(sb.x), bfhi(sb.x), bflo(sb.y), bfhi(sb.y)};
        }
    }
}
__device__ __forceinline__ void ssd_out_pass(const Params& p, const bf16* proj, const bf16* sinp  , const LAS bf16* Cs, const LAS bf16* CB, const LAS bf16* XT,
                                             const LAS float* dth, const LAS float* csh  , LAS float* ssqh  , float Dh, size_t trow0, int h, int hh, int lsel, int r, int hf,
                                             unsigned (&yp)[2][2][8]) {
    f32x16 acc[2][2];
#pragma unroll
    for (int a = 0; a < 2; ++a)
#pragma unroll
        for (int bq = 0; bq < 2; ++bq)
#pragma unroll
            for (int e = 0; e < 16; ++e) acc[a][bq][e] = 0.f;
#pragma unroll
    for (int pt = 0; pt < 2; ++pt) {
        bf16x8 af[8];
#pragma unroll
        for (int ks = 0; ks < 8; ++ks) af[ks] = *(const bf16x8*)(sinp + (pt * 32 + r) * 128 + ks * 16 + 8 * hf);
#pragma unroll
        for (int j = 0; j < 2; ++j) { const int lt = j == 0 ? (lsel ? 1 : 0) : (lsel ? 2 : 3);
#pragma unroll
            for (int ks = 0; ks < 8; ++ks) { const bf16x8 bq = *(const LAS bf16x8*)(Cs + (lt * 32 + r) * SPT + ks * 16 + 8 * hf); acc[pt][j] = MFMA32(af[ks], bq, acc[pt][j]); } }
    }
#pragma unroll
    for (int j = 0; j < 2; ++j) { const int lt = j == 0 ? (lsel ? 1 : 0) : (lsel ? 2 : 3); const float el = __expf(csh[lt * 32 + r]);
#pragma unroll
        for (int pt = 0; pt < 2; ++pt) acc[pt][j] = acc[pt][j] * el; }
#pragma unroll
    for (int j = 0; j < 2; ++j) { const int lt = j == 0 ? (lsel ? 1 : 0) : (lsel ? 2 : 3); const int lcol = lt * 32 + r; const float csL = csh[lcol]; const int nks = 2 * lt + 2;
        for (int ks = 0; ks < nks; ++ks) { const int s0 = ks * 16 + 8 * hf;
            const v4u cbv = *(const LAS v4u*)(CB + lcol * SPT + s0);
            const f32x4 c0 = *(const LAS f32x4*)(csh + s0), c1 = *(const LAS f32x4*)(csh + s0 + 4), d0 = *(const LAS f32x4*)(dth + s0), d1 = *(const LAS f32x4*)(dth + s0 + 4);
            float cbf[8]; unpack8(cbv, cbf); float m[8];
#pragma unroll
            for (int jj = 0; jj < 8; ++jj) { const float cs_s = jj < 4 ? c0[jj & 3] : c1[jj & 3], dt_s = jj < 4 ? d0[jj & 3] : d1[jj & 3];
                float v = cbf[jj] * __expf(fminf(csL - cs_s, 0.f)) * dt_s; v = (s0 + jj <= lcol) ? v : 0.f; m[jj] = (s0 + jj == lcol) ? v + Dh : v; }
            v4u mp; mp.x = pk2(m[0], m[1]); mp.y = pk2(m[2], m[3]); mp.z = pk2(m[4], m[5]); mp.w = pk2(m[6], m[7]);
            const bf16x8 mf = __builtin_bit_cast(bf16x8, mp);
#pragma unroll
            for (int pt = 0; pt < 2; ++pt) { const bf16x8 a = *(const LAS bf16x8*)(XT + (hh * 64 + pt * 32 + r) * SPT + s0); acc[pt][j] = MFMA32(a, mf, acc[pt][j]); }
        } }
#pragma unroll
    for (int j = 0; j < 2; ++j) { const int lt = j == 0 ? (lsel ? 1 : 0) : (lsel ? 2 : 3); const size_t t = trow0 + lt * 32 + r; float ss = 0.f;
#pragma unroll
        for (int pt = 0; pt < 2; ++pt)
#pragma unroll
            for (int pp = 0; pp < 2; ++pp) {
                const v4u z16 = *(const v4u*)(proj + t * PROJ_LD + COL_Z + h * 64 + pt * 32 + 16 * pp + 8 * hf);
                const v2u s0 = __builtin_amdgcn_permlane32_swap(z16.x, z16.z, false, false), s1 = __builtin_amdgcn_permlane32_swap(z16.y, z16.w, false, false);
#pragma unroll
                for (int qq = 0; qq < 2; ++qq) { const int q = 2 * pp + qq; const unsigned zx = qq == 0 ? s0.x : s0.y, zy = qq == 0 ? s1.x : s1.y;
                    const float z0 = bflo(zx), z1 = bfhi(zx), z2 = bflo(zy), z3 = bfhi(zy);
                    const float g0 = acc[pt][j][4 * q] * (z0 * fsigmoid(z0)), g1 = acc[pt][j][4 * q + 1] * (z1 * fsigmoid(z1)), g2 = acc[pt][j][4 * q + 2] * (z2 * fsigmoid(z2)), g3 = acc[pt][j][4 * q + 3] * (z3 * fsigmoid(z3));
                    yp[pt][j][2 * q] = pk2(g0, g1); yp[pt][j][2 * q + 1] = pk2(g2, g3);
                    ss += (g0 * g0 + g1 * g1) + (g2 * g2 + g3 * g3); } }
        ss += __shfl_xor(ss, 32);
        if (hf == 0) ssqh[lt * 32 + r] = ss; }
}
__device__ __forceinline__ void ssd_out_store(const Params& p, bf16* mix, const LAS float* ssqp, size_t trow0, int h, int lsel, int r, int hf, const unsigned (&yp)[2][2][8]) {
    f32x4 w4[2][4];
#pragma unroll
    for (int pt = 0; pt < 2; ++pt)
#pragma unroll
        for (int q = 0; q < 4; ++q) w4[pt][q] = *(const f32x4*)(p.ssm_norm_w + h * 64 + pt * 32 + 8 * q + 4 * hf);
#pragma unroll
    for (int pt = 0; pt < 2; ++pt) { asm volatile("" : "+v"(w4[pt][0]), "+v"(w4[pt][1]), "+v"(w4[pt][2]), "+v"(w4[pt][3])); }
#pragma unroll
    for (int j = 0; j < 2; ++j) { const int lt = j == 0 ? (lsel ? 1 : 0) : (lsel ? 2 : 3); const int l = lt * 32 + r; const size_t t = trow0 + l;
        float tot = 0.f;
#pragma unroll
        for (int hd = 0; hd < 8; ++hd) tot += ssqp[hd * 128 + l];
        const float rstd = rsqrtf(tot * (1.f / 512.f) + EPS);
#pragma unroll
#if OUTPROJ_F8
        for (int pt = 0; pt < 2; ++pt) { unsigned dq[4]; const float rs = rstd * FP8_SA;
#pragma unroll
            for (int q = 0; q < 4; ++q) { const unsigned u0 = yp[pt][j][2 * q], u1 = yp[pt][j][2 * q + 1];
                dq[q] = pk4_fp8(sat8(bflo(u0) * rs * w4[pt][q][0]), sat8(bfhi(u0) * rs * w4[pt][q][1]), sat8(bflo(u1) * rs * w4[pt][q][2]), sat8(bfhi(u1) * rs * w4[pt][q][3])); }
            const v2u r0 = __builtin_amdgcn_permlane32_swap(dq[0], dq[2], false, false), r1 = __builtin_amdgcn_permlane32_swap(dq[1], dq[3], false, false);
            *(v4u*)((unsigned char*)mix + t * 2048 + 1024 + h * 64 + pt * 32 + 16 * hf) = (v4u){r0.x, r0.y, r1.x, r1.y}; }
#else
        for (int pt = 0; pt < 2; ++pt)
#pragma unroll
            for (int pp = 0; pp < 2; ++pp) { unsigned oa[2], ob[2];
#pragma unroll
                for (int qq = 0; qq < 2; ++qq) { const int q = 2 * pp + qq; const unsigned u0 = yp[pt][j][2 * q], u1 = yp[pt][j][2 * q + 1];
                    const unsigned x0 = pk2(bflo(u0) * rstd * w4[pt][q][0], bfhi(u0) * rstd * w4[pt][q][1]), x1 = pk2(bflo(u1) * rstd * w4[pt][q][2], bfhi(u1) * rstd * w4[pt][q][3]);
                    if (qq == 0) { oa[0] = x0; oa[1] = x1; } else { ob[0] = x0; ob[1] = x1; } }
                const v2u r0 = __builtin_amdgcn_permlane32_swap(oa[0], ob[0], false, false), r1 = __builtin_amdgcn_permlane32_swap(oa[1], ob[1], false, false);
                *(v4u*)(mix + t * D + 1024 + h * 64 + pt * 32 + 16 * pp + 8 * hf) = (v4u){r0.x, r1.x, r0.y, r1.y}; }
#endif
    }
}
__device__ __forceinline__ void phase_ssd_out(const Params& p, LAS unsigned char* lds, int G, int lane, int wave) {
    const bf16* proj = (const bf16*)(p.ws + WS_PROJ); const bf16* sin = (const bf16*)(p.ws + WS_SIN); bf16* mix = (bf16*)(p.ws + WS_MIX);
    LAS bf16* Cs = (LAS bf16*)lds;
    LAS bf16* Bs = Cs + 128 * SPT;
    LAS bf16* XT = Bs + 128 * SPT;
    LAS float* dtl = (LAS float*)(lds + 512 * SPT * 2);
    LAS float* csl = dtl + 1024; LAS float* ssqp = csl + 1024; LAS float* wtot = ssqp + 1024;
    const int tid = threadIdx.x, r = lane & 31, hf = lane >> 5;
    for (int item = blockIdx.x; item < NB * 64 * 2; item += G) {
        const int b = item >> 7, c = (item >> 1) & 63, g = item & 1;
        const int h0 = g * 8; const size_t trow0 = (size_t)b * SEQ + c * 128; const int tl0 = c * 128;
        __syncthreads();
        { int tz_ = threadIdx.x; asm volatile("" : "+v"(tz_)); ssd_tables(p, dtl, csl, wtot, trow0, h0, 8, tz_ & 63, __builtin_amdgcn_readfirstlane(tz_ >> 6)); }
        int tq = threadIdx.x; asm volatile("" : "+v"(tq));
        for (int task = tq; task < 64 * 16; task += NTHREADS) { const int cg = task >> 4, run = task & 15;
            if (cg < 16) conv_task<false, false>(p, proj, trow0, tl0, run, 1280 + g * 128 + cg * 8, Cs, cg * 8, nullptr);
            else if (cg < 32) conv_task<false, false>(p, proj, trow0, tl0, run, 1024 + g * 128 + (cg - 16) * 8, Bs, (cg - 16) * 8, nullptr);
            else conv_task<true, false>(p, proj, trow0, tl0, run, h0 * 64 + (cg - 32) * 8, XT, (cg - 32) * 8, nullptr); }
        __syncthreads();
        {
            int tz_ = threadIdx.x; asm volatile("" : "+v"(tz_)); const int wave = __builtin_amdgcn_readfirstlane(tz_ >> 6), r = tz_ & 31, hf = (tz_ >> 5) & 1;
            f32x16 cb[2];
#pragma unroll
            for (int q = 0; q < 2; ++q) { const int tile = 2 * wave + q, lt = tile >> 2, st = tile & 3;
#pragma unroll
                for (int e = 0; e < 16; ++e) cb[q][e] = 0.f;
                if (st <= lt) {
#pragma unroll
                    for (int ks = 0; ks < 8; ++ks) { const bf16x8 a = *(const LAS bf16x8*)(Cs + (lt * 32 + r) * SPT + ks * 16 + 8 * hf), bq = *(const LAS bf16x8*)(Bs + (st * 32 + r) * SPT + ks * 16 + 8 * hf);
                        cb[q] = MFMA32(a, bq, cb[q]); } } }
            __syncthreads();
#pragma unroll
            for (int q = 0; q < 2; ++q) { const int tile = 2 * wave + q, lt = tile >> 2, st = tile & 3;
                if (st <= lt) {
#pragma unroll
                    for (int e = 0; e < 16; ++e) Bs[(lt * 32 + (e & 3) + 8 * (e >> 2) + 4 * hf) * SPT + st * 32 + r] = (bf16)f2bf(cb[q][e]); } }
        }
        __syncthreads();
        unsigned y0[2][2][8], y1[2][2][8];
#define FRESH_IDS() int tz_ = threadIdx.x; asm volatile("" : "+v"(tz_)); const int wv_ = __builtin_amdgcn_readfirstlane(tz_ >> 6), hh = wv_ >> 1, lsel = wv_ & 1, r_ = tz_ & 31, hf_ = (tz_ >> 5) & 1
        { FRESH_IDS(); const int h = h0 + hh;
          ssd_out_pass(p, proj, sin + (((size_t)b * 64 + c) * 16 + h) * 64 * 128, Cs, Bs, XT, dtl + hh * 128, csl + hh * 128, ssqp + hh * 128, p.d_skip[h], trow0, h, hh, lsel, r_, hf_, y0); }
        __syncthreads();
        { int tz_ = threadIdx.x; asm volatile("" : "+v"(tz_)); const int cg = tz_ >> 4, run = tz_ & 15; conv_task<true, false>(p, proj, trow0, tl0, run, (h0 + 4) * 64 + cg * 8, XT, cg * 8, nullptr); }
        __syncthreads();
        { FRESH_IDS(); const int h = h0 + 4 + hh;
          ssd_out_pass(p, proj, sin + (((size_t)b * 64 + c) * 16 + h) * 64 * 128, Cs, Bs, XT, dtl + (4 + hh) * 128, csl + (4 + hh) * 128, ssqp + (4 + hh) * 128, p.d_skip[h], trow0, h, hh, lsel, r_, hf_, y1); }
        __syncthreads();
        { FRESH_IDS(); ssd_out_store(p, mix, ssqp, trow0, h0 + hh, lsel, r_, hf_, y0); }
        { FRESH_IDS(); ssd_out_store(p, mix, ssqp, trow0, h0 + 4 + hh, lsel, r_, hf_, y1); }
#undef FRESH_IDS
    }
}


__device__ __forceinline__ void phase_attn(const Params& p, LAS unsigned char* lds, int G) {
    const bf16* proj = (const bf16*)(p.ws + WS_PROJ); bf16* mix = (bf16*)(p.ws + WS_MIX);
    bf16* att = OUTPROJ_F8 ? (bf16*)(p.ws + WS_ATT) : mix; constexpr size_t ALD = OUTPROJ_F8 ? 1024 : D;
    constexpr int KP = 72, VP = 260; constexpr float NEG = -1.0e30f;
    LAS bf16* Ks = (LAS bf16*)lds;
    LAS bf16* VT = Ks + 2 * 256 * KP;
    LAS float* ssqp = (LAS float*)(lds + 2 * 256 * KP * 2 + 2 * 64 * VP * 2);
    for (int item = blockIdx.x; item < NB * 64; item += G) {
        const int b = item >> 6, n = item & 63;
        __syncthreads();
        {
            int tz = threadIdx.x; asm volatile("" : "+v"(tz));
            const int j = tz >> 1, hk = tz & 1, pos = n * 128 - 128 + j;
            LAS bf16* kd = Ks + (hk * 256 + j) * KP; LAS bf16* vd = VT + hk * 64 * VP + j;
            if (pos >= 0) {
                const bf16* kp = proj + (size_t)(b * SEQ + pos) * PROJ_LD + COL_K + hk * 64;
                v4u kq[8]; float ss = 0.f;
#pragma unroll
                for (int c = 0; c < 8; ++c) { kq[c] = *(const v4u*)(kp + 8 * c); float f[8]; unpack8(kq[c], f);
#pragma unroll
                    for (int e = 0; e < 8; ++e) ss += f[e] * f[e]; }
                const float rstd = rsqrtf(ss * (1.f / 64.f) + EPS);
#pragma unroll
                for (int c = 0; c < 8; ++c) { float f[8]; unpack8(kq[c], f); const f32x4 w0 = *(const f32x4*)(p.k_norm_w + 8 * c), w1 = *(const f32x4*)(p.k_norm_w + 8 * c + 4);
                    *(LAS v4u*)(kd + 8 * c) = (v4u){pk2(f[0] * rstd * w0[0], f[1] * rstd * w0[1]), pk2(f[2] * rstd * w0[2], f[3] * rstd * w0[3]), pk2(f[4] * rstd * w1[0], f[5] * rstd * w1[1]), pk2(f[6] * rstd * w1[2], f[7] * rstd * w1[3])}; }
                const bf16* vp = kp + (COL_V - COL_K);
#pragma unroll
                for (int c = 0; c < 8; ++c) { const v4u q = *(const v4u*)(vp + 8 * c);
                    vd[(8 * c + 0) * VP] = (bf16)(q.x & 0xffffu); vd[(8 * c + 1) * VP] = (bf16)(q.x >> 16); vd[(8 * c + 2) * VP] = (bf16)(q.y & 0xffffu); vd[(8 * c + 3) * VP] = (bf16)(q.y >> 16);
                    vd[(8 * c + 4) * VP] = (bf16)(q.z & 0xffffu); vd[(8 * c + 5) * VP] = (bf16)(q.z >> 16); vd[(8 * c + 6) * VP] = (bf16)(q.w & 0xffffu); vd[(8 * c + 7) * VP] = (bf16)(q.w >> 16); }
            } else {
#pragma unroll
                for (int c = 0; c < 8; ++c) *(LAS v4u*)(kd + 8 * c) = (v4u){0u, 0u, 0u, 0u};
#pragma unroll
                for (int d = 0; d < 64; ++d) vd[d * VP] = (bf16)0;
            }
        }
        __syncthreads();
        {
            int tz = threadIdx.x; asm volatile("" : "+v"(tz));
            const int wave = __builtin_amdgcn_readfirstlane(tz >> 6), r = tz & 31, hf = (tz >> 5) & 1, hk = wave >> 2, wl = wave & 3;
            const LAS bf16* Kh = Ks + hk * 256 * KP; const LAS bf16* Vh = VT + hk * 64 * VP;
            f32x4 qw[4][2];
#pragma unroll
            for (int ks = 0; ks < 4; ++ks) { qw[ks][0] = *(const f32x4*)(p.q_norm_w + 16 * ks + 8 * hf); qw[ks][1] = *(const f32x4*)(p.q_norm_w + 16 * ks + 8 * hf + 4); }
            v4u qn[4];
            { const bf16* qp0 = proj + ((size_t)b * SEQ + n * 128 + r) * PROJ_LD + COL_Q + (hk * 8 + wl * 2) * 64 + 8 * hf;
#pragma unroll
              for (int ks = 0; ks < 4; ++ks) qn[ks] = *(const v4u*)(qp0 + 16 * ks); }
            for (int it = 0; it < 8; ++it) {
                const int hsel = it >> 2, qt = it & 3;
                const int hq = hk * 8 + wl * 2 + hsel; const float sink = p.sinks[hq] * 1.44269504f;
                {
                    const size_t tok = (size_t)b * SEQ + n * 128 + qt * 32 + r;
                    bf16x8 qf[4];
                    {
                        v4u qv[4]; float ss = 0.f;
#pragma unroll
                        for (int ks = 0; ks < 4; ++ks) { qv[ks] = qn[ks]; float f[8]; unpack8(qv[ks], f);
#pragma unroll
                            for (int e = 0; e < 8; ++e) ss += f[e] * f[e]; }
                        if (it < 7) { const int it2 = it + 1, hq2 = hk * 8 + wl * 2 + (it2 >> 2);
                            const bf16* qp2 = proj + ((size_t)b * SEQ + n * 128 + (it2 & 3) * 32 + r) * PROJ_LD + COL_Q + hq2 * 64 + 8 * hf;
#pragma unroll
                            for (int ks = 0; ks < 4; ++ks) qn[ks] = *(const v4u*)(qp2 + 16 * ks); }
                        ss += __shfl_xor(ss, 32);
                        const float rstd = rsqrtf(ss * (1.f / 64.f) + EPS) * (0.125f * 1.44269504f);
#pragma unroll
                        for (int ks = 0; ks < 4; ++ks) { float f[8]; unpack8(qv[ks], f); const f32x4 w0 = qw[ks][0], w1 = qw[ks][1];
                            const v4u o = (v4u){pk2(f[0] * rstd * w0[0], f[1] * rstd * w0[1]), pk2(f[2] * rstd * w0[2], f[3] * rstd * w0[3]), pk2(f[4] * rstd * w1[0], f[5] * rstd * w1[1]), pk2(f[6] * rstd * w1[2], f[7] * rstd * w1[3])};
                            qf[ks] = __builtin_bit_cast(bf16x8, o); }
                    }
                    f32x16 sc[5];
#pragma unroll
                    for (int jt = 0; jt < 5; ++jt) {
#pragma unroll
                        for (int e = 0; e < 16; ++e) sc[jt][e] = 0.f;
#pragma unroll
                        for (int ks = 0; ks < 4; ++ks) { const bf16x8 a = *(const LAS bf16x8*)(Kh + ((qt + jt) * 32 + r) * KP + ks * 16 + 8 * hf); sc[jt] = MFMA32(a, qf[ks], sc[jt]); } }
#pragma unroll
                    for (int e = 0; e < 16; ++e) { const int kk = (e & 3) + 8 * (e >> 2) + 4 * hf;
                        sc[0][e] = (kk > r) ? sc[0][e] : NEG; sc[4][e] = (kk <= r) ? sc[4][e] : NEG; }
                    if (n == 0) {
#pragma unroll
                        for (int jt = 0; jt < 4; ++jt) if (qt + jt < 4) {
#pragma unroll
                            for (int e = 0; e < 16; ++e) sc[jt][e] = NEG; } }
                    float m = sink;
#pragma unroll
                    for (int jt = 0; jt < 5; ++jt)
#pragma unroll
                        for (int e = 0; e < 16; ++e) m = fmaxf(m, sc[jt][e]);
                    m = fmaxf(m, __shfl_xor(m, 32));
                    float l = 0.f;
#pragma unroll
                    for (int jt = 0; jt < 5; ++jt)
#pragma unroll
                        for (int e = 0; e < 16; ++e) { const float pv = __builtin_amdgcn_exp2f(sc[jt][e] - m); sc[jt][e] = pv; l += pv; }
                    l += __shfl_xor(l, 32); l += __builtin_amdgcn_exp2f(sink - m);
                    f32x16 o[2];
#pragma unroll
                    for (int dt = 0; dt < 2; ++dt)
#pragma unroll
                        for (int e = 0; e < 16; ++e) o[dt][e] = 0.f;
#pragma unroll
                    for (int jt = 0; jt < 5; ++jt)
#pragma unroll
                        for (int s2 = 0; s2 < 2; ++s2) {
                            const v4u pp = (v4u){pk2(sc[jt][8 * s2], sc[jt][8 * s2 + 1]), pk2(sc[jt][8 * s2 + 2], sc[jt][8 * s2 + 3]), pk2(sc[jt][8 * s2 + 4], sc[jt][8 * s2 + 5]), pk2(sc[jt][8 * s2 + 6], sc[jt][8 * s2 + 7])};
                            const bf16x8 pf = __builtin_bit_cast(bf16x8, pp);
                            const int kb = (qt + jt) * 32 + 16 * s2 + 4 * hf;
#pragma unroll
                            for (int dt = 0; dt < 2; ++dt) { const LAS bf16* vr = Vh + (dt * 32 + r) * VP + kb;
                                const v2u a0 = *(const LAS v2u*)vr, a1 = *(const LAS v2u*)(vr + 8);
                                const v4u av = (v4u){a0.x, a0.y, a1.x, a1.y};
                                o[dt] = MFMA32(__builtin_bit_cast(bf16x8, av), pf, o[dt]); }
                        }
                    const float inv = 1.0f / l; float ss = 0.f;
#pragma unroll
                    for (int dt = 0; dt < 2; ++dt)
#pragma unroll
                        for (int pp = 0; pp < 2; ++pp) {
                            unsigned pa[2], pb[2];
#pragma unroll
                            for (int qq = 0; qq < 2; ++qq) { const int q = 2 * pp + qq; const float g0 = o[dt][4 * q] * inv, g1 = o[dt][4 * q + 1] * inv, g2 = o[dt][4 * q + 2] * inv, g3 = o[dt][4 * q + 3] * inv;
                                ss += (g0 * g0 + g1 * g1) + (g2 * g2 + g3 * g3);
                                if (qq == 0) { pa[0] = pk2(g0, g1); pa[1] = pk2(g2, g3); } else { pb[0] = pk2(g0, g1); pb[1] = pk2(g2, g3); } }
                            const v2u r0 = __builtin_amdgcn_permlane32_swap(pa[0], pb[0], false, false), r1 = __builtin_amdgcn_permlane32_swap(pa[1], pb[1], false, false);
                            *(v4u*)(att + tok * ALD + hq * 64 + dt * 32 + 16 * pp + 8 * hf) = (v4u){r0.x, r1.x, r0.y, r1.y}; }
                    ss += __shfl_xor(ss, 32);
                    if (hf == 0) ssqp[hq * 128 + qt * 32 + r] = ss;
                }
            }
        }
        __syncthreads();
        {
            int tz = threadIdx.x; asm volatile("" : "+v"(tz));
            const int wave = __builtin_amdgcn_readfirstlane(tz >> 6), r = tz & 31, hf = (tz >> 5) & 1, hk = wave >> 2, wl = wave & 3;
            for (int qt = 0; qt < 4; ++qt) {
                const size_t tok = (size_t)b * SEQ + n * 128 + qt * 32 + r;
                float tot = 0.f;
#pragma unroll
                for (int hd = 0; hd < 16; ++hd) tot += ssqp[hd * 128 + qt * 32 + r];
                const float rstd = rsqrtf(tot * (1.f / 1024.f) + EPS);
                v4u uu[2][2][2];
#pragma unroll
                for (int hsel = 0; hsel < 2; ++hsel)
#pragma unroll
                    for (int dt = 0; dt < 2; ++dt)
#pragma unroll
                        for (int pp = 0; pp < 2; ++pp) uu[hsel][dt][pp] = *(const v4u*)(att + tok * ALD + (hk * 8 + wl * 2 + hsel) * 64 + dt * 32 + 16 * pp + 8 * hf);
#pragma unroll
                for (int hsel = 0; hsel < 2; ++hsel)
#pragma unroll
                    for (int dt = 0; dt < 2; ++dt) { asm volatile("" : "+v"(uu[hsel][dt][0]), "+v"(uu[hsel][dt][1])); }
#if OUTPROJ_F8
#pragma unroll
                for (int hsel = 0; hsel < 2; ++hsel)
#pragma unroll
                    for (int dt = 0; dt < 2; ++dt) { unsigned fa[2], fb[2]; const float rs = rstd * FP8_SA;
#pragma unroll
                        for (int pp = 0; pp < 2; ++pp) { const int col = (hk * 8 + wl * 2 + hsel) * 64 + dt * 32 + 16 * pp + 8 * hf;
                            const v4u u = uu[hsel][dt][pp]; const f32x4 w0 = *(const f32x4*)(p.attn_out_norm_w + col), w1 = *(const f32x4*)(p.attn_out_norm_w + col + 4);
                            const unsigned d0 = pk4_fp8(sat8(bflo(u.x) * rs * w0[0]), sat8(bfhi(u.x) * rs * w0[1]), sat8(bflo(u.y) * rs * w0[2]), sat8(bfhi(u.y) * rs * w0[3]));
                            const unsigned d1 = pk4_fp8(sat8(bflo(u.z) * rs * w1[0]), sat8(bfhi(u.z) * rs * w1[1]), sat8(bflo(u.w) * rs * w1[2]), sat8(bfhi(u.w) * rs * w1[3]));
                            if (pp == 0) { fa[0] = d0; fa[1] = d1; } else { fb[0] = d0; fb[1] = d1; } }
                        const v2u r0 = __builtin_amdgcn_permlane32_swap(fa[0], fb[0], false, false), r1 = __builtin_amdgcn_permlane32_swap(fa[1], fb[1], false, false);
                        *(v4u*)((unsigned char*)mix + tok * 2048 + (hk * 8 + wl * 2 + hsel) * 64 + dt * 32 + 16 * hf) = (v4u){r0.x, r1.x, r0.y, r1.y}; }
#else
#pragma unroll
                for (int hsel = 0; hsel < 2; ++hsel)
#pragma unroll
                    for (int dt = 0; dt < 2; ++dt)
#pragma unroll
                        for (int pp = 0; pp < 2; ++pp) { const int col = (hk * 8 + wl * 2 + hsel) * 64 + dt * 32 + 16 * pp + 8 * hf;
                            const v4u u = uu[hsel][dt][pp]; const f32x4 w0 = *(const f32x4*)(p.attn_out_norm_w + col), w1 = *(const f32x4*)(p.attn_out_norm_w + col + 4);
                            *(v4u*)(mix + tok * D + col) = (v4u){pk2(bflo(u.x) * rstd * w0[0], bfhi(u.x) * rstd * w0[1]), pk2(bflo(u.y) * rstd * w0[2], bfhi(u.y) * rstd * w0[3]),
                                                                 pk2(bflo(u.z) * rstd * w1[0], bfhi(u.z) * rstd * w1[1]), pk2(bflo(u.w) * rstd * w1[2], bfhi(u.w) * rstd * w1[3])}; }
#endif
            }
        }
    }
}

__device__ __forceinline__ void phase_router(const Params& p, LAS unsigned char* lds, unsigned* ctl, int G, int wave, int lane) {
    const bf16* x1 = (const bf16*)(p.ws + WS_X1); const float* ssq = (const float*)(p.ws + WS_SSQ); unsigned char* hf = p.ws + WS_HF;
    int* stok = (int*)(p.ws + WS_STOK); float* sgate = (float*)(p.ws + WS_SGATE); int* toke = (int*)(p.ws + WS_TOKE); int* tokp = (int*)(p.ws + WS_TOKP);
    LAS float* lg = (LAS float*)lds + wave * (16 * 33);
    LAS int* hist = (LAS int*)(lds + 32768); LAS int* gbase = hist + 32;
    const int tid = threadIdx.x, i16 = lane & 15, kq = lane >> 4;
    LAS unsigned char* wring = lds + 65536; LAS float* fnw = (LAS float*)(lds + 98304);
    const unsigned char* wsrc = p.ws + WS_WRB + (size_t)wave * 1024 + lane * 16;
    __syncthreads();
    ((LAS f32x4*)fnw)[tid] = ((const f32x4*)p.ffn_norm_w)[tid];
#define RT_DMA(c) do { _Pragma("unroll") for (int _i = 0; _i < 2; ++_i) __builtin_amdgcn_global_load_lds((const unsigned*)(wsrc + (size_t)(c) * 16384 + _i * 8192), (LAS unsigned*)(wring + ((c) & 1) * 16384 + wave * 1024 + _i * 8192), 16, 0, 0); \
        asm volatile("" ::: "memory"); } while (0)
    for (int tb = blockIdx.x * 8; tb < T / 16; tb += G * 8) {
        if (tid < 32) hist[tid] = 0;
        RT_DMA(0);
        __syncthreads();
        const int tok = (tb + wave) * 16 + i16;
        float s = 0.f;
        { const f32x4* sp = (const f32x4*)(ssq + (size_t)tok * 32 + kq * 8); const f32x4 a = sp[0], b = sp[1]; s = ((a[0] + a[1]) + (a[2] + a[3])) + ((b[0] + b[1]) + (b[2] + b[3])); }
        s += __shfl_xor(s, 16); s += __shfl_xor(s, 32);
        const float rstd = rsqrtf(s * (1.f / D) + EPS);
        f32x4 acc0 = (f32x4){0.f, 0.f, 0.f, 0.f}, acc1 = (f32x4){0.f, 0.f, 0.f, 0.f};
        const bf16* xr = x1 + (size_t)tok * D + 8 * kq;
        unsigned char* hr = hf + (size_t)tok * D + 8 * kq;
        v4u xq[4];
#pragma unroll
        for (int u = 0; u < 4; ++u) xq[u] = *(const v4u*)(xr + 32 * u);
        unsigned hlo = 0, hhi = 0;
        asm volatile("s_waitcnt vmcnt(0)" ::: "memory");
        __syncthreads();
        for (int j4 = 0; j4 < 64; j4 += 4) {
            f32x4 xc[4][2], gq[4][2]; v4u wf[4][2][2];
            const LAS v4u* wl = (const LAS v4u*)(wring + ((j4 >> 2) & 1) * 16384) + lane;
#pragma unroll
            for (int u = 0; u < 4; ++u) { float f[8]; unpack8(xq[u], f); xc[u][0] = (f32x4){f[0], f[1], f[2], f[3]}; xc[u][1] = (f32x4){f[4], f[5], f[6], f[7]}; }
            if (j4 + 4 < 64) {
#pragma unroll
                for (int u = 0; u < 4; ++u) xq[u] = *(const v4u*)(xr + 32 * (j4 + 4 + u)); }
#pragma unroll
            for (int u = 0; u < 4; ++u) { gq[u][0] = *(const LAS f32x4*)(fnw + 32 * (j4 + u) + 8 * kq); gq[u][1] = *(const LAS f32x4*)(fnw + 32 * (j4 + u) + 8 * kq + 4);
#pragma unroll
                for (int hfl = 0; hfl < 2; ++hfl)
#pragma unroll
                    for (int hl = 0; hl < 2; ++hl) wf[u][hfl][hl] = wl[((u * 2 + hfl) * 2 + hl) * 64]; }
            asm volatile("" ::: "memory");
            if (j4 + 4 < 64) RT_DMA((j4 >> 2) + 1);
#pragma unroll
            for (int u = 0; u < 4; ++u) {
                float hv[8];
#pragma unroll
                for (int k = 0; k < 4; ++k) { hv[k] = xc[u][0][k] * rstd * gq[u][0][k]; hv[4 + k] = xc[u][1][k] * rstd * gq[u][1][k]; }
                { const unsigned flo = pk4_fp8(sat8(hv[0] * FP8_SA), sat8(hv[1] * FP8_SA), sat8(hv[2] * FP8_SA), sat8(hv[3] * FP8_SA)), fhi = pk4_fp8(sat8(hv[4] * FP8_SA), sat8(hv[5] * FP8_SA), sat8(hv[6] * FP8_SA), sat8(hv[7] * FP8_SA));
                  if ((u & 1) == 0) { hlo = flo; hhi = fhi; }
                  else { const v2u r0 = __builtin_amdgcn_permlane16_swap(hlo, flo, false, false), r1 = __builtin_amdgcn_permlane16_swap(hhi, fhi, false, false);
                         *(v4u*)(hf + (size_t)tok * D + 32 * (j4 + u - 1 + (kq & 1)) + 16 * (kq >> 1)) = (v4u){r0.x, r1.x, r0.y, r1.y}; } }
                v4u ah, al;
                ah.x = pk2(hv[0], hv[1]); ah.y = pk2(hv[2], hv[3]); ah.z = pk2(hv[4], hv[5]); ah.w = pk2(hv[6], hv[7]);
                al.x = pk2(hv[0] - bflo(ah.x), hv[1] - bfhi(ah.x)); al.y = pk2(hv[2] - bflo(ah.y), hv[3] - bfhi(ah.y)); al.z = pk2(hv[4] - bflo(ah.z), hv[5] - bfhi(ah.z)); al.w = pk2(hv[6] - bflo(ah.w), hv[7] - bfhi(ah.w));
                const bf16x8 fah = __builtin_bit_cast(bf16x8, ah), fal = __builtin_bit_cast(bf16x8, al);
                acc0 = __builtin_amdgcn_mfma_f32_16x16x32_bf16(fah, __builtin_bit_cast(bf16x8, wf[u][0][0]), acc0, 0, 0, 0);
                acc0 = __builtin_amdgcn_mfma_f32_16x16x32_bf16(fah, __builtin_bit_cast(bf16x8, wf[u][0][1]), acc0, 0, 0, 0);
                acc0 = __builtin_amdgcn_mfma_f32_16x16x32_bf16(fal, __builtin_bit_cast(bf16x8, wf[u][0][0]), acc0, 0, 0, 0);
                acc1 = __builtin_amdgcn_mfma_f32_16x16x32_bf16(fah, __builtin_bit_cast(bf16x8, wf[u][1][0]), acc1, 0, 0, 0);
                acc1 = __builtin_amdgcn_mfma_f32_16x16x32_bf16(fah, __builtin_bit_cast(bf16x8, wf[u][1][1]), acc1, 0, 0, 0);
                acc1 = __builtin_amdgcn_mfma_f32_16x16x32_bf16(fal, __builtin_bit_cast(bf16x8, wf[u][1][0]), acc1, 0, 0, 0);
            }
            asm volatile("s_waitcnt vmcnt(2)" ::: "memory");
            __builtin_amdgcn_s_barrier();
            asm volatile("" ::: "memory");
        }
        { const float bb0 = p.b_router[i16], bb1 = p.b_router[16 + i16];
#pragma unroll
          for (int r = 0; r < 4; ++r) { lg[(4 * kq + r) * 33 + i16] = acc0[r] + bb0; lg[(4 * kq + r) * 33 + 16 + i16] = acc1[r] + bb1; } }
        LDS_WAIT(); asm volatile("" ::: "memory");
        int se[4]; float sv[4], gt[4]; int rk[4];
        if (lane < 16) {
            float v[32];
#pragma unroll
            for (int e = 0; e < 32; ++e) v[e] = lg[lane * 33 + e];
#pragma unroll
            for (int k = 0; k < 4; ++k) { float best = -3.0e38f; int bi = 0;
#pragma unroll
                for (int e = 0; e < 32; ++e) { const bool tk = v[e] > best; best = tk ? v[e] : best; bi = tk ? e : bi; }
                se[k] = bi; sv[k] = best;
#pragma unroll
                for (int e = 0; e < 32; ++e) v[e] = (e == bi) ? -3.0e38f : v[e]; }
            const float e1 = __expf(sv[1] - sv[0]), e2 = __expf(sv[2] - sv[0]), e3 = __expf(sv[3] - sv[0]);
            const float inv = 1.0f / (1.0f + e1 + e2 + e3);
            gt[0] = inv; gt[1] = e1 * inv; gt[2] = e2 * inv; gt[3] = e3 * inv;
#pragma unroll
            for (int k = 0; k < 4; ++k) rk[k] = __hip_atomic_fetch_add(&hist[se[k]], 1, __ATOMIC_RELAXED, __HIP_MEMORY_SCOPE_WORKGROUP);
        }
        __syncthreads();
        if (tid < 32) gbase[tid] = (int)__hip_atomic_fetch_add(ctl + CW_CNT + 64 * tid, (unsigned)hist[tid], __ATOMIC_RELAXED, __HIP_MEMORY_SCOPE_AGENT);
        __syncthreads();
        if (lane < 16) {
            const int tk = (tb + wave) * 16 + lane;
#pragma unroll
            for (int k = 0; k < 4; ++k) { const int pos = gbase[se[k]] + rk[k];
                stok[(size_t)se[k] * T + pos] = tk; sgate[(size_t)se[k] * T + pos] = gt[k]; toke[tk * 4 + k] = se[k]; tokp[tk * 4 + k] = pos; }
        }
        __syncthreads();
    }
}

__device__ __forceinline__ void moe_table(unsigned* ctl, LAS int* tstart, LAS int* lcnt) {
    __syncthreads();
    if (threadIdx.x < 32) lcnt[threadIdx.x] = (int)__hip_atomic_load(ctl + CW_CNT + 64 * threadIdx.x, __ATOMIC_RELAXED, __HIP_MEMORY_SCOPE_AGENT);
    __syncthreads();
    if (threadIdx.x == 0) { int a = 0; for (int e = 0; e < NE; ++e) { tstart[e] = a; a += (lcnt[e] + 255) >> 8; } tstart[NE] = a; }
    __syncthreads();
}

__device__ __forceinline__ void phase_combine(const Params& p, const LAS int* tstart, int gw, int NGW, int lane) {
    const unsigned char* y2 = p.ws + WS_Y2; const int* toke = (const int*)(p.ws + WS_TOKE); const int* tokp = (const int*)(p.ws + WS_TOKP);
    constexpr float DY = 1.0f / FP8_SY;
    typedef int i32x4v __attribute__((ext_vector_type(4)));
    i32x4v ne = (i32x4v){0, 0, 0, 0}, np = ne;
    if (gw < T) { ne = *(const i32x4v*)(toke + gw * 4); np = *(const i32x4v*)(tokp + gw * 4); }
    for (int m = gw; m < T; m += NGW) {
        const i32x4v ce = ne, cp = np;
        if (m + NGW < T) { ne = *(const i32x4v*)(toke + (m + NGW) * 4); np = *(const i32x4v*)(tokp + (m + NGW) * 4); }
        const unsigned char* yr[4];
#pragma unroll
        for (int k = 0; k < 4; ++k) yr[k] = y2 + ((size_t)tstart[ce[k]] * 256 + cp[k]) * D;
        float* op = p.out + (size_t)m * D; const bf16* xp = (const bf16*)(p.ws + WS_X1) + (size_t)m * D;
#pragma unroll
        for (int j = 0; j < 2; ++j) { const int c = (j * 64 + lane) * 16;
            v4u w[4];
#pragma unroll
            for (int k = 0; k < 4; ++k) w[k] = *(const v4u*)(yr[k] + c);
            f32x4 a[4];
            { const v4u xa = *(const v4u*)(xp + c), xb = *(const v4u*)(xp + c + 8); float fa[8], fb[8]; unpack8(xa, fa); unpack8(xb, fb);
              a[0] = (f32x4){fa[0], fa[1], fa[2], fa[3]}; a[1] = (f32x4){fa[4], fa[5], fa[6], fa[7]}; a[2] = (f32x4){fb[0], fb[1], fb[2], fb[3]}; a[3] = (f32x4){fb[4], fb[5], fb[6], fb[7]}; }
#pragma unroll
            for (int q = 0; q < 4; ++q) { float s0 = 0.f, s1 = 0.f, s2 = 0.f, s3 = 0.f;
#pragma unroll
                for (int k = 0; k < 4; ++k) { const int wd = (int)(q == 0 ? w[k].x : q == 1 ? w[k].y : q == 2 ? w[k].z : w[k].w);
                    const f32x2 lo = __builtin_amdgcn_cvt_pk_f32_fp8(wd, false), hi = __builtin_amdgcn_cvt_pk_f32_fp8(wd, true);
                    s0 += lo.x; s1 += lo.y; s2 += hi.x; s3 += hi.y; }
                a[q][0] += s0 * DY; a[q][1] += s1 * DY; a[q][2] += s2 * DY; a[q][3] += s3 * DY;
                *(f32x4*)(op + c + 4 * q) = a[q]; }
        }
    }
}

constexpr int N_PHASES = 10;
__global__ void __launch_bounds__(NTHREADS, 2) hymba_fwd(Params p) {
    extern __shared__ __attribute__((aligned(16))) unsigned char lds_raw[];
    LAS unsigned char* lds = (LAS unsigned char*)lds_raw;
    volatile LAS unsigned* MISC = (volatile LAS unsigned*)(lds + MISC_OFF);
    LAS int* tstart = (LAS int*)(lds + MISC_OFF + 256);
    LAS int* lcnt = (LAS int*)(lds + MISC_OFF + 512);
    const int tid = threadIdx.x, lane = tid & 63, wave = __builtin_amdgcn_readfirstlane(tid >> 6);
    const int G = gridDim.x;
    const int vcu = (G % 8 == 0) ? (blockIdx.x % 8) * (G / 8) + blockIdx.x / 8 : blockIdx.x;
    const int gw = vcu * NWAVES + wave, NGW = G * NWAVES;
    unsigned* ctl = (unsigned*)(p.ws + WS_CTL);
    if (tid < 64) MISC[tid] = 0u;
    __syncthreads();
    const int lo = p.ph_lo, hi = p.ph_hi;
    XcdBarrier bar; bar.bar = ctl + CW_BAR; bar.x = 0; bar.st = nullptr;
    if (hi - lo > 1) bar = xcd_barrier_post(ctl + CW_BAR, MISC + 8);
#ifndef PHMASK
#define PHMASK 0x3ff
#endif
#define IN(k) (((PHMASK >> (k)) & 1) && lo <= (k) && (k) < hi)
#define SEAM(k) do { if (IN(k) && IN((k) + 1)) xcd_barrier(bar); } while (0)

    if (IN(0)) { phase_prologue(p, lds, gw, NGW, wave, lane); }
    SEAM(0);
    int cid = (int)blockIdx.x;
    if (hi - lo > 1 && lo == 0) {
        if (tid == 0) {
            bool ok = (G % 8 == 0);
            for (unsigned j = 0; j < 16; ++j) { const unsigned cj = xb_ld(&bar.bar[XB_XCNT(j)]); ok = ok && (j < 8 ? cj == (unsigned)(G / 8) : cj == 0u); }
            MISC[12] = ok ? (MISC[10] * 8u + bar.x) : (unsigned)blockIdx.x;
        }
        __syncthreads();
        cid = (int)MISC[12];
    }
    if (IN(1)) {
        const int ncw = (G < 8 * NCV) ? G : 8 * NCV;
        if (cid < ncw) convert_experts(p, cid * NWAVES + wave, ncw * NWAVES, lane);
        LAS int* tk = (LAS int*)(lds + MISC_OFF + 768);
        unsigned* tick = ctl + CW_TICK + 64 * (cid & 7);
        __syncthreads();
        if (tid == 0) { tk[0] = (int)__hip_atomic_fetch_add(tick, 1u, __ATOMIC_RELAXED, __HIP_MEMORY_SCOPE_AGENT); tk[1] = (int)__hip_atomic_fetch_add(tick, 1u, __ATOMIC_RELAXED, __HIP_MEMORY_SCOPE_AGENT); }
        __syncthreads();
        pg8::SchedQueue S{(const char*)(p.ws + WS_HN), (const char*)(p.ws + WS_WIN), T / 256, NIN_PAD / 256, (T / 256) * (NIN_PAD / 256) / 8, cid & 7, tick, tk};
        EpiInProj E{(bf16*)(p.ws + WS_PROJ), (float*)(p.ws + WS_DT)};
        pg8::gemm_phase<EpiInProj, pg8::SchedQueue>(lds, S, E);
    }
    SEAM(1);
    if (IN(2)) { if (!(p.variant & 1)) phase_ssd_states(p, lds, G, lane, wave); if (!(p.variant & 2)) phase_attn(p, lds, G); }
    SEAM(2);
    if (IN(3)) { phase_ssd_scan(p, G); }
    SEAM(3);
    if (IN(4)) { phase_ssd_out(p, lds, G, lane, wave); }
    SEAM(4);
    if (IN(5)) {
        EpiOutProj E{p.x, (bf16*)(p.ws + WS_X1), (float*)(p.ws + WS_SSQ)};
#if PROBE_CRIP5
        if (p.variant) { pg8::SchedDenseT<PROBE_CRIP5, OUTPROJ_F8 != 0> S{(const char*)(p.ws + WS_MIX), (const char*)(p.ws + WS_WOUT), T / 256, D / 256, G, cid};
            pg8::gemm_phase<EpiOutProj, pg8::SchedDenseT<PROBE_CRIP5, OUTPROJ_F8 != 0>>(lds, S, E); } else
#endif
        { pg8::SchedDenseT<0, OUTPROJ_F8 != 0> S{(const char*)(p.ws + WS_MIX), (const char*)(p.ws + WS_WOUT), T / 256, D / 256, G, cid};
          pg8::gemm_phase<EpiOutProj, pg8::SchedDenseT<0, OUTPROJ_F8 != 0>>(lds, S, E); }
    }
    SEAM(5);
    if (IN(6)) { phase_router(p, lds, ctl, G, wave, lane); }
    SEAM(6);
    if (IN(7)) {
        moe_table(ctl, tstart, lcnt);
        EpiGateUp E{p.ws + WS_HB, p.b_gate, p.b_up};
#if PROBE_CRIP7
        if (p.variant) { pg8::SchedMoE<true, PROBE_CRIP7> S{(const char*)(p.ws + WS_HF), (const char*)(p.ws + WS_WGU), (const int*)(p.ws + WS_STOK), tstart, lcnt, (2 * FF) / 256, 2 * FF, G, cid};
            pg8::gemm_phase<EpiGateUp, pg8::SchedMoE<true, PROBE_CRIP7>>(lds, S, E); } else
#endif
        { pg8::SchedMoE<true> S{(const char*)(p.ws + WS_HF), (const char*)(p.ws + WS_WGU), (const int*)(p.ws + WS_STOK), tstart, lcnt, (2 * FF) / 256, 2 * FF, G, cid};
          pg8::gemm_phase<EpiGateUp, pg8::SchedMoE<true>>(lds, S, E); }
    }
    SEAM(7);
    if (IN(8)) {
        moe_table(ctl, tstart, lcnt);
        EpiDown E{p.ws + WS_Y2, p.b_down, (const float*)(p.ws + WS_SGATE), tstart};
#if PROBE_CRIP
        if (p.variant) { pg8::SchedMoE<false, PROBE_CRIP> S{(const char*)(p.ws + WS_HB), (const char*)(p.ws + WS_WD), (const int*)(p.ws + WS_STOK), tstart, lcnt, D / 256, D, G, cid};
            pg8::gemm_phase<EpiDown, pg8::SchedMoE<false, PROBE_CRIP>>(lds, S, E); } else
#endif
        { pg8::SchedMoE<false> S{(const char*)(p.ws + WS_HB), (const char*)(p.ws + WS_WD), (const int*)(p.ws + WS_STOK), tstart, lcnt, D / 256, D, G, cid};
          pg8::gemm_phase<EpiDown, pg8::SchedMoE<false>>(lds, S, E); }
    }
    SEAM(8);
    if (IN(9)) { moe_table(ctl, tstart, lcnt); phase_combine(p, tstart, gw, NGW, lane); }
#undef IN
#undef SEAM
}

extern "C" void kernel_launch(void* const* d_in, const int* in_sizes, int n_in, void* d_out, int out_size, void* d_ws, size_t ws_size, hipStream_t stream) {
    static int grid = 0;
    if (grid == 0) {
        if (n_in != 23 || out_size != T * D || ws_size < WS_END) { fprintf(stderr, "kernel_launch: unexpected sizes n_in %d out %d ws %zu\n", n_in, out_size, ws_size); grid = -1; return; }
        int dev = 0, cus = 0;
        if (hipGetDevice(&dev) != hipSuccess || hipDeviceGetAttribute(&cus, hipDeviceAttributeMultiprocessorCount, dev) != hipSuccess) { grid = -1; return; }
        if (hipFuncSetAttribute((const void*)hymba_fwd, hipFuncAttributeMaxDynamicSharedMemorySize, LDS_BYTES) != hipSuccess) { fprintf(stderr, "kernel_launch: hipFuncSetAttribute failed\n"); grid = -1; return; }
        int per_cu = 0;
        if (hipOccupancyMaxActiveBlocksPerMultiprocessor(&per_cu, (const void*)hymba_fwd, NTHREADS, LDS_BYTES) != hipSuccess || per_cu < 1) fprintf(stderr, "kernel_launch: occupancy query says %d\n", per_cu);
        (void)hipGetLastError();
        grid = cus;
    }
    if (grid < 0) return;
    (void)hipMemsetAsync((char*)d_ws + WS_CTL, 0, CTL_BYTES, stream);
    Params p{};
    const float** pp = (const float**)&p;
    for (int i = 0; i < 23; ++i) pp[i] = (const float*)d_in[i];
    p.out = (float*)d_out; p.ws = (unsigned char*)d_ws;
#if MK_MULTI || (PROBE_REPEAT >= 0) || PROBE_CRIP || PROBE_P2 || PROBE_P6 || PROBE_CRIP7 || PROBE_CRIP5
    for (int ph = 0; ph < N_PHASES; ++ph) { p.ph_lo = ph; p.ph_hi = ph + 1;
        if (PROBE_P2 && ph == 2) { p.variant = PROBE_P2; hipLaunchKernelGGL(hymba_fwd, dim3(grid), dim3(NTHREADS), LDS_BYTES, stream, p); p.variant = 0; }
        if (PROBE_P6 && ph == 6) { hipLaunchKernelGGL(hymba_fwd, dim3(grid), dim3(NTHREADS), LDS_BYTES, stream, p); (void)hipMemsetAsync((char*)d_ws + WS_CTL + CW_CNT * 4, 0, 64 * 4 * NE, stream); }
        if (PROBE_CRIP5 && ph == 5) { p.variant = 1; hipLaunchKernelGGL(hymba_fwd, dim3(grid), dim3(NTHREADS), LDS_BYTES, stream, p); p.variant = 0; }
        if (PROBE_CRIP7 && ph == 7) { p.variant = 1; hipLaunchKernelGGL(hymba_fwd, dim3(grid), dim3(NTHREADS), LDS_BYTES, stream, p); p.variant = 0; }
        if (PROBE_CRIP && ph == 8) { p.variant = 1; hipLaunchKernelGGL(hymba_fwd, dim3(grid), dim3(NTHREADS), LDS_BYTES, stream, p); p.variant = 0; }
        for (int r = 0; r < (ph == PROBE_REPEAT ? 2 : 1); ++r) hipLaunchKernelGGL(hymba_fwd, dim3(grid), dim3(NTHREADS), LDS_BYTES, stream, p); }
#else
    p.ph_lo = 0; p.ph_hi = N_PHASES; hipLaunchKernelGGL(hymba_fwd, dim3(grid), dim3(NTHREADS), LDS_BYTES, stream, p);
#endif
}
```
